# Optimizing an MI355X kernel written in HIP

```python
import jax
import jax.numpy as jnp
from jax import lax
import numpy as np

D_MODEL = 1024
BATCH = 8
SEQ = 2048
DEPTH = 2

DN_ALPHA = (2.0 * DEPTH) ** 0.25
DN_BETA = (8.0 * DEPTH) ** -0.25
LN_EPS = 1e-5

RWKV_WIDTH = D_MODEL // 2
RWKV_HEAD = 64
RWKV_HEADS = RWKV_WIDTH // RWKV_HEAD
RWKV_W_RANK = 64
RWKV_A_RANK = 64
RWKV_G_RANK = 128
RWKV_GN_EPS = 1e-5 * RWKV_HEAD
RWKV_COLS = 3 * RWKV_WIDTH + RWKV_W_RANK + RWKV_A_RANK + RWKV_G_RANK

MLSTM_WIDTH = D_MODEL // 2
MLSTM_HEAD = 128
MLSTM_HEADS = MLSTM_WIDTH // MLSTM_HEAD
MLSTM_CONV = 4
MLSTM_CHUNK = 64
MLSTM_COLS = 4 * MLSTM_WIDTH + 2 * MLSTM_HEADS

FOX_HEAD = 64
FOX_HEADS = D_MODEL // FOX_HEAD
FOX_WIDTH = FOX_HEADS * FOX_HEAD
FOX_QBLOCK = 128
FOX_COLS = 4 * FOX_WIDTH + FOX_HEADS

PEER_HEADS = 8
PEER_NKEYS = 128
PEER_EXPERTS = PEER_NKEYS * PEER_NKEYS
PEER_TOPK = 16
PEER_DKEY = 256
PEER_DHALF = PEER_DKEY // 2
PEER_TOKBLOCK = 128

kernel_name = 'hybrid_rwkv7_mlstm_fox_peer'


def split_cols(p, sizes):
    out, start = [], 0
    for s in sizes:
        out.append(p[..., start:start + s])
        start += s
    return out


def layer_norm(x, g, b):
    xf = x.astype(jnp.float32)
    mu = jnp.mean(xf, -1, keepdims=True)
    var = jnp.mean(jnp.square(xf - mu), -1, keepdims=True)
    return ((xf - mu) * lax.rsqrt(var + LN_EPS) * g + b).astype(x.dtype)


def head_norm(y, g, b, eps):
    yf = y.astype(jnp.float32)
    mu = jnp.mean(yf, -1, keepdims=True)
    var = jnp.mean(jnp.square(yf - mu), -1, keepdims=True)
    return ((yf - mu) * lax.rsqrt(var + eps) * g + b).astype(y.dtype)


def rms_norm(y, g):
    yf = y.astype(jnp.float32)
    return (yf * lax.rsqrt(jnp.mean(yf * yf, -1, keepdims=True) + 1e-6) * g).astype(y.dtype)


def token_shift(z):
    return jnp.pad(z, ((0, 0), (1, 0), (0, 0)))[:, :-1]


def causal_conv(z, w, b):
    c = z.shape[-1]
    out = lax.conv_general_dilated(z, w[:, None, :].astype(z.dtype), window_strides=(1,),
                                   padding=((w.shape[0] - 1, 0),),
                                   dimension_numbers=('NWC', 'WIO', 'NWC'),
                                   feature_group_count=c)
    return out + b


def rwkv7_mix(p, mu, w0, w_up, a0, a_up, g_up, k_k, k_a, r_k, ln_g, ln_b):
    B, S, _ = p.shape
    H, N = RWKV_HEADS, RWKV_HEAD
    f32 = jnp.float32
    p = p + (token_shift(p) - p) * mu
    r, k, v, xw, xa, xg = split_cols(p, (RWKV_WIDTH, RWKV_WIDTH, RWKV_WIDTH,
                                         RWKV_W_RANK, RWKV_A_RANK, RWKV_G_RANK))
    log_w = -jnp.exp(-jax.nn.softplus(-(w0 + jnp.tanh(xw) @ w_up).astype(f32)) - 0.5)
    a = jax.nn.sigmoid((a0 + xa @ a_up).astype(f32))
    g = jax.nn.sigmoid(xg) @ g_up
    heads = lambda t: t.reshape(B, S, H, N)
    kk = heads(k * k_k).astype(f32)
    kk = kk / jnp.maximum(jnp.sqrt(jnp.sum(kk * kk, -1, keepdims=True)), 1e-12)
    k = k.astype(f32) * (1.0 + (a - 1.0) * k_a)
    r_h = heads(r).astype(f32)
    k_h = heads(k)
    v_h = heads(v).astype(f32)
    a_h = heads(a)
    w_h = jnp.exp(heads(log_w))

    def step(state, inp):
        r_t, w_t, k_t, v_t, kk_t, a_t = inp
        s_kk = jnp.einsum('bhvk,bhk->bhv', state, kk_t)
        state = (state * w_t[:, :, None, :]
                 - s_kk[..., None] * (kk_t * a_t)[:, :, None, :]
                 + v_t[..., None] * k_t[:, :, None, :])
        return state, jnp.einsum('bhvk,bhk->bhv', state, r_t)

    seq_first = lambda t: jnp.moveaxis(t, 1, 0)
    state0 = jnp.zeros((B, H, N, N), f32)
    _, y = lax.scan(step, state0, (seq_first(r_h), seq_first(w_h), seq_first(k_h),
                                   seq_first(v_h), seq_first(kk), seq_first(a_h)))
    y = jnp.moveaxis(y, 0, 1)
    y = head_norm(y, ln_g, ln_b, RWKV_GN_EPS)
    y = y + jnp.sum(r_h * k_h * r_k, -1, keepdims=True) * v_h
    return (y.reshape(B, S, RWKV_WIDTH) * g).astype(p.dtype)


def mlstm_chunkwise(q, k, v, ig, lf):
    B, S, H, D = q.shape
    L = MLSTM_CHUNK
    NC = S // L

    def to_chunks(t):
        t = t.reshape((B, NC, L, H) + t.shape[3:])
        return jnp.moveaxis(t, (1, 3), (0, 2))

    causal = jnp.tril(jnp.ones((L, L), dtype=bool))

    def body(carry, inp):
        C, n, m = carry
        qc, kc, vc, igc, lfc = inp
        b = jnp.cumsum(lfc, axis=-1)
        dmat = jnp.where(causal, b[..., :, None] - b[..., None, :] + igc[..., None, :], -jnp.inf)
        inter = b + m[..., None]
        m_t = jnp.maximum(inter, jnp.max(dmat, -1))
        weights = jnp.exp(dmat - m_t[..., None])
        sc = jnp.einsum('bhtd,bhsd->bhts', qc, kc) * weights
        carry_in = jnp.exp(inter - m_t)
        num = (jnp.einsum('bhts,bhsd->bhtd', sc, vc)
               + carry_in[..., None] * jnp.einsum('bhtk,bhkv->bhtv', qc, C))
        den = jnp.sum(sc, -1) + carry_in * jnp.einsum('bhtk,bhk->bht', qc, n)
        h = num / jnp.maximum(jnp.abs(den), jnp.exp(-m_t))[..., None]
        b_last = b[..., -1]
        gs = b_last[..., None] - b + igc
        m_new = jnp.maximum(b_last + m, jnp.max(gs, -1))
        ws = jnp.exp(gs - m_new[..., None])
        keep = jnp.exp(b_last + m - m_new)
        C = keep[..., None, None] * C + jnp.einsum('bhs,bhsk,bhsv->bhkv', ws, kc, vc)
        n = keep[..., None] * n + jnp.einsum('bhs,bhsk->bhk', ws, kc)
        return (C, n, m_new), h

    f32 = jnp.float32
    init = (jnp.zeros((B, H, D, D), f32), jnp.zeros((B, H, D), f32), jnp.zeros((B, H), f32))
    _, h = lax.scan(body, init, (to_chunks(q), to_chunks(k), to_chunks(v),
                                 to_chunks(ig), to_chunks(lf)))
    return jnp.moveaxis(h, (0, 2), (1, 3)).reshape(B, S, H, D)


def mlstm_mix(p, conv_w, conv_b, ig_b, fg_b, hn_g, hn_b):
    B, S, _ = p.shape
    H, N = MLSTM_HEADS, MLSTM_HEAD
    f32 = jnp.float32
    q, k, v, o, ig, fg = split_cols(p, (MLSTM_WIDTH, MLSTM_WIDTH, MLSTM_WIDTH, MLSTM_WIDTH, H, H))
    qk = jax.nn.silu(causal_conv(jnp.concatenate([q, k], -1), conv_w, conv_b))
    q, k = qk[..., :MLSTM_WIDTH], qk[..., MLSTM_WIDTH:]
    heads = lambda t: t.reshape(B, S, H, N).astype(f32)
    q = heads(q) * (N ** -0.5)
    ig = (ig + ig_b).astype(f32)
    lf = jax.nn.log_sigmoid((fg + fg_b).astype(f32))
    h = mlstm_chunkwise(q, heads(k), heads(v), ig, lf)
    h = head_norm(h, hn_g, hn_b, LN_EPS).reshape(B, S, MLSTM_WIDTH).astype(p.dtype)
    return jax.nn.sigmoid(o) * h


def even_mixer(x, w_in, mu, w0, w_up, a0, a_up, g_up, k_k, k_a, r_k, rln_g, rln_b,
               conv_w, conv_b, ig_b, fg_b, hn_g, hn_b, w_out):
    p = x @ w_in
    y_a = rwkv7_mix(p[..., :RWKV_COLS], mu, w0, w_up, a0, a_up, g_up, k_k, k_a, r_k, rln_g, rln_b)
    y_b = mlstm_mix(p[..., RWKV_COLS:], conv_w, conv_b, ig_b, fg_b, hn_g, hn_b)
    return jnp.concatenate([y_a, y_b], -1) @ w_out


def fox_attention(q, k, v, logf):
    B, S, H, D = q.shape
    NB = S // FOX_QBLOCK
    c = jnp.cumsum(logf, axis=1)
    c_key = jnp.transpose(c, (0, 2, 1))[:, :, None, :]
    q_blocks = jnp.moveaxis(q.reshape(B, NB, FOX_QBLOCK, H, D), 1, 0)
    c_blocks = jnp.moveaxis(c.reshape(B, NB, FOX_QBLOCK, H), 1, 0)
    key_pos = jnp.arange(S)
    scale = D ** -0.5

    def one_block(args):
        qb, cb, blk = args
        q_pos = blk * FOX_QBLOCK + jnp.arange(FOX_QBLOCK)
        logits = jnp.einsum('bqhd,bkhd->bhqk', qb, k).astype(jnp.float32) * scale
        logits = logits + jnp.transpose(cb, (0, 2, 1))[..., None] - c_key
        logits = jnp.where(key_pos[None, :] <= q_pos[:, None], logits, -jnp.inf)
        probs = jax.nn.softmax(logits, axis=-1).astype(v.dtype)
        return jnp.einsum('bhqk,bkhd->bqhd', probs, v)

    out = lax.map(one_block, (q_blocks, c_blocks, jnp.arange(NB)))
    return jnp.moveaxis(out, 0, 1).reshape(B, S, H, D)


def odd_mixer(x, w_in, qn_g, kn_g, f_b, w_out):
    B, S, _ = x.shape
    p = x @ w_in
    q, k, v, og, fl = split_cols(p, (FOX_WIDTH, FOX_WIDTH, FOX_WIDTH, FOX_WIDTH, FOX_HEADS))
    heads = lambda t: t.reshape(B, S, FOX_HEADS, FOX_HEAD)
    q = rms_norm(heads(q), qn_g)
    k = rms_norm(heads(k), kn_g)
    logf = jax.nn.log_sigmoid((fl + f_b).astype(jnp.float32))
    o = fox_attention(q, k, heads(v), logf).reshape(B, S, FOX_WIDTH)
    return (jax.nn.sigmoid(og) * o) @ w_out


def peer_ffn(x, w_q, sub_k1, sub_k2, u_tab, v_tab):
    B, S, Dm = x.shape
    K = PEER_TOPK
    xt = x.reshape((B * S) // PEER_TOKBLOCK, PEER_TOKBLOCK, Dm)

    def block(xb):
        T = xb.shape[0]
        q = (xb @ w_q).reshape(T, PEER_HEADS, 2, PEER_DHALF)
        s1 = jnp.einsum('thd,hnd->thn', q[:, :, 0], sub_k1)
        s2 = jnp.einsum('thd,hnd->thn', q[:, :, 1], sub_k2)
        v1, i1 = lax.top_k(s1, K)
        v2, i2 = lax.top_k(s2, K)
        cand = (v1[..., :, None] + v2[..., None, :]).reshape(T, PEER_HEADS, K * K)
        sc, ci = lax.top_k(cand, K)
        e1 = jnp.take_along_axis(i1, ci // K, axis=-1)
        e2 = jnp.take_along_axis(i2, ci % K, axis=-1)
        eid = e1 * PEER_NKEYS + e2
        gate = jax.nn.softmax(sc.astype(jnp.float32), axis=-1).astype(xb.dtype)
        act = jax.nn.gelu(jnp.einsum('td,thkd->thk', xb, u_tab[eid]), approximate=False)
        return jnp.einsum('thk,thkd->td', gate * act, v_tab[eid])

    return lax.map(block, xt).reshape(B, S, Dm)


def setup_inputs(seed: int = 0) -> dict:
    key = jax.random.key(seed)
    keys = iter(jax.random.split(key, 128))
    nk = lambda: next(keys)
    D = D_MODEL
    s_in = D ** -0.5
    nrm = lambda shape, scale: jax.random.normal(nk(), shape, jnp.float32) * scale
    uni = lambda shape, lo, hi: jax.random.uniform(nk(), shape, jnp.float32, minval=lo, maxval=hi)
    gain = lambda shape: 1.0 + 0.1 * jax.random.normal(nk(), shape, jnp.float32)
    bias = lambda shape: 0.01 * jax.random.normal(nk(), shape, jnp.float32)

    def peer_params():
        return (nrm((D, PEER_HEADS * PEER_DKEY), s_in),
                nrm((PEER_HEADS, PEER_NKEYS, PEER_DHALF), PEER_DHALF ** -0.5),
                nrm((PEER_HEADS, PEER_NKEYS, PEER_DHALF), PEER_DHALF ** -0.5),
                nrm((PEER_EXPERTS, D), s_in),
                nrm((PEER_EXPERTS, D), DN_BETA))

    x = jax.random.normal(nk(), (BATCH, SEQ, D), jnp.float32)
    l0_w_in = jnp.concatenate([
        nrm((D, RWKV_WIDTH), s_in), nrm((D, RWKV_WIDTH), s_in), nrm((D, RWKV_WIDTH), s_in * DN_BETA),
        nrm((D, RWKV_W_RANK), s_in), nrm((D, RWKV_A_RANK), s_in), nrm((D, RWKV_G_RANK), s_in),
        nrm((D, MLSTM_WIDTH), s_in), nrm((D, MLSTM_WIDTH), s_in), nrm((D, MLSTM_WIDTH), s_in * DN_BETA),
        nrm((D, MLSTM_WIDTH), s_in), nrm((D, MLSTM_HEADS), s_in), nrm((D, MLSTM_HEADS), s_in)], axis=1)
    l0_rwkv_mu = uni((RWKV_COLS,), 0.0, 1.0)
    l0_rwkv_w0 = uni((RWKV_WIDTH,), -6.0, 1.0)
    l0_rwkv_w_up = nrm((RWKV_W_RANK, RWKV_WIDTH), 0.1)
    l0_rwkv_a0 = nrm((RWKV_WIDTH,), 0.1)
    l0_rwkv_a_up = nrm((RWKV_A_RANK, RWKV_WIDTH), 0.1)
    l0_rwkv_g_up = nrm((RWKV_G_RANK, RWKV_WIDTH), RWKV_G_RANK ** -0.5)
    l0_rwkv_k_k = 0.85 + 0.05 * jax.random.normal(nk(), (RWKV_WIDTH,), jnp.float32)
    l0_rwkv_k_a = gain((RWKV_WIDTH,))
    l0_rwkv_r_k = nrm((RWKV_HEADS, RWKV_HEAD), 0.1)
    l0_rwkv_ln_g = gain((RWKV_HEADS, RWKV_HEAD))
    l0_rwkv_ln_b = bias((RWKV_HEADS, RWKV_HEAD))
    l0_mlstm_conv_w = nrm((MLSTM_CONV, 2 * MLSTM_WIDTH), MLSTM_CONV ** -0.5)
    l0_mlstm_conv_b = bias((2 * MLSTM_WIDTH,))
    l0_mlstm_ig_b = nrm((MLSTM_HEADS,), 0.1)
    l0_mlstm_fg_b = uni((MLSTM_HEADS,), 3.0, 6.0)
    l0_mlstm_hn_g = gain((MLSTM_HEADS, MLSTM_HEAD))
    l0_mlstm_hn_b = bias((MLSTM_HEADS, MLSTM_HEAD))
    l0_w_out = nrm((RWKV_WIDTH + MLSTM_WIDTH, D), (RWKV_WIDTH + MLSTM_WIDTH) ** -0.5 * DN_BETA)
    l0_ln1_g, l0_ln1_b = gain((D,)), bias((D,))
    l0_peer_wq, l0_peer_k1, l0_peer_k2, l0_peer_u, l0_peer_v = peer_params()
    l0_ln2_g, l0_ln2_b = gain((D,)), bias((D,))

    l1_w_in = jnp.concatenate([
        nrm((D, FOX_WIDTH), s_in), nrm((D, FOX_WIDTH), s_in), nrm((D, FOX_WIDTH), s_in * DN_BETA),
        nrm((D, FOX_WIDTH), s_in), nrm((D, FOX_HEADS), s_in)], axis=1)
    l1_fox_qn_g = gain((FOX_HEADS, FOX_HEAD))
    l1_fox_kn_g = gain((FOX_HEADS, FOX_HEAD))
    l1_fox_f_b = uni((FOX_HEADS,), 1.0, 6.0)
    l1_w_out = nrm((FOX_WIDTH, D), FOX_WIDTH ** -0.5 * DN_BETA)
    l1_ln1_g, l1_ln1_b = gain((D,)), bias((D,))
    l1_peer_wq, l1_peer_k1, l1_peer_k2, l1_peer_u, l1_peer_v = peer_params()
    l1_ln2_g, l1_ln2_b = gain((D,)), bias((D,))

    return {
        'x': x,
        'l0_w_in': l0_w_in, 'l0_rwkv_mu': l0_rwkv_mu, 'l0_rwkv_w0': l0_rwkv_w0,
        'l0_rwkv_w_up': l0_rwkv_w_up, 'l0_rwkv_a0': l0_rwkv_a0, 'l0_rwkv_a_up': l0_rwkv_a_up,
        'l0_rwkv_g_up': l0_rwkv_g_up, 'l0_rwkv_k_k': l0_rwkv_k_k, 'l0_rwkv_k_a': l0_rwkv_k_a,
        'l0_rwkv_r_k': l0_rwkv_r_k, 'l0_rwkv_ln_g': l0_rwkv_ln_g, 'l0_rwkv_ln_b': l0_rwkv_ln_b,
        'l0_mlstm_conv_w': l0_mlstm_conv_w, 'l0_mlstm_conv_b': l0_mlstm_conv_b,
        'l0_mlstm_ig_b': l0_mlstm_ig_b, 'l0_mlstm_fg_b': l0_mlstm_fg_b,
        'l0_mlstm_hn_g': l0_mlstm_hn_g, 'l0_mlstm_hn_b': l0_mlstm_hn_b,
        'l0_w_out': l0_w_out, 'l0_ln1_g': l0_ln1_g, 'l0_ln1_b': l0_ln1_b,
        'l0_peer_wq': l0_peer_wq, 'l0_peer_k1': l0_peer_k1, 'l0_peer_k2': l0_peer_k2,
        'l0_peer_u': l0_peer_u, 'l0_peer_v': l0_peer_v, 'l0_ln2_g': l0_ln2_g, 'l0_ln2_b': l0_ln2_b,
        'l1_w_in': l1_w_in, 'l1_fox_qn_g': l1_fox_qn_g, 'l1_fox_kn_g': l1_fox_kn_g,
        'l1_fox_f_b': l1_fox_f_b, 'l1_w_out': l1_w_out, 'l1_ln1_g': l1_ln1_g, 'l1_ln1_b': l1_ln1_b,
        'l1_peer_wq': l1_peer_wq, 'l1_peer_k1': l1_peer_k1, 'l1_peer_k2': l1_peer_k2,
        'l1_peer_u': l1_peer_u, 'l1_peer_v': l1_peer_v, 'l1_ln2_g': l1_ln2_g, 'l1_ln2_b': l1_ln2_b,
    }


def reference(x, l0_w_in, l0_rwkv_mu, l0_rwkv_w0, l0_rwkv_w_up, l0_rwkv_a0, l0_rwkv_a_up,
              l0_rwkv_g_up, l0_rwkv_k_k, l0_rwkv_k_a, l0_rwkv_r_k, l0_rwkv_ln_g, l0_rwkv_ln_b,
              l0_mlstm_conv_w, l0_mlstm_conv_b, l0_mlstm_ig_b, l0_mlstm_fg_b,
              l0_mlstm_hn_g, l0_mlstm_hn_b, l0_w_out, l0_ln1_g, l0_ln1_b,
              l0_peer_wq, l0_peer_k1, l0_peer_k2, l0_peer_u, l0_peer_v, l0_ln2_g, l0_ln2_b,
              l1_w_in, l1_fox_qn_g, l1_fox_kn_g, l1_fox_f_b, l1_w_out, l1_ln1_g, l1_ln1_b,
              l1_peer_wq, l1_peer_k1, l1_peer_k2, l1_peer_u, l1_peer_v, l1_ln2_g, l1_ln2_b):
    mixer_params = (
        (l0_w_in, l0_rwkv_mu, l0_rwkv_w0, l0_rwkv_w_up, l0_rwkv_a0, l0_rwkv_a_up, l0_rwkv_g_up,
         l0_rwkv_k_k, l0_rwkv_k_a, l0_rwkv_r_k, l0_rwkv_ln_g, l0_rwkv_ln_b,
         l0_mlstm_conv_w, l0_mlstm_conv_b, l0_mlstm_ig_b, l0_mlstm_fg_b,
         l0_mlstm_hn_g, l0_mlstm_hn_b, l0_w_out),
        (l1_w_in, l1_fox_qn_g, l1_fox_kn_g, l1_fox_f_b, l1_w_out),
    )
    norm_params = ((l0_ln1_g, l0_ln1_b, l0_ln2_g, l0_ln2_b),
                   (l1_ln1_g, l1_ln1_b, l1_ln2_g, l1_ln2_b))
    peer_params = ((l0_peer_wq, l0_peer_k1, l0_peer_k2, l0_peer_u, l0_peer_v),
                   (l1_peer_wq, l1_peer_k1, l1_peer_k2, l1_peer_u, l1_peer_v))
    for layer in range(DEPTH):
        mixer = even_mixer if layer % 2 == 0 else odd_mixer
        ln1_g, ln1_b, ln2_g, ln2_b = norm_params[layer]
        x = layer_norm(DN_ALPHA * x + mixer(x, *mixer_params[layer]), ln1_g, ln1_b)
        x = layer_norm(DN_ALPHA * x + peer_ffn(x, *peer_params[layer]), ln2_g, ln2_b)
    return x
```

```cpp
#include <hip/hip_runtime.h>
#include <cstdio>
#include <cstdint>
#include <cmath>
namespace pg8 {
#define PG8_LAS __attribute__((address_space(3)))
typedef unsigned short bf16_t;
typedef short bf16x8 __attribute__((ext_vector_type(8)));
typedef float f32x4 __attribute__((ext_vector_type(4)));
typedef unsigned u32x4 __attribute__((ext_vector_type(4)));
constexpr int BM = 256, BK = 64, HALF = 128, HTB = HALF * BK * 2  , STAGE_BYTES = 8 * HTB, NXCD = 8, WGM = 8;

__host__ __device__ __forceinline__ int lds_byte(int r, int c) { const int st = (r >> 4) * 2 + (c >> 5), rr = r & 15, cc = c & 31, ob = rr * 64 + cc * 2; return st * 1024 + (ob ^ (((ob >> 9) & 1) << 5)); }
__host__ __device__ __forceinline__ void stage_rc(int b, int& R, int& C) { const int st = b / 1024, sb = b % 1024, swz = sb ^ (((sb >> 9) & 1) << 5); R = (st >> 1) * 16 + swz / 64; C = (st & 1) * 32 + (swz % 64) / 2; }
__host__ __device__ __forceinline__ int perm32(int rho) { const int n = rho >> 4, i = rho & 15; return 8 * (i >> 2) + 4 * n + (i & 3); }

struct Unit { int pm, pn; };
struct Gemm { const bf16_t* A; const bf16_t* Bt; int M, N, K; };

struct StaticOrder {
    int nM, nN, nwg, G, c;
    __host__ __device__ void init(int M, int N, int G_, int c_) { nM = M / BM; nN = N / BM; nwg = nM * nN; G = G_; c = c_; }
    __host__ __device__ bool next(int i, Unit& u) const {
        const long L = (long)i * G + c; if (L >= nwg) return false;
        int wgid = (int)L; { const int q = nwg / NXCD, r = nwg % NXCD, xcd = wgid % NXCD, off = wgid / NXCD; wgid = (xcd < r ? xcd * (q + 1) : r * (q + 1) + (xcd - r) * q) + off; }
        const int nig = WGM * nN, gid = wgid / nig, fm = gid * WGM, gsz = (nM - fm) < WGM ? (nM - fm) : WGM;
        u.pm = fm + ((wgid % nig) % gsz); u.pn = (wgid % nig) / gsz; return true;
    }
    __device__ __forceinline__ void a_ready(const Unit&) const {}
    __device__ __forceinline__ void done(const Unit&) const {}
};

__device__ __forceinline__ unsigned cvt_pk_bf16(float lo, float hi) { unsigned r; asm volatile("v_cvt_pk_bf16_f32 %0, %1, %2" : "=v"(r) : "v"(lo), "v"(hi)); return r; }
typedef float f32x2 __attribute__((ext_vector_type(2)));
__device__ __forceinline__ f32x2 gelu_pk(f32x2 v) {
    const f32x2 av = __builtin_elementwise_abs(v), d = av * 0.2316418882f + 1.0f;
    f32x2 t; t.x = __builtin_amdgcn_rcpf(d.x); t.y = __builtin_amdgcn_rcpf(d.y);
    f32x2 q = t * 0.5307027145f + (-0.7265760135f); q = q * t + 0.7107068705f; q = q * t + (-0.142248368f); q = q * t + 0.127414796f; q = q * t;
    const f32x2 s = (v * v) * (-0.72134752044f);
    f32x2 e; e.x = __builtin_amdgcn_exp2f(s.x); e.y = __builtin_amdgcn_exp2f(s.y);
    const f32x2 m = v * (q * e), r = v - m;
    f32x2 o; o.x = v.x < 0.f ? m.x : r.x; o.y = v.y < 0.f ? m.y : r.y; return o;
}

template <int ACT  > struct EpiBf16 {
    static constexpr bool PERM = true, AFTER_DRAIN = false; static_assert(ACT == 0 || ACT == 1, "EpiBf16: ACT is 0 (none) or 1 (gelu_pk)");
    bf16_t* O; int ldc; const float* bias; int split_cols; size_t split_stride; float scale0;
    __device__ __forceinline__ void operator()(const f32x4 (&acc)[2][2][4][2], const Unit& u, int wr, int wc, int fr, int fq) const {
        const int row0 = u.pm * BM + wr * 64 + fr; int colt = u.pn * BM; bf16_t* base = O;
        float sc = 1.f; if (split_cols) { const int t = colt / split_cols; base += (size_t)t * split_stride; colt -= t * split_cols; if (t == 0) sc = scale0; }
        const int col0 = colt + wc * 32 + 8 * fq, bcol0 = u.pn * BM + wc * 32 + 8 * fq;
        f32x4 bv[2][2];
#pragma unroll
        for (int bj = 0; bj < 2; ++bj)
#pragma unroll
            for (int n = 0; n < 2; ++n) bv[bj][n] = bias ? *(const f32x4*)(bias + bcol0 + bj * HALF + 4 * n) : (f32x4){0.f, 0.f, 0.f, 0.f};
#pragma unroll
        for (int ai = 0; ai < 2; ++ai)
#pragma unroll
            for (int m = 0; m < 4; ++m) { bf16_t* rowp = base + (size_t)(row0 + ai * HALF + m * 16) * ldc + col0;
#pragma unroll
                for (int bj = 0; bj < 2; ++bj) { f32x4 v0 = acc[ai][bj][m][0] + bv[bj][0], v1 = acc[ai][bj][m][1] + bv[bj][1];
                    if (ACT == 1) { f32x2 a = gelu_pk((f32x2){v0[0], v0[1]}), b = gelu_pk((f32x2){v0[2], v0[3]}), c = gelu_pk((f32x2){v1[0], v1[1]}), d = gelu_pk((f32x2){v1[2], v1[3]});
                        v0 = (f32x4){a.x, a.y, b.x, b.y}; v1 = (f32x4){c.x, c.y, d.x, d.y}; }
                    v0 = v0 * sc; v1 = v1 * sc; u32x4 w; w.x = cvt_pk_bf16(v0[0], v0[1]); w.y = cvt_pk_bf16(v0[2], v0[3]); w.z = cvt_pk_bf16(v1[0], v1[1]); w.w = cvt_pk_bf16(v1[2], v1[3]);
                    *(u32x4*)(rowp + bj * HALF) = w; } }
    }
};

struct PanelStats {
    unsigned* xbuf;
    unsigned* cnt;
    unsigned* tmo;
    int ntn; float eps;
    unsigned code;
    __device__ __forceinline__ bool run(const f32x4 (&v)[2][2][4][2], const Unit& u, int wr, int wc, int fr, int fq, PG8_LAS unsigned char* lds, int wid, int lane) const {
        typedef float f32x2v __attribute__((ext_vector_type(2)));
        PG8_LAS f32x2v* P = (PG8_LAS f32x2v*)lds;
        PG8_LAS f32x2v* S = (PG8_LAS f32x2v*)(lds + 8192);
        PG8_LAS unsigned* flag = (PG8_LAS unsigned*)(lds + 8192 + 2048);
#pragma unroll
        for (int ai = 0; ai < 2; ++ai)
#pragma unroll
            for (int m = 0; m < 4; ++m) {
                float s = 0.f;
#pragma unroll
                for (int bj = 0; bj < 2; ++bj)
#pragma unroll
                    for (int n = 0; n < 2; ++n) { const f32x4 x = v[ai][bj][m][n]; s += (x[0] + x[1]) + (x[2] + x[3]); }
                s += __shfl_xor(s, 16); s += __shfl_xor(s, 32);
                const float mw = s * (1.0f / 64.0f); float q = 0.f;
#pragma unroll
                for (int bj = 0; bj < 2; ++bj)
#pragma unroll
                    for (int n = 0; n < 2; ++n) { const f32x4 d = v[ai][bj][m][n] - mw; q += (d[0] * d[0] + d[1] * d[1]) + (d[2] * d[2] + d[3] * d[3]); }
                q += __shfl_xor(q, 16); q += __shfl_xor(q, 32);
                if (fq == 0) P[(ai * HALF + wr * 64 + m * 16 + fr) * 4 + wc] = (f32x2v){mw, q};
            }
        asm volatile("s_waitcnt lgkmcnt(0)" ::: "memory"); __builtin_amdgcn_s_barrier(); asm volatile("" ::: "memory");
#if defined(BROKEN_EXCHANGE_NO_WAIT)
#warning BROKEN CONTROL BUILD: the row-statistics exchange does not wait; results are wrong by design
        if (blockIdx.x >= 64) { const long long t0_ = clock64(); while (clock64() - t0_ < 60000) __builtin_amdgcn_s_sleep(8); }
#endif
        const int row = wid * 32 + (lane & 31);
        if (lane < 32) {
            const f32x2v a = P[row * 4 + 0], b = P[row * 4 + 1], c = P[row * 4 + 2], d = P[row * 4 + 3];
            const float mt = (a.x + b.x + c.x + d.x) * 0.25f;
            const float da = a.x - mt, db = b.x - mt, dc = c.x - mt, dd = d.x - mt;
            const float m2 = (a.y + b.y) + (c.y + d.y) + 64.0f * ((da * da + db * db) + (dc * dc + dd * dd));
            unsigned long long* slot = (unsigned long long*)xbuf + ((size_t)(u.pm * BM + row) * 4 + u.pn);
            __hip_atomic_store(slot, ((unsigned long long)__float_as_uint(m2) << 32) | __float_as_uint(mt), __ATOMIC_RELAXED, __HIP_MEMORY_SCOPE_AGENT);
        }
        asm volatile("s_waitcnt vmcnt(0)" ::: "memory");
        if (lane == 0) __hip_atomic_fetch_add(cnt + 64 * u.pm, 1u, __ATOMIC_RELAXED, __HIP_MEMORY_SCOPE_AGENT);
        if (wid == 0) {
            bool dead = false; const unsigned long long t0 = __builtin_amdgcn_s_memrealtime(); const unsigned want = 8u * (unsigned)ntn;
            for (;;) {
#if defined(BROKEN_EXCHANGE_NO_WAIT)
                break;
#endif
                if ((unsigned)__builtin_amdgcn_readfirstlane(__hip_atomic_load(cnt + 64 * u.pm, __ATOMIC_RELAXED, __HIP_MEMORY_SCOPE_AGENT)) >= want) break;
                if (__builtin_amdgcn_s_memrealtime() - t0 > 2000000ull) {
                    if (lane == 0) { unsigned expect = 0u; __hip_atomic_compare_exchange_strong(tmo + 1, &expect, code | (unsigned)(u.pm & 0xff), __ATOMIC_RELAXED, __ATOMIC_RELAXED, __HIP_MEMORY_SCOPE_AGENT);
                                     __hip_atomic_store(tmo, 1u, __ATOMIC_RELAXED, __HIP_MEMORY_SCOPE_AGENT); }
                    dead = true; break; }
                __builtin_amdgcn_s_sleep(2);
            }
            __builtin_amdgcn_fence(__ATOMIC_ACQUIRE, "agent");
            if (lane == 0) flag[0] = dead ? 1u : 0u;
        }
        asm volatile("s_waitcnt vmcnt(0) lgkmcnt(0)" ::: "memory"); __builtin_amdgcn_s_barrier(); asm volatile("" ::: "memory");
        const bool bad = flag[0] != 0u;
        if (lane < 32) {
            const unsigned long long* slot = (const unsigned long long*)xbuf + (size_t)(u.pm * BM + row) * 4; float mt[4], m2[4]; float ms = 0.f;
#pragma unroll
            for (int t = 0; t < 4; ++t) { if (t < ntn) { const unsigned long long w = __hip_atomic_load(slot + t, __ATOMIC_RELAXED, __HIP_MEMORY_SCOPE_AGENT); mt[t] = __uint_as_float((unsigned)w); m2[t] = __uint_as_float((unsigned)(w >> 32)); } else { mt[t] = 0.f; m2[t] = 0.f; } ms += mt[t]; }
            const float mean = ms / (float)ntn; float q = 0.f;
#pragma unroll
            for (int t = 0; t < 4; ++t) if (t < ntn) { const float dm = mt[t] - mean; q += m2[t] + 256.0f * dm * dm; }
            S[row] = (f32x2v){mean, 1.0f / sqrtf(q / (256.0f * (float)ntn) + eps)};
        }
        asm volatile("s_waitcnt lgkmcnt(0)" ::: "memory"); __builtin_amdgcn_s_barrier(); asm volatile("" ::: "memory");
        return bad;
    }
};
struct EpiLnRes {
    static constexpr bool PERM = false, AFTER_DRAIN = true;
    const float* base; float* out; int ldc; const float* bias; PanelStats st; unsigned poison;
    __device__ __forceinline__ void fused(f32x4 (&acc)[2][2][4][2], const Unit& u, int wr, int wc, int fr, int fq, PG8_LAS unsigned char* lds, int wid, int lane) const {
        typedef float f32x2v __attribute__((ext_vector_type(2)));
        const PG8_LAS f32x2v* S = (const PG8_LAS f32x2v*)(lds + 8192);
        const int col0 = u.pn * BM + wc * 32 + 4 * fq;
#pragma unroll
        for (int bj = 0; bj < 2; ++bj)
#pragma unroll
            for (int n = 0; n < 2; ++n) { const f32x4 bv = bias ? *(const f32x4*)(bias + col0 + bj * HALF + n * 16) : (f32x4){0.f, 0.f, 0.f, 0.f};
#pragma unroll
                for (int ai = 0; ai < 2; ++ai)
#pragma unroll
                    for (int m = 0; m < 4; ++m) acc[ai][bj][m][n] += bv; }
        f32x4 pre[4][2][2];
#pragma unroll
        for (int m = 0; m < 4; ++m) { const size_t off = (size_t)(u.pm * BM + wr * 64 + m * 16 + fr) * ldc + col0;
#pragma unroll
            for (int bj = 0; bj < 2; ++bj)
#pragma unroll
                for (int n = 0; n < 2; ++n) pre[m][bj][n] = *(const f32x4*)(base + off + bj * HALF + n * 16); }
        const bool bad = st.run(acc, u, wr, wc, fr, fq, lds, wid, lane) || poison != 0u;
        const float qnan = __builtin_nanf("");
#pragma unroll
        for (int ai = 0; ai < 2; ++ai)
#pragma unroll
            for (int m = 0; m < 4; ++m) { const int r = ai * HALF + wr * 64 + m * 16 + fr; const f32x2v sr = S[r]; const size_t off = (size_t)(u.pm * BM + r) * ldc + col0;
#pragma unroll
                for (int bj = 0; bj < 2; ++bj)
#pragma unroll
                    for (int n = 0; n < 2; ++n) { const f32x4 bs = ai == 0 ? pre[m][bj][n] : *(const f32x4*)(base + off + bj * HALF + n * 16); f32x4 o = bs + (acc[ai][bj][m][n] - sr.x) * sr.y;
                        if (bad) o = (f32x4){qnan, qnan, qnan, qnan}; *(f32x4*)(out + off + bj * HALF + n * 16) = o; }
                if (m & 1) asm volatile("" ::: "memory"); }
    }
};
struct EpiLnResLn {
    static constexpr bool PERM = false, AFTER_DRAIN = true;
    const float* base; float* out; bf16_t* xn; int ldc; const float* bias; PanelStats st1, st2; unsigned poison;
    __device__ __forceinline__ void fused(f32x4 (&acc)[2][2][4][2], const Unit& u, int wr, int wc, int fr, int fq, PG8_LAS unsigned char* lds, int wid, int lane) const {
        typedef float f32x2v __attribute__((ext_vector_type(2))); typedef unsigned u32x2v __attribute__((ext_vector_type(2)));
        const PG8_LAS f32x2v* S = (const PG8_LAS f32x2v*)(lds + 8192);
        const int col0 = u.pn * BM + wc * 32 + 4 * fq;
#pragma unroll
        for (int bj = 0; bj < 2; ++bj)
#pragma unroll
            for (int n = 0; n < 2; ++n) { const f32x4 bv = bias ? *(const f32x4*)(bias + col0 + bj * HALF + n * 16) : (f32x4){0.f, 0.f, 0.f, 0.f};
#pragma unroll
                for (int ai = 0; ai < 2; ++ai)
#pragma unroll
                    for (int m = 0; m < 4; ++m) acc[ai][bj][m][n] += bv; }
        bool bad = st1.run(acc, u, wr, wc, fr, fq, lds, wid, lane) || poison != 0u;
        const float qnan = __builtin_nanf("");
#pragma unroll
        for (int ai = 0; ai < 2; ++ai)
#pragma unroll
            for (int m = 0; m < 4; ++m) { const int r = ai * HALF + wr * 64 + m * 16 + fr; const f32x2v sr = S[r]; const size_t off = (size_t)(u.pm * BM + r) * ldc + col0;
#pragma unroll
                for (int bj = 0; bj < 2; ++bj)
#pragma unroll
                    for (int n = 0; n < 2; ++n) { const f32x4 bs = *(const f32x4*)(base + off + bj * HALF + n * 16); acc[ai][bj][m][n] = bs + (acc[ai][bj][m][n] - sr.x) * sr.y; }
                asm volatile("" : "+v"(acc[ai][0][m][0]), "+v"(acc[ai][0][m][1]), "+v"(acc[ai][1][m][0]), "+v"(acc[ai][1][m][1]));
                if (m & 1) asm volatile("" ::: "memory"); }
        const bool bad1 = bad;
        bad = st2.run(acc, u, wr, wc, fr, fq, lds, wid, lane) || bad;
#pragma unroll
        for (int ai = 0; ai < 2; ++ai)
#pragma unroll
            for (int m = 0; m < 4; ++m) { const int r = ai * HALF + wr * 64 + m * 16 + fr; const f32x2v sr = S[r]; const size_t off = (size_t)(u.pm * BM + r) * ldc + col0;
#pragma unroll
                for (int bj = 0; bj < 2; ++bj)
#pragma unroll
                    for (int n = 0; n < 2; ++n) { const f32x4 x1 = acc[ai][bj][m][n]; *(f32x4*)(out + off + bj * HALF + n * 16) = bad1 ? (f32x4){qnan, qnan, qnan, qnan} : x1;
                        const f32x4 o = (x1 - sr.x) * sr.y; u32x2v w; w.x = cvt_pk_bf16(o[0], o[1]); w.y = cvt_pk_bf16(o[2], o[3]);
                        if (bad) { w.x = 0x7fc07fc0u; w.y = 0x7fc07fc0u; } *(u32x2v*)(xn + off + bj * HALF + n * 16) = w; }
                asm volatile("" ::: "memory"); }
    }
};

template <class Epi, class Sched, bool ALIGN_EPI = false, bool SP2 = false>
__device__ __forceinline__ void gemm_phase(PG8_LAS unsigned char* lds, const Gemm g, const Sched& S, const Epi& E) {
    const int tid = threadIdx.x, wid = __builtin_amdgcn_readfirstlane(tid >> 6), lane = tid & 63, wr = wid >> 2, wc = wid & 3, fr = lane & 15, fq = lane >> 4;
    const int K = g.K, nt = K / BK;
    unsigned voffA[2], voffB[2];
#pragma unroll
    for (int i = 0; i < 2; ++i) { int R, C; stage_rc(tid * 16 + i * 8192, R, C); const int Rb = Epi::PERM ? ((R & ~31) + perm32(R & 31)) : R;
        voffA[i] = (unsigned)(R * K + C) * 2u; voffB[i] = (unsigned)(Rb * K + C) * 2u; }
    const size_t kstep = (size_t)(BK * 2);
    const size_t hstep = (size_t)HALF * K * 2;
    const size_t tstep = 2 * hstep;
    const unsigned ldsw = (unsigned)wid * 1024u;
    const int aoff = lds_byte(wr * 64 + fr, fq * 8), boff = lds_byte(wc * 32 + fr, fq * 8);
#define PG8_SA(b, h) (((b) * 2 + (h)) * HTB)
#define PG8_SB(b, h) ((4 + (b) * 2 + (h)) * HTB)
#define PG8_STAGE(bufoff, gbase, voff) do { _Pragma("unroll") for (int _i = 0; _i < 2; ++_i) \
        __builtin_amdgcn_global_load_lds((const unsigned*)((const char*)(gbase) + (voff)[_i]), (PG8_LAS unsigned*)(lds + (bufoff) + ldsw + _i * 8192), 16, 0, 0); } while (0)
#define PG8_LDA(dst, b, h) do { _Pragma("unroll") for (int m = 0; m < 4; ++m) _Pragma("unroll") for (int k = 0; k < 2; ++k) dst[m][k] = *(const PG8_LAS bf16x8*)(lds + PG8_SA(b, h) + aoff + m * 2048 + k * 1024); } while (0)
#define PG8_LDB(dst, b, h) do { _Pragma("unroll") for (int n = 0; n < 2; ++n) _Pragma("unroll") for (int k = 0; k < 2; ++k) dst[n][k] = *(const PG8_LAS bf16x8*)(lds + PG8_SB(b, h) + boff + n * 2048 + k * 1024); } while (0)
#define PG8_MMA(ai, bj, At, Bt) do { __builtin_amdgcn_s_setprio(1); _Pragma("unroll") for (int m = 0; m < 4; ++m) _Pragma("unroll") for (int n = 0; n < 2; ++n) _Pragma("unroll") for (int k = 0; k < 2; ++k) \
        acc[ai][bj][m][n] = __builtin_amdgcn_mfma_f32_16x16x32_bf16(Bt[n][k], At[m][k], acc[ai][bj][m][n], 0, 0, 0); __builtin_amdgcn_s_setprio(0); } while (0)
#define PG8_WAIT_V(n) asm volatile("s_waitcnt vmcnt(" #n ")" ::: "memory")
#define PG8_WAIT_L(n) asm volatile("s_waitcnt lgkmcnt(" #n ")" ::: "memory")
#define PG8_BAR __builtin_amdgcn_s_barrier()
#define PG8_SCHED __builtin_amdgcn_sched_barrier(0)
    Unit cur, nxt; int ui = 0;
    if (!S.next(0, cur)) return;
    f32x4 acc[2][2][4][2];
#pragma unroll
    for (int a = 0; a < 2; ++a)
#pragma unroll
        for (int b = 0; b < 2; ++b)
#pragma unroll
            for (int m = 0; m < 4; ++m)
#pragma unroll
                for (int n = 0; n < 2; ++n) acc[a][b][m][n] = (f32x4){0.f, 0.f, 0.f, 0.f};
    bf16x8 At[4][2], B0[2][2], B1[2][2];
    const char* cA = (const char*)g.A + (size_t)cur.pm * tstep; const char* cB = (const char*)g.Bt + (size_t)cur.pn * tstep;
    S.a_ready(cur);
    if constexpr (SP2) {
        PG8_STAGE(PG8_SB(0, 0), cB, voffB); PG8_STAGE(PG8_SB(0, 1), cB + hstep, voffB); PG8_STAGE(PG8_SA(0, 0), cA, voffA); PG8_STAGE(PG8_SA(0, 1), cA + hstep, voffA);
        if (wr == 1) PG8_BAR;
        PG8_WAIT_V(2); PG8_BAR;
        PG8_STAGE(PG8_SB(1, 0), cB + kstep, voffB); PG8_STAGE(PG8_SA(1, 0), cA + kstep, voffA); PG8_STAGE(PG8_SB(1, 1), cB + hstep + kstep, voffB);
        PG8_WAIT_V(6); PG8_BAR;
    } else {
        PG8_STAGE(PG8_SB(0, 0), cB, voffB); PG8_STAGE(PG8_SA(0, 0), cA, voffA); PG8_STAGE(PG8_SB(0, 1), cB + hstep, voffB); PG8_STAGE(PG8_SA(0, 1), cA + hstep, voffA);
        if (wr == 1) PG8_BAR;
        PG8_WAIT_V(4); PG8_BAR;
        PG8_STAGE(PG8_SB(1, 0), cB + kstep, voffB); PG8_STAGE(PG8_SA(1, 0), cA + kstep, voffA); PG8_STAGE(PG8_SB(1, 1), cB + hstep + kstep, voffB);
        PG8_WAIT_V(6); PG8_BAR;
    }
    for (;;) {
        const bool has_next = S.next(ui + 1, nxt);
        const char* nA = has_next ? (const char*)g.A + (size_t)nxt.pm * tstep : cA; const char* nB = has_next ? (const char*)g.Bt + (size_t)nxt.pn * tstep : cB;
        for (int t = 0; t < nt; t += 2) {
            const bool last = (t == nt - 2);
            const char* a1 = cA + (size_t)(t + 1) * kstep;
            const char* a2 = last ? nA : cA + (size_t)(t + 2) * kstep; const char* b2 = last ? nB : cB + (size_t)(t + 2) * kstep;
            const char* a3 = a2 + kstep; const char* b3 = b2 + kstep;
            if (last && has_next) S.a_ready(nxt);
            if constexpr (SP2) {
            PG8_LDB(B0, 0, 0); PG8_LDB(B1, 0, 1); PG8_SCHED; PG8_LDA(At, 0, 0); PG8_STAGE(PG8_SA(1, 1), a1 + hstep, voffA);
            PG8_WAIT_V(8); PG8_WAIT_L(0); PG8_BAR; PG8_MMA(0, 0, At, B0); PG8_MMA(0, 1, At, B1); PG8_BAR; PG8_SCHED;
            PG8_LDA(At, 0, 1); PG8_STAGE(PG8_SB(0, 0), b2, voffB); PG8_STAGE(PG8_SB(0, 1), b2 + hstep, voffB); PG8_STAGE(PG8_SA(0, 0), a2, voffA);
            PG8_WAIT_V(8); PG8_WAIT_L(0); PG8_BAR; PG8_MMA(1, 0, At, B0); PG8_MMA(1, 1, At, B1); PG8_BAR; PG8_SCHED;
            PG8_LDB(B0, 1, 0); PG8_LDB(B1, 1, 1); PG8_SCHED; PG8_LDA(At, 1, 0); PG8_STAGE(PG8_SA(0, 1), a2 + hstep, voffA);
            PG8_WAIT_V(8); PG8_WAIT_L(0); PG8_BAR; PG8_MMA(0, 0, At, B0); PG8_MMA(0, 1, At, B1); PG8_BAR; PG8_SCHED;
            PG8_LDA(At, 1, 1); PG8_STAGE(PG8_SB(1, 0), b3, voffB); PG8_STAGE(PG8_SB(1, 1), b3 + hstep, voffB); PG8_STAGE(PG8_SA(1, 0), a3, voffA);
            PG8_WAIT_V(8); PG8_WAIT_L(0); PG8_BAR; PG8_MMA(1, 0, At, B0); PG8_MMA(1, 1, At, B1); PG8_BAR; PG8_SCHED;
            } else {
            PG8_LDB(B0, 0, 0); PG8_SCHED; PG8_LDA(At, 0, 0); PG8_STAGE(PG8_SA(1, 1), a1 + hstep, voffA);
            PG8_WAIT_L(8); PG8_BAR; PG8_WAIT_L(0); PG8_MMA(0, 0, At, B0); PG8_BAR; PG8_SCHED;
            PG8_LDB(B1, 0, 1); PG8_STAGE(PG8_SB(0, 0), b2, voffB);
            PG8_BAR; PG8_WAIT_L(0); PG8_MMA(0, 1, At, B1); PG8_BAR;
            PG8_LDA(At, 0, 1); PG8_STAGE(PG8_SA(0, 0), a2, voffA);
            PG8_BAR; PG8_WAIT_L(0); PG8_MMA(1, 0, At, B0); PG8_BAR; PG8_SCHED;
            PG8_STAGE(PG8_SB(0, 1), b2 + hstep, voffB);
            PG8_WAIT_V(6); PG8_BAR; PG8_MMA(1, 1, At, B1); PG8_BAR;
            PG8_LDB(B0, 1, 0); PG8_SCHED; PG8_LDA(At, 1, 0); PG8_STAGE(PG8_SA(0, 1), a2 + hstep, voffA);
            PG8_WAIT_L(8); PG8_BAR; PG8_WAIT_L(0); PG8_MMA(0, 0, At, B0); PG8_BAR; PG8_SCHED;
            PG8_LDB(B1, 1, 1); PG8_STAGE(PG8_SB(1, 0), b3, voffB);
            PG8_BAR; PG8_WAIT_L(0); PG8_MMA(0, 1, At, B1); PG8_BAR;
            PG8_LDA(At, 1, 1); PG8_STAGE(PG8_SA(1, 0), a3, voffA);
            PG8_BAR; PG8_WAIT_L(0); PG8_MMA(1, 0, At, B0); PG8_BAR; PG8_SCHED;
            PG8_STAGE(PG8_SB(1, 1), b3 + hstep, voffB);
            PG8_WAIT_V(6); PG8_BAR; PG8_MMA(1, 1, At, B1); PG8_BAR;
            }
        }
        if constexpr (ALIGN_EPI) { if (wr == 0) PG8_BAR; }
        if constexpr (!Epi::AFTER_DRAIN) { E(acc, cur, wr, wc, fr, fq); S.done(cur); }
        if (!has_next) break;
#pragma unroll
        for (int a = 0; a < 2; ++a)
#pragma unroll
            for (int b = 0; b < 2; ++b)
#pragma unroll
                for (int m = 0; m < 4; ++m)
#pragma unroll
                    for (int n = 0; n < 2; ++n) acc[a][b][m][n] = (f32x4){0.f, 0.f, 0.f, 0.f};
        cur = nxt; cA = nA; cB = nB; ++ui;
        if constexpr (ALIGN_EPI) { if (wr == 1) PG8_BAR; }
    }
    PG8_WAIT_V(0);
    if constexpr (!ALIGN_EPI) { if (wr == 0) PG8_BAR; }
    PG8_BAR;
    if constexpr (Epi::AFTER_DRAIN) { E.fused(acc, cur, wr, wc, fr, fq, lds, wid, lane); S.done(cur); }
#undef PG8_SA
#undef PG8_SB
#undef PG8_STAGE
#undef PG8_LDA
#undef PG8_LDB
#undef PG8_MMA
#undef PG8_WAIT_V
#undef PG8_WAIT_L
#undef PG8_BAR
#undef PG8_SCHED
}
}

typedef unsigned short bf16_t;
typedef short bf16x8_t __attribute__((ext_vector_type(8)));
typedef float f32x4_t __attribute__((ext_vector_type(4)));
constexpr int T_TOK = 16384, DM = 1024, SEQ = 2048, NBATCH = 8;
constexpr int L0_COLS = 3848, L0_MAIN = 3840, L1_COLS = 4112, L1_MAIN = 4096;
constexpr float DN_ALPHA = 1.4142135623730951f;
constexpr float LN_EPS = 1e-5f;
constexpr int NTHR = 512;

__device__ __forceinline__ unsigned f2bf(float f) { unsigned u = __float_as_uint(f); return (u + 0x7fffu + ((u >> 16) & 1u)) >> 16; }
__device__ __forceinline__ unsigned pk2(float lo, float hi) { return f2bf(lo) | (f2bf(hi) << 16); }
__device__ __forceinline__ float bflo(unsigned w) { return __uint_as_float(w << 16); }
__device__ __forceinline__ float bfhi(unsigned w) { return __uint_as_float(w & 0xffff0000u); }
__device__ __forceinline__ float bf2f(bf16_t h) { return __uint_as_float(((unsigned)h) << 16); }
__device__ __forceinline__ float wave_sum(float v) {
#pragma unroll
    for (int o = 32; o >= 1; o >>= 1) v += __shfl_xor(v, o);
    return v;
}
__device__ __forceinline__ float sigmoid_f(float x) { return 1.0f / (1.0f + __expf(-x)); }
__device__ __forceinline__ float log_sigmoid_f(float x) { return fminf(x, 0.f) - log1pf(__expf(-fabsf(x))); }
__device__ __forceinline__ void unpack8(const uint4 w, float* f) {
    f[0] = bflo(w.x); f[1] = bfhi(w.x); f[2] = bflo(w.y); f[3] = bfhi(w.y); f[4] = bflo(w.z); f[5] = bfhi(w.z); f[6] = bflo(w.w); f[7] = bfhi(w.w);
}
__device__ __forceinline__ void unpack4(const uint2 w, float* f) { f[0] = bflo(w.x); f[1] = bfhi(w.x); f[2] = bflo(w.y); f[3] = bfhi(w.y); }

__global__ void __launch_bounds__(256) transpose_cvt_kernel(const float* __restrict__ W, int K, int ldw, int c0, int N, bf16_t* __restrict__ WT) {
    __shared__ float tile[64][65];
    const int nb = N / 64; const int kb = blockIdx.x / nb, nbi = blockIdx.x % nb; const int k0 = kb * 64, n0 = nbi * 64;
    for (int i = threadIdx.x; i < 4096; i += 256) { const int kk = i >> 6, nn = i & 63; tile[kk][nn] = W[(size_t)(k0 + kk) * ldw + c0 + n0 + nn]; }
    __syncthreads();
    for (int i = threadIdx.x; i < 2048; i += 256) { const int nn = i >> 5, kp = (i & 31) * 2;
        const unsigned v = pk2(tile[kp][nn], tile[kp + 1][nn]); *(unsigned*)(WT + (size_t)(n0 + nn) * K + k0 + kp) = v; }
}
__global__ void __launch_bounds__(256) cvt_bf16_kernel(const float* __restrict__ src, bf16_t* __restrict__ dst, size_t n8) {
    for (size_t i = (size_t)blockIdx.x * blockDim.x + threadIdx.x; i < n8; i += (size_t)gridDim.x * blockDim.x) {
        const float4 a = ((const float4*)src)[2 * i], b = ((const float4*)src)[2 * i + 1];
        uint4 o; o.x = pk2(a.x, a.y); o.y = pk2(a.z, a.w); o.z = pk2(b.x, b.y); o.w = pk2(b.z, b.w); ((uint4*)dst)[i] = o; }
}
__global__ void __launch_bounds__(256) build_wlr_kernel(const float* __restrict__ w_up, const float* __restrict__ a_up, const float* __restrict__ g_up, bf16_t* __restrict__ WT) {
    const int i = blockIdx.x * 256 + threadIdx.x; if (i >= 1536 * 256) return; const int n = i >> 8, k = i & 255; float v = 0.f;
    if (n < 512) { if (k < 64) v = w_up[k * 512 + n]; }
    else if (n < 1024) { if (k >= 64 && k < 128) v = a_up[(k - 64) * 512 + (n - 512)]; }
    else { if (k >= 128) v = g_up[(k - 128) * 512 + (n - 1024)]; }
    WT[i] = (bf16_t)f2bf(v);
}

namespace pg8 {
struct EpiF32 {
    static constexpr bool PERM = false, AFTER_DRAIN = false;
    float* C; long ldc;
    __device__ __forceinline__ void operator()(const f32x4 (&acc)[2][2][4][2], const Unit& u, int wr, int wc, int fr, int fq) const {
        const int row0 = u.pm * BM + wr * 64 + fr, col0 = u.pn * BM + wc * 32 + 4 * fq;
#pragma unroll
        for (int ai = 0; ai < 2; ++ai)
#pragma unroll
            for (int m = 0; m < 4; ++m) { float* rowp = C + (size_t)(row0 + ai * HALF + m * 16) * ldc + col0;
#pragma unroll
                for (int bj = 0; bj < 2; ++bj)
#pragma unroll
                    for (int n = 0; n < 2; ++n) *(f32x4*)(rowp + bj * HALF + n * 16) = acc[ai][bj][m][n]; }
    }
};
struct EpiBf16P {
    static constexpr bool PERM = true, AFTER_DRAIN = false;
    bf16_t* O; long ldc;
    __device__ __forceinline__ void operator()(const f32x4 (&acc)[2][2][4][2], const Unit& u, int wr, int wc, int fr, int fq) const {
        const int row0 = u.pm * BM + wr * 64 + fr; const int col0 = u.pn * BM + wc * 32 + 8 * fq;
#pragma unroll
        for (int ai = 0; ai < 2; ++ai)
#pragma unroll
            for (int m = 0; m < 4; ++m) { bf16_t* rowp = O + (size_t)(row0 + ai * HALF + m * 16) * ldc + col0;
#pragma unroll
                for (int bj = 0; bj < 2; ++bj) { const f32x4 v0 = acc[ai][bj][m][0], v1 = acc[ai][bj][m][1];
                    u32x4 w; w.x = cvt_pk_bf16(v0[0], v0[1]); w.y = cvt_pk_bf16(v0[2], v0[3]); w.z = cvt_pk_bf16(v1[0], v1[1]); w.w = cvt_pk_bf16(v1[2], v1[3]);
                    *(u32x4*)(rowp + bj * HALF) = w; } }
    }
};
struct EpiLowrank {
    static constexpr bool PERM = false, AFTER_DRAIN = false;
    float* lrw; bf16_t* lra; bf16_t* lrg; const float* w0; const float* a0;
    __device__ __forceinline__ void operator()(const f32x4 (&acc)[2][2][4][2], const Unit& u, int wr, int wc, int fr, int fq) const {
        const int row0 = u.pm * BM + wr * 64 + fr; const int sel = u.pn >> 1; const int colb = (u.pn & 1) * BM + wc * 32 + 4 * fq;
#pragma unroll
        for (int ai = 0; ai < 2; ++ai)
#pragma unroll
            for (int m = 0; m < 4; ++m) { const size_t rowoff = (size_t)(row0 + ai * HALF + m * 16) * 512;
#pragma unroll
                for (int bj = 0; bj < 2; ++bj)
#pragma unroll
                    for (int n = 0; n < 2; ++n) { const int c = colb + bj * HALF + n * 16; f32x4 v = acc[ai][bj][m][n];
                        if (sel == 0) { const f32x4 bv = *(const f32x4*)(w0 + c); *(f32x4*)(lrw + rowoff + c) = v + bv; }
                        else if (sel == 1) { const f32x4 bv = *(const f32x4*)(a0 + c); v = v + bv; uint2 o; o.x = pk2(v[0], v[1]); o.y = pk2(v[2], v[3]); *(uint2*)(lra + rowoff + c) = o; }
                        else { uint2 o; o.x = pk2(v[0], v[1]); o.y = pk2(v[2], v[3]); *(uint2*)(lrg + rowoff + c) = o; } } }
    }
};
}

template <class Epi>
__global__ void __launch_bounds__(512, 2) gemm_kernel(const bf16_t* A, const bf16_t* Bt, int M, int N, int K, int pad0, Epi E) {
    extern __shared__ __attribute__((aligned(16))) unsigned char lds_dyn[];
    pg8::Gemm g; g.A = A; g.Bt = Bt; g.M = M; g.N = N; g.K = K;
    pg8::StaticOrder S; S.init(g.M, g.N, (int)gridDim.x, (int)blockIdx.x);
    pg8::gemm_phase<Epi, pg8::StaticOrder, true, true>((PG8_LAS unsigned char*)lds_dyn, g, S, E);
}

template <int NG>
__global__ void __launch_bounds__(512) gates_kernel(const float* __restrict__ X, const float* __restrict__ W, int ldw, int c0, float* __restrict__ out) {
    extern __shared__ __attribute__((aligned(16))) unsigned char lds_dyn[];
    float* wg = (float*)lds_dyn;
    for (int i = threadIdx.x; i < NG * 1024; i += 512) { const int k = i / NG, g = i % NG; wg[g * 1024 + k] = W[(size_t)k * ldw + c0 + g]; }
    __syncthreads();
    const int lane = threadIdx.x & 63, wv = threadIdx.x >> 6;
    for (int t = blockIdx.x * 8 + wv; t < T_TOK; t += gridDim.x * 8) {
        float x[16];
#pragma unroll
        for (int j = 0; j < 16; ++j) x[j] = X[(size_t)t * 1024 + lane + 64 * j];
#pragma unroll 1
        for (int g = 0; g < NG; ++g) { float p = 0.f;
#pragma unroll
            for (int j = 0; j < 16; ++j) p += x[j] * wg[g * 1024 + lane + 64 * j];
            p = wave_sum(p); if (lane == 0) out[(size_t)t * 16 + g] = p; }
    }
}
__global__ void __launch_bounds__(256) rwkv_prep_kernel(const bf16_t* __restrict__ P0, const float* __restrict__ mu, bf16_t* __restrict__ App) {
    const size_t i = (size_t)blockIdx.x * 256 + threadIdx.x; if (i >= (size_t)T_TOK * 256) return;
    const int t = (int)(i >> 8), c = (int)(i & 255), col = 1536 + c;
    const float cur = bf2f(P0[(size_t)t * L0_MAIN + col]); const float prev = (t % SEQ) ? bf2f(P0[(size_t)(t - 1) * L0_MAIN + col]) : 0.f;
    float v = cur + (prev - cur) * mu[col];
    if (c < 64) v = tanhf(v); else if (c >= 128) v = sigmoid_f(v);
    App[i] = (bf16_t)f2bf(v);
}
__global__ void __launch_bounds__(512) ln_kernel(const float* xin, const float* mix, const float* g, const float* b, float* xout, bf16_t* xb) {
    const int lane = threadIdx.x & 63, wv = threadIdx.x >> 6;
    for (int t = blockIdx.x * 8 + wv; t < T_TOK; t += gridDim.x * 8) {
        float4 y[4]; float s = 0.f;
#pragma unroll
        for (int j = 0; j < 4; ++j) { const float4 a = *(const float4*)(xin + (size_t)t * 1024 + 4 * lane + 256 * j), m = *(const float4*)(mix + (size_t)t * 1024 + 4 * lane + 256 * j);
            y[j].x = DN_ALPHA * a.x + m.x; y[j].y = DN_ALPHA * a.y + m.y; y[j].z = DN_ALPHA * a.z + m.z; y[j].w = DN_ALPHA * a.w + m.w; s += (y[j].x + y[j].y) + (y[j].z + y[j].w); }
        const float mean = wave_sum(s) * (1.f / 1024.f); float q = 0.f;
#pragma unroll
        for (int j = 0; j < 4; ++j) { y[j].x -= mean; y[j].y -= mean; y[j].z -= mean; y[j].w -= mean; q += (y[j].x * y[j].x + y[j].y * y[j].y) + (y[j].z * y[j].z + y[j].w * y[j].w); }
        const float rstd = rsqrtf(wave_sum(q) * (1.f / 1024.f) + LN_EPS);
#pragma unroll
        for (int j = 0; j < 4; ++j) { const float4 gg = *(const float4*)(g + 4 * lane + 256 * j), bb = *(const float4*)(b + 4 * lane + 256 * j);
            float4 o; o.x = y[j].x * rstd * gg.x + bb.x; o.y = y[j].y * rstd * gg.y + bb.y; o.z = y[j].z * rstd * gg.z + bb.z; o.w = y[j].w * rstd * gg.w + bb.w;
            *(float4*)(xout + (size_t)t * 1024 + 4 * lane + 256 * j) = o; uint2 w; w.x = pk2(o.x, o.y); w.y = pk2(o.z, o.w); *(uint2*)(xb + (size_t)t * 1024 + 4 * lane + 256 * j) = w; }
    }
}
__global__ void __launch_bounds__(64) fox_cumsum_kernel(const float* __restrict__ gates, const float* __restrict__ f_b, float* __restrict__ cum) {
    const int bh = blockIdx.x, b = bh >> 4, h = bh & 15, lane = threadIdx.x; const float fb = f_b[h];
    float lf[32]; double run = 0.0;
#pragma unroll
    for (int j = 0; j < 32; ++j) { const int s = lane * 32 + j; lf[j] = log_sigmoid_f(gates[((size_t)b * SEQ + s) * 16 + h] + fb); run += (double)lf[j]; }
    double incl = run;
#pragma unroll
    for (int o = 1; o < 64; o <<= 1) { const double v = __shfl_up(incl, o); if (lane >= o) incl += v; }
    double acc = incl - run;
#pragma unroll
    for (int j = 0; j < 32; ++j) { acc += (double)lf[j]; cum[(size_t)bh * SEQ + lane * 32 + j] = (float)acc; }
}

struct RwkvArgs { const bf16_t* P0; const float* lrw; const bf16_t* lra; const bf16_t* lrg; const float* mu; const float* k_k; const float* k_a; const float* r_k; const float* ln_g; const float* ln_b; bf16_t* ycat; };
constexpr int RW_CS = 32;
constexpr int RW_LDS_BYTES = 8 * RW_CS * 64 * 4;

#define RW_LOAD_RAW(chunk) do { const int sg_ = (chunk) * RW_CS + ls; const size_t row_ = tok0 + sg_; \
    const bf16_t* pc_ = A.P0 + row_ * L0_MAIN + hc; \
    rc = *(const uint2*)(pc_); kc = *(const uint2*)(pc_ + 512); vc = *(const uint2*)(pc_ + 1024); \
    if (sg_ > 0) { const bf16_t* pp_ = pc_ - L0_MAIN; rp = *(const uint2*)(pp_); kp = *(const uint2*)(pp_ + 512); vp = *(const uint2*)(pp_ + 1024); } \
    else { rp = make_uint2(0u, 0u); kp = rp; vp = rp; } \
    rwl = *(const float4*)(A.lrw + row_ * 512 + hc); ra = *(const uint2*)(A.lra + row_ * 512 + hc); rg = *(const uint2*)(A.lrg + row_ * 512 + hc); } while (0)

__device__ __forceinline__ void rwkv_scan_unit(const RwkvArgs& A, int bh, float* smem) {
    const int tid = threadIdx.x; const int b = bh >> 3, h = bh & 7;
    float* sr = smem; float* sw = sr + 2048; float* sk = sw + 2048; float* skk = sk + 2048; float* snb = skk + 2048; float* sv = snb + 2048; float* sg = sv + 2048; float* sy = sg + 2048;
    const int ls = tid >> 4, lc = (tid & 15) * 4; const int hc = h * 64 + lc;
    float c_mur[4], c_muk[4], c_muv[4], c_kk[4], c_ka[4], c_rk[4], c_lng[4], c_lnb[4];
#pragma unroll
    for (int j = 0; j < 4; ++j) { c_mur[j] = A.mu[hc + j]; c_muk[j] = A.mu[512 + hc + j]; c_muv[j] = A.mu[1024 + hc + j]; c_kk[j] = A.k_k[hc + j]; c_ka[j] = A.k_a[hc + j];
        c_rk[j] = A.r_k[hc + j]; c_lng[j] = A.ln_g[hc + j]; c_lnb[j] = A.ln_b[hc + j]; }
    const int srow = tid >> 3, sq = (tid & 7) * 8;
    float S[8];
#pragma unroll
    for (int j = 0; j < 8; ++j) S[j] = 0.f;
    const size_t tok0 = (size_t)b * SEQ;
    uint2 rc, kc, vc, rp, kp, vp, ra, rg; float4 rwl;
    RW_LOAD_RAW(0);
    for (int chunk = 0; chunk < SEQ / RW_CS; ++chunk) {
        {
            float frc[4], fkc[4], fvc[4], frp[4], fkp[4], fvp[4], fa[4], fg[4];
            unpack4(rc, frc); unpack4(kc, fkc); unpack4(vc, fvc); unpack4(rp, frp); unpack4(kp, fkp); unpack4(vp, fvp); unpack4(ra, fa); unpack4(rg, fg);
            const float zw[4] = {rwl.x, rwl.y, rwl.z, rwl.w};
            float r_l[4], k_l[4], v_l[4], w_[4], a_[4], kkr[4]; float ss = 0.f;
#pragma unroll
            for (int j = 0; j < 4; ++j) {
                r_l[j] = frc[j] + (frp[j] - frc[j]) * c_mur[j]; k_l[j] = fkc[j] + (fkp[j] - fkc[j]) * c_muk[j]; v_l[j] = fvc[j] + (fvp[j] - fvc[j]) * c_muv[j];
                const float sig = sigmoid_f(zw[j]); w_[j] = __expf(-0.6065306597126334f * sig); a_[j] = sigmoid_f(fa[j]);
                kkr[j] = k_l[j] * c_kk[j]; ss += kkr[j] * kkr[j]; }
            ss += __shfl_xor(ss, 1); ss += __shfl_xor(ss, 2); ss += __shfl_xor(ss, 4); ss += __shfl_xor(ss, 8);
            const float inv = 1.0f / fmaxf(sqrtf(ss), 1e-12f);
            const int o = ls * 64 + lc;
#pragma unroll
            for (int j = 0; j < 4; ++j) { const float kk = kkr[j] * inv;
                sr[o + j] = r_l[j]; sw[o + j] = w_[j]; sk[o + j] = k_l[j] * (1.0f + (a_[j] - 1.0f) * c_ka[j]); skk[o + j] = kk; snb[o + j] = -kk * a_[j]; sv[o + j] = v_l[j]; sg[o + j] = fg[j]; }
        }
        __syncthreads();
        if (chunk + 1 < SEQ / RW_CS) RW_LOAD_RAW(chunk + 1);
        for (int s = 0; s < RW_CS; ++s) {
            const float4 kk0 = *(const float4*)(skk + s * 64 + sq), kk1 = *(const float4*)(skk + s * 64 + sq + 4);
            const float4 w0 = *(const float4*)(sw + s * 64 + sq), w1 = *(const float4*)(sw + s * 64 + sq + 4);
            const float4 nb0 = *(const float4*)(snb + s * 64 + sq), nb1 = *(const float4*)(snb + s * 64 + sq + 4);
            const float4 k0 = *(const float4*)(sk + s * 64 + sq), k1 = *(const float4*)(sk + s * 64 + sq + 4);
            const float4 r0 = *(const float4*)(sr + s * 64 + sq), r1 = *(const float4*)(sr + s * 64 + sq + 4);
            const float vv = sv[s * 64 + srow];
            float sa = (S[0] * kk0.x + S[1] * kk0.y) + (S[2] * kk0.z + S[3] * kk0.w) + (S[4] * kk1.x + S[5] * kk1.y) + (S[6] * kk1.z + S[7] * kk1.w);
            sa += __shfl_xor(sa, 1); sa += __shfl_xor(sa, 2); sa += __shfl_xor(sa, 4);
            S[0] = S[0] * w0.x + sa * nb0.x + vv * k0.x; S[1] = S[1] * w0.y + sa * nb0.y + vv * k0.y; S[2] = S[2] * w0.z + sa * nb0.z + vv * k0.z; S[3] = S[3] * w0.w + sa * nb0.w + vv * k0.w;
            S[4] = S[4] * w1.x + sa * nb1.x + vv * k1.x; S[5] = S[5] * w1.y + sa * nb1.y + vv * k1.y; S[6] = S[6] * w1.z + sa * nb1.z + vv * k1.z; S[7] = S[7] * w1.w + sa * nb1.w + vv * k1.w;
            float y = (S[0] * r0.x + S[1] * r0.y) + (S[2] * r0.z + S[3] * r0.w) + (S[4] * r1.x + S[5] * r1.y) + (S[6] * r1.z + S[7] * r1.w);
            y += __shfl_xor(y, 1); y += __shfl_xor(y, 2); y += __shfl_xor(y, 4);
            if ((tid & 7) == 0) sy[s * 64 + srow] = y;
        }
        __syncthreads();
        {
            const int o = ls * 64 + lc; float y4[4]; float s1 = 0.f, bp = 0.f;
#pragma unroll
            for (int j = 0; j < 4; ++j) { y4[j] = sy[o + j]; s1 += y4[j]; bp += sr[o + j] * sk[o + j] * c_rk[j]; }
            s1 += __shfl_xor(s1, 1); s1 += __shfl_xor(s1, 2); s1 += __shfl_xor(s1, 4); s1 += __shfl_xor(s1, 8);
            bp += __shfl_xor(bp, 1); bp += __shfl_xor(bp, 2); bp += __shfl_xor(bp, 4); bp += __shfl_xor(bp, 8);
            const float mean = s1 * (1.f / 64.f); float q = 0.f;
#pragma unroll
            for (int j = 0; j < 4; ++j) { y4[j] -= mean; q += y4[j] * y4[j]; }
            q += __shfl_xor(q, 1); q += __shfl_xor(q, 2); q += __shfl_xor(q, 4); q += __shfl_xor(q, 8);
            const float rstd = rsqrtf(q * (1.f / 64.f) + 64.0f * 1e-5f);
            float ov[4];
#pragma unroll
            for (int j = 0; j < 4; ++j) ov[j] = (y4[j] * rstd * c_lng[j] + c_lnb[j] + bp * sv[o + j]) * sg[o + j];
            uint2 w; w.x = pk2(ov[0], ov[1]); w.y = pk2(ov[2], ov[3]);
            *(uint2*)(A.ycat + (tok0 + (size_t)chunk * RW_CS + ls) * 1024 + hc) = w;
        }
        __syncthreads();
    }
}
__global__ void __launch_bounds__(512) rwkv_scan_kernel(RwkvArgs A) {
    extern __shared__ __attribute__((aligned(16))) unsigned char lds_dyn[];
    rwkv_scan_unit(A, (int)blockIdx.x, (float*)lds_dyn);
}

struct MlstmArgs { const bf16_t* P0; const float* gates; const float* conv_w; const float* conv_b; const float* ig_b; const float* fg_b; const float* hn_g; const float* hn_b; bf16_t* ycat; };
constexpr int ML_QS = 132;
constexpr int ML_LDS_FLOATS = 64 * ML_QS + 64 * 128 + 64 * 128 + 64 * 65 + 64 * ML_QS + 64 * 10 + 128 + 128;
constexpr int ML_LDS_BYTES = ML_LDS_FLOATS * 4;

__global__ void __launch_bounds__(128) mlstm_kernel(MlstmArgs A) {
    extern __shared__ __attribute__((aligned(16))) unsigned char lds_dyn[];
    float* qs = (float*)lds_dyn; float* ks = qs + 64 * ML_QS; float* vs = ks + 64 * 128; float* sc = vs + 64 * 128; float* hs = sc + 64 * 65;
    float* sig = hs + 64 * ML_QS; float* slf = sig + 64; float* sb = slf + 64; float* smt = sb + 64; float* scarry = smt + 64; float* sden = scarry + 64; float* sws = sden + 64;
    float* smean = sws + 64; float* srstd = smean + 64; float* spad = srstd + 64; float* sdenp = spad + 64;   float* sn = sdenp + 128;
    const int tid = threadIdx.x; const int bh = blockIdx.x, b = bh >> 2, h = bh & 3;
    const size_t tok0 = (size_t)b * SEQ;
    const int cq = h * 128 + tid;
    float wq[4], wk[4];
#pragma unroll
    for (int j = 0; j < 4; ++j) { wq[j] = A.conv_w[j * 1024 + cq]; wk[j] = A.conv_w[j * 1024 + 512 + cq]; }
    const float bq = A.conv_b[cq], bk = A.conv_b[512 + cq];
    const float igb = A.ig_b[h], fgb = A.fg_b[h];
    const float hng = A.hn_g[cq], hnb = A.hn_b[cq];
    float zq1 = 0.f, zq2 = 0.f, zq3 = 0.f, zk1 = 0.f, zk2 = 0.f, zk3 = 0.f;
    float C[128];
#pragma unroll
    for (int k = 0; k < 128; ++k) C[k] = 0.f;
    sn[tid] = 0.f;
    float m_run = 0.f;
    for (int chunk = 0; chunk < SEQ / 64; ++chunk) {
        const size_t row0 = tok0 + (size_t)chunk * 64;
        for (int t = 0; t < 64; ++t) { const bf16_t* pr = A.P0 + (row0 + t) * L0_MAIN;
            const float zq = bf2f(pr[1792 + cq]), zk = bf2f(pr[2304 + cq]);
            const float cvq = wq[3] * zq + wq[2] * zq1 + wq[1] * zq2 + wq[0] * zq3 + bq; const float cvk = wk[3] * zk + wk[2] * zk1 + wk[1] * zk2 + wk[0] * zk3 + bk;
            zq3 = zq2; zq2 = zq1; zq1 = zq; zk3 = zk2; zk2 = zk1; zk1 = zk;
            qs[t * ML_QS + tid] = cvq * sigmoid_f(cvq) * 0.08838834764831845f; ks[t * 128 + tid] = cvk * sigmoid_f(cvk); vs[t * 128 + tid] = bf2f(pr[2816 + cq]); }
        if (tid < 64) { const float* gr = A.gates + (row0 + tid) * 16; sig[tid] = gr[h] + igb; slf[tid] = log_sigmoid_f(gr[4 + h] + fgb); }
        __syncthreads();
        if (tid < 64) { float bsum = 0.f; for (int s = 0; s <= tid; ++s) bsum += slf[s]; sb[tid] = bsum; }
        __syncthreads();
        const float b_last = sb[63];
        float gmax = -INFINITY; for (int s = 0; s < 64; ++s) gmax = fmaxf(gmax, b_last - sb[s] + sig[s]);
        const float m_new = fmaxf(b_last + m_run, gmax); const float keep = __expf(b_last + m_run - m_new);
        if (tid < 64) { const float bt = sb[tid]; float mx = -INFINITY; for (int s = 0; s <= tid; ++s) mx = fmaxf(mx, bt - sb[s] + sig[s]);
            const float mt = fmaxf(bt + m_run, mx); smt[tid] = mt; scarry[tid] = __expf(bt + m_run - mt); sws[tid] = __expf(b_last - bt + sig[tid] - m_new); }
        __syncthreads();
        { const int t = tid & 63, sh = tid >> 6; const float bt = sb[t], mt = smt[t]; float dsum = 0.f;
            for (int s = sh * 32; s < sh * 32 + 32; ++s) { float val = 0.f;
                if (s <= t) { float dot = 0.f;
#pragma unroll 8
                    for (int k = 0; k < 128; k += 4) { const float4 qa = *(const float4*)(qs + t * ML_QS + k), kb = *(const float4*)(ks + s * 128 + k); dot += (qa.x * kb.x + qa.y * kb.y) + (qa.z * kb.z + qa.w * kb.w); }
                    val = dot * __expf(bt - sb[s] + sig[s] - mt); }
                sc[t * 65 + s] = val; dsum += val; }
            sdenp[sh * 64 + t] = dsum; }
        __syncthreads();
        if (tid < 64) { float qn = 0.f; for (int k = 0; k < 128; ++k) qn += qs[tid * ML_QS + k] * sn[k];
            const float den = sdenp[tid] + sdenp[64 + tid] + scarry[tid] * qn; sden[tid] = fmaxf(fabsf(den), __expf(-smt[tid])); }
        __syncthreads();
        for (int t = 0; t < 64; ++t) { float acc = 0.f; for (int s = 0; s <= t; ++s) acc += sc[t * 65 + s] * vs[s * 128 + tid];
            float qc = 0.f;
#pragma unroll
            for (int k = 0; k < 128; k += 4) { const float4 qa = *(const float4*)(qs + t * ML_QS + k); qc += (qa.x * C[k] + qa.y * C[k + 1]) + (qa.z * C[k + 2] + qa.w * C[k + 3]); }
            hs[t * ML_QS + tid] = (acc + scarry[t] * qc) / sden[t]; }
        __syncthreads();
        { const int t = tid >> 1, hf = tid & 1; float s1 = 0.f; for (int k = 0; k < 64; ++k) s1 += hs[t * ML_QS + hf * 64 + k];
            s1 += __shfl_xor(s1, 1); const float mean = s1 * (1.f / 128.f); float q = 0.f; for (int k = 0; k < 64; ++k) { const float d = hs[t * ML_QS + hf * 64 + k] - mean; q += d * d; }
            q += __shfl_xor(q, 1); if (hf == 0) { smean[t] = mean; srstd[t] = rsqrtf(q * (1.f / 128.f) + LN_EPS); } }
        __syncthreads();
        for (int t = 0; t < 64; ++t) { const float hn = (hs[t * ML_QS + tid] - smean[t]) * srstd[t] * hng + hnb; const float og = bf2f(A.P0[(row0 + t) * L0_MAIN + 3328 + cq]);
            A.ycat[(row0 + t) * 1024 + 512 + cq] = (bf16_t)f2bf(hn * sigmoid_f(og)); }
#pragma unroll
        for (int k = 0; k < 128; ++k) C[k] *= keep;
        for (int s = 0; s < 64; ++s) { const float wv = sws[s] * vs[s * 128 + tid];
#pragma unroll
            for (int k = 0; k < 128; k += 4) { const float4 kb = *(const float4*)(ks + s * 128 + k); C[k] += kb.x * wv; C[k + 1] += kb.y * wv; C[k + 2] += kb.z * wv; C[k + 3] += kb.w * wv; } }
        { float nn = keep * sn[tid]; for (int s = 0; s < 64; ++s) nn += sws[s] * ks[s * 128 + tid]; __syncthreads(); sn[tid] = nn; }
        m_run = m_new;
        __syncthreads();
    }
}

struct AttnArgs { const bf16_t* P1; const float* cum; const float* qn_g; const float* kn_g; bf16_t* out; };
constexpr int AT_LDS_BYTES = (2 * 32 * 64 + 32) * 4;
__device__ __forceinline__ void attn_unit_valu(const AttnArgs& A, int bh, int qb, float* smem) {
    float* Ks = smem; float* Vs = Ks + 2048; float* cj = Vs + 2048;
    const int tid = threadIdx.x; const int b = bh >> 4, h = bh & 15; const int hf = tid & 1; const int i = qb * 256 + (tid >> 1); const size_t row = (size_t)b * SEQ + i;
    float q[32], o[32];
    { float ss = 0.f;
#pragma unroll
        for (int c = 0; c < 4; ++c) { const uint4 w = *(const uint4*)(A.P1 + row * L1_MAIN + h * 64 + hf * 32 + c * 8); unpack8(w, q + c * 8); }
#pragma unroll
        for (int d = 0; d < 32; ++d) ss += q[d] * q[d];
        ss += __shfl_xor(ss, 1);
        const float r = rsqrtf(ss * (1.f / 64.f) + 1e-6f) * 0.125f;
#pragma unroll
        for (int d = 0; d < 32; ++d) { q[d] = q[d] * r * A.qn_g[h * 64 + hf * 32 + d]; o[d] = 0.f; } }
    const float ci = A.cum[(size_t)bh * SEQ + i];
    float m = -INFINITY, l = 0.f;
    const int ntiles = (qb * 256 + 256) / 32;
    const int lkey = tid >> 4, ld4 = (tid & 15) * 4;
    float kg[4];
#pragma unroll
    for (int j = 0; j < 4; ++j) kg[j] = A.kn_g[h * 64 + ld4 + j];
    for (int kt = 0; kt < ntiles; ++kt) {
        { const size_t krow = (size_t)b * SEQ + kt * 32 + lkey; float fk[4], fv[4];
            unpack4(*(const uint2*)(A.P1 + krow * L1_MAIN + 1024 + h * 64 + ld4), fk); unpack4(*(const uint2*)(A.P1 + krow * L1_MAIN + 2048 + h * 64 + ld4), fv);
            float ss = (fk[0] * fk[0] + fk[1] * fk[1]) + (fk[2] * fk[2] + fk[3] * fk[3]);
            ss += __shfl_xor(ss, 1); ss += __shfl_xor(ss, 2); ss += __shfl_xor(ss, 4); ss += __shfl_xor(ss, 8);
            const float r = rsqrtf(ss * (1.f / 64.f) + 1e-6f);
#pragma unroll
            for (int j = 0; j < 4; ++j) { Ks[lkey * 64 + ld4 + j] = fk[j] * r * kg[j]; Vs[lkey * 64 + ld4 + j] = fv[j]; }
            if ((tid & 15) == 0) cj[lkey] = A.cum[(size_t)bh * SEQ + kt * 32 + lkey]; }
        __syncthreads();
#pragma unroll 1
        for (int sub = 0; sub < 8; ++sub) {
            float s[4]; float mx = -INFINITY;
#pragma unroll
            for (int jj = 0; jj < 4; ++jj) { const int j = sub * 4 + jj; float dot = 0.f;
#pragma unroll
                for (int d = 0; d < 32; d += 4) { const float4 kv = *(const float4*)(Ks + j * 64 + hf * 32 + d); dot += (q[d] * kv.x + q[d + 1] * kv.y) + (q[d + 2] * kv.z + q[d + 3] * kv.w); }
                dot += __shfl_xor(dot, 1);
                float sv_ = dot + ci - cj[j]; if (kt * 32 + j > i) sv_ = -INFINITY; s[jj] = sv_; mx = fmaxf(mx, sv_); }
            const float mnew = fmaxf(m, mx); const float scl = __expf(m - mnew); float psum = 0.f;
#pragma unroll
            for (int jj = 0; jj < 4; ++jj) { s[jj] = __expf(s[jj] - mnew); psum += s[jj]; }
            l = l * scl + psum; m = mnew;
#pragma unroll
            for (int d = 0; d < 32; ++d) o[d] *= scl;
#pragma unroll
            for (int jj = 0; jj < 4; ++jj) { const int j = sub * 4 + jj; const float p = s[jj];
#pragma unroll
                for (int d = 0; d < 32; d += 4) { const float4 vv = *(const float4*)(Vs + j * 64 + hf * 32 + d); o[d] += p * vv.x; o[d + 1] += p * vv.y; o[d + 2] += p * vv.z; o[d + 3] += p * vv.w; } }
        }
        __syncthreads();
    }
    const float il = 1.0f / l;
#pragma unroll
    for (int c = 0; c < 4; ++c) { float og[8]; unpack8(*(const uint4*)(A.P1 + row * L1_MAIN + 3072 + h * 64 + hf * 32 + c * 8), og);
        uint4 w; w.x = pk2(o[c * 8 + 0] * il * sigmoid_f(og[0]), o[c * 8 + 1] * il * sigmoid_f(og[1])); w.y = pk2(o[c * 8 + 2] * il * sigmoid_f(og[2]), o[c * 8 + 3] * il * sigmoid_f(og[3]));
        w.z = pk2(o[c * 8 + 4] * il * sigmoid_f(og[4]), o[c * 8 + 5] * il * sigmoid_f(og[5])); w.w = pk2(o[c * 8 + 6] * il * sigmoid_f(og[6]), o[c * 8 + 7] * il * sigmoid_f(og[7]));
        *(uint4*)(A.out + row * 1024 + h * 64 + hf * 32 + c * 8) = w; }
}
__global__ void __launch_bounds__(512) attn_valu_kernel(AttnArgs A) {
    extern __shared__ __attribute__((aligned(16))) unsigned char lds_dyn[];
    const int bh = blockIdx.x >> 1, pr = blockIdx.x & 1;
#pragma unroll 1
    for (int u = 0; u < 4; ++u) { const int qb = (u == 0) ? pr : (u == 1) ? 7 - pr : (u == 2) ? 2 + pr : 5 - pr; attn_unit_valu(A, bh, qb, (float*)lds_dyn); }
}

struct PeerSArgs { const bf16_t* Q; const bf16_t* K1b; const bf16_t* K2b; int* eid; float* gate; };
constexpr int PS_QT = 0, PS_KB = 64 * 528, PS_KB2 = PS_KB + 128 * 272, PS_L1 = PS_KB + 2 * 128 * 272, PS_L2 = PS_L1 + 4096, PS_LDS_BYTES = PS_L2 + 4096;
__device__ __forceinline__ unsigned ord_f(float f) { const unsigned b = __float_as_uint(f); return b ^ ((b >> 31) ? 0xFFFFFFFFu : 0x80000000u); }
__device__ __forceinline__ float unord_f(unsigned u) { const unsigned b = (u & 0x80000000u) ? (u ^ 0x80000000u) : ~u; return __uint_as_float(b); }
#define TOPK_INSERT(L, x) do { unsigned x_ = (x); _Pragma("unroll") for (int q_ = 0; q_ < 16; ++q_) { const unsigned hi_ = max(L[q_], x_); x_ = min(L[q_], x_); L[q_] = hi_; } } while (0)

__device__ __forceinline__ void peer_scores_unit(const PeerSArgs& A, int tile, int h, unsigned char* smem) {
    const int tid = threadIdx.x, lane = tid & 63, wv = tid >> 6;
#pragma unroll
    for (int i = 0; i < 4; ++i) { const int idx = tid + 512 * i; const int row = idx >> 5, c = idx & 31;
        *(uint4*)(smem + PS_QT + row * 528 + c * 16) = *(const uint4*)(A.Q + (size_t)(tile * 64 + row) * 2048 + h * 256 + c * 8); }
#pragma unroll
    for (int i = 0; i < 4; ++i) { const int idx = tid + 512 * i; const int row = idx >> 4, c = idx & 15;
        *(uint4*)(smem + PS_KB + row * 272 + c * 16) = *(const uint4*)(A.K1b + (size_t)(h * 128 + row) * 128 + c * 8);
        *(uint4*)(smem + PS_KB2 + row * 272 + c * 16) = *(const uint4*)(A.K2b + (size_t)(h * 128 + row) * 128 + c * 8); }
    __syncthreads();
    const int half = wv >> 2, mt = wv & 3; const int fr = lane & 15, fq = lane >> 4;
    f32x4_t acc[8];
#pragma unroll
    for (int n = 0; n < 8; ++n) acc[n] = (f32x4_t){0.f, 0.f, 0.f, 0.f};
    { const unsigned char* qbase = smem + PS_QT + (16 * mt + fr) * 528 + (half * 128 + 8 * fq) * 2; const unsigned char* kbase = smem + (half ? PS_KB2 : PS_KB) + fr * 272 + (8 * fq) * 2;
#pragma unroll
        for (int ks = 0; ks < 4; ++ks) { const bf16x8_t qf = *(const bf16x8_t*)(qbase + ks * 64);
#pragma unroll
            for (int n = 0; n < 8; ++n) { const bf16x8_t kf = *(const bf16x8_t*)(kbase + n * 16 * 272 + ks * 64); acc[n] = __builtin_amdgcn_mfma_f32_16x16x32_bf16(kf, qf, acc[n], 0, 0, 0); } } }
    __syncthreads();
    { float* sT = (float*)(smem + PS_KB + half * 128 * 272);
#pragma unroll
        for (int n = 0; n < 8; ++n)
#pragma unroll
            for (int r = 0; r < 4; ++r) sT[(16 * n + 4 * fq + r) * 68 + 16 * mt + fr] = acc[n][r]; }
    __syncthreads();
    if (wv == 0 || wv == 4) { const float* sT = (const float*)(smem + PS_KB + half * 128 * 272); unsigned L[16];
#pragma unroll
        for (int j = 0; j < 16; ++j) L[j] = 0u;
        for (int key = 0; key < 128; ++key) { const unsigned u = (ord_f(sT[key * 68 + lane]) & ~0x7Fu) | (unsigned)(127 - key); TOPK_INSERT(L, u); }
        unsigned* lst = (unsigned*)(smem + (half ? PS_L2 : PS_L1));
#pragma unroll
        for (int j = 0; j < 16; ++j) lst[j * 64 + lane] = L[j]; }
    __syncthreads();
    if (wv == 0) { const unsigned* l1 = (const unsigned*)(smem + PS_L1); const unsigned* l2 = (const unsigned*)(smem + PS_L2);
        float v1[16], v2[16];
#pragma unroll
        for (int j = 0; j < 16; ++j) { v1[j] = unord_f(l1[j * 64 + lane]); v2[j] = unord_f(l2[j * 64 + lane]); }
        unsigned L[16];
#pragma unroll
        for (int j = 0; j < 16; ++j) L[j] = 0u;
#pragma unroll
        for (int i = 0; i < 16; ++i)
#pragma unroll
            for (int j = 0; j < 16; ++j) if ((i + 1) * (j + 1) <= 16) { const unsigned u = (ord_f(v1[i] + v2[j]) & ~0xFFu) | (unsigned)(255 - (i * 16 + j)); TOPK_INSERT(L, u); }
        float e[16]; float sum = 0.f; const float mx = unord_f(L[0]);
#pragma unroll
        for (int k = 0; k < 16; ++k) { e[k] = __expf(unord_f(L[k]) - mx); sum += e[k]; }
        const float inv = 1.0f / sum; const size_t ob = (size_t)(tile * 64 + lane) * 128 + h * 16;
#pragma unroll
        for (int k = 0; k < 16; ++k) { const int idx = 255 - (int)(L[k] & 0xFFu); const int i = idx >> 4, j = idx & 15;
            const int e1 = 127 - (int)(l1[i * 64 + lane] & 0x7Fu), e2 = 127 - (int)(l2[j * 64 + lane] & 0x7Fu);
            A.eid[ob + k] = e1 * 128 + e2; A.gate[ob + k] = e[k] * inv; } }
    __syncthreads();
}
__global__ void __launch_bounds__(512) peer_scores_kernel(PeerSArgs A) {
    extern __shared__ __attribute__((aligned(16))) unsigned char lds_dyn[];
    for (int u = blockIdx.x; u < 256 * 8; u += gridDim.x) peer_scores_unit(A, u >> 3, u & 7, lds_dyn);
}

struct PeerGArgs { float* X; const int* eid; const float* gate; const bf16_t* U; const bf16_t* V; const float* lng; const float* lnb; bf16_t* xb; };
__device__ __forceinline__ void peer_gather_token(const PeerGArgs& A, int t, int lane) {
    float x[16];
    { const float4 a0 = *(const float4*)(A.X + (size_t)t * 1024 + lane * 8), a1 = *(const float4*)(A.X + (size_t)t * 1024 + lane * 8 + 4);
      const float4 b0 = *(const float4*)(A.X + (size_t)t * 1024 + 512 + lane * 8), b1 = *(const float4*)(A.X + (size_t)t * 1024 + 512 + lane * 8 + 4);
      x[0] = a0.x; x[1] = a0.y; x[2] = a0.z; x[3] = a0.w; x[4] = a1.x; x[5] = a1.y; x[6] = a1.z; x[7] = a1.w; x[8] = b0.x; x[9] = b0.y; x[10] = b0.z; x[11] = b0.w; x[12] = b1.x; x[13] = b1.y; x[14] = b1.z; x[15] = b1.w; }
    const int e_lo = A.eid[(size_t)t * 128 + lane], e_hi = A.eid[(size_t)t * 128 + 64 + lane];
    const float g_lo = A.gate[(size_t)t * 128 + lane], g_hi = A.gate[(size_t)t * 128 + 64 + lane];
    float acc[16];
#pragma unroll
    for (int j = 0; j < 16; ++j) acc[j] = 0.f;
    for (int k0 = 0; k0 < 128; k0 += 4) {
        int e[4]; float g[4]; uint4 u0[4], u1[4], v0[4], v1[4];
#pragma unroll
        for (int i = 0; i < 4; ++i) { const int k = k0 + i; e[i] = __shfl(k0 < 64 ? e_lo : e_hi, k & 63); g[i] = __shfl(k0 < 64 ? g_lo : g_hi, k & 63);
            const bf16_t* ur = A.U + (size_t)e[i] * 1024 + lane * 8; u0[i] = *(const uint4*)ur; u1[i] = *(const uint4*)(ur + 512);
            const bf16_t* vr = A.V + (size_t)e[i] * 1024 + lane * 8; v0[i] = *(const uint4*)vr; v1[i] = *(const uint4*)(vr + 512); }
#pragma unroll
        for (int i = 0; i < 4; ++i) { float f[16]; unpack8(u0[i], f); unpack8(u1[i], f + 8); float dot = 0.f;
#pragma unroll
            for (int j = 0; j < 16; ++j) dot += x[j] * f[j];
            dot = wave_sum(dot);
            const float c = g[i] * 0.5f * dot * (1.0f + erff(dot * 0.7071067811865476f));
            unpack8(v0[i], f); unpack8(v1[i], f + 8);
#pragma unroll
            for (int j = 0; j < 16; ++j) acc[j] += c * f[j]; }
    }
    float s = 0.f;
#pragma unroll
    for (int j = 0; j < 16; ++j) { acc[j] += DN_ALPHA * x[j]; s += acc[j]; }
    const float mean = wave_sum(s) * (1.f / 1024.f); float q = 0.f;
#pragma unroll
    for (int j = 0; j < 16; ++j) { acc[j] -= mean; q += acc[j] * acc[j]; }
    const float rstd = rsqrtf(wave_sum(q) * (1.f / 1024.f) + LN_EPS);
#pragma unroll
    for (int hf = 0; hf < 2; ++hf) { const int c0 = hf * 512 + lane * 8; float ov[8];
#pragma unroll
        for (int j = 0; j < 8; ++j) ov[j] = acc[hf * 8 + j] * rstd * A.lng[c0 + j] + A.lnb[c0 + j];
        *(float4*)(A.X + (size_t)t * 1024 + c0) = make_float4(ov[0], ov[1], ov[2], ov[3]); *(float4*)(A.X + (size_t)t * 1024 + c0 + 4) = make_float4(ov[4], ov[5], ov[6], ov[7]);
        uint4 w; w.x = pk2(ov[0], ov[1]); w.y = pk2(ov[2], ov[3]); w.z = pk2(ov[4], ov[5]); w.w = pk2(ov[6], ov[7]); *(uint4*)(A.xb + (size_t)t * 1024 + c0) = w; }
}
__global__ void __launch_bounds__(512) peer_gather_kernel(PeerGArgs A) {
    const int lane = threadIdx.x & 63, wv = threadIdx.x >> 6;
    for (int t = blockIdx.x * 8 + wv; t < T_TOK; t += gridDim.x * 8) peer_gather_token(A, t, lane);
}

constexpr size_t MiB = 1u << 20;
constexpr size_t WS_CTL = 0, WS_W0IN = 1 * MiB, WS_WLR = 9 * MiB, WS_W0OUT = 10 * MiB, WS_WQ0 = 12 * MiB, WS_W1IN = 16 * MiB, WS_W1OUT = 24 * MiB, WS_WQ1 = 26 * MiB;
constexpr size_t WS_PK = 30 * MiB;
constexpr size_t WS_GATES = 31 * MiB, WS_CUM = 32 * MiB, WS_APP = 33 * MiB, WS_EID = 41 * MiB, WS_GATE = 49 * MiB, WS_ACTA = 57 * MiB;
constexpr size_t WS_TABU = 89 * MiB, WS_TABV = 121 * MiB, WS_P = 153 * MiB, WS_LRW = 281 * MiB, WS_LRA = 313 * MiB, WS_LRG = 329 * MiB, WS_END = 345 * MiB;
constexpr size_t WS_MIX = WS_P, WS_Q = WS_P + 64 * MiB;

template <class Epi> static void launch_gemm(hipStream_t st, const bf16_t* A, const bf16_t* Bt, int M, int N, int K, Epi E) {
    static bool attr_done = false;
    if (!attr_done) { (void)hipFuncSetAttribute((const void*)gemm_kernel<Epi>, hipFuncAttributeMaxDynamicSharedMemorySize, pg8::STAGE_BYTES); attr_done = true; }
    hipLaunchKernelGGL(gemm_kernel<Epi>, dim3(256), dim3(512), pg8::STAGE_BYTES, st, A, Bt, M, N, K, 0, E);
}
static void launch_transpose(hipStream_t st, const float* W, int K, int ldw, int c0, int N, bf16_t* WT) {
    hipLaunchKernelGGL(transpose_cvt_kernel, dim3((K / 64) * (N / 64)), dim3(256), 0, st, W, K, ldw, c0, N, WT);
}
static void launch_cvt(hipStream_t st, const float* src, bf16_t* dst, size_t n) {
    hipLaunchKernelGGL(cvt_bf16_kernel, dim3(2048), dim3(256), 0, st, src, dst, n / 8);
}

extern "C" void kernel_launch(void* const* d_in, const int* in_sizes, int n_in, void* d_out, int out_size, void* d_ws, size_t ws_size, hipStream_t stream) {
    if (n_in != 43 || ws_size < WS_END) { fprintf(stderr, "kernel_launch: unexpected n_in %d or ws_size %zu (< %zu)\n", n_in, ws_size, (size_t)WS_END); return; }
    const float* const* in = (const float* const*)d_in;
    unsigned char* ws = (unsigned char*)d_ws; float* out = (float*)d_out;
    bf16_t* W0IN = (bf16_t*)(ws + WS_W0IN); bf16_t* WLR = (bf16_t*)(ws + WS_WLR); bf16_t* W0OUT = (bf16_t*)(ws + WS_W0OUT); bf16_t* WQ0 = (bf16_t*)(ws + WS_WQ0);
    bf16_t* W1IN = (bf16_t*)(ws + WS_W1IN); bf16_t* W1OUT = (bf16_t*)(ws + WS_W1OUT); bf16_t* WQ1 = (bf16_t*)(ws + WS_WQ1); bf16_t* PK = (bf16_t*)(ws + WS_PK);
    float* GATES = (float*)(ws + WS_GATES); float* CUM = (float*)(ws + WS_CUM); bf16_t* APP = (bf16_t*)(ws + WS_APP); int* EID = (int*)(ws + WS_EID); float* GATE = (float*)(ws + WS_GATE);
    bf16_t* ACTA = (bf16_t*)(ws + WS_ACTA); bf16_t* TABU = (bf16_t*)(ws + WS_TABU); bf16_t* TABV = (bf16_t*)(ws + WS_TABV); bf16_t* P = (bf16_t*)(ws + WS_P);
    float* MIX = (float*)(ws + WS_MIX); bf16_t* Q = (bf16_t*)(ws + WS_Q); float* LRW = (float*)(ws + WS_LRW); bf16_t* LRA = (bf16_t*)(ws + WS_LRA); bf16_t* LRG = (bf16_t*)(ws + WS_LRG);
    static bool attr_done = false;
    if (!attr_done) {
        (void)hipFuncSetAttribute((const void*)gates_kernel<16>, hipFuncAttributeMaxDynamicSharedMemorySize, 16 * 4096);
        (void)hipFuncSetAttribute((const void*)gates_kernel<8>, hipFuncAttributeMaxDynamicSharedMemorySize, 8 * 4096);
        (void)hipFuncSetAttribute((const void*)rwkv_scan_kernel, hipFuncAttributeMaxDynamicSharedMemorySize, RW_LDS_BYTES);
        (void)hipFuncSetAttribute((const void*)mlstm_kernel, hipFuncAttributeMaxDynamicSharedMemorySize, ML_LDS_BYTES);
        (void)hipFuncSetAttribute((const void*)attn_valu_kernel, hipFuncAttributeMaxDynamicSharedMemorySize, AT_LDS_BYTES);
        (void)hipFuncSetAttribute((const void*)peer_scores_kernel, hipFuncAttributeMaxDynamicSharedMemorySize, PS_LDS_BYTES);
        attr_done = true;
    }
    launch_transpose(stream, in[1], 1024, L0_COLS, 0, L0_MAIN, W0IN);
    hipLaunchKernelGGL(build_wlr_kernel, dim3(1536), dim3(256), 0, stream, in[4], in[6], in[7], WLR);
    launch_transpose(stream, in[19], 1024, 1024, 0, 1024, W0OUT);
    launch_transpose(stream, in[22], 1024, 2048, 0, 2048, WQ0);
    launch_transpose(stream, in[29], 1024, L1_COLS, 0, L1_MAIN, W1IN);
    launch_transpose(stream, in[33], 1024, 1024, 0, 1024, W1OUT);
    launch_transpose(stream, in[36], 1024, 2048, 0, 2048, WQ1);
    launch_cvt(stream, in[23], PK, 131072); launch_cvt(stream, in[24], PK + 131072, 131072); launch_cvt(stream, in[37], PK + 262144, 131072); launch_cvt(stream, in[38], PK + 393216, 131072);
    launch_cvt(stream, in[0], ACTA, (size_t)T_TOK * 1024);
    launch_cvt(stream, in[25], TABU, (size_t)16384 * 1024); launch_cvt(stream, in[26], TABV, (size_t)16384 * 1024);
    launch_gemm(stream, ACTA, W0IN, T_TOK, L0_MAIN, 1024, pg8::EpiBf16P{P, L0_MAIN});
    hipLaunchKernelGGL(gates_kernel<8>, dim3(256), dim3(512), 8 * 4096, stream, in[0], in[1], L0_COLS, L0_MAIN, GATES);
    hipLaunchKernelGGL(rwkv_prep_kernel, dim3(T_TOK), dim3(256), 0, stream, P, in[2], APP);
    launch_gemm(stream, APP, WLR, T_TOK, 1536, 256, pg8::EpiLowrank{LRW, LRA, LRG, in[3], in[5]});
    { RwkvArgs a{P, LRW, LRA, LRG, in[2], in[8], in[9], in[10], in[11], in[12], ACTA}; hipLaunchKernelGGL(rwkv_scan_kernel, dim3(64), dim3(512), RW_LDS_BYTES, stream, a); }
    { MlstmArgs a{P, GATES, in[13], in[14], in[15], in[16], in[17], in[18], ACTA}; hipLaunchKernelGGL(mlstm_kernel, dim3(32), dim3(128), ML_LDS_BYTES, stream, a); }
    launch_gemm(stream, ACTA, W0OUT, T_TOK, 1024, 1024, pg8::EpiF32{MIX, 1024});
    hipLaunchKernelGGL(ln_kernel, dim3(512), dim3(512), 0, stream, in[0], MIX, in[20], in[21], out, ACTA);
    launch_gemm(stream, ACTA, WQ0, T_TOK, 2048, 1024, pg8::EpiBf16P{Q, 2048});
    { PeerSArgs a{Q, PK, PK + 131072, EID, GATE}; hipLaunchKernelGGL(peer_scores_kernel, dim3(512), dim3(512), PS_LDS_BYTES, stream, a); }
    { PeerGArgs a{out, EID, GATE, TABU, TABV, in[27], in[28], ACTA}; hipLaunchKernelGGL(peer_gather_kernel, dim3(1024), dim3(512), 0, stream, a); }
    launch_cvt(stream, in[39], TABU, (size_t)16384 * 1024); launch_cvt(stream, in[40], TABV, (size_t)16384 * 1024);
    launch_gemm(stream, ACTA, W1IN, T_TOK, L1_MAIN, 1024, pg8::EpiBf16P{P, L1_MAIN});
    hipLaunchKernelGGL(gates_kernel<16>, dim3(256), dim3(512), 16 * 4096, stream, (const float*)out, in[29], L1_COLS, L1_MAIN, GATES);
    hipLaunchKernelGGL(fox_cumsum_kernel, dim3(128), dim3(64), 0, stream, GATES, in[32], CUM);
    { AttnArgs a{P, CUM, in[30], in[31], ACTA}; hipLaunchKernelGGL(attn_valu_kernel, dim3(256), dim3(512), AT_LDS_BYTES, stream, a); }
    launch_gemm(stream, ACTA, W1OUT, T_TOK, 1024, 1024, pg8::EpiF32{MIX, 1024});
    hipLaunchKernelGGL(ln_kernel, dim3(512), dim3(512), 0, stream, (const float*)out, MIX, in[34], in[35], out, ACTA);
    launch_gemm(stream, ACTA, WQ1, T_TOK, 2048, 1024, pg8::EpiBf16P{Q, 2048});
    { PeerSArgs a{Q, PK + 262144, PK + 393216, EID, GATE}; hipLaunchKernelGGL(peer_scores_kernel, dim3(512), dim3(512), PS_LDS_BYTES, stream, a); }
    { PeerGArgs a{out, EID, GATE, TABU, TABV, in[41], in[42], ACTA}; hipLaunchKernelGGL(peer_gather_kernel, dim3(1024), dim3(512), 0, stream, a); }
}
```

```cpp
#include <hip/hip_runtime.h>
#include <cstdio>
#include <cstdint>
#include <cmath>
#include <cstring>
__device__ __forceinline__ int opaque_tid() { int t = (int)threadIdx.x; asm volatile("" : "+v"(t)); return t; }
namespace pg8 {
#define PG8_LAS __attribute__((address_space(3)))
typedef unsigned short bf16_t;
typedef short bf16x8 __attribute__((ext_vector_type(8)));
typedef float f32x4 __attribute__((ext_vector_type(4)));
typedef unsigned u32x4 __attribute__((ext_vector_type(4)));
constexpr int BM = 256, BK = 64, HALF = 128, HTB = HALF * BK * 2  , STAGE_BYTES = 8 * HTB, NXCD = 8, WGM = 8;

__host__ __device__ __forceinline__ int lds_byte(int r, int c) { const int st = (r >> 4) * 2 + (c >> 5), rr = r & 15, cc = c & 31, ob = rr * 64 + cc * 2; return st * 1024 + (ob ^ (((ob >> 9) & 1) << 5)); }
__host__ __device__ __forceinline__ void stage_rc(int b, int& R, int& C) { const int st = b / 1024, sb = b % 1024, swz = sb ^ (((sb >> 9) & 1) << 5); R = (st >> 1) * 16 + swz / 64; C = (st & 1) * 32 + (swz % 64) / 2; }
__host__ __device__ __forceinline__ int perm32(int rho) { const int n = rho >> 4, i = rho & 15; return 8 * (i >> 2) + 4 * n + (i & 3); }

struct Unit { int pm, pn; };
struct Gemm { const bf16_t* A; const bf16_t* Bt; int M, N, K; };

struct StaticOrder {
    int nM, nN, nwg, G, c;
    __host__ __device__ void init(int M, int N, int G_, int c_) { nM = M / BM; nN = N / BM; nwg = nM * nN; G = G_; c = c_; }
    __host__ __device__ bool next(int i, Unit& u) const {
        const long L = (long)i * G + c; if (L >= nwg) return false;
        int wgid = (int)L; { const int q = nwg / NXCD, r = nwg % NXCD, xcd = wgid % NXCD, off = wgid / NXCD; wgid = (xcd < r ? xcd * (q + 1) : r * (q + 1) + (xcd - r) * q) + off; }
        const int nig = WGM * nN, gid = wgid / nig, fm = gid * WGM, gsz = (nM - fm) < WGM ? (nM - fm) : WGM;
        u.pm = fm + ((wgid % nig) % gsz); u.pn = (wgid % nig) / gsz; return true;
    }
    __device__ __forceinline__ void a_ready(const Unit&) const {}
    __device__ __forceinline__ void done(const Unit&) const {}
};

__device__ __forceinline__ unsigned cvt_pk_bf16(float lo, float hi) { unsigned r; asm volatile("v_cvt_pk_bf16_f32 %0, %1, %2" : "=v"(r) : "v"(lo), "v"(hi)); return r; }
typedef float f32x2 __attribute__((ext_vector_type(2)));
__device__ __forceinline__ f32x2 gelu_pk(f32x2 v) {
    const f32x2 av = __builtin_elementwise_abs(v), d = av * 0.2316418882f + 1.0f;
    f32x2 t; t.x = __builtin_amdgcn_rcpf(d.x); t.y = __builtin_amdgcn_rcpf(d.y);
    f32x2 q = t * 0.5307027145f + (-0.7265760135f); q = q * t + 0.7107068705f; q = q * t + (-0.142248368f); q = q * t + 0.127414796f; q = q * t;
    const f32x2 s = (v * v) * (-0.72134752044f);
    f32x2 e; e.x = __builtin_amdgcn_exp2f(s.x); e.y = __builtin_amdgcn_exp2f(s.y);
    const f32x2 m = v * (q * e), r = v - m;
    f32x2 o; o.x = v.x < 0.f ? m.x : r.x; o.y = v.y < 0.f ? m.y : r.y; return o;
}

template <int ACT  > struct EpiBf16 {
    static constexpr bool PERM = true, AFTER_DRAIN = false; static_assert(ACT == 0 || ACT == 1, "EpiBf16: ACT is 0 (none) or 1 (gelu_pk)");
    bf16_t* O; int ldc; const float* bias; int split_cols; size_t split_stride; float scale0;
    __device__ __forceinline__ void operator()(const f32x4 (&acc)[2][2][4][2], const Unit& u, int wr, int wc, int fr, int fq) const {
        const int row0 = u.pm * BM + wr * 64 + fr; int colt = u.pn * BM; bf16_t* base = O;
        float sc = 1.f; if (split_cols) { const int t = colt / split_cols; base += (size_t)t * split_stride; colt -= t * split_cols; if (t == 0) sc = scale0; }
        const int col0 = colt + wc * 32 + 8 * fq, bcol0 = u.pn * BM + wc * 32 + 8 * fq;
        f32x4 bv[2][2];
#pragma unroll
        for (int bj = 0; bj < 2; ++bj)
#pragma unroll
            for (int n = 0; n < 2; ++n) bv[bj][n] = bias ? *(const f32x4*)(bias + bcol0 + bj * HALF + 4 * n) : (f32x4){0.f, 0.f, 0.f, 0.f};
#pragma unroll
        for (int ai = 0; ai < 2; ++ai)
#pragma unroll
            for (int m = 0; m < 4; ++m) { bf16_t* rowp = base + (size_t)(row0 + ai * HALF + m * 16) * ldc + col0;
#pragma unroll
                for (int bj = 0; bj < 2; ++bj) { f32x4 v0 = acc[ai][bj][m][0] + bv[bj][0], v1 = acc[ai][bj][m][1] + bv[bj][1];
                    if (ACT == 1) { f32x2 a = gelu_pk((f32x2){v0[0], v0[1]}), b = gelu_pk((f32x2){v0[2], v0[3]}), c = gelu_pk((f32x2){v1[0], v1[1]}), d = gelu_pk((f32x2){v1[2], v1[3]});
                        v0 = (f32x4){a.x, a.y, b.x, b.y}; v1 = (f32x4){c.x, c.y, d.x, d.y}; }
                    v0 = v0 * sc; v1 = v1 * sc; u32x4 w; w.x = cvt_pk_bf16(v0[0], v0[1]); w.y = cvt_pk_bf16(v0[2], v0[3]); w.z = cvt_pk_bf16(v1[0], v1[1]); w.w = cvt_pk_bf16(v1[2], v1[3]);
                    *(u32x4*)(rowp + bj * HALF) = w; } }
    }
};

struct PanelStats {
    unsigned* xbuf;
    unsigned* cnt;
    unsigned* tmo;
    int ntn; float eps;
    unsigned code;
    __device__ __forceinline__ bool run(const f32x4 (&v)[2][2][4][2], const Unit& u, int wr, int wc, int fr, int fq, PG8_LAS unsigned char* lds, int wid, int lane) const {
        typedef float f32x2v __attribute__((ext_vector_type(2)));
        PG8_LAS f32x2v* P = (PG8_LAS f32x2v*)lds;
        PG8_LAS f32x2v* S = (PG8_LAS f32x2v*)(lds + 8192);
        PG8_LAS unsigned* flag = (PG8_LAS unsigned*)(lds + 8192 + 2048);
#pragma unroll
        for (int ai = 0; ai < 2; ++ai)
#pragma unroll
            for (int m = 0; m < 4; ++m) {
                float s = 0.f;
#pragma unroll
                for (int bj = 0; bj < 2; ++bj)
#pragma unroll
                    for (int n = 0; n < 2; ++n) { const f32x4 x = v[ai][bj][m][n]; s += (x[0] + x[1]) + (x[2] + x[3]); }
                s += __shfl_xor(s, 16); s += __shfl_xor(s, 32);
                const float mw = s * (1.0f / 64.0f); float q = 0.f;
#pragma unroll
                for (int bj = 0; bj < 2; ++bj)
#pragma unroll
                    for (int n = 0; n < 2; ++n) { const f32x4 d = v[ai][bj][m][n] - mw; q += (d[0] * d[0] + d[1] * d[1]) + (d[2] * d[2] + d[3] * d[3]); }
                q += __shfl_xor(q, 16); q += __shfl_xor(q, 32);
                if (fq == 0) P[(ai * HALF + wr * 64 + m * 16 + fr) * 4 + wc] = (f32x2v){mw, q};
            }
        asm volatile("s_waitcnt lgkmcnt(0)" ::: "memory"); __builtin_amdgcn_s_barrier(); asm volatile("" ::: "memory");
#if defined(BROKEN_EXCHANGE_NO_WAIT)
#warning BROKEN CONTROL BUILD: the row-statistics exchange does not wait; results are wrong by design
        if (blockIdx.x >= 64) { const long long t0_ = clock64(); while (clock64() - t0_ < 60000) __builtin_amdgcn_s_sleep(8); }
#endif
        const int row = wid * 32 + (lane & 31);
        if (lane < 32) {
            const f32x2v a = P[row * 4 + 0], b = P[row * 4 + 1], c = P[row * 4 + 2], d = P[row * 4 + 3];
            const float mt = (a.x + b.x + c.x + d.x) * 0.25f;
            const float da = a.x - mt, db = b.x - mt, dc = c.x - mt, dd = d.x - mt;
            const float m2 = (a.y + b.y) + (c.y + d.y) + 64.0f * ((da * da + db * db) + (dc * dc + dd * dd));
            unsigned long long* slot = (unsigned long long*)xbuf + ((size_t)(u.pm * BM + row) * 4 + u.pn);
            __hip_atomic_store(slot, ((unsigned long long)__float_as_uint(m2) << 32) | __float_as_uint(mt), __ATOMIC_RELAXED, __HIP_MEMORY_SCOPE_AGENT);
        }
        asm volatile("s_waitcnt vmcnt(0)" ::: "memory");
        if (lane == 0) __hip_atomic_fetch_add(cnt + 64 * u.pm, 1u, __ATOMIC_RELAXED, __HIP_MEMORY_SCOPE_AGENT);
        if (wid == 0) {
            bool dead = false; const unsigned long long t0 = __builtin_amdgcn_s_memrealtime(); const unsigned want = 8u * (unsigned)ntn;
            for (;;) {
#if defined(BROKEN_EXCHANGE_NO_WAIT)
                break;
#endif
                if ((unsigned)__builtin_amdgcn_readfirstlane(__hip_atomic_load(cnt + 64 * u.pm, __ATOMIC_RELAXED, __HIP_MEMORY_SCOPE_AGENT)) >= want) break;
                if (__builtin_amdgcn_s_memrealtime() - t0 > 2000000ull) {
                    if (lane == 0) { unsigned expect = 0u; __hip_atomic_compare_exchange_strong(tmo + 1, &expect, code | (unsigned)(u.pm & 0xff), __ATOMIC_RELAXED, __ATOMIC_RELAXED, __HIP_MEMORY_SCOPE_AGENT);
                                     __hip_atomic_store(tmo, 1u, __ATOMIC_RELAXED, __HIP_MEMORY_SCOPE_AGENT); }
                    dead = true; break; }
                __builtin_amdgcn_s_sleep(2);
            }
            __builtin_amdgcn_fence(__ATOMIC_ACQUIRE, "agent");
            if (lane == 0) flag[0] = dead ? 1u : 0u;
        }
        asm volatile("s_waitcnt vmcnt(0) lgkmcnt(0)" ::: "memory"); __builtin_amdgcn_s_barrier(); asm volatile("" ::: "memory");
        const bool bad = flag[0] != 0u;
        if (lane < 32) {
            const unsigned long long* slot = (const unsigned long long*)xbuf + (size_t)(u.pm * BM + row) * 4; float mt[4], m2[4]; float ms = 0.f;
#pragma unroll
            for (int t = 0; t < 4; ++t) { if (t < ntn) { const unsigned long long w = __hip_atomic_load(slot + t, __ATOMIC_RELAXED, __HIP_MEMORY_SCOPE_AGENT); mt[t] = __uint_as_float((unsigned)w); m2[t] = __uint_as_float((unsigned)(w >> 32)); } else { mt[t] = 0.f; m2[t] = 0.f; } ms += mt[t]; }
            const float mean = ms / (float)ntn; float q = 0.f;
#pragma unroll
            for (int t = 0; t < 4; ++t) if (t < ntn) { const float dm = mt[t] - mean; q += m2[t] + 256.0f * dm * dm; }
            S[row] = (f32x2v){mean, 1.0f / sqrtf(q / (256.0f * (float)ntn) + eps)};
        }
        asm volatile("s_waitcnt lgkmcnt(0)" ::: "memory"); __builtin_amdgcn_s_barrier(); asm volatile("" ::: "memory");
        return bad;
    }
};
struct EpiLnRes {
    static constexpr bool PERM = false, AFTER_DRAIN = true;
    const float* base; float* out; int ldc; const float* bias; PanelStats st; unsigned poison;
    __device__ __forceinline__ void fused(f32x4 (&acc)[2][2][4][2], const Unit& u, int wr, int wc, int fr, int fq, PG8_LAS unsigned char* lds, int wid, int lane) const {
        typedef float f32x2v __attribute__((ext_vector_type(2)));
        const PG8_LAS f32x2v* S = (const PG8_LAS f32x2v*)(lds + 8192);
        const int col0 = u.pn * BM + wc * 32 + 4 * fq;
#pragma unroll
        for (int bj = 0; bj < 2; ++bj)
#pragma unroll
            for (int n = 0; n < 2; ++n) { const f32x4 bv = bias ? *(const f32x4*)(bias + col0 + bj * HALF + n * 16) : (f32x4){0.f, 0.f, 0.f, 0.f};
#pragma unroll
                for (int ai = 0; ai < 2; ++ai)
#pragma unroll
                    for (int m = 0; m < 4; ++m) acc[ai][bj][m][n] += bv; }
        f32x4 pre[4][2][2];
#pragma unroll
        for (int m = 0; m < 4; ++m) { const size_t off = (size_t)(u.pm * BM + wr * 64 + m * 16 + fr) * ldc + col0;
#pragma unroll
            for (int bj = 0; bj < 2; ++bj)
#pragma unroll
                for (int n = 0; n < 2; ++n) pre[m][bj][n] = *(const f32x4*)(base + off + bj * HALF + n * 16); }
        const bool bad = st.run(acc, u, wr, wc, fr, fq, lds, wid, lane) || poison != 0u;
        const float qnan = __builtin_nanf("");
#pragma unroll
        for (int ai = 0; ai < 2; ++ai)
#pragma unroll
            for (int m = 0; m < 4; ++m) { const int r = ai * HALF + wr * 64 + m * 16 + fr; const f32x2v sr = S[r]; const size_t off = (size_t)(u.pm * BM + r) * ldc + col0;
#pragma unroll
                for (int bj = 0; bj < 2; ++bj)
#pragma unroll
                    for (int n = 0; n < 2; ++n) { const f32x4 bs = ai == 0 ? pre[m][bj][n] : *(const f32x4*)(base + off + bj * HALF + n * 16); f32x4 o = bs + (acc[ai][bj][m][n] - sr.x) * sr.y;
                        if (bad) o = (f32x4){qnan, qnan, qnan, qnan}; *(f32x4*)(out + off + bj * HALF + n * 16) = o; }
                if (m & 1) asm volatile("" ::: "memory"); }
    }
};
struct EpiLnResLn {
    static constexpr bool PERM = false, AFTER_DRAIN = true;
    const float* base; float* out; bf16_t* xn; int ldc; const float* bias; PanelStats st1, st2; unsigned poison;
    __device__ __forceinline__ void fused(f32x4 (&acc)[2][2][4][2], const Unit& u, int wr, int wc, int fr, int fq, PG8_LAS unsigned char* lds, int wid, int lane) const {
        typedef float f32x2v __attribute__((ext_vector_type(2))); typedef unsigned u32x2v __attribute__((ext_vector_type(2)));
        const PG8_LAS f32x2v* S = (const PG8_LAS f32x2v*)(lds + 8192);
        const int col0 = u.pn * BM + wc * 32 + 4 * fq;
#pragma unroll
        for (int bj = 0; bj < 2; ++bj)
#pragma unroll
            for (int n = 0; n < 2; ++n) { const f32x4 bv = bias ? *(const f32x4*)(bias + col0 + bj * HALF + n * 16) : (f32x4){0.f, 0.f, 0.f, 0.f};
#pragma unroll
                for (int ai = 0; ai < 2; ++ai)
#pragma unroll
                    for (int m = 0; m < 4; ++m) acc[ai][bj][m][n] += bv; }
        bool bad = st1.run(acc, u, wr, wc, fr, fq, lds, wid, lane) || poison != 0u;
        const float qnan = __builtin_nanf("");
#pragma unroll
        for (int ai = 0; ai < 2; ++ai)
#pragma unroll
            for (int m = 0; m < 4; ++m) { const int r = ai * HALF + wr * 64 + m * 16 + fr; const f32x2v sr = S[r]; const size_t off = (size_t)(u.pm * BM + r) * ldc + col0;
#pragma unroll
                for (int bj = 0; bj < 2; ++bj)
#pragma unroll
                    for (int n = 0; n < 2; ++n) { const f32x4 bs = *(const f32x4*)(base + off + bj * HALF + n * 16); acc[ai][bj][m][n] = bs + (acc[ai][bj][m][n] - sr.x) * sr.y; }
                asm volatile("" : "+v"(acc[ai][0][m][0]), "+v"(acc[ai][0][m][1]), "+v"(acc[ai][1][m][0]), "+v"(acc[ai][1][m][1]));
                if (m & 1) asm volatile("" ::: "memory"); }
        const bool bad1 = bad;
        bad = st2.run(acc, u, wr, wc, fr, fq, lds, wid, lane) || bad;
#pragma unroll
        for (int ai = 0; ai < 2; ++ai)
#pragma unroll
            for (int m = 0; m < 4; ++m) { const int r = ai * HALF + wr * 64 + m * 16 + fr; const f32x2v sr = S[r]; const size_t off = (size_t)(u.pm * BM + r) * ldc + col0;
#pragma unroll
                for (int bj = 0; bj < 2; ++bj)
#pragma unroll
                    for (int n = 0; n < 2; ++n) { const f32x4 x1 = acc[ai][bj][m][n]; *(f32x4*)(out + off + bj * HALF + n * 16) = bad1 ? (f32x4){qnan, qnan, qnan, qnan} : x1;
                        const f32x4 o = (x1 - sr.x) * sr.y; u32x2v w; w.x = cvt_pk_bf16(o[0], o[1]); w.y = cvt_pk_bf16(o[2], o[3]);
                        if (bad) { w.x = 0x7fc07fc0u; w.y = 0x7fc07fc0u; } *(u32x2v*)(xn + off + bj * HALF + n * 16) = w; }
                asm volatile("" ::: "memory"); }
    }
};

template <class Epi, class Sched, bool ALIGN_EPI = false, bool SP2 = false>
__device__ __forceinline__ void gemm_phase(PG8_LAS unsigned char* lds, const Gemm g, const Sched& S, const Epi& E) {
    const int tid = opaque_tid(), wid = __builtin_amdgcn_readfirstlane(tid >> 6), lane = tid & 63, wr = wid >> 2, wc = wid & 3, fr = lane & 15, fq = lane >> 4;
    const int K = g.K, nt = K / BK;
    unsigned voffA[2], voffB[2];
#pragma unroll
    for (int i = 0; i < 2; ++i) { int R, C; stage_rc(tid * 16 + i * 8192, R, C); const int Rb = Epi::PERM ? ((R & ~31) + perm32(R & 31)) : R;
        voffA[i] = (unsigned)(R * K + C) * 2u; voffB[i] = (unsigned)(Rb * K + C) * 2u; }
    const size_t kstep = (size_t)(BK * 2);
    const size_t hstep = (size_t)HALF * K * 2;
    const size_t tstep = 2 * hstep;
    const unsigned ldsw = (unsigned)wid * 1024u;
    const int aoff = lds_byte(wr * 64 + fr, fq * 8), boff = lds_byte(wc * 32 + fr, fq * 8);
#define PG8_SA(b, h) (((b) * 2 + (h)) * HTB)
#define PG8_SB(b, h) ((4 + (b) * 2 + (h)) * HTB)
#define PG8_STAGE(bufoff, gbase, voff) do { _Pragma("unroll") for (int _i = 0; _i < 2; ++_i) \
        __builtin_amdgcn_global_load_lds((const unsigned*)((const char*)(gbase) + (voff)[_i]), (PG8_LAS unsigned*)(lds + (bufoff) + ldsw + _i * 8192), 16, 0, 0); } while (0)
#define PG8_LDA(dst, b, h) do { _Pragma("unroll") for (int m = 0; m < 4; ++m) _Pragma("unroll") for (int k = 0; k < 2; ++k) dst[m][k] = *(const PG8_LAS bf16x8*)(lds + PG8_SA(b, h) + aoff + m * 2048 + k * 1024); } while (0)
#define PG8_LDB(dst, b, h) do { _Pragma("unroll") for (int n = 0; n < 2; ++n) _Pragma("unroll") for (int k = 0; k < 2; ++k) dst[n][k] = *(const PG8_LAS bf16x8*)(lds + PG8_SB(b, h) + boff + n * 2048 + k * 1024); } while (0)
#define PG8_MMA(ai, bj, At, Bt) do { __builtin_amdgcn_s_setprio(1); _Pragma("unroll") for (int m = 0; m < 4; ++m) _Pragma("unroll") for (int n = 0; n < 2; ++n) _Pragma("unroll") for (int k = 0; k < 2; ++k) \
        acc[ai][bj][m][n] = __builtin_amdgcn_mfma_f32_16x16x32_bf16(Bt[n][k], At[m][k], acc[ai][bj][m][n], 0, 0, 0); __builtin_amdgcn_s_setprio(0); } while (0)
#define PG8_WAIT_V(n) asm volatile("s_waitcnt vmcnt(" #n ")" ::: "memory")
#define PG8_WAIT_L(n) asm volatile("s_waitcnt lgkmcnt(" #n ")" ::: "memory")
#define PG8_BAR __builtin_amdgcn_s_barrier()
#define PG8_SCHED __builtin_amdgcn_sched_barrier(0)
    Unit cur, nxt; int ui = 0;
    if (!S.next(0, cur)) return;
    f32x4 acc[2][2][4][2];
#pragma unroll
    for (int a = 0; a < 2; ++a)
#pragma unroll
        for (int b = 0; b < 2; ++b)
#pragma unroll
            for (int m = 0; m < 4; ++m)
#pragma unroll
                for (int n = 0; n < 2; ++n) acc[a][b][m][n] = (f32x4){0.f, 0.f, 0.f, 0.f};
    bf16x8 At[4][2], B0[2][2], B1[2][2];
    const char* cA = (const char*)g.A + (size_t)cur.pm * tstep; const char* cB = (const char*)g.Bt + (size_t)cur.pn * tstep;
    S.a_ready(cur);
    if constexpr (SP2) {
        PG8_STAGE(PG8_SB(0, 0), cB, voffB); PG8_STAGE(PG8_SB(0, 1), cB + hstep, voffB); PG8_STAGE(PG8_SA(0, 0), cA, voffA); PG8_STAGE(PG8_SA(0, 1), cA + hstep, voffA);
        if (wr == 1) PG8_BAR;
        PG8_WAIT_V(2); PG8_BAR;
        PG8_STAGE(PG8_SB(1, 0), cB + kstep, voffB); PG8_STAGE(PG8_SA(1, 0), cA + kstep, voffA); PG8_STAGE(PG8_SB(1, 1), cB + hstep + kstep, voffB);
        PG8_WAIT_V(6); PG8_BAR;
    } else {
        PG8_STAGE(PG8_SB(0, 0), cB, voffB); PG8_STAGE(PG8_SA(0, 0), cA, voffA); PG8_STAGE(PG8_SB(0, 1), cB + hstep, voffB); PG8_STAGE(PG8_SA(0, 1), cA + hstep, voffA);
        if (wr == 1) PG8_BAR;
        PG8_WAIT_V(4); PG8_BAR;
        PG8_STAGE(PG8_SB(1, 0), cB + kstep, voffB); PG8_STAGE(PG8_SA(1, 0), cA + kstep, voffA); PG8_STAGE(PG8_SB(1, 1), cB + hstep + kstep, voffB);
        PG8_WAIT_V(6); PG8_BAR;
    }
    for (;;) {
        const bool has_next = S.next(ui + 1, nxt);
        const char* nA = has_next ? (const char*)g.A + (size_t)nxt.pm * tstep : cA; const char* nB = has_next ? (const char*)g.Bt + (size_t)nxt.pn * tstep : cB;
        for (int t = 0; t < nt; t += 2) {
            const bool last = (t == nt - 2);
            const char* a1 = cA + (size_t)(t + 1) * kstep;
            const char* a2 = last ? nA : cA + (size_t)(t + 2) * kstep; const char* b2 = last ? nB : cB + (size_t)(t + 2) * kstep;
            const char* a3 = a2 + kstep; const char* b3 = b2 + kstep;
            if (last && has_next) S.a_ready(nxt);
            if constexpr (SP2) {
            PG8_LDB(B0, 0, 0); PG8_LDB(B1, 0, 1); PG8_SCHED; PG8_LDA(At, 0, 0); PG8_STAGE(PG8_SA(1, 1), a1 + hstep, voffA);
            PG8_WAIT_V(8); PG8_WAIT_L(0); PG8_BAR; PG8_MMA(0, 0, At, B0); PG8_MMA(0, 1, At, B1); PG8_BAR; PG8_SCHED;
            PG8_LDA(At, 0, 1); PG8_STAGE(PG8_SB(0, 0), b2, voffB); PG8_STAGE(PG8_SB(0, 1), b2 + hstep, voffB); PG8_STAGE(PG8_SA(0, 0), a2, voffA);
            PG8_WAIT_V(8); PG8_WAIT_L(0); PG8_BAR; PG8_MMA(1, 0, At, B0); PG8_MMA(1, 1, At, B1); PG8_BAR; PG8_SCHED;
            PG8_LDB(B0, 1, 0); PG8_LDB(B1, 1, 1); PG8_SCHED; PG8_LDA(At, 1, 0); PG8_STAGE(PG8_SA(0, 1), a2 + hstep, voffA);
            PG8_WAIT_V(8); PG8_WAIT_L(0); PG8_BAR; PG8_MMA(0, 0, At, B0); PG8_MMA(0, 1, At, B1); PG8_BAR; PG8_SCHED;
            PG8_LDA(At, 1, 1); PG8_STAGE(PG8_SB(1, 0), b3, voffB); PG8_STAGE(PG8_SB(1, 1), b3 + hstep, voffB); PG8_STAGE(PG8_SA(1, 0), a3, voffA);
            PG8_WAIT_V(8); PG8_WAIT_L(0); PG8_BAR; PG8_MMA(1, 0, At, B0); PG8_MMA(1, 1, At, B1); PG8_BAR; PG8_SCHED;
            } else {
            PG8_LDB(B0, 0, 0); PG8_SCHED; PG8_LDA(At, 0, 0); PG8_STAGE(PG8_SA(1, 1), a1 + hstep, voffA);
            PG8_WAIT_L(8); PG8_BAR; PG8_WAIT_L(0); PG8_MMA(0, 0, At, B0); PG8_BAR; PG8_SCHED;
            PG8_LDB(B1, 0, 1); PG8_STAGE(PG8_SB(0, 0), b2, voffB);
            PG8_BAR; PG8_WAIT_L(0); PG8_MMA(0, 1, At, B1); PG8_BAR;
            PG8_LDA(At, 0, 1); PG8_STAGE(PG8_SA(0, 0), a2, voffA);
            PG8_BAR; PG8_WAIT_L(0); PG8_MMA(1, 0, At, B0); PG8_BAR; PG8_SCHED;
            PG8_STAGE(PG8_SB(0, 1), b2 + hstep, voffB);
            PG8_WAIT_V(6); PG8_BAR; PG8_MMA(1, 1, At, B1); PG8_BAR;
            PG8_LDB(B0, 1, 0); PG8_SCHED; PG8_LDA(At, 1, 0); PG8_STAGE(PG8_SA(0, 1), a2 + hstep, voffA);
            PG8_WAIT_L(8); PG8_BAR; PG8_WAIT_L(0); PG8_MMA(0, 0, At, B0); PG8_BAR; PG8_SCHED;
            PG8_LDB(B1, 1, 1); PG8_STAGE(PG8_SB(1, 0), b3, voffB);
            PG8_BAR; PG8_WAIT_L(0); PG8_MMA(0, 1, At, B1); PG8_BAR;
            PG8_LDA(At, 1, 1); PG8_STAGE(PG8_SA(1, 0), a3, voffA);
            PG8_BAR; PG8_WAIT_L(0); PG8_MMA(1, 0, At, B0); PG8_BAR; PG8_SCHED;
            PG8_STAGE(PG8_SB(1, 1), b3 + hstep, voffB);
            PG8_WAIT_V(6); PG8_BAR; PG8_MMA(1, 1, At, B1); PG8_BAR;
            }
        }
        if constexpr (ALIGN_EPI) { if (wr == 0) PG8_BAR; }
        if constexpr (!Epi::AFTER_DRAIN) { E(acc, cur, wr, wc, fr, fq); S.done(cur); }
        if (!has_next) break;
#pragma unroll
        for (int a = 0; a < 2; ++a)
#pragma unroll
            for (int b = 0; b < 2; ++b)
#pragma unroll
                for (int m = 0; m < 4; ++m)
#pragma unroll
                    for (int n = 0; n < 2; ++n) acc[a][b][m][n] = (f32x4){0.f, 0.f, 0.f, 0.f};
        cur = nxt; cA = nA; cB = nB; ++ui;
        if constexpr (ALIGN_EPI) { if (wr == 1) PG8_BAR; }
    }
    PG8_WAIT_V(0);
    if constexpr (!ALIGN_EPI) { if (wr == 0) PG8_BAR; }
    PG8_BAR;
    if constexpr (Epi::AFTER_DRAIN) { E.fused(acc, cur, wr, wc, fr, fq, lds, wid, lane); S.done(cur); }
#undef PG8_SA
#undef PG8_SB
#undef PG8_STAGE
#undef PG8_LDA
#undef PG8_LDB
#undef PG8_MMA
#undef PG8_WAIT_V
#undef PG8_WAIT_L
#undef PG8_BAR
#undef PG8_SCHED
}
}
#define GAS __attribute__((address_space(1)))
#define LAS __attribute__((address_space(3)))
typedef GAS unsigned gu32;
typedef GAS unsigned long long gu64;
#define RLX_AGENT __ATOMIC_RELAXED, __HIP_MEMORY_SCOPE_AGENT
#define XB_TMO      128
#define XB_XCNT(j)  (256  + 64 * (j))
#define XB_XSUB(j)  (1280 + 64 * (j))
#define XB_XGEN(j)  (2304 + 64 * (j))
#define XB_TOP      3328
#define XB_TOPGEN   3392
#define XCD_BAR_WORDS 3456
#define XB_SPIN_CAP (1u << 18)

__device__ __forceinline__ unsigned xb_ld(unsigned* p)              { return __hip_atomic_load(p, __ATOMIC_RELAXED, __HIP_MEMORY_SCOPE_AGENT); }
__device__ __forceinline__ unsigned xb_add(unsigned* p, unsigned v) { return __hip_atomic_fetch_add(p, v, __ATOMIC_RELAXED, __HIP_MEMORY_SCOPE_AGENT); }
__device__ __forceinline__ unsigned xb_xcc_id() { return (unsigned)__builtin_amdgcn_s_getreg((3 << 11) | 20) & 0xFu; }
#define XB_SPIN(cond, bar) do { unsigned _sp = 0; while (cond) { __builtin_amdgcn_s_sleep(1); \
    if ((++_sp & 255u) == 0u) { if (xb_ld(&(bar)[XB_TMO])) break; if (_sp > XB_SPIN_CAP) { atomicAdd(&(bar)[XB_TMO], 1u); break; } } } } while (0)

struct XcdBarrier {
    unsigned* bar; unsigned x;
    volatile LAS unsigned* st;
};

__device__ __forceinline__ XcdBarrier xcd_barrier_post(unsigned* bar, volatile LAS unsigned* st) {
    XcdBarrier b; b.bar = bar; b.x = xb_xcc_id(); b.st = st;
    if (threadIdx.x == 0) (void)xb_add(&bar[XB_XCNT(b.x)], 1u);
    return b;
}
__device__ __forceinline__ void xcd_barrier_complete(unsigned* bar, unsigned x, unsigned& nloc, unsigned& nx) {
    const unsigned G = gridDim.x * gridDim.y * gridDim.z;
    unsigned sum, cnt, mine, sp = 0u;
    for (;;) {
        sum = 0u; cnt = 0u; mine = 0u;
#pragma unroll
        for (unsigned j = 0; j < 16; ++j) { const unsigned c = xb_ld(&bar[XB_XCNT(j)]); sum += c; cnt += (c > 0u) ? 1u : 0u; mine = (j == x) ? c : mine; }
        if (sum == G) break;
        __builtin_amdgcn_s_sleep(1);
        if ((++sp & 255u) == 0u) { if (xb_ld(&bar[XB_TMO])) break; if (sp > XB_SPIN_CAP) { atomicAdd(&bar[XB_TMO], 1u); break; } }
    }
    nloc = mine > 0u ? mine : 1u; nx = cnt > 0u ? cnt : 1u;
}

__device__ __forceinline__ void xcd_barrier(const XcdBarrier& b) {
    asm volatile("s_waitcnt vmcnt(0)" ::: "memory");
    __syncthreads();
    if (threadIdx.x == 0) {
        unsigned* bar = b.bar;
        __builtin_amdgcn_s_waitcnt(0);
        unsigned nloc = b.st[0], nx = b.st[1];
        if (nloc == 0u) { xcd_barrier_complete(bar, b.x, nloc, nx); b.st[0] = nloc; b.st[1] = nx; }
        const unsigned old = xb_add(&bar[XB_XSUB(b.x)], 1u);
        const unsigned gen = old / nloc;
        if (old + 1u == (gen + 1u) * nloc) {
            __builtin_amdgcn_fence(__ATOMIC_RELEASE, "agent");
            asm volatile("s_waitcnt vmcnt(0)" ::: "memory");
            const unsigned og = xb_add(&bar[XB_TOP], 1u);
            const unsigned tg = og / nx;
            if (og + 1u == (tg + 1u) * nx) xb_add(&bar[XB_TOPGEN], 1u);
            else XB_SPIN(xb_ld(&bar[XB_TOPGEN]) == tg, bar);
            __builtin_amdgcn_fence(__ATOMIC_ACQUIRE, "agent");
            xb_add(&bar[XB_XGEN(b.x)], 1u);
            asm volatile("s_waitcnt vmcnt(0)" ::: "memory");
        } else {
            XB_SPIN(xb_ld(&bar[XB_XGEN(b.x)]) == gen, bar);
            __builtin_amdgcn_fence(__ATOMIC_ACQUIRE, "agent");
            asm volatile("s_waitcnt vmcnt(0)" ::: "memory");
        }
    }
    __syncthreads();
}

typedef unsigned short bf16_t;
typedef short bf16x8_t __attribute__((ext_vector_type(8)));
typedef float f32x4_t __attribute__((ext_vector_type(4)));
constexpr int T_TOK = 16384, DM = 1024, SEQ = 2048, NBATCH = 8;
constexpr int L0_COLS = 3848, L0_MAIN = 3840, L1_COLS = 4112, L1_MAIN = 4096;
constexpr float DN_ALPHA = 1.4142135623730951f;
constexpr float LN_EPS = 1e-5f;
constexpr int NTHR = 512;

__device__ __forceinline__ unsigned f2bf(float f) { unsigned u = __float_as_uint(f); return (u + 0x7fffu + ((u >> 16) & 1u)) >> 16; }
__device__ __forceinline__ unsigned pk2(float lo, float hi) { return f2bf(lo) | (f2bf(hi) << 16); }
__device__ __forceinline__ float bflo(unsigned w) { return __uint_as_float(w << 16); }
__device__ __forceinline__ float bfhi(unsigned w) { return __uint_as_float(w & 0xffff0000u); }
__device__ __forceinline__ float bf2f(bf16_t h) { return __uint_as_float(((unsigned)h) << 16); }
__device__ __forceinline__ float wave_sum(float v) {
#pragma unroll
    for (int o = 32; o >= 1; o >>= 1) v += __shfl_xor(v, o);
    return v;
}
__device__ __forceinline__ float sigmoid_f(float x) { return 1.0f / (1.0f + __expf(-x)); }
__device__ __forceinline__ float log_sigmoid_f(float x) { return fminf(x, 0.f) - log1pf(__expf(-fabsf(x))); }
__device__ __forceinline__ void unpack8(const uint4 w, float* f) {
    f[0] = bflo(w.x); f[1] = bfhi(w.x); f[2] = bflo(w.y); f[3] = bfhi(w.y); f[4] = bflo(w.z); f[5] = bfhi(w.z); f[6] = bflo(w.w); f[7] = bfhi(w.w);
}
__device__ __forceinline__ void unpack4(const uint2 w, float* f) { f[0] = bflo(w.x); f[1] = bfhi(w.x); f[2] = bflo(w.y); f[3] = bfhi(w.y); }

__device__ __forceinline__ void transpose_cvt_phase(const float* __restrict__ W, int K, int ldw, int c0, int N, bf16_t* __restrict__ WT, int bid, int nblk, float* tile  ) {
    const int nb = N / 64, nunits = (K / 64) * nb;
    for (int u = bid; u < nunits; u += nblk) {
        const int kb = u / nb, nbi = u % nb; const int k0 = kb * 64, n0 = nbi * 64;
        for (int i = opaque_tid(); i < 4096; i += NTHR) { const int kk = i >> 6, nn = i & 63; tile[kk * 65 + nn] = W[(size_t)(k0 + kk) * ldw + c0 + n0 + nn]; }
        __syncthreads();
        for (int i = opaque_tid(); i < 2048; i += NTHR) { const int nn = i >> 5, kp = (i & 31) * 2;
            const unsigned v = pk2(tile[kp * 65 + nn], tile[(kp + 1) * 65 + nn]); *(unsigned*)(WT + (size_t)(n0 + nn) * K + k0 + kp) = v; }
        __syncthreads();
    }
}
__device__ __forceinline__ void cvt_bf16_phase(const float* __restrict__ src, bf16_t* __restrict__ dst, size_t n8, int bid, int nblk) {
    for (size_t i = (size_t)bid * NTHR + opaque_tid(); i < n8; i += (size_t)nblk * NTHR) {
        const float4 a = ((const float4*)src)[2 * i], b = ((const float4*)src)[2 * i + 1];
        uint4 o; o.x = pk2(a.x, a.y); o.y = pk2(a.z, a.w); o.z = pk2(b.x, b.y); o.w = pk2(b.z, b.w); ((uint4*)dst)[i] = o; }
}
__device__ __forceinline__ void build_wlr_phase(const float* __restrict__ w_up, const float* __restrict__ a_up, const float* __restrict__ g_up, bf16_t* __restrict__ WT, int bid, int nblk) {
    for (int i = bid * NTHR + opaque_tid(); i < 1536 * 256; i += nblk * NTHR) { const int n = i >> 8, k = i & 255; float v = 0.f;
        if (n < 512) { if (k < 64) v = w_up[k * 512 + n]; }
        else if (n < 1024) { if (k >= 64 && k < 128) v = a_up[(k - 64) * 512 + (n - 512)]; }
        else { if (k >= 128) v = g_up[(k - 128) * 512 + (n - 1024)]; }
        WT[i] = (bf16_t)f2bf(v); }
}

namespace pg8 {
struct EpiF32 {
    static constexpr bool PERM = false, AFTER_DRAIN = false;
    float* C; long ldc;
    __device__ __forceinline__ void operator()(const f32x4 (&acc)[2][2][4][2], const Unit& u, int wr, int wc, int fr, int fq) const {
        const int row0 = u.pm * BM + wr * 64 + fr, col0 = u.pn * BM + wc * 32 + 4 * fq;
#pragma unroll
        for (int ai = 0; ai < 2; ++ai)
#pragma unroll
            for (int m = 0; m < 4; ++m) { float* rowp = C + (size_t)(row0 + ai * HALF + m * 16) * ldc + col0;
#pragma unroll
                for (int bj = 0; bj < 2; ++bj)
#pragma unroll
                    for (int n = 0; n < 2; ++n) *(f32x4*)(rowp + bj * HALF + n * 16) = acc[ai][bj][m][n]; }
    }
};
struct EpiBf16P {
    static constexpr bool PERM = true, AFTER_DRAIN = false;
    bf16_t* O; long ldc;
    __device__ __forceinline__ void operator()(const f32x4 (&acc)[2][2][4][2], const Unit& u, int wr, int wc, int fr, int fq) const {
        const int row0 = u.pm * BM + wr * 64 + fr; const int col0 = u.pn * BM + wc * 32 + 8 * fq;
#pragma unroll
        for (int ai = 0; ai < 2; ++ai)
#pragma unroll
            for (int m = 0; m < 4; ++m) { bf16_t* rowp = O + (size_t)(row0 + ai * HALF + m * 16) * ldc + col0;
#pragma unroll
                for (int bj = 0; bj < 2; ++bj) { const f32x4 v0 = acc[ai][bj][m][0], v1 = acc[ai][bj][m][1];
                    u32x4 w; w.x = cvt_pk_bf16(v0[0], v0[1]); w.y = cvt_pk_bf16(v0[2], v0[3]); w.z = cvt_pk_bf16(v1[0], v1[1]); w.w = cvt_pk_bf16(v1[2], v1[3]);
                    *(u32x4*)(rowp + bj * HALF) = w; } }
    }
};
struct EpiLowrank {
    static constexpr bool PERM = false, AFTER_DRAIN = false;
    float* lrw; bf16_t* lra; bf16_t* lrg; const float* w0; const float* a0;
    __device__ __forceinline__ void operator()(const f32x4 (&acc)[2][2][4][2], const Unit& u, int wr, int wc, int fr, int fq) const {
        const int row0 = u.pm * BM + wr * 64 + fr; const int sel = u.pn >> 1; const int colb = (u.pn & 1) * BM + wc * 32 + 4 * fq;
#pragma unroll
        for (int ai = 0; ai < 2; ++ai)
#pragma unroll
            for (int m = 0; m < 4; ++m) { const size_t rowoff = (size_t)(row0 + ai * HALF + m * 16) * 512;
#pragma unroll
                for (int bj = 0; bj < 2; ++bj)
#pragma unroll
                    for (int n = 0; n < 2; ++n) { const int c = colb + bj * HALF + n * 16; f32x4 v = acc[ai][bj][m][n];
                        if (sel == 0) { const f32x4 bv = *(const f32x4*)(w0 + c); *(f32x4*)(lrw + rowoff + c) = v + bv; }
                        else if (sel == 1) { const f32x4 bv = *(const f32x4*)(a0 + c); v = v + bv; uint2 o; o.x = pk2(v[0], v[1]); o.y = pk2(v[2], v[3]); *(uint2*)(lra + rowoff + c) = o; }
                        else { uint2 o; o.x = pk2(v[0], v[1]); o.y = pk2(v[2], v[3]); *(uint2*)(lrg + rowoff + c) = o; } } }
    }
};
}

template <int NG>
__device__ __forceinline__ void gates_phase(const float* X, const float* __restrict__ W, int ldw, int c0, float* __restrict__ out, int bid, int nblk, float* wg  ) {
    for (int i = opaque_tid(); i < NG * 1024; i += NTHR) { const int k = i / NG, g = i % NG; wg[g * 1024 + k] = W[(size_t)k * ldw + c0 + g]; }
    __syncthreads();
    const int lane = opaque_tid() & 63, wv = opaque_tid() >> 6;
    for (int t = bid * 8 + wv; t < T_TOK; t += nblk * 8) {
        float x[16];
#pragma unroll
        for (int j = 0; j < 16; ++j) x[j] = X[(size_t)t * 1024 + lane + 64 * j];
#pragma unroll 1
        for (int g = 0; g < NG; ++g) { float p = 0.f;
#pragma unroll
            for (int j = 0; j < 16; ++j) p += x[j] * wg[g * 1024 + lane + 64 * j];
            p = wave_sum(p); if (lane == 0) out[(size_t)t * 16 + g] = p; }
    }
    __syncthreads();
}
__device__ __forceinline__ void rwkv_prep_phase(const bf16_t* __restrict__ P0, const float* __restrict__ mu, bf16_t* __restrict__ App, int bid, int nblk) {
    for (size_t i = (size_t)bid * NTHR + opaque_tid(); i < (size_t)T_TOK * 256; i += (size_t)nblk * NTHR) {
        const int t = (int)(i >> 8), c = (int)(i & 255), col = 1536 + c;
        const float cur = bf2f(P0[(size_t)t * L0_MAIN + col]); const float prev = (t % SEQ) ? bf2f(P0[(size_t)(t - 1) * L0_MAIN + col]) : 0.f;
        float v = cur + (prev - cur) * mu[col];
        if (c < 64) v = tanhf(v); else if (c >= 128) v = sigmoid_f(v);
        App[i] = (bf16_t)f2bf(v); }
}
__device__ __forceinline__ void ln_phase(const float* xin, const float* mix, const float* g, const float* b, float* xout, bf16_t* xb, int bid, int nblk) {
    const int lane = opaque_tid() & 63, wv = opaque_tid() >> 6;
    for (int t = bid * 8 + wv; t < T_TOK; t += nblk * 8) {
        float4 y[4]; float s = 0.f;
#pragma unroll
        for (int j = 0; j < 4; ++j) { const float4 a = *(const float4*)(xin + (size_t)t * 1024 + 4 * lane + 256 * j), m = *(const float4*)(mix + (size_t)t * 1024 + 4 * lane + 256 * j);
            y[j].x = DN_ALPHA * a.x + m.x; y[j].y = DN_ALPHA * a.y + m.y; y[j].z = DN_ALPHA * a.z + m.z; y[j].w = DN_ALPHA * a.w + m.w; s += (y[j].x + y[j].y) + (y[j].z + y[j].w); }
        const float mean = wave_sum(s) * (1.f / 1024.f); float q = 0.f;
#pragma unroll
        for (int j = 0; j < 4; ++j) { y[j].x -= mean; y[j].y -= mean; y[j].z -= mean; y[j].w -= mean; q += (y[j].x * y[j].x + y[j].y * y[j].y) + (y[j].z * y[j].z + y[j].w * y[j].w); }
        const float rstd = rsqrtf(wave_sum(q) * (1.f / 1024.f) + LN_EPS);
#pragma unroll
        for (int j = 0; j < 4; ++j) { const float4 gg = *(const float4*)(g + 4 * lane + 256 * j), bb = *(const float4*)(b + 4 * lane + 256 * j);
            float4 o; o.x = y[j].x * rstd * gg.x + bb.x; o.y = y[j].y * rstd * gg.y + bb.y; o.z = y[j].z * rstd * gg.z + bb.z; o.w = y[j].w * rstd * gg.w + bb.w;
            *(float4*)(xout + (size_t)t * 1024 + 4 * lane + 256 * j) = o; uint2 w; w.x = pk2(o.x, o.y); w.y = pk2(o.z, o.w); *(uint2*)(xb + (size_t)t * 1024 + 4 * lane + 256 * j) = w; }
    }
}
__device__ __forceinline__ void fox_cumsum_phase(const float* __restrict__ gates, const float* __restrict__ f_b, float* __restrict__ cum, int bid, int nblk) {
    const int lane = opaque_tid() & 63, wv = opaque_tid() >> 6;
    for (int bh = bid * 8 + wv; bh < 128; bh += nblk * 8) {
        const int b = bh >> 4, h = bh & 15; const float fb = f_b[h];
        float lf[32]; double run = 0.0;
#pragma unroll
        for (int j = 0; j < 32; ++j) { const int s = lane * 32 + j; lf[j] = log_sigmoid_f(gates[((size_t)b * SEQ + s) * 16 + h] + fb); run += (double)lf[j]; }
        double incl = run;
#pragma unroll
        for (int o = 1; o < 64; o <<= 1) { const double v = __shfl_up(incl, o); if (lane >= o) incl += v; }
        double acc = incl - run;
#pragma unroll
        for (int j = 0; j < 32; ++j) { acc += (double)lf[j]; cum[(size_t)bh * SEQ + lane * 32 + j] = (float)acc; }
    }
}

struct RwkvArgs { const bf16_t* P0; const float* lrw; const bf16_t* lra; const bf16_t* lrg; const float* mu; const float* k_k; const float* k_a; const float* r_k; const float* ln_g; const float* ln_b; bf16_t* ycat; };
constexpr int RW_CS = 32;
constexpr int RW_LDS_BYTES = 8 * RW_CS * 64 * 4;

#define RW_LOAD_RAW(chunk) do { const int sg_ = (chunk) * RW_CS + ls; const size_t row_ = tok0 + sg_; \
    const bf16_t* pc_ = A.P0 + row_ * L0_MAIN + hc; \
    rc = *(const uint2*)(pc_); kc = *(const uint2*)(pc_ + 512); vc = *(const uint2*)(pc_ + 1024); \
    if (sg_ > 0) { const bf16_t* pp_ = pc_ - L0_MAIN; rp = *(const uint2*)(pp_); kp = *(const uint2*)(pp_ + 512); vp = *(const uint2*)(pp_ + 1024); } \
    else { rp = make_uint2(0u, 0u); kp = rp; vp = rp; } \
    rwl = *(const float4*)(A.lrw + row_ * 512 + hc); ra = *(const uint2*)(A.lra + row_ * 512 + hc); rg = *(const uint2*)(A.lrg + row_ * 512 + hc); } while (0)

__device__ __forceinline__ void rwkv_scan_unit(const RwkvArgs& A, int bh, float* smem) {
    const int tid = opaque_tid(); const int b = bh >> 3, h = bh & 7;
    float* sr = smem; float* sw = sr + 2048; float* sk = sw + 2048; float* skk = sk + 2048; float* snb = skk + 2048; float* sv = snb + 2048; float* sg = sv + 2048; float* sy = sg + 2048;
    const int ls = tid >> 4, lc = (tid & 15) * 4; const int hc = h * 64 + lc;
    float c_mur[4], c_muk[4], c_muv[4], c_kk[4], c_ka[4], c_rk[4], c_lng[4], c_lnb[4];
#pragma unroll
    for (int j = 0; j < 4; ++j) { c_mur[j] = A.mu[hc + j]; c_muk[j] = A.mu[512 + hc + j]; c_muv[j] = A.mu[1024 + hc + j]; c_kk[j] = A.k_k[hc + j]; c_ka[j] = A.k_a[hc + j];
        c_rk[j] = A.r_k[hc + j]; c_lng[j] = A.ln_g[hc + j]; c_lnb[j] = A.ln_b[hc + j]; }
    const int srow = tid >> 3, sq = (tid & 7) * 8;
    float S[8];
#pragma unroll
    for (int j = 0; j < 8; ++j) S[j] = 0.f;
    const size_t tok0 = (size_t)b * SEQ;
    uint2 rc, kc, vc, rp, kp, vp, ra, rg; float4 rwl;
    RW_LOAD_RAW(0);
    for (int chunk = 0; chunk < SEQ / RW_CS; ++chunk) {
        {
            float frc[4], fkc[4], fvc[4], frp[4], fkp[4], fvp[4], fa[4], fg[4];
            unpack4(rc, frc); unpack4(kc, fkc); unpack4(vc, fvc); unpack4(rp, frp); unpack4(kp, fkp); unpack4(vp, fvp); unpack4(ra, fa); unpack4(rg, fg);
            const float zw[4] = {rwl.x, rwl.y, rwl.z, rwl.w};
            float r_l[4], k_l[4], v_l[4], w_[4], a_[4], kkr[4]; float ss = 0.f;
#pragma unroll
            for (int j = 0; j < 4; ++j) {
                r_l[j] = frc[j] + (frp[j] - frc[j]) * c_mur[j]; k_l[j] = fkc[j] + (fkp[j] - fkc[j]) * c_muk[j]; v_l[j] = fvc[j] + (fvp[j] - fvc[j]) * c_muv[j];
                const float sig = sigmoid_f(zw[j]); w_[j] = __expf(-0.6065306597126334f * sig); a_[j] = sigmoid_f(fa[j]);
                kkr[j] = k_l[j] * c_kk[j]; ss += kkr[j] * kkr[j]; }
            ss += __shfl_xor(ss, 1); ss += __shfl_xor(ss, 2); ss += __shfl_xor(ss, 4); ss += __shfl_xor(ss, 8);
            const float inv = 1.0f / fmaxf(sqrtf(ss), 1e-12f);
            const int o = ls * 64 + lc;
#pragma unroll
            for (int j = 0; j < 4; ++j) { const float kk = kkr[j] * inv;
                sr[o + j] = r_l[j]; sw[o + j] = w_[j]; sk[o + j] = k_l[j] * (1.0f + (a_[j] - 1.0f) * c_ka[j]); skk[o + j] = kk; snb[o + j] = -kk * a_[j]; sv[o + j] = v_l[j]; sg[o + j] = fg[j]; }
        }
        __syncthreads();
        if (chunk + 1 < SEQ / RW_CS) RW_LOAD_RAW(chunk + 1);
        for (int s = 0; s < RW_CS; ++s) {
            const float4 kk0 = *(const float4*)(skk + s * 64 + sq), kk1 = *(const float4*)(skk + s * 64 + sq + 4);
            const float4 w0 = *(const float4*)(sw + s * 64 + sq), w1 = *(const float4*)(sw + s * 64 + sq + 4);
            const float4 nb0 = *(const float4*)(snb + s * 64 + sq), nb1 = *(const float4*)(snb + s * 64 + sq + 4);
            const float4 k0 = *(const float4*)(sk + s * 64 + sq), k1 = *(const float4*)(sk + s * 64 + sq + 4);
            const float4 r0 = *(const float4*)(sr + s * 64 + sq), r1 = *(const float4*)(sr + s * 64 + sq + 4);
            const float vv = sv[s * 64 + srow];
            float sa = (S[0] * kk0.x + S[1] * kk0.y) + (S[2] * kk0.z + S[3] * kk0.w) + (S[4] * kk1.x + S[5] * kk1.y) + (S[6] * kk1.z + S[7] * kk1.w);
            sa += __shfl_xor(sa, 1); sa += __shfl_xor(sa, 2); sa += __shfl_xor(sa, 4);
            S[0] = S[0] * w0.x + sa * nb0.x + vv * k0.x; S[1] = S[1] * w0.y + sa * nb0.y + vv * k0.y; S[2] = S[2] * w0.z + sa * nb0.z + vv * k0.z; S[3] = S[3] * w0.w + sa * nb0.w + vv * k0.w;
            S[4] = S[4] * w1.x + sa * nb1.x + vv * k1.x; S[5] = S[5] * w1.y + sa * nb1.y + vv * k1.y; S[6] = S[6] * w1.z + sa * nb1.z + vv * k1.z; S[7] = S[7] * w1.w + sa * nb1.w + vv * k1.w;
            float y = (S[0] * r0.x + S[1] * r0.y) + (S[2] * r0.z + S[3] * r0.w) + (S[4] * r1.x + S[5] * r1.y) + (S[6] * r1.z + S[7] * r1.w);
            y += __shfl_xor(y, 1); y += __shfl_xor(y, 2); y += __shfl_xor(y, 4);
            if ((tid & 7) == 0) sy[s * 64 + srow] = y;
        }
        __syncthreads();
        {
            const int o = ls * 64 + lc; float y4[4]; float s1 = 0.f, bp = 0.f;
#pragma unroll
            for (int j = 0; j < 4; ++j) { y4[j] = sy[o + j]; s1 += y4[j]; bp += sr[o + j] * sk[o + j] * c_rk[j]; }
            s1 += __shfl_xor(s1, 1); s1 += __shfl_xor(s1, 2); s1 += __shfl_xor(s1, 4); s1 += __shfl_xor(s1, 8);
            bp += __shfl_xor(bp, 1); bp += __shfl_xor(bp, 2); bp += __shfl_xor(bp, 4); bp += __shfl_xor(bp, 8);
            const float mean = s1 * (1.f / 64.f); float q = 0.f;
#pragma unroll
            for (int j = 0; j < 4; ++j) { y4[j] -= mean; q += y4[j] * y4[j]; }
            q += __shfl_xor(q, 1); q += __shfl_xor(q, 2); q += __shfl_xor(q, 4); q += __shfl_xor(q, 8);
            const float rstd = rsqrtf(q * (1.f / 64.f) + 64.0f * 1e-5f);
            float ov[4];
#pragma unroll
            for (int j = 0; j < 4; ++j) ov[j] = (y4[j] * rstd * c_lng[j] + c_lnb[j] + bp * sv[o + j]) * sg[o + j];
            uint2 w; w.x = pk2(ov[0], ov[1]); w.y = pk2(ov[2], ov[3]);
            *(uint2*)(A.ycat + (tok0 + (size_t)chunk * RW_CS + ls) * 1024 + hc) = w;
        }
        __syncthreads();
    }
}
struct MlstmArgs { const bf16_t* P0; const float* gates; const float* conv_w; const float* conv_b; const float* ig_b; const float* fg_b; const float* hn_g; const float* hn_b; bf16_t* ycat; };
constexpr int ML_QS = 132;
constexpr int ML_LDS_FLOATS = 64 * ML_QS + 64 * 128 + 64 * 64 + 64 * 65 + 64 * ML_QS + 4 * 8 * 128 + 64 * 10 + 512 + 128;
constexpr int ML_LDS_BYTES = ML_LDS_FLOATS * 4;

__device__ __forceinline__ void mlstm_unit(const MlstmArgs& A, int bh, float* smem) {
    float* qs = smem; float* ks = qs + 64 * ML_QS; bf16_t* vsb = (bf16_t*)(ks + 64 * 128); float* sc = ks + 64 * 128 + 64 * 64; float* hs = sc + 64 * 65; float* red = hs + 64 * ML_QS;
    float* sig = red + 4 * 8 * 128; float* slf = sig + 64; float* sb = slf + 64; float* smt = sb + 64; float* scarry = smt + 64; float* sden = scarry + 64; float* sws = sden + 64;
    float* smean = sws + 64; float* srstd = smean + 64; float* spad = srstd + 64; float* sdenp = spad + 64;   float* sn = sdenp + 512;
    const int tid = opaque_tid(); const int v = tid & 127, part = tid >> 7; const int b = bh >> 2, h = bh & 3;
    const size_t tok0 = (size_t)b * SEQ;
    const int cq = h * 128 + v;
    float wq[4], wk[4];
#pragma unroll
    for (int j = 0; j < 4; ++j) { wq[j] = A.conv_w[j * 1024 + cq]; wk[j] = A.conv_w[j * 1024 + 512 + cq]; }
    const float bq = A.conv_b[cq], bk = A.conv_b[512 + cq];
    const float igb = A.ig_b[h], fgb = A.fg_b[h];
    const float hng = A.hn_g[cq], hnb = A.hn_b[cq];
    float zq1 = 0.f, zq2 = 0.f, zq3 = 0.f, zk1 = 0.f, zk2 = 0.f, zk3 = 0.f;
    float C[32];
#pragma unroll
    for (int k = 0; k < 32; ++k) C[k] = 0.f;
    if (tid < 128) sn[tid] = 0.f;
    float m_run = 0.f;
    for (int chunk = 0; chunk < SEQ / 64; ++chunk) {
        const size_t row0 = tok0 + (size_t)chunk * 64;
        if (part == 0) {
            for (int t = 0; t < 64; ++t) { const bf16_t* pr = A.P0 + (row0 + t) * L0_MAIN;
                const float zq = bf2f(pr[1792 + cq]), zk = bf2f(pr[2304 + cq]);
                const float cvq = wq[3] * zq + wq[2] * zq1 + wq[1] * zq2 + wq[0] * zq3 + bq; const float cvk = wk[3] * zk + wk[2] * zk1 + wk[1] * zk2 + wk[0] * zk3 + bk;
                zq3 = zq2; zq2 = zq1; zq1 = zq; zk3 = zk2; zk2 = zk1; zk1 = zk;
                qs[t * ML_QS + v] = cvq * sigmoid_f(cvq) * 0.08838834764831845f; ks[t * 128 + v] = cvk * sigmoid_f(cvk); vsb[t * 128 + v] = pr[2816 + cq]; }
            if (tid < 64) { const float* gr = A.gates + (row0 + tid) * 16; sig[tid] = gr[h] + igb; slf[tid] = log_sigmoid_f(gr[4 + h] + fgb); }
        }
        __syncthreads();
        if (tid < 64) { float bsum = 0.f; for (int s = 0; s <= tid; ++s) bsum += slf[s]; sb[tid] = bsum; }
        __syncthreads();
        const float b_last = sb[63];
        float gmax = -INFINITY; for (int s = 0; s < 64; ++s) gmax = fmaxf(gmax, b_last - sb[s] + sig[s]);
        const float m_new = fmaxf(b_last + m_run, gmax); const float keep = __expf(b_last + m_run - m_new);
        if (tid < 64) { const float bt = sb[tid]; float mx = -INFINITY; for (int s = 0; s <= tid; ++s) mx = fmaxf(mx, bt - sb[s] + sig[s]);
            const float mt = fmaxf(bt + m_run, mx); smt[tid] = mt; scarry[tid] = __expf(bt + m_run - mt); sws[tid] = __expf(b_last - bt + sig[tid] - m_new); }
        __syncthreads();
        { const int t = tid & 63, sh = tid >> 6; const float bt = sb[t], mt = smt[t]; float dsum = 0.f;
            for (int s = sh * 8; s < sh * 8 + 8; ++s) { float val = 0.f;
                if (s <= t) { float dot = 0.f;
#pragma unroll 8
                    for (int k = 0; k < 128; k += 4) { const float4 qa = *(const float4*)(qs + t * ML_QS + k), kb = *(const float4*)(ks + s * 128 + k); dot += (qa.x * kb.x + qa.y * kb.y) + (qa.z * kb.z + qa.w * kb.w); }
                    val = dot * __expf(bt - sb[s] + sig[s] - mt); }
                sc[t * 65 + s] = val; dsum += val; }
            sdenp[sh * 64 + t] = dsum; }
        __syncthreads();
        if (tid < 64) { float qn = 0.f; for (int k = 0; k < 128; ++k) qn += qs[tid * ML_QS + k] * sn[k];
            float den = scarry[tid] * qn;
#pragma unroll
            for (int p = 0; p < 8; ++p) den += sdenp[p * 64 + tid];
            sden[tid] = fmaxf(fabsf(den), __expf(-smt[tid])); }
        __syncthreads();
        for (int batch = 0; batch < 8; ++batch) {
#pragma unroll 2
            for (int tt = 0; tt < 8; ++tt) { const int t = batch * 8 + tt; float qc = 0.f;
#pragma unroll
                for (int k = 0; k < 32; k += 4) { const float4 qa = *(const float4*)(qs + t * ML_QS + part * 32 + k); qc += (qa.x * C[k] + qa.y * C[k + 1]) + (qa.z * C[k + 2] + qa.w * C[k + 3]); }
                red[(part * 8 + tt) * 128 + v] = qc; }
            __syncthreads();
#pragma unroll
            for (int j = 0; j < 2; ++j) { const int tt = part * 2 + j, t = batch * 8 + tt;
                const float qc = (red[(0 * 8 + tt) * 128 + v] + red[(1 * 8 + tt) * 128 + v]) + (red[(2 * 8 + tt) * 128 + v] + red[(3 * 8 + tt) * 128 + v]);
                float acc = 0.f; for (int s = 0; s <= t; ++s) acc += sc[t * 65 + s] * bf2f(vsb[s * 128 + v]);
                hs[t * ML_QS + v] = (acc + scarry[t] * qc) / sden[t]; }
            __syncthreads();
        }
        { const int t = tid >> 3, oc = tid & 7; float s1 = 0.f;
#pragma unroll
            for (int k = 0; k < 16; ++k) s1 += hs[t * ML_QS + oc * 16 + k];
            s1 += __shfl_xor(s1, 1); s1 += __shfl_xor(s1, 2); s1 += __shfl_xor(s1, 4); const float mean = s1 * (1.f / 128.f); float q = 0.f;
#pragma unroll
            for (int k = 0; k < 16; ++k) { const float d = hs[t * ML_QS + oc * 16 + k] - mean; q += d * d; }
            q += __shfl_xor(q, 1); q += __shfl_xor(q, 2); q += __shfl_xor(q, 4); if (oc == 0) { smean[t] = mean; srstd[t] = rsqrtf(q * (1.f / 128.f) + LN_EPS); } }
        __syncthreads();
        for (int t = part * 16; t < part * 16 + 16; ++t) { const float hn = (hs[t * ML_QS + v] - smean[t]) * srstd[t] * hng + hnb; const float og = bf2f(A.P0[(row0 + t) * L0_MAIN + 3328 + cq]);
            A.ycat[(row0 + t) * 1024 + 512 + cq] = (bf16_t)f2bf(hn * sigmoid_f(og)); }
#pragma unroll
        for (int k = 0; k < 32; ++k) C[k] *= keep;
        for (int s = 0; s < 64; ++s) { const float wv = sws[s] * bf2f(vsb[s * 128 + v]);
#pragma unroll
            for (int k = 0; k < 32; k += 4) { const float4 kb = *(const float4*)(ks + s * 128 + part * 32 + k); C[k] += kb.x * wv; C[k + 1] += kb.y * wv; C[k + 2] += kb.z * wv; C[k + 3] += kb.w * wv; } }
        if (tid < 128) { float nn = keep * sn[tid]; for (int s = 0; s < 64; ++s) nn += sws[s] * ks[s * 128 + tid]; sn[tid] = nn; }
        m_run = m_new;
        __syncthreads();
    }
}

struct AttnArgs { const bf16_t* P1; const float* cum; const float* qn_g; const float* kn_g; bf16_t* out; };
constexpr int AT_LDS_BYTES = (2 * 32 * 64 + 32) * 4;
__device__ __forceinline__ void attn_unit_valu(const AttnArgs& A, int bh, int qb, float* smem) {
    float* Ks = smem; float* Vs = Ks + 2048; float* cj = Vs + 2048;
    const int tid = opaque_tid(); const int b = bh >> 4, h = bh & 15; const int hf = tid & 1; const int i = qb * 256 + (tid >> 1); const size_t row = (size_t)b * SEQ + i;
    float q[32], o[32];
    { float ss = 0.f;
#pragma unroll
        for (int c = 0; c < 4; ++c) { const uint4 w = *(const uint4*)(A.P1 + row * L1_MAIN + h * 64 + hf * 32 + c * 8); unpack8(w, q + c * 8); }
#pragma unroll
        for (int d = 0; d < 32; ++d) ss += q[d] * q[d];
        ss += __shfl_xor(ss, 1);
        const float r = rsqrtf(ss * (1.f / 64.f) + 1e-6f) * 0.125f;
#pragma unroll
        for (int d = 0; d < 32; ++d) { q[d] = q[d] * r * A.qn_g[h * 64 + hf * 32 + d]; o[d] = 0.f; } }
    const float ci = A.cum[(size_t)bh * SEQ + i];
    float m = -INFINITY, l = 0.f;
    const int ntiles = (qb * 256 + 256) / 32;
    const int lkey = tid >> 4, ld4 = (tid & 15) * 4;
    float kg[4];
#pragma unroll
    for (int j = 0; j < 4; ++j) kg[j] = A.kn_g[h * 64 + ld4 + j];
    for (int kt = 0; kt < ntiles; ++kt) {
        { const size_t krow = (size_t)b * SEQ + kt * 32 + lkey; float fk[4], fv[4];
            unpack4(*(const uint2*)(A.P1 + krow * L1_MAIN + 1024 + h * 64 + ld4), fk); unpack4(*(const uint2*)(A.P1 + krow * L1_MAIN + 2048 + h * 64 + ld4), fv);
            float ss = (fk[0] * fk[0] + fk[1] * fk[1]) + (fk[2] * fk[2] + fk[3] * fk[3]);
            ss += __shfl_xor(ss, 1); ss += __shfl_xor(ss, 2); ss += __shfl_xor(ss, 4); ss += __shfl_xor(ss, 8);
            const float r = rsqrtf(ss * (1.f / 64.f) + 1e-6f);
#pragma unroll
            for (int j = 0; j < 4; ++j) { Ks[lkey * 64 + ld4 + j] = fk[j] * r * kg[j]; Vs[lkey * 64 + ld4 + j] = fv[j]; }
            if ((tid & 15) == 0) cj[lkey] = A.cum[(size_t)bh * SEQ + kt * 32 + lkey]; }
        __syncthreads();
#pragma unroll 1
        for (int sub = 0; sub < 8; ++sub) {
            float s[4]; float mx = -INFINITY;
#pragma unroll
            for (int jj = 0; jj < 4; ++jj) { const int j = sub * 4 + jj; float dot = 0.f;
#pragma unroll
                for (int d = 0; d < 32; d += 4) { const float4 kv = *(const float4*)(Ks + j * 64 + hf * 32 + d); dot += (q[d] * kv.x + q[d + 1] * kv.y) + (q[d + 2] * kv.z + q[d + 3] * kv.w); }
                dot += __shfl_xor(dot, 1);
                float sv_ = dot + ci - cj[j]; if (kt * 32 + j > i) sv_ = -INFINITY; s[jj] = sv_; mx = fmaxf(mx, sv_); }
            const float mnew = fmaxf(m, mx); const float scl = __expf(m - mnew); float psum = 0.f;
#pragma unroll
            for (int jj = 0; jj < 4; ++jj) { s[jj] = __expf(s[jj] - mnew); psum += s[jj]; }
            l = l * scl + psum; m = mnew;
#pragma unroll
            for (int d = 0; d < 32; ++d) o[d] *= scl;
#pragma unroll
            for (int jj = 0; jj < 4; ++jj) { const int j = sub * 4 + jj; const float p = s[jj];
#pragma unroll
                for (int d = 0; d < 32; d += 4) { const float4 vv = *(const float4*)(Vs + j * 64 + hf * 32 + d); o[d] += p * vv.x; o[d + 1] += p * vv.y; o[d + 2] += p * vv.z; o[d + 3] += p * vv.w; } }
        }
        __syncthreads();
    }
    const float il = 1.0f / l;
#pragma unroll
    for (int c = 0; c < 4; ++c) { float og[8]; unpack8(*(const uint4*)(A.P1 + row * L1_MAIN + 3072 + h * 64 + hf * 32 + c * 8), og);
        uint4 w; w.x = pk2(o[c * 8 + 0] * il * sigmoid_f(og[0]), o[c * 8 + 1] * il * sigmoid_f(og[1])); w.y = pk2(o[c * 8 + 2] * il * sigmoid_f(og[2]), o[c * 8 + 3] * il * sigmoid_f(og[3]));
        w.z = pk2(o[c * 8 + 4] * il * sigmoid_f(og[4]), o[c * 8 + 5] * il * sigmoid_f(og[5])); w.w = pk2(o[c * 8 + 6] * il * sigmoid_f(og[6]), o[c * 8 + 7] * il * sigmoid_f(og[7]));
        *(uint4*)(A.out + row * 1024 + h * 64 + hf * 32 + c * 8) = w; }
}
__device__ __forceinline__ void attn_valu_phase(const AttnArgs& A, int bid, int nblk, float* smem) {
    for (int su = bid; su < 256; su += nblk) { const int bh = su >> 1, pr = su & 1;
#pragma unroll 1
        for (int u = 0; u < 4; ++u) { const int qb = (u == 0) ? pr : (u == 1) ? 7 - pr : (u == 2) ? 2 + pr : 5 - pr; attn_unit_valu(A, bh, qb, smem); } }
}

struct PeerSArgs { const bf16_t* Q; const bf16_t* K1b; const bf16_t* K2b; int* eid; float* gate; };
constexpr int PS_QT = 0, PS_KB = 64 * 528, PS_KB2 = PS_KB + 128 * 272, PS_L1 = PS_KB + 2 * 128 * 272, PS_L2 = PS_L1 + 4096, PS_LDS_BYTES = PS_L2 + 4096;
__device__ __forceinline__ unsigned ord_f(float f) { const unsigned b = __float_as_uint(f); return b ^ ((b >> 31) ? 0xFFFFFFFFu : 0x80000000u); }
__device__ __forceinline__ float unord_f(unsigned u) { const unsigned b = (u & 0x80000000u) ? (u ^ 0x80000000u) : ~u; return __uint_as_float(b); }
#define TOPK_INSERT(L, x) do { unsigned x_ = (x); _Pragma("unroll") for (int q_ = 0; q_ < 16; ++q_) { const unsigned hi_ = max(L[q_], x_); x_ = min(L[q_], x_); L[q_] = hi_; } } while (0)

__device__ __forceinline__ void peer_scores_unit(const PeerSArgs& A, int tile, int h, unsigned char* smem) {
    const int tid = opaque_tid(), lane = tid & 63, wv = tid >> 6;
#pragma unroll
    for (int i = 0; i < 4; ++i) { const int idx = tid + 512 * i; const int row = idx >> 5, c = idx & 31;
        *(uint4*)(smem + PS_QT + row * 528 + c * 16) = *(const uint4*)(A.Q + (size_t)(tile * 64 + row) * 2048 + h * 256 + c * 8); }
#pragma unroll
    for (int i = 0; i < 4; ++i) { const int idx = tid + 512 * i; const int row = idx >> 4, c = idx & 15;
        *(uint4*)(smem + PS_KB + row * 272 + c * 16) = *(const uint4*)(A.K1b + (size_t)(h * 128 + row) * 128 + c * 8);
        *(uint4*)(smem + PS_KB2 + row * 272 + c * 16) = *(const uint4*)(A.K2b + (size_t)(h * 128 + row) * 128 + c * 8); }
    __syncthreads();
    const int half = wv >> 2, mt = wv & 3; const int fr = lane & 15, fq = lane >> 4;
    f32x4_t acc[8];
#pragma unroll
    for (int n = 0; n < 8; ++n) acc[n] = (f32x4_t){0.f, 0.f, 0.f, 0.f};
    { const unsigned char* qbase = smem + PS_QT + (16 * mt + fr) * 528 + (half * 128 + 8 * fq) * 2; const unsigned char* kbase = smem + (half ? PS_KB2 : PS_KB) + fr * 272 + (8 * fq) * 2;
#pragma unroll
        for (int ks = 0; ks < 4; ++ks) { const bf16x8_t qf = *(const bf16x8_t*)(qbase + ks * 64);
#pragma unroll
            for (int n = 0; n < 8; ++n) { const bf16x8_t kf = *(const bf16x8_t*)(kbase + n * 16 * 272 + ks * 64); acc[n] = __builtin_amdgcn_mfma_f32_16x16x32_bf16(kf, qf, acc[n], 0, 0, 0); } } }
    __syncthreads();
    { float* sT = (float*)(smem + PS_KB + half * 128 * 272);
#pragma unroll
        for (int n = 0; n < 8; ++n)
#pragma unroll
            for (int r = 0; r < 4; ++r) sT[(16 * n + 4 * fq + r) * 68 + 16 * mt + fr] = acc[n][r]; }
    __syncthreads();
    if (wv == 0 || wv == 4) { const float* sT = (const float*)(smem + PS_KB + half * 128 * 272); unsigned L[16];
#pragma unroll
        for (int j = 0; j < 16; ++j) L[j] = 0u;
        for (int key = 0; key < 128; ++key) { const unsigned u = (ord_f(sT[key * 68 + lane]) & ~0x7Fu) | (unsigned)(127 - key); TOPK_INSERT(L, u); }
        unsigned* lst = (unsigned*)(smem + (half ? PS_L2 : PS_L1));
#pragma unroll
        for (int j = 0; j < 16; ++j) lst[j * 64 + lane] = L[j]; }
    __syncthreads();
    if (wv == 0) { const unsigned* l1 = (const unsigned*)(smem + PS_L1); const unsigned* l2 = (const unsigned*)(smem + PS_L2);
        float v1[16], v2[16];
#pragma unroll
        for (int j = 0; j < 16; ++j) { v1[j] = unord_f(l1[j * 64 + lane]); v2[j] = unord_f(l2[j * 64 + lane]); }
        unsigned L[16];
#pragma unroll
        for (int j = 0; j < 16; ++j) L[j] = 0u;
#pragma unroll
        for (int i = 0; i < 16; ++i)
#pragma unroll
            for (int j = 0; j < 16; ++j) if ((i + 1) * (j + 1) <= 16) { const unsigned u = (ord_f(v1[i] + v2[j]) & ~0xFFu) | (unsigned)(255 - (i * 16 + j)); TOPK_INSERT(L, u); }
        float e[16]; float sum = 0.f; const float mx = unord_f(L[0]);
#pragma unroll
        for (int k = 0; k < 16; ++k) { e[k] = __expf(unord_f(L[k]) - mx); sum += e[k]; }
        const float inv = 1.0f / sum; const size_t ob = (size_t)(tile * 64 + lane) * 128 + h * 16;
#pragma unroll
        for (int k = 0; k < 16; ++k) { const int idx = 255 - (int)(L[k] & 0xFFu); const int i = idx >> 4, j = idx & 15;
            const int e1 = 127 - (int)(l1[i * 64 + lane] & 0x7Fu), e2 = 127 - (int)(l2[j * 64 + lane] & 0x7Fu);
            A.eid[ob + k] = e1 * 128 + e2; A.gate[ob + k] = e[k] * inv; } }
    __syncthreads();
}
__device__ __forceinline__ void peer_scores_phase(const PeerSArgs& A, int bid, int nblk, unsigned char* smem) {
    for (int u = bid; u < 256 * 8; u += nblk) peer_scores_unit(A, u >> 3, u & 7, smem);
}

struct PeerGArgs { float* X; const int* eid; const float* gate; const bf16_t* U; const bf16_t* V; const float* lng; const float* lnb; bf16_t* xb; };
__device__ __forceinline__ void peer_gather_token(const PeerGArgs& A, int t, int lane) {
    float x[16];
    { const float4 a0 = *(const float4*)(A.X + (size_t)t * 1024 + lane * 8), a1 = *(const float4*)(A.X + (size_t)t * 1024 + lane * 8 + 4);
      const float4 b0 = *(const float4*)(A.X + (size_t)t * 1024 + 512 + lane * 8), b1 = *(const float4*)(A.X + (size_t)t * 1024 + 512 + lane * 8 + 4);
      x[0] = a0.x; x[1] = a0.y; x[2] = a0.z; x[3] = a0.w; x[4] = a1.x; x[5] = a1.y; x[6] = a1.z; x[7] = a1.w; x[8] = b0.x; x[9] = b0.y; x[10] = b0.z; x[11] = b0.w; x[12] = b1.x; x[13] = b1.y; x[14] = b1.z; x[15] = b1.w; }
    const int e_lo = A.eid[(size_t)t * 128 + lane], e_hi = A.eid[(size_t)t * 128 + 64 + lane];
    const float g_lo = A.gate[(size_t)t * 128 + lane], g_hi = A.gate[(size_t)t * 128 + 64 + lane];
    float acc[16];
#pragma unroll
    for (int j = 0; j < 16; ++j) acc[j] = 0.f;
    for (int k0 = 0; k0 < 128; k0 += 4) {
        int e[4]; float g[4]; uint4 u0[4], u1[4], v0[4], v1[4];
#pragma unroll
        for (int i = 0; i < 4; ++i) { const int k = k0 + i; e[i] = __shfl(k0 < 64 ? e_lo : e_hi, k & 63); g[i] = __shfl(k0 < 64 ? g_lo : g_hi, k & 63);
            const bf16_t* ur = A.U + (size_t)e[i] * 1024 + lane * 8; u0[i] = *(const uint4*)ur; u1[i] = *(const uint4*)(ur + 512);
            const bf16_t* vr = A.V + (size_t)e[i] * 1024 + lane * 8; v0[i] = *(const uint4*)vr; v1[i] = *(const uint4*)(vr + 512); }
#pragma unroll
        for (int i = 0; i < 4; ++i) { float f[16]; unpack8(u0[i], f); unpack8(u1[i], f + 8); float dot = 0.f;
#pragma unroll
            for (int j = 0; j < 16; ++j) dot += x[j] * f[j];
            dot = wave_sum(dot);
            const float c = g[i] * 0.5f * dot * (1.0f + erff(dot * 0.7071067811865476f));
            unpack8(v0[i], f); unpack8(v1[i], f + 8);
#pragma unroll
            for (int j = 0; j < 16; ++j) acc[j] += c * f[j]; }
    }
    float s = 0.f;
#pragma unroll
    for (int j = 0; j < 16; ++j) { acc[j] += DN_ALPHA * x[j]; s += acc[j]; }
    const float mean = wave_sum(s) * (1.f / 1024.f); float q = 0.f;
#pragma unroll
    for (int j = 0; j < 16; ++j) { acc[j] -= mean; q += acc[j] * acc[j]; }
    const float rstd = rsqrtf(wave_sum(q) * (1.f / 1024.f) + LN_EPS);
#pragma unroll
    for (int hf = 0; hf < 2; ++hf) { const int c0 = hf * 512 + lane * 8; float ov[8];
#pragma unroll
        for (int j = 0; j < 8; ++j) ov[j] = acc[hf * 8 + j] * rstd * A.lng[c0 + j] + A.lnb[c0 + j];
        *(float4*)(A.X + (size_t)t * 1024 + c0) = make_float4(ov[0], ov[1], ov[2], ov[3]); *(float4*)(A.X + (size_t)t * 1024 + c0 + 4) = make_float4(ov[4], ov[5], ov[6], ov[7]);
        uint4 w; w.x = pk2(ov[0], ov[1]); w.y = pk2(ov[2], ov[3]); w.z = pk2(ov[4], ov[5]); w.w = pk2(ov[6], ov[7]); *(uint4*)(A.xb + (size_t)t * 1024 + c0) = w; }
}
__device__ __forceinline__ void peer_gather_phase(const PeerGArgs& A, int bid, int nblk) {
    const int lane = opaque_tid() & 63, wv = opaque_tid() >> 6;
    for (int t = bid * 8 + wv; t < T_TOK; t += nblk * 8) peer_gather_token(A, t, lane);
}

constexpr size_t MiB = 1u << 20;
constexpr size_t WS_CTL = 0, CTL_ZERO_BYTES = 64 * 1024, WS_W0IN = 1 * MiB, WS_WLR = 9 * MiB, WS_W0OUT = 10 * MiB, WS_WQ0 = 12 * MiB, WS_W1IN = 16 * MiB, WS_W1OUT = 24 * MiB, WS_WQ1 = 26 * MiB;
constexpr size_t WS_PK = 30 * MiB;
constexpr size_t WS_GATES = 31 * MiB, WS_CUM = 32 * MiB, WS_APP = 33 * MiB, WS_EID = 41 * MiB, WS_GATE = 49 * MiB, WS_ACTA = 57 * MiB;
constexpr size_t WS_TABU = 89 * MiB, WS_TABV = 121 * MiB, WS_P = 153 * MiB, WS_LRW = 281 * MiB, WS_LRA = 313 * MiB, WS_LRG = 329 * MiB, WS_END = 345 * MiB;
constexpr size_t WS_MIX = WS_P, WS_Q = WS_P + 64 * MiB;
constexpr int CW_BAR = 1024;
static_assert((CW_BAR + XCD_BAR_WORDS) * 4 <= (int)CTL_ZERO_BYTES, "barrier words inside the memset region");
constexpr int LDS_BYTES = 160 * 1024, LDS_MISC_OFF = LDS_BYTES - 256;
static_assert(ML_LDS_BYTES <= LDS_MISC_OFF && PS_LDS_BYTES <= LDS_MISC_OFF && pg8::STAGE_BYTES <= LDS_MISC_OFF, "phase scratch below the LDS control words");

struct MegaArgs { const float* in[43]; float* out; unsigned char* ws; };

__global__ void __launch_bounds__(NTHR, 2) mega_kernel(MegaArgs a) {
    extern __shared__ __attribute__((aligned(16))) unsigned char lds[];
    const int tid = opaque_tid(); const int bid = (int)blockIdx.x, nblk = (int)gridDim.x;
    unsigned char* ws = a.ws; float* out = a.out;
    bf16_t* W0IN = (bf16_t*)(ws + WS_W0IN); bf16_t* WLR = (bf16_t*)(ws + WS_WLR); bf16_t* W0OUT = (bf16_t*)(ws + WS_W0OUT); bf16_t* WQ0 = (bf16_t*)(ws + WS_WQ0);
    bf16_t* W1IN = (bf16_t*)(ws + WS_W1IN); bf16_t* W1OUT = (bf16_t*)(ws + WS_W1OUT); bf16_t* WQ1 = (bf16_t*)(ws + WS_WQ1); bf16_t* PK = (bf16_t*)(ws + WS_PK);
    float* GATES = (float*)(ws + WS_GATES); float* CUM = (float*)(ws + WS_CUM); bf16_t* APP = (bf16_t*)(ws + WS_APP); int* EID = (int*)(ws + WS_EID); float* GATE = (float*)(ws + WS_GATE);
    bf16_t* ACTA = (bf16_t*)(ws + WS_ACTA); bf16_t* TABU = (bf16_t*)(ws + WS_TABU); bf16_t* TABV = (bf16_t*)(ws + WS_TABV); bf16_t* P = (bf16_t*)(ws + WS_P);
    float* MIX = (float*)(ws + WS_MIX); bf16_t* Q = (bf16_t*)(ws + WS_Q); float* LRW = (float*)(ws + WS_LRW); bf16_t* LRA = (bf16_t*)(ws + WS_LRA); bf16_t* LRG = (bf16_t*)(ws + WS_LRG);
    if (tid < 64) ((LAS unsigned*)((LAS unsigned char*)lds + LDS_MISC_OFF))[tid] = 0u;
    __syncthreads();
    XcdBarrier bar = xcd_barrier_post((unsigned*)(ws + WS_CTL) + CW_BAR, (volatile LAS unsigned*)((LAS unsigned char*)lds + LDS_MISC_OFF + 32));
#define GRID_BAR() xcd_barrier(bar)
#define GEMM_PHASE(EpiT, Aop, Bop, Mv, Nv, Kv, Eobj) do { pg8::Gemm g_; g_.A = (Aop); g_.Bt = (Bop); g_.M = (Mv); g_.N = (Nv); g_.K = (Kv); pg8::StaticOrder S_; S_.init((Mv), (Nv), nblk, bid); \
        pg8::gemm_phase<EpiT, pg8::StaticOrder, true, true>((PG8_LAS unsigned char*)lds, g_, S_, (Eobj)); } while (0)

    {
        float* tile = (float*)lds;
        transpose_cvt_phase(a.in[1], 1024, L0_COLS, 0, L0_MAIN, W0IN, bid, nblk, tile);
        transpose_cvt_phase(a.in[19], 1024, 1024, 0, 1024, W0OUT, bid, nblk, tile);
        transpose_cvt_phase(a.in[22], 1024, 2048, 0, 2048, WQ0, bid, nblk, tile);
        transpose_cvt_phase(a.in[29], 1024, L1_COLS, 0, L1_MAIN, W1IN, bid, nblk, tile);
        transpose_cvt_phase(a.in[33], 1024, 1024, 0, 1024, W1OUT, bid, nblk, tile);
        transpose_cvt_phase(a.in[36], 1024, 2048, 0, 2048, WQ1, bid, nblk, tile);
        build_wlr_phase(a.in[4], a.in[6], a.in[7], WLR, bid, nblk);
        cvt_bf16_phase(a.in[23], PK, 131072 / 8, bid, nblk); cvt_bf16_phase(a.in[24], PK + 131072, 131072 / 8, bid, nblk);
        cvt_bf16_phase(a.in[37], PK + 262144, 131072 / 8, bid, nblk); cvt_bf16_phase(a.in[38], PK + 393216, 131072 / 8, bid, nblk);
        cvt_bf16_phase(a.in[0], ACTA, (size_t)T_TOK * 1024 / 8, bid, nblk);
        cvt_bf16_phase(a.in[25], TABU, (size_t)16384 * 1024 / 8, bid, nblk); cvt_bf16_phase(a.in[26], TABV, (size_t)16384 * 1024 / 8, bid, nblk);
    }
    GRID_BAR();
    { pg8::EpiBf16P E; E.O = P; E.ldc = L0_MAIN; GEMM_PHASE(pg8::EpiBf16P, ACTA, W0IN, T_TOK, L0_MAIN, 1024, E); }
    gates_phase<8>(a.in[0], a.in[1], L0_COLS, L0_MAIN, GATES, bid, nblk, (float*)lds);
    GRID_BAR();
    rwkv_prep_phase(P, a.in[2], APP, bid, nblk);
    GRID_BAR();
    { pg8::EpiLowrank E; E.lrw = LRW; E.lra = LRA; E.lrg = LRG; E.w0 = a.in[3]; E.a0 = a.in[5]; GEMM_PHASE(pg8::EpiLowrank, APP, WLR, T_TOK, 1536, 256, E); }
    GRID_BAR();
    {
        RwkvArgs ra; ra.P0 = P; ra.lrw = LRW; ra.lra = LRA; ra.lrg = LRG; ra.mu = a.in[2]; ra.k_k = a.in[8]; ra.k_a = a.in[9]; ra.r_k = a.in[10]; ra.ln_g = a.in[11]; ra.ln_b = a.in[12]; ra.ycat = ACTA;
        MlstmArgs ma; ma.P0 = P; ma.gates = GATES; ma.conv_w = a.in[13]; ma.conv_b = a.in[14]; ma.ig_b = a.in[15]; ma.fg_b = a.in[16]; ma.hn_g = a.in[17]; ma.hn_b = a.in[18]; ma.ycat = ACTA;
        for (int u = bid; u < 96; u += nblk) { if (u < 64) rwkv_scan_unit(ra, u, (float*)lds); else mlstm_unit(ma, u - 64, (float*)lds); }
    }
    GRID_BAR();
    { pg8::EpiF32 E; E.C = MIX; E.ldc = 1024; GEMM_PHASE(pg8::EpiF32, ACTA, W0OUT, T_TOK, 1024, 1024, E); }
    GRID_BAR();
    ln_phase(a.in[0], MIX, a.in[20], a.in[21], out, ACTA, bid, nblk);
    GRID_BAR();
    { pg8::EpiBf16P E; E.O = Q; E.ldc = 2048; GEMM_PHASE(pg8::EpiBf16P, ACTA, WQ0, T_TOK, 2048, 1024, E); }
    GRID_BAR();
    { PeerSArgs sa; sa.Q = Q; sa.K1b = PK; sa.K2b = PK + 131072; sa.eid = EID; sa.gate = GATE; peer_scores_phase(sa, bid, nblk, lds); }
    GRID_BAR();
    { PeerGArgs ga; ga.X = out; ga.eid = EID; ga.gate = GATE; ga.U = TABU; ga.V = TABV; ga.lng = a.in[27]; ga.lnb = a.in[28]; ga.xb = ACTA; peer_gather_phase(ga, bid, nblk); }
    GRID_BAR();
    cvt_bf16_phase(a.in[39], TABU, (size_t)16384 * 1024 / 8, bid, nblk); cvt_bf16_phase(a.in[40], TABV, (size_t)16384 * 1024 / 8, bid, nblk);
    { pg8::EpiBf16P E; E.O = P; E.ldc = L1_MAIN; GEMM_PHASE(pg8::EpiBf16P, ACTA, W1IN, T_TOK, L1_MAIN, 1024, E); }
    gates_phase<16>(out, a.in[29], L1_COLS, L1_MAIN, GATES, bid, nblk, (float*)lds);
    GRID_BAR();
    fox_cumsum_phase(GATES, a.in[32], CUM, bid, nblk);
    GRID_BAR();
    { AttnArgs aa; aa.P1 = P; aa.cum = CUM; aa.qn_g = a.in[30]; aa.kn_g = a.in[31]; aa.out = ACTA; attn_valu_phase(aa, bid, nblk, (float*)lds); }
    GRID_BAR();
    { pg8::EpiF32 E; E.C = MIX; E.ldc = 1024; GEMM_PHASE(pg8::EpiF32, ACTA, W1OUT, T_TOK, 1024, 1024, E); }
    GRID_BAR();
    ln_phase(out, MIX, a.in[34], a.in[35], out, ACTA, bid, nblk);
    GRID_BAR();
    { pg8::EpiBf16P E; E.O = Q; E.ldc = 2048; GEMM_PHASE(pg8::EpiBf16P, ACTA, WQ1, T_TOK, 2048, 1024, E); }
    GRID_BAR();
    { PeerSArgs sa; sa.Q = Q; sa.K1b = PK + 262144; sa.K2b = PK + 393216; sa.eid = EID; sa.gate = GATE; peer_scores_phase(sa, bid, nblk, lds); }
    GRID_BAR();
    { PeerGArgs ga; ga.X = out; ga.eid = EID; ga.gate = GATE; ga.U = TABU; ga.V = TABV; ga.lng = a.in[41]; ga.lnb = a.in[42]; ga.xb = ACTA; peer_gather_phase(ga, bid, nblk); }
#undef GRID_BAR
#undef GEMM_PHASE
}

extern "C" void kernel_launch(void* const* d_in, const int* in_sizes, int n_in, void* d_out, int out_size, void* d_ws, size_t ws_size, hipStream_t stream) {
    static int grid = 0;
    if (grid == 0) {
        if (n_in != 43 || ws_size < WS_END) { fprintf(stderr, "kernel_launch: unexpected n_in %d or ws_size %zu (< %zu); nothing launched\n", n_in, ws_size, (size_t)WS_END); grid = -1; return; }
        int dev = 0, cus = 0;
        if (hipGetDevice(&dev) != hipSuccess || hipDeviceGetAttribute(&cus, hipDeviceAttributeMultiprocessorCount, dev) != hipSuccess) { fprintf(stderr, "kernel_launch: device query failed\n"); grid = -1; return; }
        if (hipFuncSetAttribute((const void*)mega_kernel, hipFuncAttributeMaxDynamicSharedMemorySize, LDS_BYTES) != hipSuccess) { fprintf(stderr, "kernel_launch: hipFuncSetAttribute failed\n"); grid = -1; return; }
        (void)hipGetLastError();
        grid = cus;
    }
    if (grid < 0) return;
    (void)hipMemsetAsync((char*)d_ws + WS_CTL, 0, CTL_ZERO_BYTES, stream);
    MegaArgs a; memset(&a, 0, sizeof(a));
    for (int i = 0; i < 43; ++i) a.in[i] = (const float*)d_in[i];
    a.out = (float*)d_out; a.ws = (unsigned char*)d_ws;
    hipLaunchKernelGGL(mega_kernel, dim3(grid), dim3(NTHR), LDS_BYTES, stream, a);
}
```

```cpp
#include <hip/hip_runtime.h>
#include <cstdio>
#include <cstdint>
#include <cmath>
#include <cstring>
__device__ __forceinline__ int opaque_tid() { int t = (int)threadIdx.x; asm volatile("" : "+v"(t)); return t; }
__device__ __forceinline__ unsigned char* opq_ptr(unsigned char* p) { return p; }
namespace pg8 {
#define PG8_LAS __attribute__((address_space(3)))
typedef unsigned short bf16_t;
typedef short bf16x8 __attribute__((ext_vector_type(8)));
typedef float f32x4 __attribute__((ext_vector_type(4)));
typedef unsigned u32x4 __attribute__((ext_vector_type(4)));
constexpr int BM = 256, BK = 64, HALF = 128, HTB = HALF * BK * 2  , STAGE_BYTES = 8 * HTB, NXCD = 8, WGM = 8;

__host__ __device__ __forceinline__ int lds_byte(int r, int c) { const int st = (r >> 4) * 2 + (c >> 5), rr = r & 15, cc = c & 31, ob = rr * 64 + cc * 2; return st * 1024 + (ob ^ (((ob >> 9) & 1) << 5)); }
__host__ __device__ __forceinline__ void stage_rc(int b, int& R, int& C) { const int st = b / 1024, sb = b % 1024, swz = sb ^ (((sb >> 9) & 1) << 5); R = (st >> 1) * 16 + swz / 64; C = (st & 1) * 32 + (swz % 64) / 2; }
__host__ __device__ __forceinline__ int perm32(int rho) { const int n = rho >> 4, i = rho & 15; return 8 * (i >> 2) + 4 * n + (i & 3); }

struct Unit { int pm, pn; };
struct Gemm { const bf16_t* A; const bf16_t* Bt; int M, N, K; };

struct StaticOrder {
    int nM, nN, nwg, G, c;
    __host__ __device__ void init(int M, int N, int G_, int c_) { nM = M / BM; nN = N / BM; nwg = nM * nN; G = G_; c = c_; }
    __host__ __device__ bool next(int i, Unit& u) const {
        const long L = (long)i * G + c; if (L >= nwg) return false;
        int wgid = (int)L; { const int q = nwg / NXCD, r = nwg % NXCD, xcd = wgid % NXCD, off = wgid / NXCD; wgid = (xcd < r ? xcd * (q + 1) : r * (q + 1) + (xcd - r) * q) + off; }
        const int nig = WGM * nN, gid = wgid / nig, fm = gid * WGM, gsz = (nM - fm) < WGM ? (nM - fm) : WGM;
        u.pm = fm + ((wgid % nig) % gsz); u.pn = (wgid % nig) / gsz; return true;
    }
    __device__ __forceinline__ void a_ready(const Unit&) const {}
    __device__ __forceinline__ void done(const Unit&) const {}
};

__device__ __forceinline__ unsigned cvt_pk_bf16(float lo, float hi) { unsigned r; asm volatile("v_cvt_pk_bf16_f32 %0, %1, %2" : "=v"(r) : "v"(lo), "v"(hi)); return r; }
typedef float f32x2 __attribute__((ext_vector_type(2)));
__device__ __forceinline__ f32x2 gelu_pk(f32x2 v) {
    const f32x2 av = __builtin_elementwise_abs(v), d = av * 0.2316418882f + 1.0f;
    f32x2 t; t.x = __builtin_amdgcn_rcpf(d.x); t.y = __builtin_amdgcn_rcpf(d.y);
    f32x2 q = t * 0.5307027145f + (-0.7265760135f); q = q * t + 0.7107068705f; q = q * t + (-0.142248368f); q = q * t + 0.127414796f; q = q * t;
    const f32x2 s = (v * v) * (-0.72134752044f);
    f32x2 e; e.x = __builtin_amdgcn_exp2f(s.x); e.y = __builtin_amdgcn_exp2f(s.y);
    const f32x2 m = v * (q * e), r = v - m;
    f32x2 o; o.x = v.x < 0.f ? m.x : r.x; o.y = v.y < 0.f ? m.y : r.y; return o;
}

template <int ACT  > struct EpiBf16 {
    static constexpr bool PERM = true, AFTER_DRAIN = false; static_assert(ACT == 0 || ACT == 1, "EpiBf16: ACT is 0 (none) or 1 (gelu_pk)");
    bf16_t* O; int ldc; const float* bias; int split_cols; size_t split_stride; float scale0;
    __device__ __forceinline__ void operator()(const f32x4 (&acc)[2][2][4][2], const Unit& u, int wr, int wc, int fr, int fq) const {
        const int row0 = u.pm * BM + wr * 64 + fr; int colt = u.pn * BM; bf16_t* base = O;
        float sc = 1.f; if (split_cols) { const int t = colt / split_cols; base += (size_t)t * split_stride; colt -= t * split_cols; if (t == 0) sc = scale0; }
        const int col0 = colt + wc * 32 + 8 * fq, bcol0 = u.pn * BM + wc * 32 + 8 * fq;
        f32x4 bv[2][2];
#pragma unroll
        for (int bj = 0; bj < 2; ++bj)
#pragma unroll
            for (int n = 0; n < 2; ++n) bv[bj][n] = bias ? *(const f32x4*)(bias + bcol0 + bj * HALF + 4 * n) : (f32x4){0.f, 0.f, 0.f, 0.f};
#pragma unroll
        for (int ai = 0; ai < 2; ++ai)
#pragma unroll
            for (int m = 0; m < 4; ++m) { bf16_t* rowp = base + (size_t)(row0 + ai * HALF + m * 16) * ldc + col0;
#pragma unroll
                for (int bj = 0; bj < 2; ++bj) { f32x4 v0 = acc[ai][bj][m][0] + bv[bj][0], v1 = acc[ai][bj][m][1] + bv[bj][1];
                    if (ACT == 1) { f32x2 a = gelu_pk((f32x2){v0[0], v0[1]}), b = gelu_pk((f32x2){v0[2], v0[3]}), c = gelu_pk((f32x2){v1[0], v1[1]}), d = gelu_pk((f32x2){v1[2], v1[3]});
                        v0 = (f32x4){a.x, a.y, b.x, b.y}; v1 = (f32x4){c.x, c.y, d.x, d.y}; }
                    v0 = v0 * sc; v1 = v1 * sc; u32x4 w; w.x = cvt_pk_bf16(v0[0], v0[1]); w.y = cvt_pk_bf16(v0[2], v0[3]); w.z = cvt_pk_bf16(v1[0], v1[1]); w.w = cvt_pk_bf16(v1[2], v1[3]);
                    *(u32x4*)(rowp + bj * HALF) = w; } }
    }
};

struct PanelStats {
    unsigned* xbuf;
    unsigned* cnt;
    unsigned* tmo;
    int ntn; float eps;
    unsigned code;
    __device__ __forceinline__ bool run(const f32x4 (&v)[2][2][4][2], const Unit& u, int wr, int wc, int fr, int fq, PG8_LAS unsigned char* lds, int wid, int lane) const {
        typedef float f32x2v __attribute__((ext_vector_type(2)));
        PG8_LAS f32x2v* P = (PG8_LAS f32x2v*)lds;
        PG8_LAS f32x2v* S = (PG8_LAS f32x2v*)(lds + 8192);
        PG8_LAS unsigned* flag = (PG8_LAS unsigned*)(lds + 8192 + 2048);
#pragma unroll
        for (int ai = 0; ai < 2; ++ai)
#pragma unroll
            for (int m = 0; m < 4; ++m) {
                float s = 0.f;
#pragma unroll
                for (int bj = 0; bj < 2; ++bj)
#pragma unroll
                    for (int n = 0; n < 2; ++n) { const f32x4 x = v[ai][bj][m][n]; s += (x[0] + x[1]) + (x[2] + x[3]); }
                s += __shfl_xor(s, 16); s += __shfl_xor(s, 32);
                const float mw = s * (1.0f / 64.0f); float q = 0.f;
#pragma unroll
                for (int bj = 0; bj < 2; ++bj)
#pragma unroll
                    for (int n = 0; n < 2; ++n) { const f32x4 d = v[ai][bj][m][n] - mw; q += (d[0] * d[0] + d[1] * d[1]) + (d[2] * d[2] + d[3] * d[3]); }
                q += __shfl_xor(q, 16); q += __shfl_xor(q, 32);
                if (fq == 0) P[(ai * HALF + wr * 64 + m * 16 + fr) * 4 + wc] = (f32x2v){mw, q};
            }
        asm volatile("s_waitcnt lgkmcnt(0)" ::: "memory"); __builtin_amdgcn_s_barrier(); asm volatile("" ::: "memory");
#if defined(BROKEN_EXCHANGE_NO_WAIT)
#warning BROKEN CONTROL BUILD: the row-statistics exchange does not wait; results are wrong by design
        if (blockIdx.x >= 64) { const long long t0_ = clock64(); while (clock64() - t0_ < 60000) __builtin_amdgcn_s_sleep(8); }
#endif
        const int row = wid * 32 + (lane & 31);
        if (lane < 32) {
            const f32x2v a = P[row * 4 + 0], b = P[row * 4 + 1], c = P[row * 4 + 2], d = P[row * 4 + 3];
            const float mt = (a.x + b.x + c.x + d.x) * 0.25f;
            const float da = a.x - mt, db = b.x - mt, dc = c.x - mt, dd = d.x - mt;
            const float m2 = (a.y + b.y) + (c.y + d.y) + 64.0f * ((da * da + db * db) + (dc * dc + dd * dd));
            unsigned long long* slot = (unsigned long long*)xbuf + ((size_t)(u.pm * BM + row) * 4 + u.pn);
            __hip_atomic_store(slot, ((unsigned long long)__float_as_uint(m2) << 32) | __float_as_uint(mt), __ATOMIC_RELAXED, __HIP_MEMORY_SCOPE_AGENT);
        }
        asm volatile("s_waitcnt vmcnt(0)" ::: "memory");
        if (lane == 0) __hip_atomic_fetch_add(cnt + 64 * u.pm, 1u, __ATOMIC_RELAXED, __HIP_MEMORY_SCOPE_AGENT);
        if (wid == 0) {
            bool dead = false; const unsigned long long t0 = __builtin_amdgcn_s_memrealtime(); const unsigned want = 8u * (unsigned)ntn;
            for (;;) {
#if defined(BROKEN_EXCHANGE_NO_WAIT)
                break;
#endif
                if ((unsigned)__builtin_amdgcn_readfirstlane(__hip_atomic_load(cnt + 64 * u.pm, __ATOMIC_RELAXED, __HIP_MEMORY_SCOPE_AGENT)) >= want) break;
                if (__builtin_amdgcn_s_memrealtime() - t0 > 2000000ull) {
                    if (lane == 0) { unsigned expect = 0u; __hip_atomic_compare_exchange_strong(tmo + 1, &expect, code | (unsigned)(u.pm & 0xff), __ATOMIC_RELAXED, __ATOMIC_RELAXED, __HIP_MEMORY_SCOPE_AGENT);
                                     __hip_atomic_store(tmo, 1u, __ATOMIC_RELAXED, __HIP_MEMORY_SCOPE_AGENT); }
                    dead = true; break; }
                __builtin_amdgcn_s_sleep(2);
            }
            __builtin_amdgcn_fence(__ATOMIC_ACQUIRE, "agent");
            if (lane == 0) flag[0] = dead ? 1u : 0u;
        }
        asm volatile("s_waitcnt vmcnt(0) lgkmcnt(0)" ::: "memory"); __builtin_amdgcn_s_barrier(); asm volatile("" ::: "memory");
        const bool bad = flag[0] != 0u;
        if (lane < 32) {
            const unsigned long long* slot = (const unsigned long long*)xbuf + (size_t)(u.pm * BM + row) * 4; float mt[4], m2[4]; float ms = 0.f;
#pragma unroll
            for (int t = 0; t < 4; ++t) { if (t < ntn) { const unsigned long long w = __hip_atomic_load(slot + t, __ATOMIC_RELAXED, __HIP_MEMORY_SCOPE_AGENT); mt[t] = __uint_as_float((unsigned)w); m2[t] = __uint_as_float((unsigned)(w >> 32)); } else { mt[t] = 0.f; m2[t] = 0.f; } ms += mt[t]; }
            const float mean = ms / (float)ntn; float q = 0.f;
#pragma unroll
            for (int t = 0; t < 4; ++t) if (t < ntn) { const float dm = mt[t] - mean; q += m2[t] + 256.0f * dm * dm; }
            S[row] = (f32x2v){mean, 1.0f / sqrtf(q / (256.0f * (float)ntn) + eps)};
        }
        asm volatile("s_waitcnt lgkmcnt(0)" ::: "memory"); __builtin_amdgcn_s_barrier(); asm volatile("" ::: "memory");
        return bad;
    }
};
struct EpiLnRes {
    static constexpr bool PERM = false, AFTER_DRAIN = true;
    const float* base; float* out; int ldc; const float* bias; PanelStats st; unsigned poison;
    __device__ __forceinline__ void fused(f32x4 (&acc)[2][2][4][2], const Unit& u, int wr, int wc, int fr, int fq, PG8_LAS unsigned char* lds, int wid, int lane) const {
        typedef float f32x2v __attribute__((ext_vector_type(2)));
        const PG8_LAS f32x2v* S = (const PG8_LAS f32x2v*)(lds + 8192);
        const int col0 = u.pn * BM + wc * 32 + 4 * fq;
#pragma unroll
        for (int bj = 0; bj < 2; ++bj)
#pragma unroll
            for (int n = 0; n < 2; ++n) { const f32x4 bv = bias ? *(const f32x4*)(bias + col0 + bj * HALF + n * 16) : (f32x4){0.f, 0.f, 0.f, 0.f};
#pragma unroll
                for (int ai = 0; ai < 2; ++ai)
#pragma unroll
                    for (int m = 0; m < 4; ++m) acc[ai][bj][m][n] += bv; }
        f32x4 pre[4][2][2];
#pragma unroll
        for (int m = 0; m < 4; ++m) { const size_t off = (size_t)(u.pm * BM + wr * 64 + m * 16 + fr) * ldc + col0;
#pragma unroll
            for (int bj = 0; bj < 2; ++bj)
#pragma unroll
                for (int n = 0; n < 2; ++n) pre[m][bj][n] = *(const f32x4*)(base + off + bj * HALF + n * 16); }
        const bool bad = st.run(acc, u, wr, wc, fr, fq, lds, wid, lane) || poison != 0u;
        const float qnan = __builtin_nanf("");
#pragma unroll
        for (int ai = 0; ai < 2; ++ai)
#pragma unroll
            for (int m = 0; m < 4; ++m) { const int r = ai * HALF + wr * 64 + m * 16 + fr; const f32x2v sr = S[r]; const size_t off = (size_t)(u.pm * BM + r) * ldc + col0;
#pragma unroll
                for (int bj = 0; bj < 2; ++bj)
#pragma unroll
                    for (int n = 0; n < 2; ++n) { const f32x4 bs = ai == 0 ? pre[m][bj][n] : *(const f32x4*)(base + off + bj * HALF + n * 16); f32x4 o = bs + (acc[ai][bj][m][n] - sr.x) * sr.y;
                        if (bad) o = (f32x4){qnan, qnan, qnan, qnan}; *(f32x4*)(out + off + bj * HALF + n * 16) = o; }
                if (m & 1) asm volatile("" ::: "memory"); }
    }
};
struct EpiLnResLn {
    static constexpr bool PERM = false, AFTER_DRAIN = true;
    const float* base; float* out; bf16_t* xn; int ldc; const float* bias; PanelStats st1, st2; unsigned poison;
    __device__ __forceinline__ void fused(f32x4 (&acc)[2][2][4][2], const Unit& u, int wr, int wc, int fr, int fq, PG8_LAS unsigned char* lds, int wid, int lane) const {
        typedef float f32x2v __attribute__((ext_vector_type(2))); typedef unsigned u32x2v __attribute__((ext_vector_type(2)));
        const PG8_LAS f32x2v* S = (const PG8_LAS f32x2v*)(lds + 8192);
        const int col0 = u.pn * BM + wc * 32 + 4 * fq;
#pragma unroll
        for (int bj = 0; bj < 2; ++bj)
#pragma unroll
            for (int n = 0; n < 2; ++n) { const f32x4 bv = bias ? *(const f32x4*)(bias + col0 + bj * HALF + n * 16) : (f32x4){0.f, 0.f, 0.f, 0.f};
#pragma unroll
                for (int ai = 0; ai < 2; ++ai)
#pragma unroll
                    for (int m = 0; m < 4; ++m) acc[ai][bj][m][n] += bv; }
        bool bad = st1.run(acc, u, wr, wc, fr, fq, lds, wid, lane) || poison != 0u;
        const float qnan = __builtin_nanf("");
#pragma unroll
        for (int ai = 0; ai < 2; ++ai)
#pragma unroll
            for (int m = 0; m < 4; ++m) { const int r = ai * HALF + wr * 64 + m * 16 + fr; const f32x2v sr = S[r]; const size_t off = (size_t)(u.pm * BM + r) * ldc + col0;
#pragma unroll
                for (int bj = 0; bj < 2; ++bj)
#pragma unroll
                    for (int n = 0; n < 2; ++n) { const f32x4 bs = *(const f32x4*)(base + off + bj * HALF + n * 16); acc[ai][bj][m][n] = bs + (acc[ai][bj][m][n] - sr.x) * sr.y; }
                asm volatile("" : "+v"(acc[ai][0][m][0]), "+v"(acc[ai][0][m][1]), "+v"(acc[ai][1][m][0]), "+v"(acc[ai][1][m][1]));
                if (m & 1) asm volatile("" ::: "memory"); }
        const bool bad1 = bad;
        bad = st2.run(acc, u, wr, wc, fr, fq, lds, wid, lane) || bad;
#pragma unroll
        for (int ai = 0; ai < 2; ++ai)
#pragma unroll
            for (int m = 0; m < 4; ++m) { const int r = ai * HALF + wr * 64 + m * 16 + fr; const f32x2v sr = S[r]; const size_t off = (size_t)(u.pm * BM + r) * ldc + col0;
#pragma unroll
                for (int bj = 0; bj < 2; ++bj)
#pragma unroll
                    for (int n = 0; n < 2; ++n) { const f32x4 x1 = acc[ai][bj][m][n]; *(f32x4*)(out + off + bj * HALF + n * 16) = bad1 ? (f32x4){qnan, qnan, qnan, qnan} : x1;
                        const f32x4 o = (x1 - sr.x) * sr.y; u32x2v w; w.x = cvt_pk_bf16(o[0], o[1]); w.y = cvt_pk_bf16(o[2], o[3]);
                        if (bad) { w.x = 0x7fc07fc0u; w.y = 0x7fc07fc0u; } *(u32x2v*)(xn + off + bj * HALF + n * 16) = w; }
                asm volatile("" ::: "memory"); }
    }
};

template <class Epi, class Sched, bool ALIGN_EPI = false, bool SP2 = false>
__device__ __forceinline__ void gemm_phase(PG8_LAS unsigned char* lds, const Gemm g, const Sched& S, const Epi& E) {
    const int tid = opaque_tid(), wid = __builtin_amdgcn_readfirstlane(tid >> 6), lane = tid & 63, wr = wid >> 2, wc = wid & 3, fr = lane & 15, fq = lane >> 4;
    const int K = g.K, nt = K / BK;
    unsigned voffA[2], voffB[2];
#pragma unroll
    for (int i = 0; i < 2; ++i) { int R, C; stage_rc(tid * 16 + i * 8192, R, C); const int Rb = Epi::PERM ? ((R & ~31) + perm32(R & 31)) : R;
        voffA[i] = (unsigned)(R * K + C) * 2u; voffB[i] = (unsigned)(Rb * K + C) * 2u; }
    const size_t kstep = (size_t)(BK * 2);
    const size_t hstep = (size_t)HALF * K * 2;
    const size_t tstep = 2 * hstep;
    const unsigned ldsw = (unsigned)wid * 1024u;
    const int aoff = lds_byte(wr * 64 + fr, fq * 8), boff = lds_byte(wc * 32 + fr, fq * 8);
#define PG8_SA(b, h) (((b) * 2 + (h)) * HTB)
#define PG8_SB(b, h) ((4 + (b) * 2 + (h)) * HTB)
#define PG8_STAGE(bufoff, gbase, voff) do { _Pragma("unroll") for (int _i = 0; _i < 2; ++_i) \
        __builtin_amdgcn_global_load_lds((const unsigned*)((const char*)(gbase) + (voff)[_i]), (PG8_LAS unsigned*)(lds + (bufoff) + ldsw + _i * 8192), 16, 0, 0); } while (0)
#define PG8_LDA(dst, b, h) do { _Pragma("unroll") for (int m = 0; m < 4; ++m) _Pragma("unroll") for (int k = 0; k < 2; ++k) dst[m][k] = *(const PG8_LAS bf16x8*)(lds + PG8_SA(b, h) + aoff + m * 2048 + k * 1024); } while (0)
#define PG8_LDB(dst, b, h) do { _Pragma("unroll") for (int n = 0; n < 2; ++n) _Pragma("unroll") for (int k = 0; k < 2; ++k) dst[n][k] = *(const PG8_LAS bf16x8*)(lds + PG8_SB(b, h) + boff + n * 2048 + k * 1024); } while (0)
#define PG8_MMA(ai, bj, At, Bt) do { __builtin_amdgcn_s_setprio(1); _Pragma("unroll") for (int m = 0; m < 4; ++m) _Pragma("unroll") for (int n = 0; n < 2; ++n) _Pragma("unroll") for (int k = 0; k < 2; ++k) \
        acc[ai][bj][m][n] = __builtin_amdgcn_mfma_f32_16x16x32_bf16(Bt[n][k], At[m][k], acc[ai][bj][m][n], 0, 0, 0); __builtin_amdgcn_s_setprio(0); } while (0)
#define PG8_WAIT_V(n) asm volatile("s_waitcnt vmcnt(" #n ")" ::: "memory")
#define PG8_WAIT_L(n) asm volatile("s_waitcnt lgkmcnt(" #n ")" ::: "memory")
#define PG8_BAR __builtin_amdgcn_s_barrier()
#define PG8_SCHED __builtin_amdgcn_sched_barrier(0)
    Unit cur, nxt; int ui = 0;
    if (!S.next(0, cur)) return;
    f32x4 acc[2][2][4][2];
#pragma unroll
    for (int a = 0; a < 2; ++a)
#pragma unroll
        for (int b = 0; b < 2; ++b)
#pragma unroll
            for (int m = 0; m < 4; ++m)
#pragma unroll
                for (int n = 0; n < 2; ++n) acc[a][b][m][n] = (f32x4){0.f, 0.f, 0.f, 0.f};
    bf16x8 At[4][2], B0[2][2], B1[2][2];
    const char* cA = (const char*)g.A + (size_t)cur.pm * tstep; const char* cB = (const char*)g.Bt + (size_t)cur.pn * tstep;
    S.a_ready(cur);
    if constexpr (SP2) {
        PG8_STAGE(PG8_SB(0, 0), cB, voffB); PG8_STAGE(PG8_SB(0, 1), cB + hstep, voffB); PG8_STAGE(PG8_SA(0, 0), cA, voffA); PG8_STAGE(PG8_SA(0, 1), cA + hstep, voffA);
        if (wr == 1) PG8_BAR;
        PG8_WAIT_V(2); PG8_BAR;
        PG8_STAGE(PG8_SB(1, 0), cB + kstep, voffB); PG8_STAGE(PG8_SA(1, 0), cA + kstep, voffA); PG8_STAGE(PG8_SB(1, 1), cB + hstep + kstep, voffB);
        PG8_WAIT_V(6); PG8_BAR;
    } else {
        PG8_STAGE(PG8_SB(0, 0), cB, voffB); PG8_STAGE(PG8_SA(0, 0), cA, voffA); PG8_STAGE(PG8_SB(0, 1), cB + hstep, voffB); PG8_STAGE(PG8_SA(0, 1), cA + hstep, voffA);
        if (wr == 1) PG8_BAR;
        PG8_WAIT_V(4); PG8_BAR;
        PG8_STAGE(PG8_SB(1, 0), cB + kstep, voffB); PG8_STAGE(PG8_SA(1, 0), cA + kstep, voffA); PG8_STAGE(PG8_SB(1, 1), cB + hstep + kstep, voffB);
        PG8_WAIT_V(6); PG8_BAR;
    }
    for (;;) {
        const bool has_next = S.next(ui + 1, nxt);
        const char* nA = has_next ? (const char*)g.A + (size_t)nxt.pm * tstep : cA; const char* nB = has_next ? (const char*)g.Bt + (size_t)nxt.pn * tstep : cB;
        for (int t = 0; t < nt; t += 2) {
            const bool last = (t == nt - 2);
            const char* a1 = cA + (size_t)(t + 1) * kstep;
            const char* a2 = last ? nA : cA + (size_t)(t + 2) * kstep; const char* b2 = last ? nB : cB + (size_t)(t + 2) * kstep;
            const char* a3 = a2 + kstep; const char* b3 = b2 + kstep;
            if (last && has_next) S.a_ready(nxt);
            if constexpr (SP2) {
            PG8_LDB(B0, 0, 0); PG8_LDB(B1, 0, 1); PG8_SCHED; PG8_LDA(At, 0, 0); PG8_STAGE(PG8_SA(1, 1), a1 + hstep, voffA);
            PG8_WAIT_V(8); PG8_WAIT_L(0); PG8_BAR; PG8_MMA(0, 0, At, B0); PG8_MMA(0, 1, At, B1); PG8_BAR; PG8_SCHED;
            PG8_LDA(At, 0, 1); PG8_STAGE(PG8_SB(0, 0), b2, voffB); PG8_STAGE(PG8_SB(0, 1), b2 + hstep, voffB); PG8_STAGE(PG8_SA(0, 0), a2, voffA);
            PG8_WAIT_V(8); PG8_WAIT_L(0); PG8_BAR; PG8_MMA(1, 0, At, B0); PG8_MMA(1, 1, At, B1); PG8_BAR; PG8_SCHED;
            PG8_LDB(B0, 1, 0); PG8_LDB(B1, 1, 1); PG8_SCHED; PG8_LDA(At, 1, 0); PG8_STAGE(PG8_SA(0, 1), a2 + hstep, voffA);
            PG8_WAIT_V(8); PG8_WAIT_L(0); PG8_BAR; PG8_MMA(0, 0, At, B0); PG8_MMA(0, 1, At, B1); PG8_BAR; PG8_SCHED;
            PG8_LDA(At, 1, 1); PG8_STAGE(PG8_SB(1, 0), b3, voffB); PG8_STAGE(PG8_SB(1, 1), b3 + hstep, voffB); PG8_STAGE(PG8_SA(1, 0), a3, voffA);
            PG8_WAIT_V(8); PG8_WAIT_L(0); PG8_BAR; PG8_MMA(1, 0, At, B0); PG8_MMA(1, 1, At, B1); PG8_BAR; PG8_SCHED;
            } else {
            PG8_LDB(B0, 0, 0); PG8_SCHED; PG8_LDA(At, 0, 0); PG8_STAGE(PG8_SA(1, 1), a1 + hstep, voffA);
            PG8_WAIT_L(8); PG8_BAR; PG8_WAIT_L(0); PG8_MMA(0, 0, At, B0); PG8_BAR; PG8_SCHED;
            PG8_LDB(B1, 0, 1); PG8_STAGE(PG8_SB(0, 0), b2, voffB);
            PG8_BAR; PG8_WAIT_L(0); PG8_MMA(0, 1, At, B1); PG8_BAR;
            PG8_LDA(At, 0, 1); PG8_STAGE(PG8_SA(0, 0), a2, voffA);
            PG8_BAR; PG8_WAIT_L(0); PG8_MMA(1, 0, At, B0); PG8_BAR; PG8_SCHED;
            PG8_STAGE(PG8_SB(0, 1), b2 + hstep, voffB);
            PG8_WAIT_V(6); PG8_BAR; PG8_MMA(1, 1, At, B1); PG8_BAR;
            PG8_LDB(B0, 1, 0); PG8_SCHED; PG8_LDA(At, 1, 0); PG8_STAGE(PG8_SA(0, 1), a2 + hstep, voffA);
            PG8_WAIT_L(8); PG8_BAR; PG8_WAIT_L(0); PG8_MMA(0, 0, At, B0); PG8_BAR; PG8_SCHED;
            PG8_LDB(B1, 1, 1); PG8_STAGE(PG8_SB(1, 0), b3, voffB);
            PG8_BAR; PG8_WAIT_L(0); PG8_MMA(0, 1, At, B1); PG8_BAR;
            PG8_LDA(At, 1, 1); PG8_STAGE(PG8_SA(1, 0), a3, voffA);
            PG8_BAR; PG8_WAIT_L(0); PG8_MMA(1, 0, At, B0); PG8_BAR; PG8_SCHED;
            PG8_STAGE(PG8_SB(1, 1), b3 + hstep, voffB);
            PG8_WAIT_V(6); PG8_BAR; PG8_MMA(1, 1, At, B1); PG8_BAR;
            }
        }
        if constexpr (ALIGN_EPI) { if (wr == 0) PG8_BAR; }
        if constexpr (!Epi::AFTER_DRAIN) { E(acc, cur, wr, wc, fr, fq); S.done(cur); }
        if (!has_next) break;
#pragma unroll
        for (int a = 0; a < 2; ++a)
#pragma unroll
            for (int b = 0; b < 2; ++b)
#pragma unroll
                for (int m = 0; m < 4; ++m)
#pragma unroll
                    for (int n = 0; n < 2; ++n) acc[a][b][m][n] = (f32x4){0.f, 0.f, 0.f, 0.f};
        cur = nxt; cA = nA; cB = nB; ++ui;
        if constexpr (ALIGN_EPI) { if (wr == 1) PG8_BAR; }
    }
    PG8_WAIT_V(0);
    if constexpr (!ALIGN_EPI) { if (wr == 0) PG8_BAR; }
    PG8_BAR;
    if constexpr (Epi::AFTER_DRAIN) { E.fused(acc, cur, wr, wc, fr, fq, lds, wid, lane); S.done(cur); }
#undef PG8_SA
#undef PG8_SB
#undef PG8_STAGE
#undef PG8_LDA
#undef PG8_LDB
#undef PG8_MMA
#undef PG8_WAIT_V
#undef PG8_WAIT_L
#undef PG8_BAR
#undef PG8_SCHED
}
}
#include <hip/hip_bf16.h>
#include <cmath>
namespace attn_body {
using bf16=__hip_bfloat16;
using bf16x8=__attribute__((ext_vector_type(8)))short;
using s16x4=__attribute__((ext_vector_type(4)))short;
using f32x16=__attribute__((ext_vector_type(16)))float;
using u32x4=__attribute__((ext_vector_type(4)))unsigned;
using f32x4b=__attribute__((ext_vector_type(4)))float;
constexpr int BATCH=8,NHEAD=16,SEQ=2048,D=64,DM=4096,DMO=1024;
constexpr int NW=8,QBLK=32,QB=QBLK*NW,KVBLK=64,NQB=SEQ/QB;
constexpr int ATTN_PITCH=DM, ATTN_UNIT_ROWS=QB;
constexpr int LDS_BIAS_OFF=86016;
__device__ __forceinline__ int crow(int r,int hi){return (r&3)+8*(r>>2)+4*hi;}
#define SBAR() __builtin_amdgcn_sched_barrier(0)
__device__ __forceinline__ void cmask(f32x16&p0,f32x16&p1,int jb,int qrel,int hi){
  const float NEG=-INFINITY; int kb=64*jb+4*hi;
  #pragma unroll
  for(int r=0;r<16;++r){int kv=kb+(r&3)+8*(r>>2); if(kv>qrel)p0[r]=NEG; if(kv+32>qrel)p1[r]=NEG;}
}

constexpr int NSLOT=3, SLOTB=8192;
constexpr int LDS_K=0, LDS_V=NSLOT*SLOTB, LDS_WS=2*NSLOT*SLOTB, LDS_OST=LDS_WS+NW*64*4, LDS_BYTES=LDS_OST+NW*4096;
constexpr float C2=0.125f*1.4426950408889634f;
__device__ __forceinline__ void glds16(const void*gsrc,unsigned lds_dst){unsigned keep;
  asm volatile("s_mov_b32 %0, m0\n\ts_mov_b32 m0, %2\n\ts_nop 0\n\tglobal_load_lds_dwordx4 %1, off\n\ts_mov_b32 m0, %0":"=&s"(keep):"v"(gsrc),"s"(lds_dst):"memory");}
__device__ __forceinline__ float max3f(float a,float b,float c){float r;asm("v_max3_f32 %0, %1, %2, %3":"=v"(r):"v"(a),"v"(b),"v"(c));return r;}
__device__ __forceinline__ float max2f(float a,float b){float r;asm("v_max_f32_e32 %0, %1, %2":"=v"(r):"v"(a),"v"(b));return r;}
__device__ __forceinline__ float fadd_s(float a,float b){float r;asm("v_add_f32_e32 %0, %1, %2":"=v"(r):"v"(a),"v"(b));return r;}
__device__ __forceinline__ float fsub_s(float a,float b){float r;asm("v_sub_f32_e32 %0, %1, %2":"=v"(r):"v"(a),"v"(b));return r;}
typedef float f32x2_t __attribute__((ext_vector_type(2))); typedef __bf16 bf16x2_t __attribute__((ext_vector_type(2)));
__device__ __forceinline__ unsigned cvtpk_s(float lo,float hi){f32x2_t v={lo,hi};bf16x2_t b=__builtin_convertvector(v,bf16x2_t);return __builtin_bit_cast(unsigned,b);}
#define WAIT_BAR(N) asm volatile("s_waitcnt vmcnt(" #N ") lgkmcnt(0)\n\ts_barrier":::"memory")

__device__ __forceinline__ void qkt(f32x16&p0,f32x16&p1,const char*Kslot,const bf16x8*qr,const f32x16&negm,int r32,int hi){
  const char*kb=Kslot+hi*1024+r32*16;
  #pragma unroll
  for(int d0=0;d0<4;++d0){
    const bf16x8 b0=*reinterpret_cast<const bf16x8*>(kb+d0*2048);
    const bf16x8 b1=*reinterpret_cast<const bf16x8*>(kb+d0*2048+512);
    if(d0==0){p0=__builtin_amdgcn_mfma_f32_32x32x16_bf16(b0,qr[0],negm,0,0,0);p1=__builtin_amdgcn_mfma_f32_32x32x16_bf16(b1,qr[0],negm,0,0,0);}
    else{p0=__builtin_amdgcn_mfma_f32_32x32x16_bf16(b0,qr[d0],p0,0,0,0);p1=__builtin_amdgcn_mfma_f32_32x32x16_bf16(b1,qr[d0],p1,0,0,0);}}
}
typedef __attribute__((address_space(3))) const char* lds_cptr;
typedef short v4i16_t __attribute__((ext_vector_type(4)));
__device__ __forceinline__ void kload8(bf16x8*kf,lds_cptr kp){
  kf[0]=*(const __attribute__((address_space(3))) bf16x8*)(kp);      kf[1]=*(const __attribute__((address_space(3))) bf16x8*)(kp+512);
  kf[2]=*(const __attribute__((address_space(3))) bf16x8*)(kp+2048); kf[3]=*(const __attribute__((address_space(3))) bf16x8*)(kp+2560);
  kf[4]=*(const __attribute__((address_space(3))) bf16x8*)(kp+4096); kf[5]=*(const __attribute__((address_space(3))) bf16x8*)(kp+4608);
  kf[6]=*(const __attribute__((address_space(3))) bf16x8*)(kp+6144); kf[7]=*(const __attribute__((address_space(3))) bf16x8*)(kp+6656);
}
__device__ __forceinline__ void kload2(bf16x8*kf,lds_cptr kp,int j){ kf[2*j]=*(const __attribute__((address_space(3))) bf16x8*)(kp+j*2048); kf[2*j+1]=*(const __attribute__((address_space(3))) bf16x8*)(kp+j*2048+512); }
__device__ __forceinline__ s16x4 vtr(lds_cptr p){ return __builtin_bit_cast(s16x4,__builtin_amdgcn_ds_read_tr16_b64_v4i16((__attribute__((address_space(3))) v4i16_t*)p)); }
__device__ __forceinline__ float rowmax(const f32x16&p0,const f32x16&p1){
  float a=max3f(p0[0],p0[1],p1[0]),b=max3f(p0[2],p0[3],p1[1]);a=max3f(a,p1[2],p1[3]);
  #pragma unroll
  for(int r=4;r<16;r+=4){a=max3f(a,p0[r],p0[r+1]);b=max3f(b,p0[r+2],p0[r+3]);a=max3f(a,p1[r],p1[r+1]);b=max3f(b,p1[r+2],p1[r+3]);}
  const float m=max2f(a,b);
  auto rr=__builtin_amdgcn_permlane32_swap(__float_as_uint(m),__float_as_uint(m),false,false);
  return max2f(__uint_as_float(rr[0]),__uint_as_float(rr[1]));
}
__device__ __forceinline__ void pv(f32x16*o,int vb,bf16x8 pa0,bf16x8 pa1,bf16x8 pa2,bf16x8 pa3){
  #pragma unroll
  for(int d0=0;d0<2;++d0){s16x4 lo[4],hi[4];
    #pragma unroll
    for(int ks=0;ks<4;++ks){
      asm volatile("ds_read_b64_tr_b16 %0,%1 offset:%c2":"=&v"(lo[ks]):"v"(vb),"i"(d0*4096+ks*1024):"memory");
      asm volatile("ds_read_b64_tr_b16 %0,%1 offset:%c2":"=&v"(hi[ks]):"v"(vb),"i"(d0*4096+ks*1024+512):"memory");}
    asm volatile("s_waitcnt lgkmcnt(0)":::"memory");SBAR();
    #define PK(k) (bf16x8){lo[k][0],lo[k][1],lo[k][2],lo[k][3],hi[k][0],hi[k][1],hi[k][2],hi[k][3]}
    o[d0]=__builtin_amdgcn_mfma_f32_32x32x16_bf16(pa0,PK(0),o[d0],0,0,0);
    o[d0]=__builtin_amdgcn_mfma_f32_32x32x16_bf16(pa1,PK(1),o[d0],0,0,0);
    o[d0]=__builtin_amdgcn_mfma_f32_32x32x16_bf16(pa2,PK(2),o[d0],0,0,0);
    o[d0]=__builtin_amdgcn_mfma_f32_32x32x16_bf16(pa3,PK(3),o[d0],0,0,0);
    #undef PK
  }
}

#ifndef ATTN_STORE16
#define ATTN_STORE16(p,v) (*(u32x4*)(p)=(v))
#endif
template<int THRL> __device__ __forceinline__ void attn_unit(int b,int h,int qb,const bf16*Q,const bf16*__restrict__ K,const bf16*__restrict__ V,const bf16*__restrict__ OG,const float*__restrict__ CUM,bf16*O,char*shm){
  const int tid=opaque_tid(),lane=tid&63,r32=lane&31,hi=lane>>5; const int wid=__builtin_amdgcn_readfirstlane(tid>>6);
  const long rowbase=(long)b*SEQ; const int q0=qb*QB;
  const bf16*Qw=Q+(rowbase+q0+wid*QBLK)*DM+h*D;
  const bf16*Kh=K+rowbase*DM+h*D,*Vh=V+rowbase*DM+h*D;
  const unsigned lds0=(unsigned)(uintptr_t)shm;
  float*wsf=(float*)(shm+LDS_WS)+wid*64;
  const bf16*ksrc=Kh+(long)lane*DM+wid*8;
  const bf16*vsrc=Vh+(long)(16*(wid&3)+(lane>>2))*DM+(wid>>2)*32+(lane&3)*8;
  const unsigned kdst=lds0+LDS_K+wid*1024, vdst=lds0+LDS_V+wid*1024;
  #define DMA_K(t,slot) glds16(ksrc+(long)(t)*KVBLK*DM,(unsigned)__builtin_amdgcn_readfirstlane(kdst+(slot)))
  #define DMA_V(t,slot) glds16(vsrc+(long)(t)*KVBLK*DM,(unsigned)__builtin_amdgcn_readfirstlane(vdst+(slot)))
  const int vb0=(int)(lds0+LDS_V)+((lane>>4)&1)*32+(lane&3)*8+(4*hi+((lane&15)>>2))*64;
  const char*Kbase=shm+LDS_K; bf16x8 kf[8];
  const lds_cptr shm3=(lds_cptr)shm; const lds_cptr kp0=shm3+LDS_K+hi*1024+r32*16; const lds_cptr vp0=shm3+LDS_V+((lane>>4)&1)*32+(lane&3)*8+(4*hi+((lane&15)>>2))*64;
  const int NT=(q0+QB)/KVBLK;
  { float*bl=(float*)(shm+LDS_BIAS_OFF); const float*cs=CUM+((long)b*NHEAD+h)*SEQ;
    for(int j=tid;j<q0+QB;j+=NW*64)bl[j]=cs[j]*(-1.4426950408889634f);
    asm volatile("s_waitcnt vmcnt(0) lgkmcnt(0)\n\ts_barrier":::"memory"); }
  const lds_cptr bp0=(lds_cptr)shm+LDS_BIAS_OFF+hi*16;
  #define BIAS(P0,P1,t) do{ const lds_cptr bp_=bp0+(t)*256; \
    _Pragma("unroll") for(int g_=0;g_<4;++g_){ const f32x4b b0_=*(const __attribute__((address_space(3))) f32x4b*)(bp_+g_*32); const f32x4b b1_=*(const __attribute__((address_space(3))) f32x4b*)(bp_+128+g_*32); \
      P0[4*g_]+=b0_[0];P0[4*g_+1]+=b0_[1];P0[4*g_+2]+=b0_[2];P0[4*g_+3]+=b0_[3]; P1[4*g_]+=b1_[0];P1[4*g_+1]+=b1_[1];P1[4*g_+2]+=b1_[2];P1[4*g_+3]+=b1_[3]; } }while(0)
  DMA_K(0,0);DMA_V(0,0);DMA_K(1,SLOTB);
  bf16x8 qr[4];
  #pragma unroll
  for(int d0=0;d0<4;++d0)qr[d0]=*reinterpret_cast<const bf16x8*>(&Qw[(long)r32*DM+d0*16+hi*8]);
  float mhat=0.f,l_reg=0.f;f32x16 o[2];o[0]=f32x16{};o[1]=f32x16{};f32x16 negm=f32x16{};asm volatile("":"+v"(negm));
  const int qrel=wid*QBLK+r32;
  #define CMASK(P0,P1,t) do{int jb_=(t)-(NT-4); if(jb_>=0)cmask(P0,P1,jb_,qrel,hi);}while(0)
  bool resc=false;
  #define START(P0,P1) do{ const float rm=rowmax(P0,P1); resc=false; \
    { const float dl=rm; mhat=fadd_s(mhat,dl); \
      _Pragma("unroll") for(int r=0;r<16;++r){P0[r]=fsub_s(P0[r],dl);P1[r]=fsub_s(P1[r],dl);} \
      _Pragma("unroll") for(int r=0;r<16;++r)negm[r]=-mhat; asm volatile("":"+v"(negm)); } \
    _Pragma("unroll") for(int r=0;r<16;++r)P0[r]=__builtin_amdgcn_exp2f(P0[r]); }while(0)
  #define RESC() do{ if(resc){ asm volatile("s_waitcnt lgkmcnt(0)":::"memory"); \
      _Pragma("unroll") for(int d_=0;d_<2;++d_) _Pragma("unroll") for(int r=0;r<16;++r)o[d_][r]*=wsf[crow(r,hi)]; } }while(0)
  f32x16 pA0,pA1,pB0,pB1;
  int sl_prev=0,sl_cur=0,sl_next=SLOTB;
  #define ROT() do{sl_prev=sl_cur;sl_cur=sl_next;sl_next=(sl_next==(NSLOT-1)*SLOTB)?0:sl_next+SLOTB;}while(0)
  DMA_K(2,2*SLOTB);
  WAIT_BAR(3);
  qkt(pA0,pA1,Kbase,qr,negm,r32,hi);asm volatile("s_nop 15\n\ts_nop 7":"+v"(pA0),"+v"(pA1));BIAS(pA0,pA1,0);CMASK(pA0,pA1,0);
  START(pA0,pA1);
  _Pragma("unroll") for(int r=0;r<16;++r)pA1[r]=__builtin_amdgcn_exp2f(pA1[r]);
  WAIT_BAR(0);
  DMA_K(3,0);DMA_V(1,SLOTB);
  ROT();
  kload8(kf,kp0+sl_cur);
  WAIT_BAR(2);
  s16x4 vlo[8],vhi[8]; u32x4 pw0,pw1,pw2,pw3;
  #define PKW(P,B) cvtpk_s(P[B],P[B+1])
  #define PAF(k) __builtin_bit_cast(bf16x8,pw##k)
  #define VFR(i) (bf16x8){vlo[i][0],vlo[i][1],vlo[i][2],vlo[i][3],vhi[i][0],vhi[i][1],vhi[i][2],vhi[i][3]}
  #define PIN(x) asm volatile("":"+v"(x))
  #define MX3(a,b,c) __builtin_fmaxf(__builtin_fmaxf((a),(b)),(c))
  #define GAPA(MF,A0,A1,A2,A3,W0,W1,PW) do{ MF; sacc+=A0; sacc+=A1; sacc+=A2; sacc+=A3; PIN(sacc); W0; W1; PIN(PW); SBAR(); }while(0)
  #define EX(v) __builtin_amdgcn_exp2f(v)
  #define GAPB(MF,X,B) do{ MF; X[B]=EX(X[B]); X[B+1]=EX(X[B+1]); X[B+2]=EX(X[B+2]); X[B+3]=EX(X[B+3]); PIN(X); SBAR(); }while(0)
  #define VRD(i) do{ vlo[i]=vtr(vp_+(((i)>>2)*4096+((i)&3)*1024)); vhi[i]=vtr(vp_+(((i)>>2)*4096+((i)&3)*1024+512)); }while(0)
  #define KRD(G,j) do{ if(G){ kload2(kf,kp0+sl_next,j); SBAR(); } }while(0)
  #define STEP(C0,C1,P0,P1,t,GK,GV,GL) do{ SBAR(); \
    const lds_cptr vp_=vp0+sl_prev; \
    VRD(0); SBAR(); float sacc=(P0[0]+P0[1]); \
    GAPA(C0=__builtin_amdgcn_mfma_f32_32x32x16_bf16(kf[0],qr[0],negm,0,0,0), P0[2],P0[3],P0[4],P0[5],     pw0[0]=PKW(P0,0), pw0[1]=PKW(P0,2), pw0); \
    VRD(4); SBAR(); GAPA(C1=__builtin_amdgcn_mfma_f32_32x32x16_bf16(kf[1],qr[0],negm,0,0,0), P0[6],P0[7],P0[8],P0[9],     pw0[2]=PKW(P0,4), pw0[3]=PKW(P0,6), pw0); \
    VRD(1); SBAR(); GAPA(C0=__builtin_amdgcn_mfma_f32_32x32x16_bf16(kf[2],qr[1],C0,0,0,0),   P0[10],P0[11],P0[12],P0[13], pw1[0]=PKW(P0,8), pw1[1]=PKW(P0,10), pw1); \
    VRD(5); SBAR(); GAPA(C1=__builtin_amdgcn_mfma_f32_32x32x16_bf16(kf[3],qr[1],C1,0,0,0),   P0[14],P0[15],P1[0],P1[1],   pw1[2]=PKW(P0,12),pw1[3]=PKW(P0,14), pw1); \
    VRD(2); SBAR(); GAPA(C0=__builtin_amdgcn_mfma_f32_32x32x16_bf16(kf[4],qr[2],C0,0,0,0),   P1[2],P1[3],P1[4],P1[5],     pw2[0]=PKW(P1,0), pw2[1]=PKW(P1,2), pw2); \
    VRD(6); SBAR(); GAPA(C1=__builtin_amdgcn_mfma_f32_32x32x16_bf16(kf[5],qr[2],C1,0,0,0),   P1[6],P1[7],P1[8],P1[9],     pw2[2]=PKW(P1,4), pw2[3]=PKW(P1,6), pw2); \
    VRD(3); SBAR(); GAPA(C0=__builtin_amdgcn_mfma_f32_32x32x16_bf16(kf[6],qr[3],C0,0,0,0),   P1[10],P1[11],P1[12],P1[13], pw3[0]=PKW(P1,8), pw3[1]=PKW(P1,10), pw3); \
    VRD(7); SBAR(); GAPA(C1=__builtin_amdgcn_mfma_f32_32x32x16_bf16(kf[7],qr[3],C1,0,0,0),   P1[14],P1[15],0.f,0.f,       pw3[2]=PKW(P1,12),pw3[3]=PKW(P1,14), pw3); \
    l_reg+=sacc; \
    if(GK){DMA_K((t)+3,sl_cur);} if(GV){DMA_V((t)+1,sl_next);} \
    BIAS(C0,C1,t); \
    CMASK(C0,C1,t); \
    { float a=MX3(C0[0],C0[1],C1[0]),b=MX3(C0[2],C0[3],C1[1]); a=MX3(a,C1[2],C1[3]); \
      _Pragma("unroll") for(int r=4;r<16;r+=4){a=MX3(a,C0[r],C0[r+1]);b=MX3(b,C0[r+2],C0[r+3]);a=MX3(a,C1[r],C1[r+1]);b=MX3(b,C1[r+2],C1[r+3]);} \
      float rm=__builtin_fmaxf(a,b); { auto rr=__builtin_amdgcn_permlane32_swap(__float_as_uint(rm),__float_as_uint(rm),false,false); rm=__builtin_fmaxf(__uint_as_float(rr[0]),__uint_as_float(rr[1])); } \
      resc=false; \
      if(__builtin_expect(__any(rm>(float)THRL),0)){ const float dl=__builtin_fmaxf(rm,0.f); mhat+=dl; \
        _Pragma("unroll") for(int r=0;r<16;++r){C0[r]-=dl;C1[r]-=dl;} \
        _Pragma("unroll") for(int r=0;r<16;++r)negm[r]=-mhat; asm volatile("":"+v"(negm)); \
        const float f=__builtin_amdgcn_exp2f(-dl); l_reg*=f; if(hi==0)wsf[r32]=f; resc=true; } } \
    SBAR(); \
    GAPB(o[0]=__builtin_amdgcn_mfma_f32_32x32x16_bf16(PAF(0),VFR(0),o[0],0,0,0), C0,0); \
    GAPB(o[1]=__builtin_amdgcn_mfma_f32_32x32x16_bf16(PAF(0),VFR(4),o[1],0,0,0), C0,4); \
    KRD(GL,0); GAPB(o[0]=__builtin_amdgcn_mfma_f32_32x32x16_bf16(PAF(1),VFR(1),o[0],0,0,0), C0,8); \
    KRD(GL,1); GAPB(o[1]=__builtin_amdgcn_mfma_f32_32x32x16_bf16(PAF(1),VFR(5),o[1],0,0,0), C0,12); \
    KRD(GL,2); GAPB(o[0]=__builtin_amdgcn_mfma_f32_32x32x16_bf16(PAF(2),VFR(2),o[0],0,0,0), C1,0); \
    KRD(GL,3); GAPB(o[1]=__builtin_amdgcn_mfma_f32_32x32x16_bf16(PAF(2),VFR(6),o[1],0,0,0), C1,4); \
    GAPB(o[0]=__builtin_amdgcn_mfma_f32_32x32x16_bf16(PAF(3),VFR(3),o[0],0,0,0), C1,8); \
    GAPB(o[1]=__builtin_amdgcn_mfma_f32_32x32x16_bf16(PAF(3),VFR(7),o[1],0,0,0), C1,12); \
    }while(0)
  int t=1;
  #undef CMASK
  #define CMASK(P0,P1,t) do{}while(0)
  for(;t+5<NT;t+=2){
    STEP(pB0,pB1,pA0,pA1,t,true,true,true);     WAIT_BAR(2); RESC(); ROT();
    STEP(pA0,pA1,pB0,pB1,t+1,true,true,true);   WAIT_BAR(2); RESC(); ROT();
  }
  #undef CMASK
  #define CMASK(P0,P1,t) do{int jb_=(t)-(NT-4); if(jb_>=0)cmask(P0,P1,jb_,qrel,hi);}while(0)
  #define ENDW(tt) do{ if((tt)+3<NT){WAIT_BAR(2);} else if((tt)+2<NT){WAIT_BAR(1);} else {WAIT_BAR(0);} }while(0)
  for(;t+1<NT;t+=2){
    STEP(pB0,pB1,pA0,pA1,t,(t+3<NT),(t+1<NT),(t+1<NT));       ENDW(t);   RESC(); ROT();
    STEP(pA0,pA1,pB0,pB1,t+1,(t+4<NT),(t+2<NT),(t+2<NT));     ENDW(t+1); RESC(); ROT();
  }
  STEP(pB0,pB1,pA0,pA1,NT-1,false,false,false); RESC();
  { float sacc=pB0[0]+pB0[1]; _Pragma("unroll") for(int r=2;r<16;++r)sacc+=pB0[r]; _Pragma("unroll") for(int r=0;r<16;++r)sacc+=pB1[r]; l_reg+=sacc;
    pw0=(u32x4){PKW(pB0,0),PKW(pB0,2),PKW(pB0,4),PKW(pB0,6)};pw1=(u32x4){PKW(pB0,8),PKW(pB0,10),PKW(pB0,12),PKW(pB0,14)};pw2=(u32x4){PKW(pB1,0),PKW(pB1,2),PKW(pB1,4),PKW(pB1,6)};pw3=(u32x4){PKW(pB1,8),PKW(pB1,10),PKW(pB1,12),PKW(pB1,14)};
    SBAR(); pv(o,vb0+sl_cur,PAF(0),PAF(1),PAF(2),PAF(3)); }
  #undef PKW
  #undef PAF
  #undef VFR
  #undef PIN
  #undef MX3
  #undef GAPA
  #undef GAPB
  #undef EX
  #undef VRD
  #undef KRD
  #undef STEP
  #undef ENDW
  {auto rr=__builtin_amdgcn_permlane32_swap(__float_as_uint(l_reg),__float_as_uint(l_reg),false,false);l_reg=__uint_as_float(rr[0])+__uint_as_float(rr[1]);}
  if(hi==0)wsf[32+r32]=l_reg;asm volatile("s_waitcnt lgkmcnt(0)":::"memory");
  float rli[16];
  #pragma unroll
  for(int r=0;r<16;++r)rli[r]=__builtin_amdgcn_rcpf(wsf[32+crow(r,hi)]);
  bf16*Ow=O+(rowbase+q0+wid*QBLK)*DMO+h*D; const bf16*Gw=OG+(rowbase+q0+wid*QBLK)*DM+h*D;
  { bf16*stg=(bf16*)(shm+LDS_OST)+wid*2048;
    #pragma unroll
    for(int r=0;r<16;++r){const int orow=crow(r,hi);
      #pragma unroll
      for(int d0=0;d0<2;++d0)stg[orow*64+d0*32+r32]=__float2bfloat16(o[d0][r]*rli[r]);}
    asm volatile("s_waitcnt lgkmcnt(0)":::"memory");
    #pragma unroll
    for(int i=0;i<4;++i){const int row=i*8+(lane>>3),ch=lane&7; u32x4 v=*(const u32x4*)(stg+row*64+ch*8); const u32x4 g=*(const u32x4*)(Gw+(long)row*DM+ch*8);
      #pragma unroll
      for(int e=0;e<4;++e){ const float o0=__uint_as_float(v[e]<<16),o1=__uint_as_float(v[e]&0xffff0000u),g0=__uint_as_float(g[e]<<16),g1=__uint_as_float(g[e]&0xffff0000u);
        v[e]=cvtpk_s(o0*__builtin_amdgcn_rcpf(1.0f+__builtin_amdgcn_exp2f(-1.4426950408889634f*g0)),o1*__builtin_amdgcn_rcpf(1.0f+__builtin_amdgcn_exp2f(-1.4426950408889634f*g1))); }
      ATTN_STORE16(Ow+(long)row*DMO+ch*8,v);} }
  asm volatile("s_waitcnt lgkmcnt(0)\n\ts_barrier":::"memory");
  #undef DMA_K
  #undef DMA_V
  #undef BIAS
  #undef CMASK
  #undef START
  #undef RESC
  #undef ROT
}
constexpr int ATTN_LDS_BYTES=LDS_BYTES;
struct AttnTensors { const bf16* Q; const bf16* K; const bf16* V; const bf16* OG; const float* CUM; bf16* O; };
struct AttnUnit { int bh; int qb; };
struct StaticOrder {
  int vcu, stride;
  __device__ __forceinline__ explicit StaticOrder(int grid,int block):vcu((grid%8==0)?(block%8)*(grid/8)+block/8:block),stride(grid){}
  __device__ __forceinline__ bool next(int i,AttnUnit&u)const{ const int su=vcu+(i>>2)*stride; if(su>=256)return false; const int p=su&1,k=i&3; u.bh=su>>1; u.qb=(k==0)?p:(k==1)?7-p:(k==2)?2+p:5-p; return true; }
  __device__ __forceinline__ void a_ready(const AttnUnit&)const{}
  __device__ __forceinline__ void done(const AttnUnit&)const{}
};
template<class Sched,int THRL=8> __device__ __forceinline__ void attn_phase(char*lds,const AttnTensors&T,const Sched&S){
  AttnUnit u;
  for(int i=0;S.next(i,u);++i){ S.a_ready(u); attn_unit<THRL>(u.bh/NHEAD,u.bh%NHEAD,u.qb,T.Q,T.K,T.V,T.OG,T.CUM,T.O,lds); S.done(u); }
}
#undef SBAR
#undef WAIT_BAR
}
#define GAS __attribute__((address_space(1)))
#define LAS __attribute__((address_space(3)))
typedef GAS unsigned gu32;
typedef GAS unsigned long long gu64;
#define RLX_AGENT __ATOMIC_RELAXED, __HIP_MEMORY_SCOPE_AGENT
#define XB_TMO      128
#define XB_XCNT(j)  (256  + 64 * (j))
#define XB_XSUB(j)  (1280 + 64 * (j))
#define XB_XGEN(j)  (2304 + 64 * (j))
#define XB_TOP      3328
#define XB_TOPGEN   3392
#define XCD_BAR_WORDS 3456
#define XB_SPIN_CAP (1u << 18)

__device__ __forceinline__ unsigned xb_ld(unsigned* p)              { return __hip_atomic_load(p, __ATOMIC_RELAXED, __HIP_MEMORY_SCOPE_AGENT); }
__device__ __forceinline__ unsigned xb_add(unsigned* p, unsigned v) { return __hip_atomic_fetch_add(p, v, __ATOMIC_RELAXED, __HIP_MEMORY_SCOPE_AGENT); }
__device__ __forceinline__ unsigned xb_xcc_id() { return (unsigned)__builtin_amdgcn_s_getreg((3 << 11) | 20) & 0xFu; }
#define XB_SPIN(cond, bar) do { unsigned _sp = 0; while (cond) { __builtin_amdgcn_s_sleep(1); \
    if ((++_sp & 255u) == 0u) { if (xb_ld(&(bar)[XB_TMO])) break; if (_sp > XB_SPIN_CAP) { atomicAdd(&(bar)[XB_TMO], 1u); break; } } } } while (0)

struct XcdBarrier {
    unsigned* bar; unsigned x;
    volatile LAS unsigned* st;
};

__device__ __forceinline__ XcdBarrier xcd_barrier_post(unsigned* bar, volatile LAS unsigned* st) {
    XcdBarrier b; b.bar = bar; b.x = xb_xcc_id(); b.st = st;
    if (threadIdx.x == 0) (void)xb_add(&bar[XB_XCNT(b.x)], 1u);
    return b;
}
__device__ __forceinline__ void xcd_barrier_complete(unsigned* bar, unsigned x, unsigned& nloc, unsigned& nx) {
    const unsigned G = gridDim.x * gridDim.y * gridDim.z;
    unsigned sum, cnt, mine, sp = 0u;
    for (;;) {
        sum = 0u; cnt = 0u; mine = 0u;
#pragma unroll
        for (unsigned j = 0; j < 16; ++j) { const unsigned c = xb_ld(&bar[XB_XCNT(j)]); sum += c; cnt += (c > 0u) ? 1u : 0u; mine = (j == x) ? c : mine; }
        if (sum == G) break;
        __builtin_amdgcn_s_sleep(1);
        if ((++sp & 255u) == 0u) { if (xb_ld(&bar[XB_TMO])) break; if (sp > XB_SPIN_CAP) { atomicAdd(&bar[XB_TMO], 1u); break; } }
    }
    nloc = mine > 0u ? mine : 1u; nx = cnt > 0u ? cnt : 1u;
}

__device__ __forceinline__ void xcd_barrier(const XcdBarrier& b) {
    asm volatile("s_waitcnt vmcnt(0)" ::: "memory");
    __syncthreads();
    if (threadIdx.x == 0) {
        unsigned* bar = b.bar;
        __builtin_amdgcn_s_waitcnt(0);
        unsigned nloc = b.st[0], nx = b.st[1];
        if (nloc == 0u) { xcd_barrier_complete(bar, b.x, nloc, nx); b.st[0] = nloc; b.st[1] = nx; }
        const unsigned old = xb_add(&bar[XB_XSUB(b.x)], 1u);
        const unsigned gen = old / nloc;
        if (old + 1u == (gen + 1u) * nloc) {
            __builtin_amdgcn_fence(__ATOMIC_RELEASE, "agent");
            asm volatile("s_waitcnt vmcnt(0)" ::: "memory");
            const unsigned og = xb_add(&bar[XB_TOP], 1u);
            const unsigned tg = og / nx;
            if (og + 1u == (tg + 1u) * nx) xb_add(&bar[XB_TOPGEN], 1u);
            else XB_SPIN(xb_ld(&bar[XB_TOPGEN]) == tg, bar);
            __builtin_amdgcn_fence(__ATOMIC_ACQUIRE, "agent");
            xb_add(&bar[XB_XGEN(b.x)], 1u);
            asm volatile("s_waitcnt vmcnt(0)" ::: "memory");
        } else {
            XB_SPIN(xb_ld(&bar[XB_XGEN(b.x)]) == gen, bar);
            __builtin_amdgcn_fence(__ATOMIC_ACQUIRE, "agent");
            asm volatile("s_waitcnt vmcnt(0)" ::: "memory");
        }
    }
    __syncthreads();
}

typedef unsigned short bf16_t;
typedef short bf16x8_t __attribute__((ext_vector_type(8)));
typedef float f32x4_t __attribute__((ext_vector_type(4)));
constexpr int T_TOK = 16384, DM = 1024, SEQ = 2048, NBATCH = 8;
constexpr int L0_COLS = 3848, L0_MAIN = 3840, L1_COLS = 4112, L1_MAIN = 4096;
constexpr float DN_ALPHA = 1.4142135623730951f;
constexpr float LN_EPS = 1e-5f;
constexpr int NTHR = 512;

__device__ __forceinline__ unsigned f2bf(float f) { unsigned u = __float_as_uint(f); return (u + 0x7fffu + ((u >> 16) & 1u)) >> 16; }
__device__ __forceinline__ unsigned pk2(float lo, float hi) { return f2bf(lo) | (f2bf(hi) << 16); }
__device__ __forceinline__ float bflo(unsigned w) { return __uint_as_float(w << 16); }
__device__ __forceinline__ float bfhi(unsigned w) { return __uint_as_float(w & 0xffff0000u); }
__device__ __forceinline__ float bf2f(bf16_t h) { return __uint_as_float(((unsigned)h) << 16); }
__device__ __forceinline__ float wave_sum(float v) {
#pragma unroll
    for (int o = 32; o >= 1; o >>= 1) v += __shfl_xor(v, o);
    return v;
}
__device__ __forceinline__ float sigmoid_f(float x) { return 1.0f / (1.0f + __expf(-x)); }
__device__ __forceinline__ float log_sigmoid_f(float x) { return fminf(x, 0.f) - log1pf(__expf(-fabsf(x))); }
__device__ __forceinline__ void unpack8(const uint4 w, float* f) {
    f[0] = bflo(w.x); f[1] = bfhi(w.x); f[2] = bflo(w.y); f[3] = bfhi(w.y); f[4] = bflo(w.z); f[5] = bfhi(w.z); f[6] = bflo(w.w); f[7] = bfhi(w.w);
}
__device__ __forceinline__ void unpack4(const uint2 w, float* f) { f[0] = bflo(w.x); f[1] = bfhi(w.x); f[2] = bflo(w.y); f[3] = bfhi(w.y); }

__device__ __forceinline__ void transpose_cvt_phase(const float* __restrict__ W, int K, int ldw, int c0, int N, bf16_t* __restrict__ WT, int bid, int nblk, float* tile  ) {
    const int nb = N / 64, nunits = (K / 64) * nb;
    for (int u = bid; u < nunits; u += nblk) {
        const int kb = u / nb, nbi = u % nb; const int k0 = kb * 64, n0 = nbi * 64;
        for (int i = opaque_tid(); i < 4096; i += NTHR) { const int kk = i >> 6, nn = i & 63; tile[kk * 65 + nn] = W[(size_t)(k0 + kk) * ldw + c0 + n0 + nn]; }
        __syncthreads();
        for (int i = opaque_tid(); i < 2048; i += NTHR) { const int nn = i >> 5, kp = (i & 31) * 2;
            const unsigned v = pk2(tile[kp * 65 + nn], tile[(kp + 1) * 65 + nn]); *(unsigned*)(WT + (size_t)(n0 + nn) * K + k0 + kp) = v; }
        __syncthreads();
    }
}
__device__ __forceinline__ void cvt_bf16_phase(const float* __restrict__ src, bf16_t* __restrict__ dst, size_t n8, int bid, int nblk) {
    for (size_t i = (size_t)bid * NTHR + opaque_tid(); i < n8; i += (size_t)nblk * NTHR) {
        const float4 a = ((const float4*)src)[2 * i], b = ((const float4*)src)[2 * i + 1];
        uint4 o; o.x = pk2(a.x, a.y); o.y = pk2(a.z, a.w); o.z = pk2(b.x, b.y); o.w = pk2(b.z, b.w); ((uint4*)dst)[i] = o; }
}
__device__ __forceinline__ void build_wlr_phase(const float* __restrict__ w_up, const float* __restrict__ a_up, const float* __restrict__ g_up, bf16_t* __restrict__ WT, int bid, int nblk) {
    for (int i = bid * NTHR + opaque_tid(); i < 1536 * 256; i += nblk * NTHR) { const int n = i >> 8, k = i & 255; float v = 0.f;
        if (n < 512) { if (k < 64) v = w_up[k * 512 + n]; }
        else if (n < 1024) { if (k >= 64 && k < 128) v = a_up[(k - 64) * 512 + (n - 512)]; }
        else { if (k >= 128) v = g_up[(k - 128) * 512 + (n - 1024)]; }
        WT[i] = (bf16_t)f2bf(v); }
}

namespace pg8 {
struct EpiF32 {
    static constexpr bool PERM = false, AFTER_DRAIN = false;
    float* C; long ldc;
    __device__ __forceinline__ void operator()(const f32x4 (&acc)[2][2][4][2], const Unit& u, int wr, int wc, int fr, int fq) const {
        const int row0 = u.pm * BM + wr * 64 + fr, col0 = u.pn * BM + wc * 32 + 4 * fq;
#pragma unroll
        for (int ai = 0; ai < 2; ++ai)
#pragma unroll
            for (int m = 0; m < 4; ++m) { float* rowp = C + (size_t)(row0 + ai * HALF + m * 16) * ldc + col0;
#pragma unroll
                for (int bj = 0; bj < 2; ++bj)
#pragma unroll
                    for (int n = 0; n < 2; ++n) *(f32x4*)(rowp + bj * HALF + n * 16) = acc[ai][bj][m][n]; }
    }
};
struct EpiBf16P {
    static constexpr bool PERM = true, AFTER_DRAIN = false;
    bf16_t* O; long ldc;
    __device__ __forceinline__ void operator()(const f32x4 (&acc)[2][2][4][2], const Unit& u, int wr, int wc, int fr, int fq) const {
        const int row0 = u.pm * BM + wr * 64 + fr; const int col0 = u.pn * BM + wc * 32 + 8 * fq;
#pragma unroll
        for (int ai = 0; ai < 2; ++ai)
#pragma unroll
            for (int m = 0; m < 4; ++m) { bf16_t* rowp = O + (size_t)(row0 + ai * HALF + m * 16) * ldc + col0;
#pragma unroll
                for (int bj = 0; bj < 2; ++bj) { const f32x4 v0 = acc[ai][bj][m][0], v1 = acc[ai][bj][m][1];
                    u32x4 w; w.x = cvt_pk_bf16(v0[0], v0[1]); w.y = cvt_pk_bf16(v0[2], v0[3]); w.z = cvt_pk_bf16(v1[0], v1[1]); w.w = cvt_pk_bf16(v1[2], v1[3]);
                    *(u32x4*)(rowp + bj * HALF) = w; } }
    }
};
struct EpiLowrank {
    static constexpr bool PERM = false, AFTER_DRAIN = false;
    float* lrw; bf16_t* lra; bf16_t* lrg; const float* w0; const float* a0;
    __device__ __forceinline__ void operator()(const f32x4 (&acc)[2][2][4][2], const Unit& u, int wr, int wc, int fr, int fq) const {
        const int row0 = u.pm * BM + wr * 64 + fr; const int sel = u.pn >> 1; const int colb = (u.pn & 1) * BM + wc * 32 + 4 * fq;
#pragma unroll
        for (int ai = 0; ai < 2; ++ai)
#pragma unroll
            for (int m = 0; m < 4; ++m) { const size_t rowoff = (size_t)(row0 + ai * HALF + m * 16) * 512;
#pragma unroll
                for (int bj = 0; bj < 2; ++bj)
#pragma unroll
                    for (int n = 0; n < 2; ++n) { const int c = colb + bj * HALF + n * 16; f32x4 v = acc[ai][bj][m][n];
                        if (sel == 0) { const f32x4 bv = *(const f32x4*)(w0 + c); *(f32x4*)(lrw + rowoff + c) = v + bv; }
                        else if (sel == 1) { const f32x4 bv = *(const f32x4*)(a0 + c); v = v + bv; uint2 o; o.x = pk2(v[0], v[1]); o.y = pk2(v[2], v[3]); *(uint2*)(lra + rowoff + c) = o; }
                        else { uint2 o; o.x = pk2(v[0], v[1]); o.y = pk2(v[2], v[3]); *(uint2*)(lrg + rowoff + c) = o; } } }
    }
};
}

template <int NG>
__device__ __forceinline__ void gates_phase(const float* X, const float* __restrict__ W, int ldw, int c0, float* __restrict__ out, int bid, int nblk, float* wg  ) {
    for (int i = opaque_tid(); i < NG * 1024; i += NTHR) { const int k = i / NG, g = i % NG; wg[g * 1024 + k] = W[(size_t)k * ldw + c0 + g]; }
    __syncthreads();
    const int lane = opaque_tid() & 63, wv = opaque_tid() >> 6;
    for (int t = bid * 8 + wv; t < T_TOK; t += nblk * 8) {
        float x[16];
#pragma unroll
        for (int j = 0; j < 16; ++j) x[j] = X[(size_t)t * 1024 + lane + 64 * j];
#pragma unroll 1
        for (int g = 0; g < NG; ++g) { float p = 0.f;
#pragma unroll
            for (int j = 0; j < 16; ++j) p += x[j] * wg[g * 1024 + lane + 64 * j];
            p = wave_sum(p); if (lane == 0) out[(size_t)t * 16 + g] = p; }
    }
    __syncthreads();
}
__device__ __forceinline__ void rwkv_prep_phase(const bf16_t* __restrict__ P0, const float* __restrict__ mu, bf16_t* __restrict__ App, int bid, int nblk) {
    for (size_t i = (size_t)bid * NTHR + opaque_tid(); i < (size_t)T_TOK * 256; i += (size_t)nblk * NTHR) {
        const int t = (int)(i >> 8), c = (int)(i & 255), col = 1536 + c;
        const float cur = bf2f(P0[(size_t)t * L0_MAIN + col]); const float prev = (t % SEQ) ? bf2f(P0[(size_t)(t - 1) * L0_MAIN + col]) : 0.f;
        float v = cur + (prev - cur) * mu[col];
        if (c < 64) v = tanhf(v); else if (c >= 128) v = sigmoid_f(v);
        App[i] = (bf16_t)f2bf(v); }
}
__device__ __forceinline__ void ln_phase(const float* xin, const float* mix, const float* g, const float* b, float* xout, bf16_t* xb, int bid, int nblk) {
    const int lane = opaque_tid() & 63, wv = opaque_tid() >> 6;
    for (int t = bid * 8 + wv; t < T_TOK; t += nblk * 8) {
        float4 y[4]; float s = 0.f;
#pragma unroll
        for (int j = 0; j < 4; ++j) { const float4 a = *(const float4*)(xin + (size_t)t * 1024 + 4 * lane + 256 * j), m = *(const float4*)(mix + (size_t)t * 1024 + 4 * lane + 256 * j);
            y[j].x = DN_ALPHA * a.x + m.x; y[j].y = DN_ALPHA * a.y + m.y; y[j].z = DN_ALPHA * a.z + m.z; y[j].w = DN_ALPHA * a.w + m.w; s += (y[j].x + y[j].y) + (y[j].z + y[j].w); }
        const float mean = wave_sum(s) * (1.f / 1024.f); float q = 0.f;
#pragma unroll
        for (int j = 0; j < 4; ++j) { y[j].x -= mean; y[j].y -= mean; y[j].z -= mean; y[j].w -= mean; q += (y[j].x * y[j].x + y[j].y * y[j].y) + (y[j].z * y[j].z + y[j].w * y[j].w); }
        const float rstd = rsqrtf(wave_sum(q) * (1.f / 1024.f) + LN_EPS);
#pragma unroll
        for (int j = 0; j < 4; ++j) { const float4 gg = *(const float4*)(g + 4 * lane + 256 * j), bb = *(const float4*)(b + 4 * lane + 256 * j);
            float4 o; o.x = y[j].x * rstd * gg.x + bb.x; o.y = y[j].y * rstd * gg.y + bb.y; o.z = y[j].z * rstd * gg.z + bb.z; o.w = y[j].w * rstd * gg.w + bb.w;
            *(float4*)(xout + (size_t)t * 1024 + 4 * lane + 256 * j) = o; uint2 w; w.x = pk2(o.x, o.y); w.y = pk2(o.z, o.w); *(uint2*)(xb + (size_t)t * 1024 + 4 * lane + 256 * j) = w; }
    }
}
__device__ __forceinline__ void fox_cumsum_phase(const float* __restrict__ gates, const float* __restrict__ f_b, float* __restrict__ cum, int bid, int nblk) {
    const int lane = opaque_tid() & 63, wv = opaque_tid() >> 6;
    for (int bh = bid * 8 + wv; bh < 128; bh += nblk * 8) {
        const int b = bh >> 4, h = bh & 15; const float fb = f_b[h];
        float lf[32]; double run = 0.0;
#pragma unroll
        for (int j = 0; j < 32; ++j) { const int s = lane * 32 + j; lf[j] = log_sigmoid_f(gates[((size_t)b * SEQ + s) * 16 + h] + fb); run += (double)lf[j]; }
        double incl = run;
#pragma unroll
        for (int o = 1; o < 64; o <<= 1) { const double v = __shfl_up(incl, o); if (lane >= o) incl += v; }
        double acc = incl - run;
#pragma unroll
        for (int j = 0; j < 32; ++j) { acc += (double)lf[j]; cum[(size_t)bh * SEQ + lane * 32 + j] = (float)acc; }
    }
}

__device__ __forceinline__ void fox_qknorm_phase(bf16_t* P1, const float* __restrict__ qn_g, const float* __restrict__ kn_g, int bid, int nblk) {
    const int tid = opaque_tid(); const int lane = tid & 63, wv = tid >> 6;
    for (int t = bid * 8 + wv; t < T_TOK; t += nblk * 8) {
#pragma unroll
        for (int which = 0; which < 2; ++which) {
            bf16_t* p = P1 + (size_t)t * L1_MAIN + which * 1024 + lane * 16; const float* g = (which ? kn_g : qn_g) + lane * 16;
            float f[16]; unpack8(*(const uint4*)p, f); unpack8(*(const uint4*)(p + 8), f + 8);
            float ss = 0.f;
#pragma unroll
            for (int j = 0; j < 16; ++j) ss += f[j] * f[j];
            ss += __shfl_xor(ss, 1); ss += __shfl_xor(ss, 2);
            const float r = rsqrtf(ss * (1.f / 64.f) + 1e-6f) * (which ? 1.0f : 0.125f * 1.4426950408889634f);
#pragma unroll
            for (int j = 0; j < 16; ++j) f[j] = f[j] * r * g[j];
            uint4 w0, w1; w0.x = pk2(f[0], f[1]); w0.y = pk2(f[2], f[3]); w0.z = pk2(f[4], f[5]); w0.w = pk2(f[6], f[7]); w1.x = pk2(f[8], f[9]); w1.y = pk2(f[10], f[11]); w1.z = pk2(f[12], f[13]); w1.w = pk2(f[14], f[15]);
            *(uint4*)p = w0; *(uint4*)(p + 8) = w1; }
    }
}

struct RwkvArgs { const bf16_t* P0; const float* lrw; const bf16_t* lra; const bf16_t* lrg; const float* mu; const float* k_k; const float* k_a; const float* r_k; const float* ln_g; const float* ln_b; bf16_t* ycat; };
constexpr int RW_CS = 32;
constexpr int RW_LDS_BYTES = 8 * RW_CS * 64 * 4;

#define RW_LOAD_RAW(chunk) do { const int sg_ = (chunk) * RW_CS + ls; const size_t row_ = tok0 + sg_; \
    const bf16_t* pc_ = A.P0 + row_ * L0_MAIN + hc; \
    rc = *(const uint2*)(pc_); kc = *(const uint2*)(pc_ + 512); vc = *(const uint2*)(pc_ + 1024); \
    if (sg_ > 0) { const bf16_t* pp_ = pc_ - L0_MAIN; rp = *(const uint2*)(pp_); kp = *(const uint2*)(pp_ + 512); vp = *(const uint2*)(pp_ + 1024); } \
    else { rp = make_uint2(0u, 0u); kp = rp; vp = rp; } \
    rwl = *(const float4*)(A.lrw + row_ * 512 + hc); ra = *(const uint2*)(A.lra + row_ * 512 + hc); rg = *(const uint2*)(A.lrg + row_ * 512 + hc); } while (0)

__device__ __forceinline__ void rwkv_scan_unit(const RwkvArgs& A, int bh, float* smem) {
    const int tid = opaque_tid(); const int b = bh >> 3, h = bh & 7;
    float* sr = smem; float* sw = sr + 2048; float* sk = sw + 2048; float* skk = sk + 2048; float* snb = skk + 2048; float* sv = snb + 2048; float* sg = sv + 2048; float* sy = sg + 2048;
    const int ls = tid >> 4, lc = (tid & 15) * 4; const int hc = h * 64 + lc;
    float c_mur[4], c_muk[4], c_muv[4], c_kk[4], c_ka[4], c_rk[4], c_lng[4], c_lnb[4];
#pragma unroll
    for (int j = 0; j < 4; ++j) { c_mur[j] = A.mu[hc + j]; c_muk[j] = A.mu[512 + hc + j]; c_muv[j] = A.mu[1024 + hc + j]; c_kk[j] = A.k_k[hc + j]; c_ka[j] = A.k_a[hc + j];
        c_rk[j] = A.r_k[hc + j]; c_lng[j] = A.ln_g[hc + j]; c_lnb[j] = A.ln_b[hc + j]; }
    const int srow = tid >> 3, sq = (tid & 7) * 8;
    float S[8];
#pragma unroll
    for (int j = 0; j < 8; ++j) S[j] = 0.f;
    const size_t tok0 = (size_t)b * SEQ;
    uint2 rc, kc, vc, rp, kp, vp, ra, rg; float4 rwl;
    RW_LOAD_RAW(0);
    for (int chunk = 0; chunk < SEQ / RW_CS; ++chunk) {
        {
            float frc[4], fkc[4], fvc[4], frp[4], fkp[4], fvp[4], fa[4], fg[4];
            unpack4(rc, frc); unpack4(kc, fkc); unpack4(vc, fvc); unpack4(rp, frp); unpack4(kp, fkp); unpack4(vp, fvp); unpack4(ra, fa); unpack4(rg, fg);
            const float zw[4] = {rwl.x, rwl.y, rwl.z, rwl.w};
            float r_l[4], k_l[4], v_l[4], w_[4], a_[4], kkr[4]; float ss = 0.f;
#pragma unroll
            for (int j = 0; j < 4; ++j) {
                r_l[j] = frc[j] + (frp[j] - frc[j]) * c_mur[j]; k_l[j] = fkc[j] + (fkp[j] - fkc[j]) * c_muk[j]; v_l[j] = fvc[j] + (fvp[j] - fvc[j]) * c_muv[j];
                const float sig = sigmoid_f(zw[j]); w_[j] = __expf(-0.6065306597126334f * sig); a_[j] = sigmoid_f(fa[j]);
                kkr[j] = k_l[j] * c_kk[j]; ss += kkr[j] * kkr[j]; }
            ss += __shfl_xor(ss, 1); ss += __shfl_xor(ss, 2); ss += __shfl_xor(ss, 4); ss += __shfl_xor(ss, 8);
            const float inv = 1.0f / fmaxf(sqrtf(ss), 1e-12f);
            const int o = ls * 64 + lc;
#pragma unroll
            for (int j = 0; j < 4; ++j) { const float kk = kkr[j] * inv;
                sr[o + j] = r_l[j]; sw[o + j] = w_[j]; sk[o + j] = k_l[j] * (1.0f + (a_[j] - 1.0f) * c_ka[j]); skk[o + j] = kk; snb[o + j] = -kk * a_[j]; sv[o + j] = v_l[j]; sg[o + j] = fg[j]; }
        }
        __syncthreads();
        if (chunk + 1 < SEQ / RW_CS) RW_LOAD_RAW(chunk + 1);
        for (int s = 0; s < RW_CS; ++s) {
            const float4 kk0 = *(const float4*)(skk + s * 64 + sq), kk1 = *(const float4*)(skk + s * 64 + sq + 4);
            const float4 w0 = *(const float4*)(sw + s * 64 + sq), w1 = *(const float4*)(sw + s * 64 + sq + 4);
            const float4 nb0 = *(const float4*)(snb + s * 64 + sq), nb1 = *(const float4*)(snb + s * 64 + sq + 4);
            const float4 k0 = *(const float4*)(sk + s * 64 + sq), k1 = *(const float4*)(sk + s * 64 + sq + 4);
            const float4 r0 = *(const float4*)(sr + s * 64 + sq), r1 = *(const float4*)(sr + s * 64 + sq + 4);
            const float vv = sv[s * 64 + srow];
            float sa = (S[0] * kk0.x + S[1] * kk0.y) + (S[2] * kk0.z + S[3] * kk0.w) + (S[4] * kk1.x + S[5] * kk1.y) + (S[6] * kk1.z + S[7] * kk1.w);
            sa += __shfl_xor(sa, 1); sa += __shfl_xor(sa, 2); sa += __shfl_xor(sa, 4);
            S[0] = S[0] * w0.x + sa * nb0.x + vv * k0.x; S[1] = S[1] * w0.y + sa * nb0.y + vv * k0.y; S[2] = S[2] * w0.z + sa * nb0.z + vv * k0.z; S[3] = S[3] * w0.w + sa * nb0.w + vv * k0.w;
            S[4] = S[4] * w1.x + sa * nb1.x + vv * k1.x; S[5] = S[5] * w1.y + sa * nb1.y + vv * k1.y; S[6] = S[6] * w1.z + sa * nb1.z + vv * k1.z; S[7] = S[7] * w1.w + sa * nb1.w + vv * k1.w;
            float y = (S[0] * r0.x + S[1] * r0.y) + (S[2] * r0.z + S[3] * r0.w) + (S[4] * r1.x + S[5] * r1.y) + (S[6] * r1.z + S[7] * r1.w);
            y += __shfl_xor(y, 1); y += __shfl_xor(y, 2); y += __shfl_xor(y, 4);
            if ((tid & 7) == 0) sy[s * 64 + srow] = y;
        }
        __syncthreads();
        {
            const int o = ls * 64 + lc; float y4[4]; float s1 = 0.f, bp = 0.f;
#pragma unroll
            for (int j = 0; j < 4; ++j) { y4[j] = sy[o + j]; s1 += y4[j]; bp += sr[o + j] * sk[o + j] * c_rk[j]; }
            s1 += __shfl_xor(s1, 1); s1 += __shfl_xor(s1, 2); s1 += __shfl_xor(s1, 4); s1 += __shfl_xor(s1, 8);
            bp += __shfl_xor(bp, 1); bp += __shfl_xor(bp, 2); bp += __shfl_xor(bp, 4); bp += __shfl_xor(bp, 8);
            const float mean = s1 * (1.f / 64.f); float q = 0.f;
#pragma unroll
            for (int j = 0; j < 4; ++j) { y4[j] -= mean; q += y4[j] * y4[j]; }
            q += __shfl_xor(q, 1); q += __shfl_xor(q, 2); q += __shfl_xor(q, 4); q += __shfl_xor(q, 8);
            const float rstd = rsqrtf(q * (1.f / 64.f) + 64.0f * 1e-5f);
            float ov[4];
#pragma unroll
            for (int j = 0; j < 4; ++j) ov[j] = (y4[j] * rstd * c_lng[j] + c_lnb[j] + bp * sv[o + j]) * sg[o + j];
            uint2 w; w.x = pk2(ov[0], ov[1]); w.y = pk2(ov[2], ov[3]);
            *(uint2*)(A.ycat + (tok0 + (size_t)chunk * RW_CS + ls) * 1024 + hc) = w;
        }
        __syncthreads();
    }
}
struct MlstmArgs { const bf16_t* P0; const float* gates; const float* conv_w; const float* conv_b; const float* ig_b; const float* fg_b; const float* hn_g; const float* hn_b; bf16_t* ycat; };
constexpr int ML_QS = 132;
constexpr int ML_LDS_FLOATS = 64 * ML_QS + 64 * 128 + 64 * 64 + 64 * 65 + 64 * ML_QS + 4 * 8 * 128 + 64 * 10 + 512 + 128;
constexpr int ML_LDS_BYTES = ML_LDS_FLOATS * 4;

__device__ __forceinline__ void mlstm_unit(const MlstmArgs& A, int bh, float* smem) {
    float* qs = smem; float* ks = qs + 64 * ML_QS; bf16_t* vsb = (bf16_t*)(ks + 64 * 128); float* sc = ks + 64 * 128 + 64 * 64; float* hs = sc + 64 * 65; float* red = hs + 64 * ML_QS;
    float* sig = red + 4 * 8 * 128; float* slf = sig + 64; float* sb = slf + 64; float* smt = sb + 64; float* scarry = smt + 64; float* sden = scarry + 64; float* sws = sden + 64;
    float* smean = sws + 64; float* srstd = smean + 64; float* spad = srstd + 64; float* sdenp = spad + 64;   float* sn = sdenp + 512;
    const int tid = opaque_tid(); const int v = tid & 127, part = tid >> 7; const int b = bh >> 2, h = bh & 3;
    const size_t tok0 = (size_t)b * SEQ;
    const int cq = h * 128 + v;
    float wq[4], wk[4];
#pragma unroll
    for (int j = 0; j < 4; ++j) { wq[j] = A.conv_w[j * 1024 + cq]; wk[j] = A.conv_w[j * 1024 + 512 + cq]; }
    const float bq = A.conv_b[cq], bk = A.conv_b[512 + cq];
    const float igb = A.ig_b[h], fgb = A.fg_b[h];
    const float hng = A.hn_g[cq], hnb = A.hn_b[cq];
    float zq1 = 0.f, zq2 = 0.f, zq3 = 0.f, zk1 = 0.f, zk2 = 0.f, zk3 = 0.f;
    float C[32];
#pragma unroll
    for (int k = 0; k < 32; ++k) C[k] = 0.f;
    if (tid < 128) sn[tid] = 0.f;
    float m_run = 0.f;
    for (int chunk = 0; chunk < SEQ / 64; ++chunk) {
        const size_t row0 = tok0 + (size_t)chunk * 64;
        if (part == 0) {
            for (int t = 0; t < 64; ++t) { const bf16_t* pr = A.P0 + (row0 + t) * L0_MAIN;
                const float zq = bf2f(pr[1792 + cq]), zk = bf2f(pr[2304 + cq]);
                const float cvq = wq[3] * zq + wq[2] * zq1 + wq[1] * zq2 + wq[0] * zq3 + bq; const float cvk = wk[3] * zk + wk[2] * zk1 + wk[1] * zk2 + wk[0] * zk3 + bk;
                zq3 = zq2; zq2 = zq1; zq1 = zq; zk3 = zk2; zk2 = zk1; zk1 = zk;
                qs[t * ML_QS + v] = cvq * sigmoid_f(cvq) * 0.08838834764831845f; ks[t * 128 + v] = cvk * sigmoid_f(cvk); vsb[t * 128 + v] = pr[2816 + cq]; }
            if (tid < 64) { const float* gr = A.gates + (row0 + tid) * 16; sig[tid] = gr[h] + igb; slf[tid] = log_sigmoid_f(gr[4 + h] + fgb); }
        }
        __syncthreads();
        if (tid < 64) { float bsum = 0.f; for (int s = 0; s <= tid; ++s) bsum += slf[s]; sb[tid] = bsum; }
        __syncthreads();
        const float b_last = sb[63];
        float gmax = -INFINITY; for (int s = 0; s < 64; ++s) gmax = fmaxf(gmax, b_last - sb[s] + sig[s]);
        const float m_new = fmaxf(b_last + m_run, gmax); const float keep = __expf(b_last + m_run - m_new);
        if (tid < 64) { const float bt = sb[tid]; float mx = -INFINITY; for (int s = 0; s <= tid; ++s) mx = fmaxf(mx, bt - sb[s] + sig[s]);
            const float mt = fmaxf(bt + m_run, mx); smt[tid] = mt; scarry[tid] = __expf(bt + m_run - mt); sws[tid] = __expf(b_last - bt + sig[tid] - m_new); }
        __syncthreads();
        { const int t = tid & 63, sh = tid >> 6; const float bt = sb[t], mt = smt[t]; float dsum = 0.f;
            for (int s = sh * 8; s < sh * 8 + 8; ++s) { float val = 0.f;
                if (s <= t) { float dot = 0.f;
#pragma unroll 8
                    for (int k = 0; k < 128; k += 4) { const float4 qa = *(const float4*)(qs + t * ML_QS + k), kb = *(const float4*)(ks + s * 128 + k); dot += (qa.x * kb.x + qa.y * kb.y) + (qa.z * kb.z + qa.w * kb.w); }
                    val = dot * __expf(bt - sb[s] + sig[s] - mt); }
                sc[t * 65 + s] = val; dsum += val; }
            sdenp[sh * 64 + t] = dsum; }
        __syncthreads();
        if (tid < 64) { float qn = 0.f; for (int k = 0; k < 128; ++k) qn += qs[tid * ML_QS + k] * sn[k];
            float den = scarry[tid] * qn;
#pragma unroll
            for (int p = 0; p < 8; ++p) den += sdenp[p * 64 + tid];
            sden[tid] = fmaxf(fabsf(den), __expf(-smt[tid])); }
        __syncthreads();
        for (int batch = 0; batch < 8; ++batch) {
#pragma unroll 2
            for (int tt = 0; tt < 8; ++tt) { const int t = batch * 8 + tt; float qc = 0.f;
#pragma unroll
                for (int k = 0; k < 32; k += 4) { const float4 qa = *(const float4*)(qs + t * ML_QS + part * 32 + k); qc += (qa.x * C[k] + qa.y * C[k + 1]) + (qa.z * C[k + 2] + qa.w * C[k + 3]); }
                red[(part * 8 + tt) * 128 + v] = qc; }
            __syncthreads();
#pragma unroll
            for (int j = 0; j < 2; ++j) { const int tt = part * 2 + j, t = batch * 8 + tt;
                const float qc = (red[(0 * 8 + tt) * 128 + v] + red[(1 * 8 + tt) * 128 + v]) + (red[(2 * 8 + tt) * 128 + v] + red[(3 * 8 + tt) * 128 + v]);
                float acc = 0.f; for (int s = 0; s <= t; ++s) acc += sc[t * 65 + s] * bf2f(vsb[s * 128 + v]);
                hs[t * ML_QS + v] = (acc + scarry[t] * qc) / sden[t]; }
            __syncthreads();
        }
        { const int t = tid >> 3, oc = tid & 7; float s1 = 0.f;
#pragma unroll
            for (int k = 0; k < 16; ++k) s1 += hs[t * ML_QS + oc * 16 + k];
            s1 += __shfl_xor(s1, 1); s1 += __shfl_xor(s1, 2); s1 += __shfl_xor(s1, 4); const float mean = s1 * (1.f / 128.f); float q = 0.f;
#pragma unroll
            for (int k = 0; k < 16; ++k) { const float d = hs[t * ML_QS + oc * 16 + k] - mean; q += d * d; }
            q += __shfl_xor(q, 1); q += __shfl_xor(q, 2); q += __shfl_xor(q, 4); if (oc == 0) { smean[t] = mean; srstd[t] = rsqrtf(q * (1.f / 128.f) + LN_EPS); } }
        __syncthreads();
        for (int t = part * 16; t < part * 16 + 16; ++t) { const float hn = (hs[t * ML_QS + v] - smean[t]) * srstd[t] * hng + hnb; const float og = bf2f(A.P0[(row0 + t) * L0_MAIN + 3328 + cq]);
            A.ycat[(row0 + t) * 1024 + 512 + cq] = (bf16_t)f2bf(hn * sigmoid_f(og)); }
#pragma unroll
        for (int k = 0; k < 32; ++k) C[k] *= keep;
        for (int s = 0; s < 64; ++s) { const float wv = sws[s] * bf2f(vsb[s * 128 + v]);
#pragma unroll
            for (int k = 0; k < 32; k += 4) { const float4 kb = *(const float4*)(ks + s * 128 + part * 32 + k); C[k] += kb.x * wv; C[k + 1] += kb.y * wv; C[k + 2] += kb.z * wv; C[k + 3] += kb.w * wv; } }
        if (tid < 128) { float nn = keep * sn[tid]; for (int s = 0; s < 64; ++s) nn += sws[s] * ks[s * 128 + tid]; sn[tid] = nn; }
        m_run = m_new;
        __syncthreads();
    }
}

struct AttnArgs { const bf16_t* P1; const float* cum; const float* qn_g; const float* kn_g; bf16_t* out; };
constexpr int AT_LDS_BYTES = (2 * 32 * 64 + 32) * 4;
__device__ __forceinline__ void attn_unit_valu(const AttnArgs& A, int bh, int qb, float* smem) {
    float* Ks = smem; float* Vs = Ks + 2048; float* cj = Vs + 2048;
    const int tid = opaque_tid(); const int b = bh >> 4, h = bh & 15; const int hf = tid & 1; const int i = qb * 256 + (tid >> 1); const size_t row = (size_t)b * SEQ + i;
    float q[32], o[32];
    { float ss = 0.f;
#pragma unroll
        for (int c = 0; c < 4; ++c) { const uint4 w = *(const uint4*)(A.P1 + row * L1_MAIN + h * 64 + hf * 32 + c * 8); unpack8(w, q + c * 8); }
#pragma unroll
        for (int d = 0; d < 32; ++d) ss += q[d] * q[d];
        ss += __shfl_xor(ss, 1);
        const float r = rsqrtf(ss * (1.f / 64.f) + 1e-6f) * 0.125f;
#pragma unroll
        for (int d = 0; d < 32; ++d) { q[d] = q[d] * r * A.qn_g[h * 64 + hf * 32 + d]; o[d] = 0.f; } }
    const float ci = A.cum[(size_t)bh * SEQ + i];
    float m = -INFINITY, l = 0.f;
    const int ntiles = (qb * 256 + 256) / 32;
    const int lkey = tid >> 4, ld4 = (tid & 15) * 4;
    float kg[4];
#pragma unroll
    for (int j = 0; j < 4; ++j) kg[j] = A.kn_g[h * 64 + ld4 + j];
    for (int kt = 0; kt < ntiles; ++kt) {
        { const size_t krow = (size_t)b * SEQ + kt * 32 + lkey; float fk[4], fv[4];
            unpack4(*(const uint2*)(A.P1 + krow * L1_MAIN + 1024 + h * 64 + ld4), fk); unpack4(*(const uint2*)(A.P1 + krow * L1_MAIN + 2048 + h * 64 + ld4), fv);
            float ss = (fk[0] * fk[0] + fk[1] * fk[1]) + (fk[2] * fk[2] + fk[3] * fk[3]);
            ss += __shfl_xor(ss, 1); ss += __shfl_xor(ss, 2); ss += __shfl_xor(ss, 4); ss += __shfl_xor(ss, 8);
            const float r = rsqrtf(ss * (1.f / 64.f) + 1e-6f);
#pragma unroll
            for (int j = 0; j < 4; ++j) { Ks[lkey * 64 + ld4 + j] = fk[j] * r * kg[j]; Vs[lkey * 64 + ld4 + j] = fv[j]; }
            if ((tid & 15) == 0) cj[lkey] = A.cum[(size_t)bh * SEQ + kt * 32 + lkey]; }
        __syncthreads();
#pragma unroll 1
        for (int sub = 0; sub < 8; ++sub) {
            float s[4]; float mx = -INFINITY;
#pragma unroll
            for (int jj = 0; jj < 4; ++jj) { const int j = sub * 4 + jj; float dot = 0.f;
#pragma unroll
                for (int d = 0; d < 32; d += 4) { const float4 kv = *(const float4*)(Ks + j * 64 + hf * 32 + d); dot += (q[d] * kv.x + q[d + 1] * kv.y) + (q[d + 2] * kv.z + q[d + 3] * kv.w); }
                dot += __shfl_xor(dot, 1);
                float sv_ = dot + ci - cj[j]; if (kt * 32 + j > i) sv_ = -INFINITY; s[jj] = sv_; mx = fmaxf(mx, sv_); }
            const float mnew = fmaxf(m, mx); const float scl = __expf(m - mnew); float psum = 0.f;
#pragma unroll
            for (int jj = 0; jj < 4; ++jj) { s[jj] = __expf(s[jj] - mnew); psum += s[jj]; }
            l = l * scl + psum; m = mnew;
#pragma unroll
            for (int d = 0; d < 32; ++d) o[d] *= scl;
#pragma unroll
            for (int jj = 0; jj < 4; ++jj) { const int j = sub * 4 + jj; const float p = s[jj];
#pragma unroll
                for (int d = 0; d < 32; d += 4) { const float4 vv = *(const float4*)(Vs + j * 64 + hf * 32 + d); o[d] += p * vv.x; o[d + 1] += p * vv.y; o[d + 2] += p * vv.z; o[d + 3] += p * vv.w; } }
        }
        __syncthreads();
    }
    const float il = 1.0f / l;
#pragma unroll
    for (int c = 0; c < 4; ++c) { float og[8]; unpack8(*(const uint4*)(A.P1 + row * L1_MAIN + 3072 + h * 64 + hf * 32 + c * 8), og);
        uint4 w; w.x = pk2(o[c * 8 + 0] * il * sigmoid_f(og[0]), o[c * 8 + 1] * il * sigmoid_f(og[1])); w.y = pk2(o[c * 8 + 2] * il * sigmoid_f(og[2]), o[c * 8 + 3] * il * sigmoid_f(og[3]));
        w.z = pk2(o[c * 8 + 4] * il * sigmoid_f(og[4]), o[c * 8 + 5] * il * sigmoid_f(og[5])); w.w = pk2(o[c * 8 + 6] * il * sigmoid_f(og[6]), o[c * 8 + 7] * il * sigmoid_f(og[7]));
        *(uint4*)(A.out + row * 1024 + h * 64 + hf * 32 + c * 8) = w; }
}
__device__ __forceinline__ void attn_valu_phase(const AttnArgs& A, int bid, int nblk, float* smem) {
    for (int su = bid; su < 256; su += nblk) { const int bh = su >> 1, pr = su & 1;
#pragma unroll 1
        for (int u = 0; u < 4; ++u) { const int qb = (u == 0) ? pr : (u == 1) ? 7 - pr : (u == 2) ? 2 + pr : 5 - pr; attn_unit_valu(A, bh, qb, smem); } }
}

struct PeerSArgs { const bf16_t* Q; const bf16_t* K1b; const bf16_t* K2b; int* eid; float* gate; };
constexpr int PS_QT = 0, PS_KB = 64 * 528, PS_KB2 = PS_KB + 128 * 272, PS_L1 = PS_KB + 2 * 128 * 272, PS_L2 = PS_L1 + 4096, PS_LDS_BYTES = PS_L2 + 4096;
__device__ __forceinline__ unsigned ord_f(float f) { const unsigned b = __float_as_uint(f); return b ^ ((b >> 31) ? 0xFFFFFFFFu : 0x80000000u); }
__device__ __forceinline__ float unord_f(unsigned u) { const unsigned b = (u & 0x80000000u) ? (u ^ 0x80000000u) : ~u; return __uint_as_float(b); }
#define TOPK_INSERT(L, x) do { unsigned x_ = (x); _Pragma("unroll") for (int q_ = 0; q_ < 16; ++q_) { const unsigned hi_ = max(L[q_], x_); x_ = min(L[q_], x_); L[q_] = hi_; } } while (0)

__device__ __forceinline__ void peer_scores_unit(const PeerSArgs& A, int tile, int h, unsigned char* smem) {
    const int tid = opaque_tid(), lane = tid & 63, wv = tid >> 6;
#pragma unroll
    for (int i = 0; i < 4; ++i) { const int idx = tid + 512 * i; const int row = idx >> 5, c = idx & 31;
        *(uint4*)(smem + PS_QT + row * 528 + c * 16) = *(const uint4*)(A.Q + (size_t)(tile * 64 + row) * 2048 + h * 256 + c * 8); }
#pragma unroll
    for (int i = 0; i < 4; ++i) { const int idx = tid + 512 * i; const int row = idx >> 4, c = idx & 15;
        *(uint4*)(smem + PS_KB + row * 272 + c * 16) = *(const uint4*)(A.K1b + (size_t)(h * 128 + row) * 128 + c * 8);
        *(uint4*)(smem + PS_KB2 + row * 272 + c * 16) = *(const uint4*)(A.K2b + (size_t)(h * 128 + row) * 128 + c * 8); }
    __syncthreads();
    const int half = wv >> 2, mt = wv & 3; const int fr = lane & 15, fq = lane >> 4;
    f32x4_t acc[8];
#pragma unroll
    for (int n = 0; n < 8; ++n) acc[n] = (f32x4_t){0.f, 0.f, 0.f, 0.f};
    { const unsigned char* qbase = smem + PS_QT + (16 * mt + fr) * 528 + (half * 128 + 8 * fq) * 2; const unsigned char* kbase = smem + (half ? PS_KB2 : PS_KB) + fr * 272 + (8 * fq) * 2;
#pragma unroll
        for (int ks = 0; ks < 4; ++ks) { const bf16x8_t qf = *(const bf16x8_t*)(qbase + ks * 64);
#pragma unroll
            for (int n = 0; n < 8; ++n) { const bf16x8_t kf = *(const bf16x8_t*)(kbase + n * 16 * 272 + ks * 64); acc[n] = __builtin_amdgcn_mfma_f32_16x16x32_bf16(kf, qf, acc[n], 0, 0, 0); } } }
    __syncthreads();
    { float* sT = (float*)(smem + PS_KB + half * 128 * 272);
#pragma unroll
        for (int n = 0; n < 8; ++n)
#pragma unroll
            for (int r = 0; r < 4; ++r) sT[(16 * n + 4 * fq + r) * 68 + 16 * mt + fr] = acc[n][r]; }
    __syncthreads();
    if (wv == 0 || wv == 4) { const float* sT = (const float*)(smem + PS_KB + half * 128 * 272); unsigned L[16];
#pragma unroll
        for (int j = 0; j < 16; ++j) L[j] = 0u;
        for (int key = 0; key < 128; ++key) { const unsigned u = (ord_f(sT[key * 68 + lane]) & ~0x7Fu) | (unsigned)(127 - key); TOPK_INSERT(L, u); }
        unsigned* lst = (unsigned*)(smem + (half ? PS_L2 : PS_L1));
#pragma unroll
        for (int j = 0; j < 16; ++j) lst[j * 64 + lane] = L[j]; }
    __syncthreads();
    if (wv == 0) { const unsigned* l1 = (const unsigned*)(smem + PS_L1); const unsigned* l2 = (const unsigned*)(smem + PS_L2);
        float v1[16], v2[16];
#pragma unroll
        for (int j = 0; j < 16; ++j) { v1[j] = unord_f(l1[j * 64 + lane]); v2[j] = unord_f(l2[j * 64 + lane]); }
        unsigned L[16];
#pragma unroll
        for (int j = 0; j < 16; ++j) L[j] = 0u;
#pragma unroll
        for (int i = 0; i < 16; ++i)
#pragma unroll
            for (int j = 0; j < 16; ++j) if ((i + 1) * (j + 1) <= 16) { const unsigned u = (ord_f(v1[i] + v2[j]) & ~0xFFu) | (unsigned)(255 - (i * 16 + j)); TOPK_INSERT(L, u); }
        float e[16]; float sum = 0.f; const float mx = unord_f(L[0]);
#pragma unroll
        for (int k = 0; k < 16; ++k) { e[k] = __expf(unord_f(L[k]) - mx); sum += e[k]; }
        const float inv = 1.0f / sum; const size_t ob = (size_t)(tile * 64 + lane) * 128 + h * 16;
#pragma unroll
        for (int k = 0; k < 16; ++k) { const int idx = 255 - (int)(L[k] & 0xFFu); const int i = idx >> 4, j = idx & 15;
            const int e1 = 127 - (int)(l1[i * 64 + lane] & 0x7Fu), e2 = 127 - (int)(l2[j * 64 + lane] & 0x7Fu);
            A.eid[ob + k] = e1 * 128 + e2; A.gate[ob + k] = e[k] * inv; } }
    __syncthreads();
}
__device__ __forceinline__ void peer_scores_phase(const PeerSArgs& A, int bid, int nblk, unsigned char* smem) {
    for (int u = bid; u < 256 * 8; u += nblk) peer_scores_unit(A, u >> 3, u & 7, smem);
}

struct PeerGArgs { const float* X; float* Xo; const int* eid; const float* gate; const bf16_t* U; const bf16_t* V; const float* lng; const float* lnb; bf16_t* xb; };
__device__ __forceinline__ void peer_gather_token(const PeerGArgs& A, int t, int lane) {
    float x[16];
    { const float4 a0 = *(const float4*)(A.X + (size_t)t * 1024 + lane * 8), a1 = *(const float4*)(A.X + (size_t)t * 1024 + lane * 8 + 4);
      const float4 b0 = *(const float4*)(A.X + (size_t)t * 1024 + 512 + lane * 8), b1 = *(const float4*)(A.X + (size_t)t * 1024 + 512 + lane * 8 + 4);
      x[0] = a0.x; x[1] = a0.y; x[2] = a0.z; x[3] = a0.w; x[4] = a1.x; x[5] = a1.y; x[6] = a1.z; x[7] = a1.w; x[8] = b0.x; x[9] = b0.y; x[10] = b0.z; x[11] = b0.w; x[12] = b1.x; x[13] = b1.y; x[14] = b1.z; x[15] = b1.w; }
    const int e_lo = A.eid[(size_t)t * 128 + lane], e_hi = A.eid[(size_t)t * 128 + 64 + lane];
    const float g_lo = A.gate[(size_t)t * 128 + lane], g_hi = A.gate[(size_t)t * 128 + 64 + lane];
    float acc[16];
#pragma unroll
    for (int j = 0; j < 16; ++j) acc[j] = 0.f;
    for (int k0 = 0; k0 < 128; k0 += 4) {
        int e[4]; float g[4]; uint4 u0[4], u1[4], v0[4], v1[4];
#pragma unroll
        for (int i = 0; i < 4; ++i) { const int k = k0 + i; e[i] = __shfl(k0 < 64 ? e_lo : e_hi, k & 63); g[i] = __shfl(k0 < 64 ? g_lo : g_hi, k & 63);
            const bf16_t* ur = A.U + (size_t)e[i] * 1024 + lane * 8; u0[i] = *(const uint4*)ur; u1[i] = *(const uint4*)(ur + 512);
            const bf16_t* vr = A.V + (size_t)e[i] * 1024 + lane * 8; v0[i] = *(const uint4*)vr; v1[i] = *(const uint4*)(vr + 512); }
#pragma unroll
        for (int i = 0; i < 4; ++i) { float f[16]; unpack8(u0[i], f); unpack8(u1[i], f + 8); float dot = 0.f;
#pragma unroll
            for (int j = 0; j < 16; ++j) dot += x[j] * f[j];
            dot = wave_sum(dot);
            const float c = g[i] * 0.5f * dot * (1.0f + erff(dot * 0.7071067811865476f));
            unpack8(v0[i], f); unpack8(v1[i], f + 8);
#pragma unroll
            for (int j = 0; j < 16; ++j) acc[j] += c * f[j]; }
    }
    float s = 0.f;
#pragma unroll
    for (int j = 0; j < 16; ++j) { acc[j] += DN_ALPHA * x[j]; s += acc[j]; }
    const float mean = wave_sum(s) * (1.f / 1024.f); float q = 0.f;
#pragma unroll
    for (int j = 0; j < 16; ++j) { acc[j] -= mean; q += acc[j] * acc[j]; }
    const float rstd = rsqrtf(wave_sum(q) * (1.f / 1024.f) + LN_EPS);
#pragma unroll
    for (int hf = 0; hf < 2; ++hf) { const int c0 = hf * 512 + lane * 8; float ov[8];
#pragma unroll
        for (int j = 0; j < 8; ++j) ov[j] = acc[hf * 8 + j] * rstd * A.lng[c0 + j] + A.lnb[c0 + j];
        *(float4*)(A.Xo + (size_t)t * 1024 + c0) = make_float4(ov[0], ov[1], ov[2], ov[3]); *(float4*)(A.Xo + (size_t)t * 1024 + c0 + 4) = make_float4(ov[4], ov[5], ov[6], ov[7]);
        uint4 w; w.x = pk2(ov[0], ov[1]); w.y = pk2(ov[2], ov[3]); w.z = pk2(ov[4], ov[5]); w.w = pk2(ov[6], ov[7]); *(uint4*)(A.xb + (size_t)t * 1024 + c0) = w; }
}
__device__ __forceinline__ void peer_gather_phase(const PeerGArgs& A, int bid, int nblk) {
    const int lane = opaque_tid() & 63, wv = opaque_tid() >> 6;
    for (int t = bid * 8 + wv; t < T_TOK; t += nblk * 8) peer_gather_token(A, t, lane);
}

namespace mlm {
typedef __attribute__((address_space(3))) unsigned char lds_u8;
typedef short v4i16_t __attribute__((ext_vector_type(4)));
typedef unsigned u32x4_t __attribute__((ext_vector_type(4)));
typedef unsigned u32x2_t __attribute__((ext_vector_type(2)));
#define MLM_LDS(T, off) (*(__attribute__((address_space(3))) T*)(smem + (off)))
constexpr int RS = 136;
constexpr int OFF_QS = 0, OFF_KS = OFF_QS + 64 * RS * 2, OFF_VS = OFF_KS + 64 * RS * 2, OFF_OG = OFF_VS + 64 * RS * 2, OFF_CT = OFF_OG + 64 * RS * 2, OFF_SC = OFF_CT + 128 * RS * 2, OFF_F = OFF_SC + 64 * 72 * 2;
constexpr int F_SIG = 0, F_SLF = 64, F_SU = 128, F_SBM = 192, F_CARRY = 256, F_WS = 320, F_SEN = 384, F_SQN = 448, F_DENP = 512, F_STAT = 640, F_SN = 896, F_SCAL = 1024, F_CW = 1032, F_CB = 2056, F_HNG = 2312, F_HNB = 2440, F_END = 2568;
constexpr int LDS_BYTES = OFF_F + F_END * 4;
__device__ __forceinline__ bf16x8_t tr_frag(const lds_u8* p, int row_stride_bytes) {
    const v4i16_t lo = __builtin_amdgcn_ds_read_tr16_b64_v4i16((__attribute__((address_space(3))) v4i16_t*)p);
    const v4i16_t hi = __builtin_amdgcn_ds_read_tr16_b64_v4i16((__attribute__((address_space(3))) v4i16_t*)(p + 4 * row_stride_bytes));
    return (bf16x8_t){lo[0], lo[1], lo[2], lo[3], hi[0], hi[1], hi[2], hi[3]};
}
#define MLM_LOAD_RAW(chunk) do { const size_t r0_ = tok0 + (size_t)(chunk) * 64 + 2 * tp; const bf16_t* pb_ = A.P0 + r0_ * L0_MAIN + h * 128 + 8 * g; \
    _Pragma("unroll") for (int i_ = 0; i_ < 5; ++i_) { const int rr_ = (chunk) * 64 + 2 * tp - 3 + i_; \
        if (rr_ >= 0) { zq[i_] = *(const uint4*)(pb_ + (long)(i_ - 3) * L0_MAIN + 1792); zk[i_] = *(const uint4*)(pb_ + (long)(i_ - 3) * L0_MAIN + 2304); } else { zq[i_] = make_uint4(0u, 0u, 0u, 0u); zk[i_] = zq[i_]; } } \
    rv[0] = *(const uint4*)(pb_ + 2816); rv[1] = *(const uint4*)(pb_ + L0_MAIN + 2816); rog[0] = *(const uint4*)(pb_ + 3328); rog[1] = *(const uint4*)(pb_ + L0_MAIN + 3328); \
    if (tid < 64) { const float* gr_ = A.gates + (tok0 + (size_t)(chunk) * 64 + tid) * 16; rgi = gr_[h]; rgf = gr_[4 + h]; } } while (0)

__device__ __forceinline__ void mlstm_unit_mfma(const MlstmArgs& A, int bh, unsigned char* smem_g) {
    lds_u8* smem = (lds_u8*)smem_g;
    __attribute__((address_space(3))) float* F = (__attribute__((address_space(3))) float*)(smem + OFF_F);
    const int tid0 = opaque_tid(); const int b = bh >> 2, h = bh & 3;
    const size_t tok0 = (size_t)b * SEQ;
#define MLM_IDX() int tid = tid0; asm volatile("" : "+v"(tid)); const int lane = tid & 63, w = __builtin_amdgcn_readfirstlane(tid >> 6), fr = lane & 15, fq = lane >> 4; \
    const int g = tid & 15, tp = tid >> 4;   const int mt = w & 3, nh = w >> 2;   \
    (void)lane; (void)fr; (void)fq; (void)g; (void)tp; (void)mt; (void)nh
    {
    MLM_IDX();
    for (int i = tid; i < 1024; i += NTHR) { const int tap = i >> 8, c = i & 255; F[F_CW + i] = A.conv_w[tap * 1024 + (c < 128 ? h * 128 + c : 512 + h * 128 + (c - 128))]; }
    if (tid < 256) F[F_CB + tid] = A.conv_b[tid < 128 ? h * 128 + tid : 512 + h * 128 + (tid - 128)];
    for (int i = tid; i < 128 * RS / 2; i += NTHR) ((__attribute__((address_space(3))) unsigned*)(smem + OFF_CT))[i] = 0u;
    if (tid < 128) F[F_SN + tid] = 0.f;
    if (tid < 128) { F[F_HNG + tid] = A.hn_g[h * 128 + tid]; F[F_HNB + tid] = A.hn_b[h * 128 + tid]; }
    }
    const float igb = A.ig_b[h], fgb = A.fg_b[h];
    f32x4_t Cacc[8];
#pragma unroll
    for (int n = 0; n < 8; ++n) Cacc[n] = (f32x4_t){0.f, 0.f, 0.f, 0.f};
    float m_old = 0.f;
    uint4 zq[5], zk[5], rv[2], rog[2]; float rgi = 0.f, rgf = 0.f;
    { MLM_IDX(); MLM_LOAD_RAW(0); }
    __syncthreads();
    for (int chunk_ = 0; chunk_ < SEQ / 64; ++chunk_) {
        int chunk = chunk_; asm volatile("" : "+s"(chunk));
        MLM_IDX();
        const size_t row0 = tok0 + (size_t)chunk * 64;
        {
            float fz[5][8];
#pragma unroll
            for (int i = 0; i < 5; ++i) unpack8(zq[i], fz[i]);
#pragma unroll
            for (int r = 0; r < 2; ++r) { float o[8];
#pragma unroll
                for (int j = 0; j < 8; ++j) { const int c = 8 * g + j; float cv = F[F_CB + c];
#pragma unroll
                    for (int tap = 0; tap < 4; ++tap) cv += F[F_CW + tap * 256 + c] * fz[r + tap][j];
                    o[j] = cv * sigmoid_f(cv) * 0.08838834764831845f; }
                MLM_LDS(u32x4_t, OFF_QS + ((2 * tp + r) * RS + 8 * g) * 2) = (u32x4_t){pk2(o[0], o[1]), pk2(o[2], o[3]), pk2(o[4], o[5]), pk2(o[6], o[7])}; }
#pragma unroll
            for (int i = 0; i < 5; ++i) unpack8(zk[i], fz[i]);
#pragma unroll
            for (int r = 0; r < 2; ++r) { float o[8];
#pragma unroll
                for (int j = 0; j < 8; ++j) { const int c = 128 + 8 * g + j; float cv = F[F_CB + c];
#pragma unroll
                    for (int tap = 0; tap < 4; ++tap) cv += F[F_CW + tap * 256 + c] * fz[r + tap][j];
                    o[j] = cv * sigmoid_f(cv); }
                MLM_LDS(u32x4_t, OFF_KS + ((2 * tp + r) * RS + 8 * g) * 2) = (u32x4_t){pk2(o[0], o[1]), pk2(o[2], o[3]), pk2(o[4], o[5]), pk2(o[6], o[7])}; }
#pragma unroll
            for (int r = 0; r < 2; ++r) { MLM_LDS(u32x4_t, OFF_VS + ((2 * tp + r) * RS + 8 * g) * 2) = (u32x4_t){rv[r].x, rv[r].y, rv[r].z, rv[r].w};
                MLM_LDS(u32x4_t, OFF_OG + ((2 * tp + r) * RS + 8 * g) * 2) = (u32x4_t){rog[r].x, rog[r].y, rog[r].z, rog[r].w}; }
            if (tid < 64) { F[F_SIG + tid] = rgi + igb; F[F_SLF + tid] = log_sigmoid_f(rgf + fgb); }
        }
        __syncthreads();
        if (chunk + 1 < SEQ / 64) MLM_LOAD_RAW(chunk + 1);
        if (w == 0) {
            const float ig = F[F_SIG + lane], lf = F[F_SLF + lane];
            float bs = lf;
#pragma unroll
            for (int o = 1; o < 64; o <<= 1) { const float v = __shfl_up(bs, o); if (lane >= o) bs += v; }
            const float u = ig - bs; float pm = u;
#pragma unroll
            for (int o = 1; o < 64; o <<= 1) { const float v = __shfl_up(pm, o); if (lane >= o) pm = fmaxf(pm, v); }
            const float mtv = bs + fmaxf(m_old, pm);
            const float b_last = __shfl(bs, 63), pm_last = __shfl(pm, 63);
            const float m_new = fmaxf(b_last + m_old, b_last + pm_last);
            F[F_SU + lane] = u; F[F_SBM + lane] = bs - mtv; F[F_CARRY + lane] = __expf(bs + m_old - mtv); F[F_WS + lane] = __expf(b_last + u - m_new); F[F_SEN + lane] = __expf(-mtv);
            if (lane == 0) F[F_SCAL] = __expf(b_last + m_old - m_new);
            m_old = m_new;
        }
        bf16x8_t qf[4];
#pragma unroll
        for (int ks = 0; ks < 4; ++ks) qf[ks] = *(const __attribute__((address_space(3))) bf16x8_t*)(smem + OFF_QS + ((16 * mt + fr) * RS + 32 * ks + 8 * fq) * 2);
        f32x4_t sacc[2];
#pragma unroll
        for (int n2 = 0; n2 < 2; ++n2) { sacc[n2] = (f32x4_t){0.f, 0.f, 0.f, 0.f};
#pragma unroll
            for (int ks = 0; ks < 4; ++ks) { const bf16x8_t kf = *(const __attribute__((address_space(3))) bf16x8_t*)(smem + OFF_KS + ((16 * (2 * nh + n2) + fr) * RS + 32 * ks + 8 * fq) * 2);
                sacc[n2] = __builtin_amdgcn_mfma_f32_16x16x32_bf16(qf[ks], kf, sacc[n2], 0, 0, 0); } }
        { const int t = tid >> 3, p = tid & 7; float f16[16];
            { const u32x4_t a_ = MLM_LDS(u32x4_t, OFF_QS + (t * RS + 16 * p) * 2), b_ = MLM_LDS(u32x4_t, OFF_QS + (t * RS + 16 * p + 8) * 2);
              unpack8(make_uint4(a_[0], a_[1], a_[2], a_[3]), f16); unpack8(make_uint4(b_[0], b_[1], b_[2], b_[3]), f16 + 8); }
            float qn = 0.f;
#pragma unroll
            for (int k = 0; k < 16; ++k) qn += f16[k] * F[F_SN + 16 * p + k];
            qn += __shfl_xor(qn, 1); qn += __shfl_xor(qn, 2); qn += __shfl_xor(qn, 4); if (p == 0) F[F_SQN + t] = qn; }
        __syncthreads();
        {
            const f32x4_t bm = *(const __attribute__((address_space(3))) f32x4_t*)(F + F_SBM + 16 * mt + 4 * fq); float rs[4] = {0.f, 0.f, 0.f, 0.f};
#pragma unroll
            for (int n2 = 0; n2 < 2; ++n2) { const int s = 16 * (2 * nh + n2) + fr; const float us = F[F_SU + s];
#pragma unroll
                for (int r = 0; r < 4; ++r) { const int t = 16 * mt + 4 * fq + r; const float wgt = __expf(bm[r] + us); const float val = (s <= t) ? sacc[n2][r] * wgt : 0.f; rs[r] += val;
                    *(__attribute__((address_space(3))) bf16_t*)(smem + OFF_SC + (t * 72 + s) * 2) = (bf16_t)f2bf(val); } }
#pragma unroll
            for (int r = 0; r < 4; ++r) { float v = rs[r]; v += __shfl_xor(v, 1); v += __shfl_xor(v, 2); v += __shfl_xor(v, 4); v += __shfl_xor(v, 8); if (fr == 0) F[F_DENP + nh * 64 + 16 * mt + 4 * fq + r] = v; }
        }
        __syncthreads();
        f32x4_t nacc[4], qacc[4];
#pragma unroll
        for (int j = 0; j < 4; ++j) { nacc[j] = (f32x4_t){0.f, 0.f, 0.f, 0.f}; qacc[j] = (f32x4_t){0.f, 0.f, 0.f, 0.f}; }
#pragma unroll
        for (int ks = 0; ks < 2; ++ks) { const bf16x8_t af = *(const __attribute__((address_space(3))) bf16x8_t*)(smem + OFF_SC + ((16 * mt + fr) * 72 + 32 * ks + 8 * fq) * 2);
#pragma unroll
            for (int j = 0; j < 4; ++j) { const bf16x8_t vf = tr_frag(smem + OFF_VS + ((32 * ks + 8 * fq + (fr >> 2)) * RS + 16 * (4 * nh + j) + 4 * (fr & 3)) * 2, RS * 2);
                nacc[j] = __builtin_amdgcn_mfma_f32_16x16x32_bf16(af, vf, nacc[j], 0, 0, 0); }
            __builtin_amdgcn_sched_barrier(0); }
#pragma unroll
        for (int ks = 0; ks < 4; ++ks) { const bf16x8_t qf2 = *(const __attribute__((address_space(3))) bf16x8_t*)(smem + OFF_QS + ((16 * mt + fr) * RS + 32 * ks + 8 * fq) * 2);
#pragma unroll
            for (int j = 0; j < 4; ++j) { const bf16x8_t cf = *(const __attribute__((address_space(3))) bf16x8_t*)(smem + OFF_CT + ((16 * (4 * nh + j) + fr) * RS + 32 * ks + 8 * fq) * 2);
                qacc[j] = __builtin_amdgcn_mfma_f32_16x16x32_bf16(qf2, cf, qacc[j], 0, 0, 0); }
            __builtin_amdgcn_sched_barrier(0); }
        float hv[4][4];
        {
            const f32x4_t cy = *(const __attribute__((address_space(3))) f32x4_t*)(F + F_CARRY + 16 * mt + 4 * fq), d0 = *(const __attribute__((address_space(3))) f32x4_t*)(F + F_DENP + 16 * mt + 4 * fq),
                          d1 = *(const __attribute__((address_space(3))) f32x4_t*)(F + F_DENP + 64 + 16 * mt + 4 * fq), qn = *(const __attribute__((address_space(3))) f32x4_t*)(F + F_SQN + 16 * mt + 4 * fq),
                          en = *(const __attribute__((address_space(3))) f32x4_t*)(F + F_SEN + 16 * mt + 4 * fq);
#pragma unroll
            for (int r = 0; r < 4; ++r) { const float den = d0[r] + d1[r] + cy[r] * qn[r]; const float inv = 1.0f / fmaxf(fabsf(den), en[r]); float s1 = 0.f, s2 = 0.f;
#pragma unroll
                for (int j = 0; j < 4; ++j) { const float hh = (nacc[j][r] + cy[r] * qacc[j][r]) * inv; hv[j][r] = hh; s1 += hh; s2 += hh * hh; }
                s1 += __shfl_xor(s1, 1); s1 += __shfl_xor(s1, 2); s1 += __shfl_xor(s1, 4); s1 += __shfl_xor(s1, 8);
                s2 += __shfl_xor(s2, 1); s2 += __shfl_xor(s2, 2); s2 += __shfl_xor(s2, 4); s2 += __shfl_xor(s2, 8);
                if (fr == 0) { F[F_STAT + (nh * 64 + 16 * mt + 4 * fq + r) * 2] = s1; F[F_STAT + (nh * 64 + 16 * mt + 4 * fq + r) * 2 + 1] = s2; } }
        }
        __syncthreads();
        {
#pragma unroll
            for (int r = 0; r < 4; ++r) { const int t = 16 * mt + 4 * fq + r;
                const float s1 = F[F_STAT + t * 2] + F[F_STAT + (64 + t) * 2], s2 = F[F_STAT + t * 2 + 1] + F[F_STAT + (64 + t) * 2 + 1];
                const float mean = s1 * (1.f / 128.f); const float var = fmaxf(s2 * (1.f / 128.f) - mean * mean, 0.f); const float rstd = rsqrtf(var + LN_EPS);
#pragma unroll
                for (int j = 0; j < 4; ++j) { const int v = 16 * (4 * nh + j) + fr; const float og = bf2f(*(const __attribute__((address_space(3))) bf16_t*)(smem + OFF_OG + (t * RS + v) * 2));
                    const float o = ((hv[j][r] - mean) * rstd * F[F_HNG + v] + F[F_HNB + v]) * sigmoid_f(og);
                    A.ycat[(row0 + t) * 1024 + 512 + h * 128 + v] = (bf16_t)f2bf(o); } }
        }
        {
            const float keep = F[F_SCAL];
#pragma unroll
            for (int n = 0; n < 8; ++n) Cacc[n] = Cacc[n] * keep;
#pragma unroll
            for (int ks = 0; ks < 2; ++ks) {
                const bf16x8_t kraw = tr_frag(smem + OFF_KS + ((32 * ks + 8 * fq + (fr >> 2)) * RS + 16 * w + 4 * (fr & 3)) * 2, RS * 2);
                const f32x4_t w0 = *(const __attribute__((address_space(3))) f32x4_t*)(F + F_WS + 32 * ks + 8 * fq), w1 = *(const __attribute__((address_space(3))) f32x4_t*)(F + F_WS + 32 * ks + 8 * fq + 4);
                float kfv[8];
#pragma unroll
                for (int j = 0; j < 8; ++j) kfv[j] = bf2f((bf16_t)kraw[j]) * (j < 4 ? w0[j] : w1[j - 4]);
                const u32x4_t pk = (u32x4_t){pk2(kfv[0], kfv[1]), pk2(kfv[2], kfv[3]), pk2(kfv[4], kfv[5]), pk2(kfv[6], kfv[7])};
                const bf16x8_t af = __builtin_bit_cast(bf16x8_t, pk);
#pragma unroll
                for (int n = 0; n < 8; ++n) { const bf16x8_t vf = tr_frag(smem + OFF_VS + ((32 * ks + 8 * fq + (fr >> 2)) * RS + 16 * n + 4 * (fr & 3)) * 2, RS * 2);
                    Cacc[n] = __builtin_amdgcn_mfma_f32_16x16x32_bf16(af, vf, Cacc[n], 0, 0, 0); }
                __builtin_amdgcn_sched_barrier(0); }
#pragma unroll
            for (int n = 0; n < 8; ++n) MLM_LDS(u32x2_t, OFF_CT + ((16 * n + fr) * RS + 16 * w + 4 * fq) * 2) = (u32x2_t){pk2(Cacc[n][0], Cacc[n][1]), pk2(Cacc[n][2], Cacc[n][3])};
            if (tid < 128) { float nn = keep * F[F_SN + tid];
                for (int s = 0; s < 64; ++s) nn += F[F_WS + s] * bf2f(*(const __attribute__((address_space(3))) bf16_t*)(smem + OFF_KS + (s * RS + tid) * 2));
                F[F_SN + tid] = nn; }
        }
        __syncthreads();
    }
}
#undef MLM_LOAD_RAW
#undef MLM_IDX
#undef MLM_LDS
}

constexpr size_t MiB = 1u << 20;
constexpr size_t WS_CTL = 0, CTL_ZERO_BYTES = 64 * 1024, WS_W0IN = 1 * MiB, WS_WLR = 9 * MiB, WS_W0OUT = 10 * MiB, WS_WQ0 = 12 * MiB, WS_W1IN = 16 * MiB, WS_W1OUT = 24 * MiB, WS_WQ1 = 26 * MiB;
constexpr size_t WS_PK = 30 * MiB;
constexpr size_t WS_GATES = 31 * MiB, WS_CUM = 32 * MiB, WS_APP = 33 * MiB, WS_EID = 41 * MiB, WS_GATE = 49 * MiB, WS_ACTA = 57 * MiB;
constexpr size_t WS_TABU = 89 * MiB, WS_TABV = 121 * MiB, WS_P = 153 * MiB, WS_LRW = 281 * MiB, WS_LRA = 313 * MiB, WS_LRG = 329 * MiB, WS_END = 345 * MiB;
constexpr size_t WS_MIX = WS_P, WS_Q = WS_P + 64 * MiB;
constexpr int CW_BAR = 1024;
static_assert((CW_BAR + XCD_BAR_WORDS) * 4 <= (int)CTL_ZERO_BYTES, "barrier words inside the memset region");
constexpr int LDS_BYTES = 160 * 1024, LDS_MISC_OFF = LDS_BYTES - 256;
static_assert(mlm::LDS_BYTES <= LDS_MISC_OFF, "mlstm LDS");
static_assert(attn_body::LDS_BIAS_OFF + 8192 <= LDS_MISC_OFF && ML_LDS_BYTES <= LDS_MISC_OFF && PS_LDS_BYTES <= LDS_MISC_OFF && pg8::STAGE_BYTES <= LDS_MISC_OFF, "phase scratch below the LDS control words");

#if defined(MLSTM_VALU)
#define MLSTM_UNIT(ma, u) mlstm_unit(ma, u, (float*)lds)
#else
#define MLSTM_UNIT(ma, u) mlm::mlstm_unit_mfma(ma, u, lds)
#endif
#ifndef PROBE_DUP
#define PROBE_DUP 0
#endif
struct MegaArgs { const float* in[43]; float* out; unsigned char* ws; };

__global__ void __launch_bounds__(NTHR, 2) mega_kernel(MegaArgs a) {
    extern __shared__ __attribute__((aligned(16))) unsigned char lds[];
    const int tid = opaque_tid(); const int bid = (int)blockIdx.x, nblk = (int)gridDim.x;
#define WSP(T, off) ((T*)(opq_ptr(a.ws) + (off)))
#define INP(i) ((const float*)opq_ptr((unsigned char*)a.in[i]))
#define OUTP ((float*)opq_ptr((unsigned char*)a.out))
#define W0IN WSP(bf16_t, WS_W0IN)
#define WLR WSP(bf16_t, WS_WLR)
#define W0OUT WSP(bf16_t, WS_W0OUT)
#define WQ0 WSP(bf16_t, WS_WQ0)
#define W1IN WSP(bf16_t, WS_W1IN)
#define W1OUT WSP(bf16_t, WS_W1OUT)
#define WQ1 WSP(bf16_t, WS_WQ1)
#define PK WSP(bf16_t, WS_PK)
#define GATES WSP(float, WS_GATES)
#define CUM WSP(float, WS_CUM)
#define APP WSP(bf16_t, WS_APP)
#define EID WSP(int, WS_EID)
#define GATE WSP(float, WS_GATE)
#define ACTA WSP(bf16_t, WS_ACTA)
#define TABU WSP(bf16_t, WS_TABU)
#define TABV WSP(bf16_t, WS_TABV)
#define PBUF WSP(bf16_t, WS_P)
#define MIX WSP(float, WS_MIX)
#define QBUF WSP(bf16_t, WS_Q)
#define LRW WSP(float, WS_LRW)
#define LRA WSP(bf16_t, WS_LRA)
#define LRG WSP(bf16_t, WS_LRG)
    if (tid < 64) ((LAS unsigned*)((LAS unsigned char*)lds + LDS_MISC_OFF))[tid] = 0u;
    __syncthreads();
    XcdBarrier bar = xcd_barrier_post(WSP(unsigned, WS_CTL) + CW_BAR, (volatile LAS unsigned*)((LAS unsigned char*)lds + LDS_MISC_OFF + 32));
#define GRID_BAR() xcd_barrier(bar)
#define GEMM_PHASE(EpiT, Aop, Bop, Mv, Nv, Kv, Eobj) do { pg8::Gemm g_; g_.A = (Aop); g_.Bt = (Bop); g_.M = (Mv); g_.N = (Nv); g_.K = (Kv); pg8::StaticOrder S_; S_.init((Mv), (Nv), nblk, bid); \
        pg8::gemm_phase<EpiT, pg8::StaticOrder, true, true>((PG8_LAS unsigned char*)lds, g_, S_, (Eobj)); } while (0)

    {
        float* tile = (float*)lds;
        transpose_cvt_phase(INP(1), 1024, L0_COLS, 0, L0_MAIN, W0IN, bid, nblk, tile);
        transpose_cvt_phase(INP(19), 1024, 1024, 0, 1024, W0OUT, bid, nblk, tile);
        transpose_cvt_phase(INP(22), 1024, 2048, 0, 2048, WQ0, bid, nblk, tile);
        transpose_cvt_phase(INP(29), 1024, L1_COLS, 0, L1_MAIN, W1IN, bid, nblk, tile);
        transpose_cvt_phase(INP(33), 1024, 1024, 0, 1024, W1OUT, bid, nblk, tile);
        transpose_cvt_phase(INP(36), 1024, 2048, 0, 2048, WQ1, bid, nblk, tile);
        build_wlr_phase(INP(4), INP(6), INP(7), WLR, bid, nblk);
        cvt_bf16_phase(INP(23), PK, 131072 / 8, bid, nblk); cvt_bf16_phase(INP(24), PK + 131072, 131072 / 8, bid, nblk);
        cvt_bf16_phase(INP(37), PK + 262144, 131072 / 8, bid, nblk); cvt_bf16_phase(INP(38), PK + 393216, 131072 / 8, bid, nblk);
        cvt_bf16_phase(INP(0), ACTA, (size_t)T_TOK * 1024 / 8, bid, nblk);
        cvt_bf16_phase(INP(25), TABU, (size_t)16384 * 1024 / 8, bid, nblk); cvt_bf16_phase(INP(26), TABV, (size_t)16384 * 1024 / 8, bid, nblk);
    }
    GRID_BAR();
#if PROBE_DUP == 4
    for (int rep_ = 0; rep_ < 8; ++rep_) { GRID_BAR(); }
#endif
    { pg8::EpiBf16P E; E.O = PBUF; E.ldc = L0_MAIN; GEMM_PHASE(pg8::EpiBf16P, ACTA, W0IN, T_TOK, L0_MAIN, 1024, E); }
    gates_phase<8>(INP(0), INP(1), L0_COLS, L0_MAIN, GATES, bid, nblk, (float*)lds);
    GRID_BAR();
    rwkv_prep_phase(PBUF, INP(2), APP, bid, nblk);
    GRID_BAR();
    { pg8::EpiLowrank E; E.lrw = LRW; E.lra = LRA; E.lrg = LRG; E.w0 = INP(3); E.a0 = INP(5); GEMM_PHASE(pg8::EpiLowrank, APP, WLR, T_TOK, 1536, 256, E); }
    GRID_BAR();
    {
        RwkvArgs ra; ra.P0 = PBUF; ra.lrw = LRW; ra.lra = LRA; ra.lrg = LRG; ra.mu = INP(2); ra.k_k = INP(8); ra.k_a = INP(9); ra.r_k = INP(10); ra.ln_g = INP(11); ra.ln_b = INP(12); ra.ycat = ACTA;
        MlstmArgs ma; ma.P0 = PBUF; ma.gates = GATES; ma.conv_w = INP(13); ma.conv_b = INP(14); ma.ig_b = INP(15); ma.fg_b = INP(16); ma.hn_g = INP(17); ma.hn_b = INP(18); ma.ycat = ACTA;
        for (int u = bid; u < 96; u += nblk) { if (u < 64) rwkv_scan_unit(ra, u, (float*)lds); else MLSTM_UNIT(ma, u - 64); }
#if PROBE_DUP == 1
        GRID_BAR();
        for (int u = bid; u < 96; u += nblk) { if (u < 64) rwkv_scan_unit(ra, u, (float*)lds); else MLSTM_UNIT(ma, u - 64); }
#endif
    }
    GRID_BAR();
    { pg8::EpiF32 E; E.C = MIX; E.ldc = 1024; GEMM_PHASE(pg8::EpiF32, ACTA, W0OUT, T_TOK, 1024, 1024, E); }
    GRID_BAR();
    ln_phase(INP(0), MIX, INP(20), INP(21), OUTP, ACTA, bid, nblk);
    GRID_BAR();
    { pg8::EpiBf16P E; E.O = QBUF; E.ldc = 2048; GEMM_PHASE(pg8::EpiBf16P, ACTA, WQ0, T_TOK, 2048, 1024, E);
#if PROBE_DUP == 5
      GRID_BAR(); GEMM_PHASE(pg8::EpiBf16P, ACTA, WQ0, T_TOK, 2048, 1024, E); GRID_BAR(); GEMM_PHASE(pg8::EpiBf16P, ACTA, WQ0, T_TOK, 2048, 1024, E);
#endif
    }
    GRID_BAR();
    { PeerSArgs sa; sa.Q = QBUF; sa.K1b = PK; sa.K2b = PK + 131072; sa.eid = EID; sa.gate = GATE; peer_scores_phase(sa, bid, nblk, lds);
#if PROBE_DUP == 3
      GRID_BAR(); peer_scores_phase(sa, bid, nblk, lds);
#endif
    }
    GRID_BAR();
#if PROBE_DUP == 2
    { PeerGArgs ga; ga.X = OUTP; ga.Xo = MIX; ga.eid = EID; ga.gate = GATE; ga.U = TABU; ga.V = TABV; ga.lng = INP(27); ga.lnb = INP(28); ga.xb = QBUF; peer_gather_phase(ga, bid, nblk); }
    GRID_BAR();
#endif
    { PeerGArgs ga; ga.X = OUTP; ga.Xo = OUTP; ga.eid = EID; ga.gate = GATE; ga.U = TABU; ga.V = TABV; ga.lng = INP(27); ga.lnb = INP(28); ga.xb = ACTA; peer_gather_phase(ga, bid, nblk); }
    GRID_BAR();
    cvt_bf16_phase(INP(39), TABU, (size_t)16384 * 1024 / 8, bid, nblk); cvt_bf16_phase(INP(40), TABV, (size_t)16384 * 1024 / 8, bid, nblk);
    { pg8::EpiBf16P E; E.O = PBUF; E.ldc = L1_MAIN; GEMM_PHASE(pg8::EpiBf16P, ACTA, W1IN, T_TOK, L1_MAIN, 1024, E); }
    gates_phase<16>(OUTP, INP(29), L1_COLS, L1_MAIN, GATES, bid, nblk, (float*)lds);
    GRID_BAR();
    fox_cumsum_phase(GATES, INP(32), CUM, bid, nblk);
#if defined(ATTN_VALU)
    GRID_BAR();
    { AttnArgs aa; aa.P1 = PBUF; aa.cum = CUM; aa.qn_g = INP(30); aa.kn_g = INP(31); aa.out = ACTA; attn_valu_phase(aa, bid, nblk, (float*)lds); }
#else
    fox_qknorm_phase(PBUF, INP(30), INP(31), bid, nblk);
    GRID_BAR();
    { const attn_body::AttnTensors AT{(const attn_body::bf16*)PBUF, (const attn_body::bf16*)(PBUF + 1024), (const attn_body::bf16*)(PBUF + 2048), (const attn_body::bf16*)(PBUF + 3072), CUM, (attn_body::bf16*)ACTA};
      const attn_body::StaticOrder S_(nblk, bid); attn_body::attn_phase<attn_body::StaticOrder>((char*)lds, AT, S_);
#if PROBE_DUP == 6
      GRID_BAR(); attn_body::attn_phase<attn_body::StaticOrder>((char*)lds, AT, S_);
#endif
    }
#endif
    GRID_BAR();
    { pg8::EpiF32 E; E.C = MIX; E.ldc = 1024; GEMM_PHASE(pg8::EpiF32, ACTA, W1OUT, T_TOK, 1024, 1024, E); }
    GRID_BAR();
    ln_phase(OUTP, MIX, INP(34), INP(35), OUTP, ACTA, bid, nblk);
    GRID_BAR();
    { pg8::EpiBf16P E; E.O = QBUF; E.ldc = 2048; GEMM_PHASE(pg8::EpiBf16P, ACTA, WQ1, T_TOK, 2048, 1024, E); }
    GRID_BAR();
    { PeerSArgs sa; sa.Q = QBUF; sa.K1b = PK + 262144; sa.K2b = PK + 393216; sa.eid = EID; sa.gate = GATE; peer_scores_phase(sa, bid, nblk, lds); }
    GRID_BAR();
    { PeerGArgs ga; ga.X = OUTP; ga.Xo = OUTP; ga.eid = EID; ga.gate = GATE; ga.U = TABU; ga.V = TABV; ga.lng = INP(41); ga.lnb = INP(42); ga.xb = ACTA; peer_gather_phase(ga, bid, nblk); }
#undef GRID_BAR
#undef GEMM_PHASE
#undef WSP
#undef INP
#undef OUTP
#undef W0IN
#undef WLR
#undef W0OUT
#undef WQ0
#undef W1IN
#undef W1OUT
#undef WQ1
#undef PK
#undef GATES
#undef CUM
#undef APP
#undef EID
#undef GATE
#undef ACTA
#undef TABU
#undef TABV
#undef PBUF
#undef MIX
#undef QBUF
#undef LRW
#undef LRA
#undef LRG
}

extern "C" void kernel_launch(void* const* d_in, const int* in_sizes, int n_in, void* d_out, int out_size, void* d_ws, size_t ws_size, hipStream_t stream) {
    static int grid = 0;
    if (grid == 0) {
        if (n_in != 43 || ws_size < WS_END) { fprintf(stderr, "kernel_launch: unexpected n_in %d or ws_size %zu (< %zu); nothing launched\n", n_in, ws_size, (size_t)WS_END); grid = -1; return; }
        int dev = 0, cus = 0;
        if (hipGetDevice(&dev) != hipSuccess || hipDeviceGetAttribute(&cus, hipDeviceAttributeMultiprocessorCount, dev) != hipSuccess) { fprintf(stderr, "kernel_launch: device query failed\n"); grid = -1; return; }
        if (hipFuncSetAttribute((const void*)mega_kernel, hipFuncAttributeMaxDynamicSharedMemorySize, LDS_BYTES) != hipSuccess) { fprintf(stderr, "kernel_launch: hipFuncSetAttribute failed\n"); grid = -1; return; }
        (void)hipGetLastError();
        grid = cus;
    }
    if (grid < 0) return;
    (void)hipMemsetAsync((char*)d_ws + WS_CTL, 0, CTL_ZERO_BYTES, stream);
    MegaArgs a; memset(&a, 0, sizeof(a));
    for (int i = 0; i < 43; ++i) a.in[i] = (const float*)d_in[i];
    a.out = (float*)d_out; a.ws = (unsigned char*)d_ws;
    hipLaunchKernelGGL(mega_kernel, dim3(grid), dim3(NTHR), LDS_BYTES, stream, a);
}
```

```cpp
#include <hip/hip_runtime.h>
#include <cstdio>
#include <cstdint>
#include <cmath>
#include <cstring>
__device__ __forceinline__ int opaque_tid() { int t = (int)threadIdx.x; asm volatile("" : "+v"(t)); return t; }
__device__ __forceinline__ unsigned char* opq_ptr(unsigned char* p) { return p; }
namespace pg8 {
#define PG8_LAS __attribute__((address_space(3)))
typedef unsigned short bf16_t;
typedef short bf16x8 __attribute__((ext_vector_type(8)));
typedef float f32x4 __attribute__((ext_vector_type(4)));
typedef unsigned u32x4 __attribute__((ext_vector_type(4)));
constexpr int BM = 256, BK = 64, HALF = 128, HTB = HALF * BK * 2  , STAGE_BYTES = 8 * HTB, NXCD = 8, WGM = 8;

__host__ __device__ __forceinline__ int lds_byte(int r, int c) { const int st = (r >> 4) * 2 + (c >> 5), rr = r & 15, cc = c & 31, ob = rr * 64 + cc * 2; return st * 1024 + (ob ^ (((ob >> 9) & 1) << 5)); }
__host__ __device__ __forceinline__ void stage_rc(int b, int& R, int& C) { const int st = b / 1024, sb = b % 1024, swz = sb ^ (((sb >> 9) & 1) << 5); R = (st >> 1) * 16 + swz / 64; C = (st & 1) * 32 + (swz % 64) / 2; }
__host__ __device__ __forceinline__ int perm32(int rho) { const int n = rho >> 4, i = rho & 15; return 8 * (i >> 2) + 4 * n + (i & 3); }

struct Unit { int pm, pn; };
struct Gemm { const bf16_t* A; const bf16_t* Bt; int M, N, K; };

struct StaticOrder {
    int nM, nN, nwg, G, c;
    __host__ __device__ void init(int M, int N, int G_, int c_) { nM = M / BM; nN = N / BM; nwg = nM * nN; G = G_; c = c_; }
    __host__ __device__ bool next(int i, Unit& u) const {
        const long L = (long)i * G + c; if (L >= nwg) return false;
        int wgid = (int)L; { const int q = nwg / NXCD, r = nwg % NXCD, xcd = wgid % NXCD, off = wgid / NXCD; wgid = (xcd < r ? xcd * (q + 1) : r * (q + 1) + (xcd - r) * q) + off; }
        const int nig = WGM * nN, gid = wgid / nig, fm = gid * WGM, gsz = (nM - fm) < WGM ? (nM - fm) : WGM;
        u.pm = fm + ((wgid % nig) % gsz); u.pn = (wgid % nig) / gsz; return true;
    }
    __device__ __forceinline__ void a_ready(const Unit&) const {}
    __device__ __forceinline__ void done(const Unit&) const {}
};

__device__ __forceinline__ unsigned cvt_pk_bf16(float lo, float hi) { unsigned r; asm volatile("v_cvt_pk_bf16_f32 %0, %1, %2" : "=v"(r) : "v"(lo), "v"(hi)); return r; }
typedef float f32x2 __attribute__((ext_vector_type(2)));
__device__ __forceinline__ f32x2 gelu_pk(f32x2 v) {
    const f32x2 av = __builtin_elementwise_abs(v), d = av * 0.2316418882f + 1.0f;
    f32x2 t; t.x = __builtin_amdgcn_rcpf(d.x); t.y = __builtin_amdgcn_rcpf(d.y);
    f32x2 q = t * 0.5307027145f + (-0.7265760135f); q = q * t + 0.7107068705f; q = q * t + (-0.142248368f); q = q * t + 0.127414796f; q = q * t;
    const f32x2 s = (v * v) * (-0.72134752044f);
    f32x2 e; e.x = __builtin_amdgcn_exp2f(s.x); e.y = __builtin_amdgcn_exp2f(s.y);
    const f32x2 m = v * (q * e), r = v - m;
    f32x2 o; o.x = v.x < 0.f ? m.x : r.x; o.y = v.y < 0.f ? m.y : r.y; return o;
}

template <int ACT  > struct EpiBf16 {
    static constexpr bool PERM = true, AFTER_DRAIN = false; static_assert(ACT == 0 || ACT == 1, "EpiBf16: ACT is 0 (none) or 1 (gelu_pk)");
    bf16_t* O; int ldc; const float* bias; int split_cols; size_t split_stride; float scale0;
    __device__ __forceinline__ void operator()(const f32x4 (&acc)[2][2][4][2], const Unit& u, int wr, int wc, int fr, int fq) const {
        const int row0 = u.pm * BM + wr * 64 + fr; int colt = u.pn * BM; bf16_t* base = O;
        float sc = 1.f; if (split_cols) { const int t = colt / split_cols; base += (size_t)t * split_stride; colt -= t * split_cols; if (t == 0) sc = scale0; }
        const int col0 = colt + wc * 32 + 8 * fq, bcol0 = u.pn * BM + wc * 32 + 8 * fq;
        f32x4 bv[2][2];
#pragma unroll
        for (int bj = 0; bj < 2; ++bj)
#pragma unroll
            for (int n = 0; n < 2; ++n) bv[bj][n] = bias ? *(const f32x4*)(bias + bcol0 + bj * HALF + 4 * n) : (f32x4){0.f, 0.f, 0.f, 0.f};
#pragma unroll
        for (int ai = 0; ai < 2; ++ai)
#pragma unroll
            for (int m = 0; m < 4; ++m) { bf16_t* rowp = base + (size_t)(row0 + ai * HALF + m * 16) * ldc + col0;
#pragma unroll
                for (int bj = 0; bj < 2; ++bj) { f32x4 v0 = acc[ai][bj][m][0] + bv[bj][0], v1 = acc[ai][bj][m][1] + bv[bj][1];
                    if (ACT == 1) { f32x2 a = gelu_pk((f32x2){v0[0], v0[1]}), b = gelu_pk((f32x2){v0[2], v0[3]}), c = gelu_pk((f32x2){v1[0], v1[1]}), d = gelu_pk((f32x2){v1[2], v1[3]});
                        v0 = (f32x4){a.x, a.y, b.x, b.y}; v1 = (f32x4){c.x, c.y, d.x, d.y}; }
                    v0 = v0 * sc; v1 = v1 * sc; u32x4 w; w.x = cvt_pk_bf16(v0[0], v0[1]); w.y = cvt_pk_bf16(v0[2], v0[3]); w.z = cvt_pk_bf16(v1[0], v1[1]); w.w = cvt_pk_bf16(v1[2], v1[3]);
                    *(u32x4*)(rowp + bj * HALF) = w; } }
    }
};

struct PanelStats {
    unsigned* xbuf;
    unsigned* cnt;
    unsigned* tmo;
    int ntn; float eps;
    unsigned code;
    __device__ __forceinline__ bool run(const f32x4 (&v)[2][2][4][2], const Unit& u, int wr, int wc, int fr, int fq, PG8_LAS unsigned char* lds, int wid, int lane) const {
        typedef float f32x2v __attribute__((ext_vector_type(2)));
        PG8_LAS f32x2v* P = (PG8_LAS f32x2v*)lds;
        PG8_LAS f32x2v* S = (PG8_LAS f32x2v*)(lds + 8192);
        PG8_LAS unsigned* flag = (PG8_LAS unsigned*)(lds + 8192 + 2048);
#pragma unroll
        for (int ai = 0; ai < 2; ++ai)
#pragma unroll
            for (int m = 0; m < 4; ++m) {
                float s = 0.f;
#pragma unroll
                for (int bj = 0; bj < 2; ++bj)
#pragma unroll
                    for (int n = 0; n < 2; ++n) { const f32x4 x = v[ai][bj][m][n]; s += (x[0] + x[1]) + (x[2] + x[3]); }
                s += __shfl_xor(s, 16); s += __shfl_xor(s, 32);
                const float mw = s * (1.0f / 64.0f); float q = 0.f;
#pragma unroll
                for (int bj = 0; bj < 2; ++bj)
#pragma unroll
                    for (int n = 0; n < 2; ++n) { const f32x4 d = v[ai][bj][m][n] - mw; q += (d[0] * d[0] + d[1] * d[1]) + (d[2] * d[2] + d[3] * d[3]); }
                q += __shfl_xor(q, 16); q += __shfl_xor(q, 32);
                if (fq == 0) P[(ai * HALF + wr * 64 + m * 16 + fr) * 4 + wc] = (f32x2v){mw, q};
            }
        asm volatile("s_waitcnt lgkmcnt(0)" ::: "memory"); __builtin_amdgcn_s_barrier(); asm volatile("" ::: "memory");
#if defined(BROKEN_EXCHANGE_NO_WAIT)
#warning BROKEN CONTROL BUILD: the row-statistics exchange does not wait; results are wrong by design
        if (blockIdx.x >= 64) { const long long t0_ = clock64(); while (clock64() - t0_ < 60000) __builtin_amdgcn_s_sleep(8); }
#endif
        const int row = wid * 32 + (lane & 31);
        if (lane < 32) {
            const f32x2v a = P[row * 4 + 0], b = P[row * 4 + 1], c = P[row * 4 + 2], d = P[row * 4 + 3];
            const float mt = (a.x + b.x + c.x + d.x) * 0.25f;
            const float da = a.x - mt, db = b.x - mt, dc = c.x - mt, dd = d.x - mt;
            const float m2 = (a.y + b.y) + (c.y + d.y) + 64.0f * ((da * da + db * db) + (dc * dc + dd * dd));
            unsigned long long* slot = (unsigned long long*)xbuf + ((size_t)(u.pm * BM + row) * 4 + u.pn);
            __hip_atomic_store(slot, ((unsigned long long)__float_as_uint(m2) << 32) | __float_as_uint(mt), __ATOMIC_RELAXED, __HIP_MEMORY_SCOPE_AGENT);
        }
        asm volatile("s_waitcnt vmcnt(0)" ::: "memory");
        if (lane == 0) __hip_atomic_fetch_add(cnt + 64 * u.pm, 1u, __ATOMIC_RELAXED, __HIP_MEMORY_SCOPE_AGENT);
        if (wid == 0) {
            bool dead = false; const unsigned long long t0 = __builtin_amdgcn_s_memrealtime(); const unsigned want = 8u * (unsigned)ntn;
            for (;;) {
#if defined(BROKEN_EXCHANGE_NO_WAIT)
                break;
#endif
                if ((unsigned)__builtin_amdgcn_readfirstlane(__hip_atomic_load(cnt + 64 * u.pm, __ATOMIC_RELAXED, __HIP_MEMORY_SCOPE_AGENT)) >= want) break;
                if (__builtin_amdgcn_s_memrealtime() - t0 > 2000000ull) {
                    if (lane == 0) { unsigned expect = 0u; __hip_atomic_compare_exchange_strong(tmo + 1, &expect, code | (unsigned)(u.pm & 0xff), __ATOMIC_RELAXED, __ATOMIC_RELAXED, __HIP_MEMORY_SCOPE_AGENT);
                                     __hip_atomic_store(tmo, 1u, __ATOMIC_RELAXED, __HIP_MEMORY_SCOPE_AGENT); }
                    dead = true; break; }
                __builtin_amdgcn_s_sleep(2);
            }
            __builtin_amdgcn_fence(__ATOMIC_ACQUIRE, "agent");
            if (lane == 0) flag[0] = dead ? 1u : 0u;
        }
        asm volatile("s_waitcnt vmcnt(0) lgkmcnt(0)" ::: "memory"); __builtin_amdgcn_s_barrier(); asm volatile("" ::: "memory");
        const bool bad = flag[0] != 0u;
        if (lane < 32) {
            const unsigned long long* slot = (const unsigned long long*)xbuf + (size_t)(u.pm * BM + row) * 4; float mt[4], m2[4]; float ms = 0.f;
#pragma unroll
            for (int t = 0; t < 4; ++t) { if (t < ntn) { const unsigned long long w = __hip_atomic_load(slot + t, __ATOMIC_RELAXED, __HIP_MEMORY_SCOPE_AGENT); mt[t] = __uint_as_float((unsigned)w); m2[t] = __uint_as_float((unsigned)(w >> 32)); } else { mt[t] = 0.f; m2[t] = 0.f; } ms += mt[t]; }
            const float mean = ms / (float)ntn; float q = 0.f;
#pragma unroll
            for (int t = 0; t < 4; ++t) if (t < ntn) { const float dm = mt[t] - mean; q += m2[t] + 256.0f * dm * dm; }
            S[row] = (f32x2v){mean, 1.0f / sqrtf(q / (256.0f * (float)ntn) + eps)};
        }
        asm volatile("s_waitcnt lgkmcnt(0)" ::: "memory"); __builtin_amdgcn_s_barrier(); asm volatile("" ::: "memory");
        return bad;
    }
};
struct EpiLnRes {
    static constexpr bool PERM = false, AFTER_DRAIN = true;
    const float* base; float* out; int ldc; const float* bias; PanelStats st; unsigned poison;
    __device__ __forceinline__ void fused(f32x4 (&acc)[2][2][4][2], const Unit& u, int wr, int wc, int fr, int fq, PG8_LAS unsigned char* lds, int wid, int lane) const {
        typedef float f32x2v __attribute__((ext_vector_type(2)));
        const PG8_LAS f32x2v* S = (const PG8_LAS f32x2v*)(lds + 8192);
        const int col0 = u.pn * BM + wc * 32 + 4 * fq;
#pragma unroll
        for (int bj = 0; bj < 2; ++bj)
#pragma unroll
            for (int n = 0; n < 2; ++n) { const f32x4 bv = bias ? *(const f32x4*)(bias + col0 + bj * HALF + n * 16) : (f32x4){0.f, 0.f, 0.f, 0.f};
#pragma unroll
                for (int ai = 0; ai < 2; ++ai)
#pragma unroll
                    for (int m = 0; m < 4; ++m) acc[ai][bj][m][n] += bv; }
        f32x4 pre[4][2][2];
#pragma unroll
        for (int m = 0; m < 4; ++m) { const size_t off = (size_t)(u.pm * BM + wr * 64 + m * 16 + fr) * ldc + col0;
#pragma unroll
            for (int bj = 0; bj < 2; ++bj)
#pragma unroll
                for (int n = 0; n < 2; ++n) pre[m][bj][n] = *(const f32x4*)(base + off + bj * HALF + n * 16); }
        const bool bad = st.run(acc, u, wr, wc, fr, fq, lds, wid, lane) || poison != 0u;
        const float qnan = __builtin_nanf("");
#pragma unroll
        for (int ai = 0; ai < 2; ++ai)
#pragma unroll
            for (int m = 0; m < 4; ++m) { const int r = ai * HALF + wr * 64 + m * 16 + fr; const f32x2v sr = S[r]; const size_t off = (size_t)(u.pm * BM + r) * ldc + col0;
#pragma unroll
                for (int bj = 0; bj < 2; ++bj)
#pragma unroll
                    for (int n = 0; n < 2; ++n) { const f32x4 bs = ai == 0 ? pre[m][bj][n] : *(const f32x4*)(base + off + bj * HALF + n * 16); f32x4 o = bs + (acc[ai][bj][m][n] - sr.x) * sr.y;
                        if (bad) o = (f32x4){qnan, qnan, qnan, qnan}; *(f32x4*)(out + off + bj * HALF + n * 16) = o; }
                if (m & 1) asm volatile("" ::: "memory"); }
    }
};
struct EpiLnResLn {
    static constexpr bool PERM = false, AFTER_DRAIN = true;
    const float* base; float* out; bf16_t* xn; int ldc; const float* bias; PanelStats st1, st2; unsigned poison;
    __device__ __forceinline__ void fused(f32x4 (&acc)[2][2][4][2], const Unit& u, int wr, int wc, int fr, int fq, PG8_LAS unsigned char* lds, int wid, int lane) const {
        typedef float f32x2v __attribute__((ext_vector_type(2))); typedef unsigned u32x2v __attribute__((ext_vector_type(2)));
        const PG8_LAS f32x2v* S = (const PG8_LAS f32x2v*)(lds + 8192);
        const int col0 = u.pn * BM + wc * 32 + 4 * fq;
#pragma unroll
        for (int bj = 0; bj < 2; ++bj)
#pragma unroll
            for (int n = 0; n < 2; ++n) { const f32x4 bv = bias ? *(const f32x4*)(bias + col0 + bj * HALF + n * 16) : (f32x4){0.f, 0.f, 0.f, 0.f};
#pragma unroll
                for (int ai = 0; ai < 2; ++ai)
#pragma unroll
                    for (int m = 0; m < 4; ++m) acc[ai][bj][m][n] += bv; }
        bool bad = st1.run(acc, u, wr, wc, fr, fq, lds, wid, lane) || poison != 0u;
        const float qnan = __builtin_nanf("");
#pragma unroll
        for (int ai = 0; ai < 2; ++ai)
#pragma unroll
            for (int m = 0; m < 4; ++m) { const int r = ai * HALF + wr * 64 + m * 16 + fr; const f32x2v sr = S[r]; const size_t off = (size_t)(u.pm * BM + r) * ldc + col0;
#pragma unroll
                for (int bj = 0; bj < 2; ++bj)
#pragma unroll
                    for (int n = 0; n < 2; ++n) { const f32x4 bs = *(const f32x4*)(base + off + bj * HALF + n * 16); acc[ai][bj][m][n] = bs + (acc[ai][bj][m][n] - sr.x) * sr.y; }
                asm volatile("" : "+v"(acc[ai][0][m][0]), "+v"(acc[ai][0][m][1]), "+v"(acc[ai][1][m][0]), "+v"(acc[ai][1][m][1]));
                if (m & 1) asm volatile("" ::: "memory"); }
        const bool bad1 = bad;
        bad = st2.run(acc, u, wr, wc, fr, fq, lds, wid, lane) || bad;
#pragma unroll
        for (int ai = 0; ai < 2; ++ai)
#pragma unroll
            for (int m = 0; m < 4; ++m) { const int r = ai * HALF + wr * 64 + m * 16 + fr; const f32x2v sr = S[r]; const size_t off = (size_t)(u.pm * BM + r) * ldc + col0;
#pragma unroll
                for (int bj = 0; bj < 2; ++bj)
#pragma unroll
                    for (int n = 0; n < 2; ++n) { const f32x4 x1 = acc[ai][bj][m][n]; *(f32x4*)(out + off + bj * HALF + n * 16) = bad1 ? (f32x4){qnan, qnan, qnan, qnan} : x1;
                        const f32x4 o = (x1 - sr.x) * sr.y; u32x2v w; w.x = cvt_pk_bf16(o[0], o[1]); w.y = cvt_pk_bf16(o[2], o[3]);
                        if (bad) { w.x = 0x7fc07fc0u; w.y = 0x7fc07fc0u; } *(u32x2v*)(xn + off + bj * HALF + n * 16) = w; }
                asm volatile("" ::: "memory"); }
    }
};

template <class Epi, class Sched, bool ALIGN_EPI = false, bool SP2 = false>
__device__ __forceinline__ void gemm_phase(PG8_LAS unsigned char* lds, const Gemm g, const Sched& S, const Epi& E) {
    const int tid = opaque_tid(), wid = __builtin_amdgcn_readfirstlane(tid >> 6), lane = tid & 63, wr = wid >> 2, wc = wid & 3, fr = lane & 15, fq = lane >> 4;
    const int K = g.K, nt = K / BK;
    unsigned voffA[2], voffB[2];
#pragma unroll
    for (int i = 0; i < 2; ++i) { int R, C; stage_rc(tid * 16 + i * 8192, R, C); const int Rb = Epi::PERM ? ((R & ~31) + perm32(R & 31)) : R;
        voffA[i] = (unsigned)(R * K + C) * 2u; voffB[i] = (unsigned)(Rb * K + C) * 2u; }
    const size_t kstep = (size_t)(BK * 2);
    const size_t hstep = (size_t)HALF * K * 2;
    const size_t tstep = 2 * hstep;
    const unsigned ldsw = (unsigned)wid * 1024u;
    const int aoff = lds_byte(wr * 64 + fr, fq * 8), boff = lds_byte(wc * 32 + fr, fq * 8);
#define PG8_SA(b, h) (((b) * 2 + (h)) * HTB)
#define PG8_SB(b, h) ((4 + (b) * 2 + (h)) * HTB)
#define PG8_STAGE(bufoff, gbase, voff) do { _Pragma("unroll") for (int _i = 0; _i < 2; ++_i) \
        __builtin_amdgcn_global_load_lds((const unsigned*)((const char*)(gbase) + (voff)[_i]), (PG8_LAS unsigned*)(lds + (bufoff) + ldsw + _i * 8192), 16, 0, 0); } while (0)
#define PG8_LDA(dst, b, h) do { _Pragma("unroll") for (int m = 0; m < 4; ++m) _Pragma("unroll") for (int k = 0; k < 2; ++k) dst[m][k] = *(const PG8_LAS bf16x8*)(lds + PG8_SA(b, h) + aoff + m * 2048 + k * 1024); } while (0)
#define PG8_LDB(dst, b, h) do { _Pragma("unroll") for (int n = 0; n < 2; ++n) _Pragma("unroll") for (int k = 0; k < 2; ++k) dst[n][k] = *(const PG8_LAS bf16x8*)(lds + PG8_SB(b, h) + boff + n * 2048 + k * 1024); } while (0)
#define PG8_MMA(ai, bj, At, Bt) do { __builtin_amdgcn_s_setprio(1); _Pragma("unroll") for (int m = 0; m < 4; ++m) _Pragma("unroll") for (int n = 0; n < 2; ++n) _Pragma("unroll") for (int k = 0; k < 2; ++k) \
        acc[ai][bj][m][n] = __builtin_amdgcn_mfma_f32_16x16x32_bf16(Bt[n][k], At[m][k], acc[ai][bj][m][n], 0, 0, 0); __builtin_amdgcn_s_setprio(0); } while (0)
#define PG8_WAIT_V(n) asm volatile("s_waitcnt vmcnt(" #n ")" ::: "memory")
#define PG8_WAIT_L(n) asm volatile("s_waitcnt lgkmcnt(" #n ")" ::: "memory")
#define PG8_BAR __builtin_amdgcn_s_barrier()
#define PG8_SCHED __builtin_amdgcn_sched_barrier(0)
    Unit cur, nxt; int ui = 0;
    if (!S.next(0, cur)) return;
    f32x4 acc[2][2][4][2];
#pragma unroll
    for (int a = 0; a < 2; ++a)
#pragma unroll
        for (int b = 0; b < 2; ++b)
#pragma unroll
            for (int m = 0; m < 4; ++m)
#pragma unroll
                for (int n = 0; n < 2; ++n) acc[a][b][m][n] = (f32x4){0.f, 0.f, 0.f, 0.f};
    bf16x8 At[4][2], B0[2][2], B1[2][2];
    const char* cA = (const char*)g.A + (size_t)cur.pm * tstep; const char* cB = (const char*)g.Bt + (size_t)cur.pn * tstep;
    S.a_ready(cur);
    if constexpr (SP2) {
        PG8_STAGE(PG8_SB(0, 0), cB, voffB); PG8_STAGE(PG8_SB(0, 1), cB + hstep, voffB); PG8_STAGE(PG8_SA(0, 0), cA, voffA); PG8_STAGE(PG8_SA(0, 1), cA + hstep, voffA);
        if (wr == 1) PG8_BAR;
        PG8_WAIT_V(2); PG8_BAR;
        PG8_STAGE(PG8_SB(1, 0), cB + kstep, voffB); PG8_STAGE(PG8_SA(1, 0), cA + kstep, voffA); PG8_STAGE(PG8_SB(1, 1), cB + hstep + kstep, voffB);
        PG8_WAIT_V(6); PG8_BAR;
    } else {
        PG8_STAGE(PG8_SB(0, 0), cB, voffB); PG8_STAGE(PG8_SA(0, 0), cA, voffA); PG8_STAGE(PG8_SB(0, 1), cB + hstep, voffB); PG8_STAGE(PG8_SA(0, 1), cA + hstep, voffA);
        if (wr == 1) PG8_BAR;
        PG8_WAIT_V(4); PG8_BAR;
        PG8_STAGE(PG8_SB(1, 0), cB + kstep, voffB); PG8_STAGE(PG8_SA(1, 0), cA + kstep, voffA); PG8_STAGE(PG8_SB(1, 1), cB + hstep + kstep, voffB);
        PG8_WAIT_V(6); PG8_BAR;
    }
    for (;;) {
        const bool has_next = S.next(ui + 1, nxt);
        const char* nA = has_next ? (const char*)g.A + (size_t)nxt.pm * tstep : cA; const char* nB = has_next ? (const char*)g.Bt + (size_t)nxt.pn * tstep : cB;
        for (int t = 0; t < nt; t += 2) {
            const bool last = (t == nt - 2);
            const char* a1 = cA + (size_t)(t + 1) * kstep;
            const char* a2 = last ? nA : cA + (size_t)(t + 2) * kstep; const char* b2 = last ? nB : cB + (size_t)(t + 2) * kstep;
            const char* a3 = a2 + kstep; const char* b3 = b2 + kstep;
            if (last && has_next) S.a_ready(nxt);
            if constexpr (SP2) {
            PG8_LDB(B0, 0, 0); PG8_LDB(B1, 0, 1); PG8_SCHED; PG8_LDA(At, 0, 0); PG8_STAGE(PG8_SA(1, 1), a1 + hstep, voffA);
            PG8_WAIT_V(8); PG8_WAIT_L(0); PG8_BAR; PG8_MMA(0, 0, At, B0); PG8_MMA(0, 1, At, B1); PG8_BAR; PG8_SCHED;
            PG8_LDA(At, 0, 1); PG8_STAGE(PG8_SB(0, 0), b2, voffB); PG8_STAGE(PG8_SB(0, 1), b2 + hstep, voffB); PG8_STAGE(PG8_SA(0, 0), a2, voffA);
            PG8_WAIT_V(8); PG8_WAIT_L(0); PG8_BAR; PG8_MMA(1, 0, At, B0); PG8_MMA(1, 1, At, B1); PG8_BAR; PG8_SCHED;
            PG8_LDB(B0, 1, 0); PG8_LDB(B1, 1, 1); PG8_SCHED; PG8_LDA(At, 1, 0); PG8_STAGE(PG8_SA(0, 1), a2 + hstep, voffA);
            PG8_WAIT_V(8); PG8_WAIT_L(0); PG8_BAR; PG8_MMA(0, 0, At, B0); PG8_MMA(0, 1, At, B1); PG8_BAR; PG8_SCHED;
            PG8_LDA(At, 1, 1); PG8_STAGE(PG8_SB(1, 0), b3, voffB); PG8_STAGE(PG8_SB(1, 1), b3 + hstep, voffB); PG8_STAGE(PG8_SA(1, 0), a3, voffA);
            PG8_WAIT_V(8); PG8_WAIT_L(0); PG8_BAR; PG8_MMA(1, 0, At, B0); PG8_MMA(1, 1, At, B1); PG8_BAR; PG8_SCHED;
            } else {
            PG8_LDB(B0, 0, 0); PG8_SCHED; PG8_LDA(At, 0, 0); PG8_STAGE(PG8_SA(1, 1), a1 + hstep, voffA);
            PG8_WAIT_L(8); PG8_BAR; PG8_WAIT_L(0); PG8_MMA(0, 0, At, B0); PG8_BAR; PG8_SCHED;
            PG8_LDB(B1, 0, 1); PG8_STAGE(PG8_SB(0, 0), b2, voffB);
            PG8_BAR; PG8_WAIT_L(0); PG8_MMA(0, 1, At, B1); PG8_BAR;
            PG8_LDA(At, 0, 1); PG8_STAGE(PG8_SA(0, 0), a2, voffA);
            PG8_BAR; PG8_WAIT_L(0); PG8_MMA(1, 0, At, B0); PG8_BAR; PG8_SCHED;
            PG8_STAGE(PG8_SB(0, 1), b2 + hstep, voffB);
            PG8_WAIT_V(6); PG8_BAR; PG8_MMA(1, 1, At, B1); PG8_BAR;
            PG8_LDB(B0, 1, 0); PG8_SCHED; PG8_LDA(At, 1, 0); PG8_STAGE(PG8_SA(0, 1), a2 + hstep, voffA);
            PG8_WAIT_L(8); PG8_BAR; PG8_WAIT_L(0); PG8_MMA(0, 0, At, B0); PG8_BAR; PG8_SCHED;
            PG8_LDB(B1, 1, 1); PG8_STAGE(PG8_SB(1, 0), b3, voffB);
            PG8_BAR; PG8_WAIT_L(0); PG8_MMA(0, 1, At, B1); PG8_BAR;
            PG8_LDA(At, 1, 1); PG8_STAGE(PG8_SA(1, 0), a3, voffA);
            PG8_BAR; PG8_WAIT_L(0); PG8_MMA(1, 0, At, B0); PG8_BAR; PG8_SCHED;
            PG8_STAGE(PG8_SB(1, 1), b3 + hstep, voffB);
            PG8_WAIT_V(6); PG8_BAR; PG8_MMA(1, 1, At, B1); PG8_BAR;
            }
        }
        if constexpr (ALIGN_EPI) { if (wr == 0) PG8_BAR; }
        if constexpr (!Epi::AFTER_DRAIN) { E(acc, cur, wr, wc, fr, fq); S.done(cur); }
        if (!has_next) break;
#pragma unroll
        for (int a = 0; a < 2; ++a)
#pragma unroll
            for (int b = 0; b < 2; ++b)
#pragma unroll
                for (int m = 0; m < 4; ++m)
#pragma unroll
                    for (int n = 0; n < 2; ++n) acc[a][b][m][n] = (f32x4){0.f, 0.f, 0.f, 0.f};
        cur = nxt; cA = nA; cB = nB; ++ui;
        if constexpr (ALIGN_EPI) { if (wr == 1) PG8_BAR; }
    }
    PG8_WAIT_V(0);
    if constexpr (!ALIGN_EPI) { if (wr == 0) PG8_BAR; }
    PG8_BAR;
    if constexpr (Epi::AFTER_DRAIN) { E.fused(acc, cur, wr, wc, fr, fq, lds, wid, lane); S.done(cur); }
#undef PG8_SA
#undef PG8_SB
#undef PG8_STAGE
#undef PG8_LDA
#undef PG8_LDB
#undef PG8_MMA
#undef PG8_WAIT_V
#undef PG8_WAIT_L
#undef PG8_BAR
#undef PG8_SCHED
}
}
#include <hip/hip_bf16.h>
#include <cmath>
namespace attn_body {
using bf16=__hip_bfloat16;
using bf16x8=__attribute__((ext_vector_type(8)))short;
using s16x4=__attribute__((ext_vector_type(4)))short;
using f32x16=__attribute__((ext_vector_type(16)))float;
using u32x4=__attribute__((ext_vector_type(4)))unsigned;
using f32x4b=__attribute__((ext_vector_type(4)))float;
constexpr int BATCH=8,NHEAD=16,SEQ=2048,D=64,DM=4096,DMO=1024;
constexpr int NW=8,QBLK=32,QB=QBLK*NW,KVBLK=64,NQB=SEQ/QB;
constexpr int ATTN_PITCH=DM, ATTN_UNIT_ROWS=QB;
constexpr int LDS_BIAS_OFF=86016;
__device__ __forceinline__ int crow(int r,int hi){return (r&3)+8*(r>>2)+4*hi;}
#define SBAR() __builtin_amdgcn_sched_barrier(0)
__device__ __forceinline__ void cmask(f32x16&p0,f32x16&p1,int jb,int qrel,int hi){
  const float NEG=-INFINITY; int kb=64*jb+4*hi;
  #pragma unroll
  for(int r=0;r<16;++r){int kv=kb+(r&3)+8*(r>>2); if(kv>qrel)p0[r]=NEG; if(kv+32>qrel)p1[r]=NEG;}
}

constexpr int NSLOT=3, SLOTB=8192;
constexpr int LDS_K=0, LDS_V=NSLOT*SLOTB, LDS_WS=2*NSLOT*SLOTB, LDS_OST=LDS_WS+NW*64*4, LDS_BYTES=LDS_OST+NW*4096;
constexpr float C2=0.125f*1.4426950408889634f;
__device__ __forceinline__ void glds16(const void*gsrc,unsigned lds_dst){unsigned keep;
  asm volatile("s_mov_b32 %0, m0\n\ts_mov_b32 m0, %2\n\ts_nop 0\n\tglobal_load_lds_dwordx4 %1, off\n\ts_mov_b32 m0, %0":"=&s"(keep):"v"(gsrc),"s"(lds_dst):"memory");}
__device__ __forceinline__ float max3f(float a,float b,float c){float r;asm("v_max3_f32 %0, %1, %2, %3":"=v"(r):"v"(a),"v"(b),"v"(c));return r;}
__device__ __forceinline__ float max2f(float a,float b){float r;asm("v_max_f32_e32 %0, %1, %2":"=v"(r):"v"(a),"v"(b));return r;}
__device__ __forceinline__ float fadd_s(float a,float b){float r;asm("v_add_f32_e32 %0, %1, %2":"=v"(r):"v"(a),"v"(b));return r;}
__device__ __forceinline__ float fsub_s(float a,float b){float r;asm("v_sub_f32_e32 %0, %1, %2":"=v"(r):"v"(a),"v"(b));return r;}
typedef float f32x2_t __attribute__((ext_vector_type(2))); typedef __bf16 bf16x2_t __attribute__((ext_vector_type(2)));
__device__ __forceinline__ unsigned cvtpk_s(float lo,float hi){f32x2_t v={lo,hi};bf16x2_t b=__builtin_convertvector(v,bf16x2_t);return __builtin_bit_cast(unsigned,b);}
#define WAIT_BAR(N) asm volatile("s_waitcnt vmcnt(" #N ") lgkmcnt(0)\n\ts_barrier":::"memory")

__device__ __forceinline__ void qkt(f32x16&p0,f32x16&p1,const char*Kslot,const bf16x8*qr,const f32x16&negm,int r32,int hi){
  const char*kb=Kslot+hi*1024+r32*16;
  #pragma unroll
  for(int d0=0;d0<4;++d0){
    const bf16x8 b0=*reinterpret_cast<const bf16x8*>(kb+d0*2048);
    const bf16x8 b1=*reinterpret_cast<const bf16x8*>(kb+d0*2048+512);
    if(d0==0){p0=__builtin_amdgcn_mfma_f32_32x32x16_bf16(b0,qr[0],negm,0,0,0);p1=__builtin_amdgcn_mfma_f32_32x32x16_bf16(b1,qr[0],negm,0,0,0);}
    else{p0=__builtin_amdgcn_mfma_f32_32x32x16_bf16(b0,qr[d0],p0,0,0,0);p1=__builtin_amdgcn_mfma_f32_32x32x16_bf16(b1,qr[d0],p1,0,0,0);}}
}
typedef __attribute__((address_space(3))) const char* lds_cptr;
typedef short v4i16_t __attribute__((ext_vector_type(4)));
__device__ __forceinline__ void kload8(bf16x8*kf,lds_cptr kp){
  kf[0]=*(const __attribute__((address_space(3))) bf16x8*)(kp);      kf[1]=*(const __attribute__((address_space(3))) bf16x8*)(kp+512);
  kf[2]=*(const __attribute__((address_space(3))) bf16x8*)(kp+2048); kf[3]=*(const __attribute__((address_space(3))) bf16x8*)(kp+2560);
  kf[4]=*(const __attribute__((address_space(3))) bf16x8*)(kp+4096); kf[5]=*(const __attribute__((address_space(3))) bf16x8*)(kp+4608);
  kf[6]=*(const __attribute__((address_space(3))) bf16x8*)(kp+6144); kf[7]=*(const __attribute__((address_space(3))) bf16x8*)(kp+6656);
}
__device__ __forceinline__ void kload2(bf16x8*kf,lds_cptr kp,int j){ kf[2*j]=*(const __attribute__((address_space(3))) bf16x8*)(kp+j*2048); kf[2*j+1]=*(const __attribute__((address_space(3))) bf16x8*)(kp+j*2048+512); }
__device__ __forceinline__ s16x4 vtr(lds_cptr p){ return __builtin_bit_cast(s16x4,__builtin_amdgcn_ds_read_tr16_b64_v4i16((__attribute__((address_space(3))) v4i16_t*)p)); }
__device__ __forceinline__ float rowmax(const f32x16&p0,const f32x16&p1){
  float a=max3f(p0[0],p0[1],p1[0]),b=max3f(p0[2],p0[3],p1[1]);a=max3f(a,p1[2],p1[3]);
  #pragma unroll
  for(int r=4;r<16;r+=4){a=max3f(a,p0[r],p0[r+1]);b=max3f(b,p0[r+2],p0[r+3]);a=max3f(a,p1[r],p1[r+1]);b=max3f(b,p1[r+2],p1[r+3]);}
  const float m=max2f(a,b);
  auto rr=__builtin_amdgcn_permlane32_swap(__float_as_uint(m),__float_as_uint(m),false,false);
  return max2f(__uint_as_float(rr[0]),__uint_as_float(rr[1]));
}
__device__ __forceinline__ void pv(f32x16*o,int vb,bf16x8 pa0,bf16x8 pa1,bf16x8 pa2,bf16x8 pa3){
  #pragma unroll
  for(int d0=0;d0<2;++d0){s16x4 lo[4],hi[4];
    #pragma unroll
    for(int ks=0;ks<4;++ks){
      asm volatile("ds_read_b64_tr_b16 %0,%1 offset:%c2":"=&v"(lo[ks]):"v"(vb),"i"(d0*4096+ks*1024):"memory");
      asm volatile("ds_read_b64_tr_b16 %0,%1 offset:%c2":"=&v"(hi[ks]):"v"(vb),"i"(d0*4096+ks*1024+512):"memory");}
    asm volatile("s_waitcnt lgkmcnt(0)":::"memory");SBAR();
    #define PK(k) (bf16x8){lo[k][0],lo[k][1],lo[k][2],lo[k][3],hi[k][0],hi[k][1],hi[k][2],hi[k][3]}
    o[d0]=__builtin_amdgcn_mfma_f32_32x32x16_bf16(pa0,PK(0),o[d0],0,0,0);
    o[d0]=__builtin_amdgcn_mfma_f32_32x32x16_bf16(pa1,PK(1),o[d0],0,0,0);
    o[d0]=__builtin_amdgcn_mfma_f32_32x32x16_bf16(pa2,PK(2),o[d0],0,0,0);
    o[d0]=__builtin_amdgcn_mfma_f32_32x32x16_bf16(pa3,PK(3),o[d0],0,0,0);
    #undef PK
  }
}

#ifndef ATTN_STORE16
#define ATTN_STORE16(p,v) (*(u32x4*)(p)=(v))
#endif
template<int THRL> __device__ __forceinline__ void attn_unit(int b,int h,int qb,const bf16*Q,const bf16*__restrict__ K,const bf16*__restrict__ V,const bf16*__restrict__ OG,const float*__restrict__ CUM,bf16*O,char*shm){
  const int tid=opaque_tid(),lane=tid&63,r32=lane&31,hi=lane>>5; const int wid=__builtin_amdgcn_readfirstlane(tid>>6);
  const long rowbase=(long)b*SEQ; const int q0=qb*QB;
  const bf16*Qw=Q+(rowbase+q0+wid*QBLK)*DM+h*D;
  const bf16*Kh=K+rowbase*DM+h*D,*Vh=V+rowbase*DM+h*D;
  const unsigned lds0=(unsigned)(uintptr_t)shm;
  float*wsf=(float*)(shm+LDS_WS)+wid*64;
  const bf16*ksrc=Kh+(long)lane*DM+wid*8;
  const bf16*vsrc=Vh+(long)(16*(wid&3)+(lane>>2))*DM+(wid>>2)*32+(lane&3)*8;
  const unsigned kdst=lds0+LDS_K+wid*1024, vdst=lds0+LDS_V+wid*1024;
  #define DMA_K(t,slot) glds16(ksrc+(long)(t)*KVBLK*DM,(unsigned)__builtin_amdgcn_readfirstlane(kdst+(slot)))
  #define DMA_V(t,slot) glds16(vsrc+(long)(t)*KVBLK*DM,(unsigned)__builtin_amdgcn_readfirstlane(vdst+(slot)))
  const int vb0=(int)(lds0+LDS_V)+((lane>>4)&1)*32+(lane&3)*8+(4*hi+((lane&15)>>2))*64;
  const char*Kbase=shm+LDS_K; bf16x8 kf[8];
  const lds_cptr shm3=(lds_cptr)shm; const lds_cptr kp0=shm3+LDS_K+hi*1024+r32*16; const lds_cptr vp0=shm3+LDS_V+((lane>>4)&1)*32+(lane&3)*8+(4*hi+((lane&15)>>2))*64;
  const int NT=(q0+QB)/KVBLK;
  { float*bl=(float*)(shm+LDS_BIAS_OFF); const float*cs=CUM+((long)b*NHEAD+h)*SEQ;
    for(int j=tid;j<q0+QB;j+=NW*64)bl[j]=cs[j]*(-1.4426950408889634f);
    asm volatile("s_waitcnt vmcnt(0) lgkmcnt(0)\n\ts_barrier":::"memory"); }
  const lds_cptr bp0=(lds_cptr)shm+LDS_BIAS_OFF+hi*16;
  #define BIAS(P0,P1,t) do{ const lds_cptr bp_=bp0+(t)*256; \
    _Pragma("unroll") for(int g_=0;g_<4;++g_){ const f32x4b b0_=*(const __attribute__((address_space(3))) f32x4b*)(bp_+g_*32); const f32x4b b1_=*(const __attribute__((address_space(3))) f32x4b*)(bp_+128+g_*32); \
      P0[4*g_]+=b0_[0];P0[4*g_+1]+=b0_[1];P0[4*g_+2]+=b0_[2];P0[4*g_+3]+=b0_[3]; P1[4*g_]+=b1_[0];P1[4*g_+1]+=b1_[1];P1[4*g_+2]+=b1_[2];P1[4*g_+3]+=b1_[3]; } }while(0)
  DMA_K(0,0);DMA_V(0,0);DMA_K(1,SLOTB);
  bf16x8 qr[4];
  #pragma unroll
  for(int d0=0;d0<4;++d0)qr[d0]=*reinterpret_cast<const bf16x8*>(&Qw[(long)r32*DM+d0*16+hi*8]);
  float mhat=0.f,l_reg=0.f;f32x16 o[2];o[0]=f32x16{};o[1]=f32x16{};f32x16 negm=f32x16{};asm volatile("":"+v"(negm));
  const int qrel=wid*QBLK+r32;
  #define CMASK(P0,P1,t) do{int jb_=(t)-(NT-4); if(jb_>=0)cmask(P0,P1,jb_,qrel,hi);}while(0)
  bool resc=false;
  #define START(P0,P1) do{ const float rm=rowmax(P0,P1); resc=false; \
    { const float dl=rm; mhat=fadd_s(mhat,dl); \
      _Pragma("unroll") for(int r=0;r<16;++r){P0[r]=fsub_s(P0[r],dl);P1[r]=fsub_s(P1[r],dl);} \
      _Pragma("unroll") for(int r=0;r<16;++r)negm[r]=-mhat; asm volatile("":"+v"(negm)); } \
    _Pragma("unroll") for(int r=0;r<16;++r)P0[r]=__builtin_amdgcn_exp2f(P0[r]); }while(0)
  #define RESC() do{ if(resc){ asm volatile("s_waitcnt lgkmcnt(0)":::"memory"); \
      _Pragma("unroll") for(int d_=0;d_<2;++d_) _Pragma("unroll") for(int r=0;r<16;++r)o[d_][r]*=wsf[crow(r,hi)]; } }while(0)
  f32x16 pA0,pA1,pB0,pB1;
  int sl_prev=0,sl_cur=0,sl_next=SLOTB;
  #define ROT() do{sl_prev=sl_cur;sl_cur=sl_next;sl_next=(sl_next==(NSLOT-1)*SLOTB)?0:sl_next+SLOTB;}while(0)
  DMA_K(2,2*SLOTB);
  WAIT_BAR(3);
  qkt(pA0,pA1,Kbase,qr,negm,r32,hi);asm volatile("s_nop 15\n\ts_nop 7":"+v"(pA0),"+v"(pA1));BIAS(pA0,pA1,0);CMASK(pA0,pA1,0);
  START(pA0,pA1);
  _Pragma("unroll") for(int r=0;r<16;++r)pA1[r]=__builtin_amdgcn_exp2f(pA1[r]);
  WAIT_BAR(0);
  DMA_K(3,0);DMA_V(1,SLOTB);
  ROT();
  kload8(kf,kp0+sl_cur);
  WAIT_BAR(2);
  s16x4 vlo[8],vhi[8]; u32x4 pw0,pw1,pw2,pw3;
  #define PKW(P,B) cvtpk_s(P[B],P[B+1])
  #define PAF(k) __builtin_bit_cast(bf16x8,pw##k)
  #define VFR(i) (bf16x8){vlo[i][0],vlo[i][1],vlo[i][2],vlo[i][3],vhi[i][0],vhi[i][1],vhi[i][2],vhi[i][3]}
  #define PIN(x) asm volatile("":"+v"(x))
  #define MX3(a,b,c) __builtin_fmaxf(__builtin_fmaxf((a),(b)),(c))
  #define GAPA(MF,A0,A1,A2,A3,W0,W1,PW) do{ MF; sacc+=A0; sacc+=A1; sacc+=A2; sacc+=A3; PIN(sacc); W0; W1; PIN(PW); SBAR(); }while(0)
  #define EX(v) __builtin_amdgcn_exp2f(v)
  #define GAPB(MF,X,B) do{ MF; X[B]=EX(X[B]); X[B+1]=EX(X[B+1]); X[B+2]=EX(X[B+2]); X[B+3]=EX(X[B+3]); PIN(X); SBAR(); }while(0)
  #define VRD(i) do{ vlo[i]=vtr(vp_+(((i)>>2)*4096+((i)&3)*1024)); vhi[i]=vtr(vp_+(((i)>>2)*4096+((i)&3)*1024+512)); }while(0)
  #define KRD(G,j) do{ if(G){ kload2(kf,kp0+sl_next,j); SBAR(); } }while(0)
  #define STEP(C0,C1,P0,P1,t,GK,GV,GL) do{ SBAR(); \
    const lds_cptr vp_=vp0+sl_prev; \
    VRD(0); SBAR(); float sacc=(P0[0]+P0[1]); \
    GAPA(C0=__builtin_amdgcn_mfma_f32_32x32x16_bf16(kf[0],qr[0],negm,0,0,0), P0[2],P0[3],P0[4],P0[5],     pw0[0]=PKW(P0,0), pw0[1]=PKW(P0,2), pw0); \
    VRD(4); SBAR(); GAPA(C1=__builtin_amdgcn_mfma_f32_32x32x16_bf16(kf[1],qr[0],negm,0,0,0), P0[6],P0[7],P0[8],P0[9],     pw0[2]=PKW(P0,4), pw0[3]=PKW(P0,6), pw0); \
    VRD(1); SBAR(); GAPA(C0=__builtin_amdgcn_mfma_f32_32x32x16_bf16(kf[2],qr[1],C0,0,0,0),   P0[10],P0[11],P0[12],P0[13], pw1[0]=PKW(P0,8), pw1[1]=PKW(P0,10), pw1); \
    VRD(5); SBAR(); GAPA(C1=__builtin_amdgcn_mfma_f32_32x32x16_bf16(kf[3],qr[1],C1,0,0,0),   P0[14],P0[15],P1[0],P1[1],   pw1[2]=PKW(P0,12),pw1[3]=PKW(P0,14), pw1); \
    VRD(2); SBAR(); GAPA(C0=__builtin_amdgcn_mfma_f32_32x32x16_bf16(kf[4],qr[2],C0,0,0,0),   P1[2],P1[3],P1[4],P1[5],     pw2[0]=PKW(P1,0), pw2[1]=PKW(P1,2), pw2); \
    VRD(6); SBAR(); GAPA(C1=__builtin_amdgcn_mfma_f32_32x32x16_bf16(kf[5],qr[2],C1,0,0,0),   P1[6],P1[7],P1[8],P1[9],     pw2[2]=PKW(P1,4), pw2[3]=PKW(P1,6), pw2); \
    VRD(3); SBAR(); GAPA(C0=__builtin_amdgcn_mfma_f32_32x32x16_bf16(kf[6],qr[3],C0,0,0,0),   P1[10],P1[11],P1[12],P1[13], pw3[0]=PKW(P1,8), pw3[1]=PKW(P1,10), pw3); \
    VRD(7); SBAR(); GAPA(C1=__builtin_amdgcn_mfma_f32_32x32x16_bf16(kf[7],qr[3],C1,0,0,0),   P1[14],P1[15],0.f,0.f,       pw3[2]=PKW(P1,12),pw3[3]=PKW(P1,14), pw3); \
    l_reg+=sacc; \
    if(GK){DMA_K((t)+3,sl_cur);} if(GV){DMA_V((t)+1,sl_next);} \
    BIAS(C0,C1,t); \
    CMASK(C0,C1,t); \
    { float a=MX3(C0[0],C0[1],C1[0]),b=MX3(C0[2],C0[3],C1[1]); a=MX3(a,C1[2],C1[3]); \
      _Pragma("unroll") for(int r=4;r<16;r+=4){a=MX3(a,C0[r],C0[r+1]);b=MX3(b,C0[r+2],C0[r+3]);a=MX3(a,C1[r],C1[r+1]);b=MX3(b,C1[r+2],C1[r+3]);} \
      float rm=__builtin_fmaxf(a,b); { auto rr=__builtin_amdgcn_permlane32_swap(__float_as_uint(rm),__float_as_uint(rm),false,false); rm=__builtin_fmaxf(__uint_as_float(rr[0]),__uint_as_float(rr[1])); } \
      resc=false; \
      if(__builtin_expect(__any(rm>(float)THRL),0)){ const float dl=__builtin_fmaxf(rm,0.f); mhat+=dl; \
        _Pragma("unroll") for(int r=0;r<16;++r){C0[r]-=dl;C1[r]-=dl;} \
        _Pragma("unroll") for(int r=0;r<16;++r)negm[r]=-mhat; asm volatile("":"+v"(negm)); \
        const float f=__builtin_amdgcn_exp2f(-dl); l_reg*=f; if(hi==0)wsf[r32]=f; resc=true; } } \
    SBAR(); \
    GAPB(o[0]=__builtin_amdgcn_mfma_f32_32x32x16_bf16(PAF(0),VFR(0),o[0],0,0,0), C0,0); \
    GAPB(o[1]=__builtin_amdgcn_mfma_f32_32x32x16_bf16(PAF(0),VFR(4),o[1],0,0,0), C0,4); \
    KRD(GL,0); GAPB(o[0]=__builtin_amdgcn_mfma_f32_32x32x16_bf16(PAF(1),VFR(1),o[0],0,0,0), C0,8); \
    KRD(GL,1); GAPB(o[1]=__builtin_amdgcn_mfma_f32_32x32x16_bf16(PAF(1),VFR(5),o[1],0,0,0), C0,12); \
    KRD(GL,2); GAPB(o[0]=__builtin_amdgcn_mfma_f32_32x32x16_bf16(PAF(2),VFR(2),o[0],0,0,0), C1,0); \
    KRD(GL,3); GAPB(o[1]=__builtin_amdgcn_mfma_f32_32x32x16_bf16(PAF(2),VFR(6),o[1],0,0,0), C1,4); \
    GAPB(o[0]=__builtin_amdgcn_mfma_f32_32x32x16_bf16(PAF(3),VFR(3),o[0],0,0,0), C1,8); \
    GAPB(o[1]=__builtin_amdgcn_mfma_f32_32x32x16_bf16(PAF(3),VFR(7),o[1],0,0,0), C1,12); \
    }while(0)
  int t=1;
  #undef CMASK
  #define CMASK(P0,P1,t) do{}while(0)
  for(;t+5<NT;t+=2){
    STEP(pB0,pB1,pA0,pA1,t,true,true,true);     WAIT_BAR(2); RESC(); ROT();
    STEP(pA0,pA1,pB0,pB1,t+1,true,true,true);   WAIT_BAR(2); RESC(); ROT();
  }
  #undef CMASK
  #define CMASK(P0,P1,t) do{int jb_=(t)-(NT-4); if(jb_>=0)cmask(P0,P1,jb_,qrel,hi);}while(0)
  #define ENDW(tt) do{ if((tt)+3<NT){WAIT_BAR(2);} else if((tt)+2<NT){WAIT_BAR(1);} else {WAIT_BAR(0);} }while(0)
  for(;t+1<NT;t+=2){
    STEP(pB0,pB1,pA0,pA1,t,(t+3<NT),(t+1<NT),(t+1<NT));       ENDW(t);   RESC(); ROT();
    STEP(pA0,pA1,pB0,pB1,t+1,(t+4<NT),(t+2<NT),(t+2<NT));     ENDW(t+1); RESC(); ROT();
  }
  STEP(pB0,pB1,pA0,pA1,NT-1,false,false,false); RESC();
  { float sacc=pB0[0]+pB0[1]; _Pragma("unroll") for(int r=2;r<16;++r)sacc+=pB0[r]; _Pragma("unroll") for(int r=0;r<16;++r)sacc+=pB1[r]; l_reg+=sacc;
    pw0=(u32x4){PKW(pB0,0),PKW(pB0,2),PKW(pB0,4),PKW(pB0,6)};pw1=(u32x4){PKW(pB0,8),PKW(pB0,10),PKW(pB0,12),PKW(pB0,14)};pw2=(u32x4){PKW(pB1,0),PKW(pB1,2),PKW(pB1,4),PKW(pB1,6)};pw3=(u32x4){PKW(pB1,8),PKW(pB1,10),PKW(pB1,12),PKW(pB1,14)};
    SBAR(); pv(o,vb0+sl_cur,PAF(0),PAF(1),PAF(2),PAF(3)); }
  #undef PKW
  #undef PAF
  #undef VFR
  #undef PIN
  #undef MX3
  #undef GAPA
  #undef GAPB
  #undef EX
  #undef VRD
  #undef KRD
  #undef STEP
  #undef ENDW
  {auto rr=__builtin_amdgcn_permlane32_swap(__float_as_uint(l_reg),__float_as_uint(l_reg),false,false);l_reg=__uint_as_float(rr[0])+__uint_as_float(rr[1]);}
  if(hi==0)wsf[32+r32]=l_reg;asm volatile("s_waitcnt lgkmcnt(0)":::"memory");
  float rli[16];
  #pragma unroll
  for(int r=0;r<16;++r)rli[r]=__builtin_amdgcn_rcpf(wsf[32+crow(r,hi)]);
  bf16*Ow=O+(rowbase+q0+wid*QBLK)*DMO+h*D; const bf16*Gw=OG+(rowbase+q0+wid*QBLK)*DM+h*D;
  { bf16*stg=(bf16*)(shm+LDS_OST)+wid*2048;
    #pragma unroll
    for(int r=0;r<16;++r){const int orow=crow(r,hi);
      #pragma unroll
      for(int d0=0;d0<2;++d0)stg[orow*64+d0*32+r32]=__float2bfloat16(o[d0][r]*rli[r]);}
    asm volatile("s_waitcnt lgkmcnt(0)":::"memory");
    #pragma unroll
    for(int i=0;i<4;++i){const int row=i*8+(lane>>3),ch=lane&7; u32x4 v=*(const u32x4*)(stg+row*64+ch*8); const u32x4 g=*(const u32x4*)(Gw+(long)row*DM+ch*8);
      #pragma unroll
      for(int e=0;e<4;++e){ const float o0=__uint_as_float(v[e]<<16),o1=__uint_as_float(v[e]&0xffff0000u),g0=__uint_as_float(g[e]<<16),g1=__uint_as_float(g[e]&0xffff0000u);
        v[e]=cvtpk_s(o0*__builtin_amdgcn_rcpf(1.0f+__builtin_amdgcn_exp2f(-1.4426950408889634f*g0)),o1*__builtin_amdgcn_rcpf(1.0f+__builtin_amdgcn_exp2f(-1.4426950408889634f*g1))); }
      ATTN_STORE16(Ow+(long)row*DMO+ch*8,v);} }
  asm volatile("s_waitcnt lgkmcnt(0)\n\ts_barrier":::"memory");
  #undef DMA_K
  #undef DMA_V
  #undef BIAS
  #undef CMASK
  #undef START
  #undef RESC
  #undef ROT
}
constexpr int ATTN_LDS_BYTES=LDS_BYTES;
struct AttnTensors { const bf16* Q; const bf16* K; const bf16* V; const bf16* OG; const float* CUM; bf16* O; };
struct AttnUnit { int bh; int qb; };
struct StaticOrder {
  int vcu, stride;
  __device__ __forceinline__ explicit StaticOrder(int grid,int block):vcu((grid%8==0)?(block%8)*(grid/8)+block/8:block),stride(grid){}
  __device__ __forceinline__ bool next(int i,AttnUnit&u)const{ const int su=vcu+(i>>2)*stride; if(su>=256)return false; const int p=su&1,k=i&3; u.bh=su>>1; u.qb=(k==0)?p:(k==1)?7-p:(k==2)?2+p:5-p; return true; }
  __device__ __forceinline__ void a_ready(const AttnUnit&)const{}
  __device__ __forceinline__ void done(const AttnUnit&)const{}
};
template<class Sched,int THRL=8> __device__ __forceinline__ void attn_phase(char*lds,const AttnTensors&T,const Sched&S){
  AttnUnit u;
  for(int i=0;S.next(i,u);++i){ S.a_ready(u); attn_unit<THRL>(u.bh/NHEAD,u.bh%NHEAD,u.qb,T.Q,T.K,T.V,T.OG,T.CUM,T.O,lds); S.done(u); }
}
#undef SBAR
#undef WAIT_BAR
}
#define GAS __attribute__((address_space(1)))
#define LAS __attribute__((address_space(3)))
typedef GAS unsigned gu32;
typedef GAS unsigned long long gu64;
#define RLX_AGENT __ATOMIC_RELAXED, __HIP_MEMORY_SCOPE_AGENT
#define XB_TMO      128
#define XB_XCNT(j)  (256  + 64 * (j))
#define XB_XSUB(j)  (1280 + 64 * (j))
#define XB_XGEN(j)  (2304 + 64 * (j))
#define XB_TOP      3328
#define XB_TOPGEN   3392
#define XCD_BAR_WORDS 3456
#define XB_SPIN_CAP (1u << 18)

__device__ __forceinline__ unsigned xb_ld(unsigned* p)              { return __hip_atomic_load(p, __ATOMIC_RELAXED, __HIP_MEMORY_SCOPE_AGENT); }
__device__ __forceinline__ unsigned xb_add(unsigned* p, unsigned v) { return __hip_atomic_fetch_add(p, v, __ATOMIC_RELAXED, __HIP_MEMORY_SCOPE_AGENT); }
__device__ __forceinline__ unsigned xb_xcc_id() { return (unsigned)__builtin_amdgcn_s_getreg((3 << 11) | 20) & 0xFu; }
#define XB_SPIN(cond, bar) do { unsigned _sp = 0; while (cond) { __builtin_amdgcn_s_sleep(1); \
    if ((++_sp & 255u) == 0u) { if (xb_ld(&(bar)[XB_TMO])) break; if (_sp > XB_SPIN_CAP) { atomicAdd(&(bar)[XB_TMO], 1u); break; } } } } while (0)

struct XcdBarrier {
    unsigned* bar; unsigned x;
    volatile LAS unsigned* st;
};

__device__ __forceinline__ XcdBarrier xcd_barrier_post(unsigned* bar, volatile LAS unsigned* st) {
    XcdBarrier b; b.bar = bar; b.x = xb_xcc_id(); b.st = st;
    if (threadIdx.x == 0) (void)xb_add(&bar[XB_XCNT(b.x)], 1u);
    return b;
}
__device__ __forceinline__ void xcd_barrier_complete(unsigned* bar, unsigned x, unsigned& nloc, unsigned& nx) {
    const unsigned G = gridDim.x * gridDim.y * gridDim.z;
    unsigned sum, cnt, mine, sp = 0u;
    for (;;) {
        sum = 0u; cnt = 0u; mine = 0u;
#pragma unroll
        for (unsigned j = 0; j < 16; ++j) { const unsigned c = xb_ld(&bar[XB_XCNT(j)]); sum += c; cnt += (c > 0u) ? 1u : 0u; mine = (j == x) ? c : mine; }
        if (sum == G) break;
        __builtin_amdgcn_s_sleep(1);
        if ((++sp & 255u) == 0u) { if (xb_ld(&bar[XB_TMO])) break; if (sp > XB_SPIN_CAP) { atomicAdd(&bar[XB_TMO], 1u); break; } }
    }
    nloc = mine > 0u ? mine : 1u; nx = cnt > 0u ? cnt : 1u;
}

__device__ __forceinline__ void xcd_barrier(const XcdBarrier& b) {
    asm volatile("s_waitcnt vmcnt(0)" ::: "memory");
    __syncthreads();
    if (threadIdx.x == 0) {
        unsigned* bar = b.bar;
        __builtin_amdgcn_s_waitcnt(0);
        unsigned nloc = b.st[0], nx = b.st[1];
        if (nloc == 0u) { xcd_barrier_complete(bar, b.x, nloc, nx); b.st[0] = nloc; b.st[1] = nx; }
        const unsigned old = xb_add(&bar[XB_XSUB(b.x)], 1u);
        const unsigned gen = old / nloc;
        if (old + 1u == (gen + 1u) * nloc) {
            __builtin_amdgcn_fence(__ATOMIC_RELEASE, "agent");
            asm volatile("s_waitcnt vmcnt(0)" ::: "memory");
            const unsigned og = xb_add(&bar[XB_TOP], 1u);
            const unsigned tg = og / nx;
            if (og + 1u == (tg + 1u) * nx) xb_add(&bar[XB_TOPGEN], 1u);
            else XB_SPIN(xb_ld(&bar[XB_TOPGEN]) == tg, bar);
            __builtin_amdgcn_fence(__ATOMIC_ACQUIRE, "agent");
            xb_add(&bar[XB_XGEN(b.x)], 1u);
            asm volatile("s_waitcnt vmcnt(0)" ::: "memory");
        } else {
            XB_SPIN(xb_ld(&bar[XB_XGEN(b.x)]) == gen, bar);
            __builtin_amdgcn_fence(__ATOMIC_ACQUIRE, "agent");
            asm volatile("s_waitcnt vmcnt(0)" ::: "memory");
        }
    }
    __syncthreads();
}

typedef unsigned short bf16_t;
typedef short bf16x8_t __attribute__((ext_vector_type(8)));
typedef float f32x4_t __attribute__((ext_vector_type(4)));
constexpr int T_TOK = 16384, DM = 1024, SEQ = 2048, NBATCH = 8;
constexpr int L0_COLS = 3848, L0_MAIN = 3840, L1_COLS = 4112, L1_MAIN = 4096;
constexpr float DN_ALPHA = 1.4142135623730951f;
constexpr float LN_EPS = 1e-5f;
constexpr int NTHR = 512;

__device__ __forceinline__ unsigned f2bf(float f) { unsigned u = __float_as_uint(f); return (u + 0x7fffu + ((u >> 16) & 1u)) >> 16; }
__device__ __forceinline__ unsigned pk2(float lo, float hi) { return f2bf(lo) | (f2bf(hi) << 16); }
__device__ __forceinline__ float bflo(unsigned w) { return __uint_as_float(w << 16); }
__device__ __forceinline__ float bfhi(unsigned w) { return __uint_as_float(w & 0xffff0000u); }
__device__ __forceinline__ float bf2f(bf16_t h) { return __uint_as_float(((unsigned)h) << 16); }
__device__ __forceinline__ float wave_sum(float v) {
#pragma unroll
    for (int o = 32; o >= 1; o >>= 1) v += __shfl_xor(v, o);
    return v;
}
__device__ __forceinline__ float sigmoid_f(float x) { return 1.0f / (1.0f + __expf(-x)); }
__device__ __forceinline__ float log_sigmoid_f(float x) { return fminf(x, 0.f) - log1pf(__expf(-fabsf(x))); }
__device__ __forceinline__ void unpack8(const uint4 w, float* f) {
    f[0] = bflo(w.x); f[1] = bfhi(w.x); f[2] = bflo(w.y); f[3] = bfhi(w.y); f[4] = bflo(w.z); f[5] = bfhi(w.z); f[6] = bflo(w.w); f[7] = bfhi(w.w);
}
__device__ __forceinline__ void unpack4(const uint2 w, float* f) { f[0] = bflo(w.x); f[1] = bfhi(w.x); f[2] = bflo(w.y); f[3] = bfhi(w.y); }

__device__ __forceinline__ void transpose_cvt_phase(const float* __restrict__ W, int K, int ldw, int c0, int N, bf16_t* __restrict__ WT, int bid, int nblk, float* tile  ) {
    const int nb = N / 64, nunits = (K / 64) * nb;
    for (int u = bid; u < nunits; u += nblk) {
        const int kb = u / nb, nbi = u % nb; const int k0 = kb * 64, n0 = nbi * 64;
        for (int i = opaque_tid(); i < 4096; i += NTHR) { const int kk = i >> 6, nn = i & 63; tile[kk * 65 + nn] = W[(size_t)(k0 + kk) * ldw + c0 + n0 + nn]; }
        __syncthreads();
        for (int i = opaque_tid(); i < 2048; i += NTHR) { const int nn = i >> 5, kp = (i & 31) * 2;
            const unsigned v = pk2(tile[kp * 65 + nn], tile[(kp + 1) * 65 + nn]); *(unsigned*)(WT + (size_t)(n0 + nn) * K + k0 + kp) = v; }
        __syncthreads();
    }
}
__device__ __forceinline__ void cvt_bf16_phase(const float* __restrict__ src, bf16_t* __restrict__ dst, size_t n8, int bid, int nblk) {
    for (size_t i = (size_t)bid * NTHR + opaque_tid(); i < n8; i += (size_t)nblk * NTHR) {
        const float4 a = ((const float4*)src)[2 * i], b = ((const float4*)src)[2 * i + 1];
        uint4 o; o.x = pk2(a.x, a.y); o.y = pk2(a.z, a.w); o.z = pk2(b.x, b.y); o.w = pk2(b.z, b.w); ((uint4*)dst)[i] = o; }
}
__device__ __forceinline__ void build_wlr_phase(const float* __restrict__ w_up, const float* __restrict__ a_up, const float* __restrict__ g_up, bf16_t* __restrict__ WT, int bid, int nblk) {
    for (int i = bid * NTHR + opaque_tid(); i < 1536 * 256; i += nblk * NTHR) { const int n = i >> 8, k = i & 255; float v = 0.f;
        if (n < 512) { if (k < 64) v = w_up[k * 512 + n]; }
        else if (n < 1024) { if (k >= 64 && k < 128) v = a_up[(k - 64) * 512 + (n - 512)]; }
        else { if (k >= 128) v = g_up[(k - 128) * 512 + (n - 1024)]; }
        WT[i] = (bf16_t)f2bf(v); }
}

namespace pg8 {
struct EpiF32 {
    static constexpr bool PERM = false, AFTER_DRAIN = false;
    float* C; long ldc;
    __device__ __forceinline__ void operator()(const f32x4 (&acc)[2][2][4][2], const Unit& u, int wr, int wc, int fr, int fq) const {
        const int row0 = u.pm * BM + wr * 64 + fr, col0 = u.pn * BM + wc * 32 + 4 * fq;
#pragma unroll
        for (int ai = 0; ai < 2; ++ai)
#pragma unroll
            for (int m = 0; m < 4; ++m) { float* rowp = C + (size_t)(row0 + ai * HALF + m * 16) * ldc + col0;
#pragma unroll
                for (int bj = 0; bj < 2; ++bj)
#pragma unroll
                    for (int n = 0; n < 2; ++n) *(f32x4*)(rowp + bj * HALF + n * 16) = acc[ai][bj][m][n]; }
    }
};
struct EpiBf16P {
    static constexpr bool PERM = true, AFTER_DRAIN = false;
    bf16_t* O; long ldc;
    __device__ __forceinline__ void operator()(const f32x4 (&acc)[2][2][4][2], const Unit& u, int wr, int wc, int fr, int fq) const {
        const int row0 = u.pm * BM + wr * 64 + fr; const int col0 = u.pn * BM + wc * 32 + 8 * fq;
#pragma unroll
        for (int ai = 0; ai < 2; ++ai)
#pragma unroll
            for (int m = 0; m < 4; ++m) { bf16_t* rowp = O + (size_t)(row0 + ai * HALF + m * 16) * ldc + col0;
#pragma unroll
                for (int bj = 0; bj < 2; ++bj) { const f32x4 v0 = acc[ai][bj][m][0], v1 = acc[ai][bj][m][1];
                    u32x4 w; w.x = cvt_pk_bf16(v0[0], v0[1]); w.y = cvt_pk_bf16(v0[2], v0[3]); w.z = cvt_pk_bf16(v1[0], v1[1]); w.w = cvt_pk_bf16(v1[2], v1[3]);
                    *(u32x4*)(rowp + bj * HALF) = w; } }
    }
};
struct EpiLowrank {
    static constexpr bool PERM = false, AFTER_DRAIN = false;
    float* lrw; bf16_t* lra; bf16_t* lrg; const float* w0; const float* a0;
    __device__ __forceinline__ void operator()(const f32x4 (&acc)[2][2][4][2], const Unit& u, int wr, int wc, int fr, int fq) const {
        const int row0 = u.pm * BM + wr * 64 + fr; const int sel = u.pn >> 1; const int colb = (u.pn & 1) * BM + wc * 32 + 4 * fq;
#pragma unroll
        for (int ai = 0; ai < 2; ++ai)
#pragma unroll
            for (int m = 0; m < 4; ++m) { const size_t rowoff = (size_t)(row0 + ai * HALF + m * 16) * 512;
#pragma unroll
                for (int bj = 0; bj < 2; ++bj)
#pragma unroll
                    for (int n = 0; n < 2; ++n) { const int c = colb + bj * HALF + n * 16; f32x4 v = acc[ai][bj][m][n];
                        if (sel == 0) { const f32x4 bv = *(const f32x4*)(w0 + c); *(f32x4*)(lrw + rowoff + c) = v + bv; }
                        else if (sel == 1) { const f32x4 bv = *(const f32x4*)(a0 + c); v = v + bv; uint2 o; o.x = pk2(v[0], v[1]); o.y = pk2(v[2], v[3]); *(uint2*)(lra + rowoff + c) = o; }
                        else { uint2 o; o.x = pk2(v[0], v[1]); o.y = pk2(v[2], v[3]); *(uint2*)(lrg + rowoff + c) = o; } } }
    }
};
}

template <int NG>
__device__ __forceinline__ void gates_phase(const float* X, const float* __restrict__ W, int ldw, int c0, float* __restrict__ out, int bid, int nblk, float* wg  ) {
    for (int i = opaque_tid(); i < NG * 1024; i += NTHR) { const int k = i / NG, g = i % NG; wg[g * 1024 + k] = W[(size_t)k * ldw + c0 + g]; }
    __syncthreads();
    const int lane = opaque_tid() & 63, wv = opaque_tid() >> 6;
    for (int t = bid * 8 + wv; t < T_TOK; t += nblk * 8) {
        float x[16];
#pragma unroll
        for (int j = 0; j < 16; ++j) x[j] = X[(size_t)t * 1024 + lane + 64 * j];
#pragma unroll 1
        for (int g = 0; g < NG; ++g) { float p = 0.f;
#pragma unroll
            for (int j = 0; j < 16; ++j) p += x[j] * wg[g * 1024 + lane + 64 * j];
            p = wave_sum(p); if (lane == 0) out[(size_t)t * 16 + g] = p; }
    }
    __syncthreads();
}
__device__ __forceinline__ void rwkv_prep_phase(const bf16_t* __restrict__ P0, const float* __restrict__ mu, bf16_t* __restrict__ App, int bid, int nblk) {
    for (size_t i = (size_t)bid * NTHR + opaque_tid(); i < (size_t)T_TOK * 256; i += (size_t)nblk * NTHR) {
        const int t = (int)(i >> 8), c = (int)(i & 255), col = 1536 + c;
        const float cur = bf2f(P0[(size_t)t * L0_MAIN + col]); const float prev = (t % SEQ) ? bf2f(P0[(size_t)(t - 1) * L0_MAIN + col]) : 0.f;
        float v = cur + (prev - cur) * mu[col];
        if (c < 64) v = tanhf(v); else if (c >= 128) v = sigmoid_f(v);
        App[i] = (bf16_t)f2bf(v); }
}
__device__ __forceinline__ void ln_phase(const float* xin, const float* mix, const float* g, const float* b, float* xout, bf16_t* xb, int bid, int nblk) {
    const int lane = opaque_tid() & 63, wv = opaque_tid() >> 6;
    for (int t = bid * 8 + wv; t < T_TOK; t += nblk * 8) {
        float4 y[4]; float s = 0.f;
#pragma unroll
        for (int j = 0; j < 4; ++j) { const float4 a = *(const float4*)(xin + (size_t)t * 1024 + 4 * lane + 256 * j), m = *(const float4*)(mix + (size_t)t * 1024 + 4 * lane + 256 * j);
            y[j].x = DN_ALPHA * a.x + m.x; y[j].y = DN_ALPHA * a.y + m.y; y[j].z = DN_ALPHA * a.z + m.z; y[j].w = DN_ALPHA * a.w + m.w; s += (y[j].x + y[j].y) + (y[j].z + y[j].w); }
        const float mean = wave_sum(s) * (1.f / 1024.f); float q = 0.f;
#pragma unroll
        for (int j = 0; j < 4; ++j) { y[j].x -= mean; y[j].y -= mean; y[j].z -= mean; y[j].w -= mean; q += (y[j].x * y[j].x + y[j].y * y[j].y) + (y[j].z * y[j].z + y[j].w * y[j].w); }
        const float rstd = rsqrtf(wave_sum(q) * (1.f / 1024.f) + LN_EPS);
#pragma unroll
        for (int j = 0; j < 4; ++j) { const float4 gg = *(const float4*)(g + 4 * lane + 256 * j), bb = *(const float4*)(b + 4 * lane + 256 * j);
            float4 o; o.x = y[j].x * rstd * gg.x + bb.x; o.y = y[j].y * rstd * gg.y + bb.y; o.z = y[j].z * rstd * gg.z + bb.z; o.w = y[j].w * rstd * gg.w + bb.w;
            *(float4*)(xout + (size_t)t * 1024 + 4 * lane + 256 * j) = o; uint2 w; w.x = pk2(o.x, o.y); w.y = pk2(o.z, o.w); *(uint2*)(xb + (size_t)t * 1024 + 4 * lane + 256 * j) = w; }
    }
}
__device__ __forceinline__ void fox_cumsum_phase(const float* __restrict__ gates, const float* __restrict__ f_b, float* __restrict__ cum, int bid, int nblk) {
    const int lane = opaque_tid() & 63, wv = opaque_tid() >> 6;
    for (int bh = bid * 8 + wv; bh < 128; bh += nblk * 8) {
        const int b = bh >> 4, h = bh & 15; const float fb = f_b[h];
        float lf[32]; double run = 0.0;
#pragma unroll
        for (int j = 0; j < 32; ++j) { const int s = lane * 32 + j; lf[j] = log_sigmoid_f(gates[((size_t)b * SEQ + s) * 16 + h] + fb); run += (double)lf[j]; }
        double incl = run;
#pragma unroll
        for (int o = 1; o < 64; o <<= 1) { const double v = __shfl_up(incl, o); if (lane >= o) incl += v; }
        double acc = incl - run;
#pragma unroll
        for (int j = 0; j < 32; ++j) { acc += (double)lf[j]; cum[(size_t)bh * SEQ + lane * 32 + j] = (float)acc; }
    }
}

__device__ __forceinline__ void fox_qknorm_phase(bf16_t* P1, const float* __restrict__ qn_g, const float* __restrict__ kn_g, int bid, int nblk) {
    const int tid = opaque_tid(); const int lane = tid & 63, wv = tid >> 6;
    for (int t = bid * 8 + wv; t < T_TOK; t += nblk * 8) {
#pragma unroll
        for (int which = 0; which < 2; ++which) {
            bf16_t* p = P1 + (size_t)t * L1_MAIN + which * 1024 + lane * 16; const float* g = (which ? kn_g : qn_g) + lane * 16;
            float f[16]; unpack8(*(const uint4*)p, f); unpack8(*(const uint4*)(p + 8), f + 8);
            float ss = 0.f;
#pragma unroll
            for (int j = 0; j < 16; ++j) ss += f[j] * f[j];
            ss += __shfl_xor(ss, 1); ss += __shfl_xor(ss, 2);
            const float r = rsqrtf(ss * (1.f / 64.f) + 1e-6f) * (which ? 1.0f : 0.125f * 1.4426950408889634f);
#pragma unroll
            for (int j = 0; j < 16; ++j) f[j] = f[j] * r * g[j];
            uint4 w0, w1; w0.x = pk2(f[0], f[1]); w0.y = pk2(f[2], f[3]); w0.z = pk2(f[4], f[5]); w0.w = pk2(f[6], f[7]); w1.x = pk2(f[8], f[9]); w1.y = pk2(f[10], f[11]); w1.z = pk2(f[12], f[13]); w1.w = pk2(f[14], f[15]);
            *(uint4*)p = w0; *(uint4*)(p + 8) = w1; }
    }
}

struct RwkvArgs { const bf16_t* P0; const float* lrw; const bf16_t* lra; const bf16_t* lrg; const float* mu; const float* k_k; const float* k_a; const float* r_k; const float* ln_g; const float* ln_b; bf16_t* ycat; };
constexpr int RW_CS = 32;
constexpr int RW_LDS_BYTES = 8 * RW_CS * 64 * 4;

#define RW_LOAD_RAW(chunk) do { const int sg_ = (chunk) * RW_CS + ls; const size_t row_ = tok0 + sg_; \
    const bf16_t* pc_ = A.P0 + row_ * L0_MAIN + hc; \
    rc = *(const uint2*)(pc_); kc = *(const uint2*)(pc_ + 512); vc = *(const uint2*)(pc_ + 1024); \
    if (sg_ > 0) { const bf16_t* pp_ = pc_ - L0_MAIN; rp = *(const uint2*)(pp_); kp = *(const uint2*)(pp_ + 512); vp = *(const uint2*)(pp_ + 1024); } \
    else { rp = make_uint2(0u, 0u); kp = rp; vp = rp; } \
    rwl = *(const float4*)(A.lrw + row_ * 512 + hc); ra = *(const uint2*)(A.lra + row_ * 512 + hc); rg = *(const uint2*)(A.lrg + row_ * 512 + hc); } while (0)

__device__ __forceinline__ void rwkv_scan_unit(const RwkvArgs& A, int bh, float* smem) {
    const int tid = opaque_tid(); const int b = bh >> 3, h = bh & 7;
    float* sr = smem; float* sw = sr + 2048; float* sk = sw + 2048; float* skk = sk + 2048; float* snb = skk + 2048; float* sv = snb + 2048; float* sg = sv + 2048; float* sy = sg + 2048;
    const int ls = tid >> 4, lc = (tid & 15) * 4; const int hc = h * 64 + lc;
    float c_mur[4], c_muk[4], c_muv[4], c_kk[4], c_ka[4], c_rk[4], c_lng[4], c_lnb[4];
#pragma unroll
    for (int j = 0; j < 4; ++j) { c_mur[j] = A.mu[hc + j]; c_muk[j] = A.mu[512 + hc + j]; c_muv[j] = A.mu[1024 + hc + j]; c_kk[j] = A.k_k[hc + j]; c_ka[j] = A.k_a[hc + j];
        c_rk[j] = A.r_k[hc + j]; c_lng[j] = A.ln_g[hc + j]; c_lnb[j] = A.ln_b[hc + j]; }
    const int srow = tid >> 3, sq = (tid & 7) * 8;
    float S[8];
#pragma unroll
    for (int j = 0; j < 8; ++j) S[j] = 0.f;
    const size_t tok0 = (size_t)b * SEQ;
    uint2 rc, kc, vc, rp, kp, vp, ra, rg; float4 rwl;
    RW_LOAD_RAW(0);
    for (int chunk = 0; chunk < SEQ / RW_CS; ++chunk) {
        {
            float frc[4], fkc[4], fvc[4], frp[4], fkp[4], fvp[4], fa[4], fg[4];
            unpack4(rc, frc); unpack4(kc, fkc); unpack4(vc, fvc); unpack4(rp, frp); unpack4(kp, fkp); unpack4(vp, fvp); unpack4(ra, fa); unpack4(rg, fg);
            const float zw[4] = {rwl.x, rwl.y, rwl.z, rwl.w};
            float r_l[4], k_l[4], v_l[4], w_[4], a_[4], kkr[4]; float ss = 0.f;
#pragma unroll
            for (int j = 0; j < 4; ++j) {
                r_l[j] = frc[j] + (frp[j] - frc[j]) * c_mur[j]; k_l[j] = fkc[j] + (fkp[j] - fkc[j]) * c_muk[j]; v_l[j] = fvc[j] + (fvp[j] - fvc[j]) * c_muv[j];
                const float sig = sigmoid_f(zw[j]); w_[j] = __expf(-0.6065306597126334f * sig); a_[j] = sigmoid_f(fa[j]);
                kkr[j] = k_l[j] * c_kk[j]; ss += kkr[j] * kkr[j]; }
            ss += __shfl_xor(ss, 1); ss += __shfl_xor(ss, 2); ss += __shfl_xor(ss, 4); ss += __shfl_xor(ss, 8);
            const float inv = 1.0f / fmaxf(sqrtf(ss), 1e-12f);
            const int o = ls * 64 + lc;
#pragma unroll
            for (int j = 0; j < 4; ++j) { const float kk = kkr[j] * inv;
                sr[o + j] = r_l[j]; sw[o + j] = w_[j]; sk[o + j] = k_l[j] * (1.0f + (a_[j] - 1.0f) * c_ka[j]); skk[o + j] = kk; snb[o + j] = -kk * a_[j]; sv[o + j] = v_l[j]; sg[o + j] = fg[j]; }
        }
        __syncthreads();
        if (chunk + 1 < SEQ / RW_CS) RW_LOAD_RAW(chunk + 1);
        for (int s = 0; s < RW_CS; ++s) {
            const float4 kk0 = *(const float4*)(skk + s * 64 + sq), kk1 = *(const float4*)(skk + s * 64 + sq + 4);
            const float4 w0 = *(const float4*)(sw + s * 64 + sq), w1 = *(const float4*)(sw + s * 64 + sq + 4);
            const float4 nb0 = *(const float4*)(snb + s * 64 + sq), nb1 = *(const float4*)(snb + s * 64 + sq + 4);
            const float4 k0 = *(const float4*)(sk + s * 64 + sq), k1 = *(const float4*)(sk + s * 64 + sq + 4);
            const float4 r0 = *(const float4*)(sr + s * 64 + sq), r1 = *(const float4*)(sr + s * 64 + sq + 4);
            const float vv = sv[s * 64 + srow];
            float sa = (S[0] * kk0.x + S[1] * kk0.y) + (S[2] * kk0.z + S[3] * kk0.w) + (S[4] * kk1.x + S[5] * kk1.y) + (S[6] * kk1.z + S[7] * kk1.w);
            sa += __shfl_xor(sa, 1); sa += __shfl_xor(sa, 2); sa += __shfl_xor(sa, 4);
            S[0] = S[0] * w0.x + sa * nb0.x + vv * k0.x; S[1] = S[1] * w0.y + sa * nb0.y + vv * k0.y; S[2] = S[2] * w0.z + sa * nb0.z + vv * k0.z; S[3] = S[3] * w0.w + sa * nb0.w + vv * k0.w;
            S[4] = S[4] * w1.x + sa * nb1.x + vv * k1.x; S[5] = S[5] * w1.y + sa * nb1.y + vv * k1.y; S[6] = S[6] * w1.z + sa * nb1.z + vv * k1.z; S[7] = S[7] * w1.w + sa * nb1.w + vv * k1.w;
            float y = (S[0] * r0.x + S[1] * r0.y) + (S[2] * r0.z + S[3] * r0.w) + (S[4] * r1.x + S[5] * r1.y) + (S[6] * r1.z + S[7] * r1.w);
            y += __shfl_xor(y, 1); y += __shfl_xor(y, 2); y += __shfl_xor(y, 4);
            if ((tid & 7) == 0) sy[s * 64 + srow] = y;
        }
        __syncthreads();
        {
            const int o = ls * 64 + lc; float y4[4]; float s1 = 0.f, bp = 0.f;
#pragma unroll
            for (int j = 0; j < 4; ++j) { y4[j] = sy[o + j]; s1 += y4[j]; bp += sr[o + j] * sk[o + j] * c_rk[j]; }
            s1 += __shfl_xor(s1, 1); s1 += __shfl_xor(s1, 2); s1 += __shfl_xor(s1, 4); s1 += __shfl_xor(s1, 8);
            bp += __shfl_xor(bp, 1); bp += __shfl_xor(bp, 2); bp += __shfl_xor(bp, 4); bp += __shfl_xor(bp, 8);
            const float mean = s1 * (1.f / 64.f); float q = 0.f;
#pragma unroll
            for (int j = 0; j < 4; ++j) { y4[j] -= mean; q += y4[j] * y4[j]; }
            q += __shfl_xor(q, 1); q += __shfl_xor(q, 2); q += __shfl_xor(q, 4); q += __shfl_xor(q, 8);
            const float rstd = rsqrtf(q * (1.f / 64.f) + 64.0f * 1e-5f);
            float ov[4];
#pragma unroll
            for (int j = 0; j < 4; ++j) ov[j] = (y4[j] * rstd * c_lng[j] + c_lnb[j] + bp * sv[o + j]) * sg[o + j];
            uint2 w; w.x = pk2(ov[0], ov[1]); w.y = pk2(ov[2], ov[3]);
            *(uint2*)(A.ycat + (tok0 + (size_t)chunk * RW_CS + ls) * 1024 + hc) = w;
        }
        __syncthreads();
    }
}
struct MlstmArgs { const bf16_t* P0; const float* gates; const float* conv_w; const float* conv_b; const float* ig_b; const float* fg_b; const float* hn_g; const float* hn_b; bf16_t* ycat; };
constexpr int ML_QS = 132;
constexpr int ML_LDS_FLOATS = 64 * ML_QS + 64 * 128 + 64 * 64 + 64 * 65 + 64 * ML_QS + 4 * 8 * 128 + 64 * 10 + 512 + 128;
constexpr int ML_LDS_BYTES = ML_LDS_FLOATS * 4;

__device__ __forceinline__ void mlstm_unit(const MlstmArgs& A, int bh, float* smem) {
    float* qs = smem; float* ks = qs + 64 * ML_QS; bf16_t* vsb = (bf16_t*)(ks + 64 * 128); float* sc = ks + 64 * 128 + 64 * 64; float* hs = sc + 64 * 65; float* red = hs + 64 * ML_QS;
    float* sig = red + 4 * 8 * 128; float* slf = sig + 64; float* sb = slf + 64; float* smt = sb + 64; float* scarry = smt + 64; float* sden = scarry + 64; float* sws = sden + 64;
    float* smean = sws + 64; float* srstd = smean + 64; float* spad = srstd + 64; float* sdenp = spad + 64;   float* sn = sdenp + 512;
    const int tid = opaque_tid(); const int v = tid & 127, part = tid >> 7; const int b = bh >> 2, h = bh & 3;
    const size_t tok0 = (size_t)b * SEQ;
    const int cq = h * 128 + v;
    float wq[4], wk[4];
#pragma unroll
    for (int j = 0; j < 4; ++j) { wq[j] = A.conv_w[j * 1024 + cq]; wk[j] = A.conv_w[j * 1024 + 512 + cq]; }
    const float bq = A.conv_b[cq], bk = A.conv_b[512 + cq];
    const float igb = A.ig_b[h], fgb = A.fg_b[h];
    const float hng = A.hn_g[cq], hnb = A.hn_b[cq];
    float zq1 = 0.f, zq2 = 0.f, zq3 = 0.f, zk1 = 0.f, zk2 = 0.f, zk3 = 0.f;
    float C[32];
#pragma unroll
    for (int k = 0; k < 32; ++k) C[k] = 0.f;
    if (tid < 128) sn[tid] = 0.f;
    float m_run = 0.f;
    for (int chunk = 0; chunk < SEQ / 64; ++chunk) {
        const size_t row0 = tok0 + (size_t)chunk * 64;
        if (part == 0) {
            for (int t = 0; t < 64; ++t) { const bf16_t* pr = A.P0 + (row0 + t) * L0_MAIN;
                const float zq = bf2f(pr[1792 + cq]), zk = bf2f(pr[2304 + cq]);
                const float cvq = wq[3] * zq + wq[2] * zq1 + wq[1] * zq2 + wq[0] * zq3 + bq; const float cvk = wk[3] * zk + wk[2] * zk1 + wk[1] * zk2 + wk[0] * zk3 + bk;
                zq3 = zq2; zq2 = zq1; zq1 = zq; zk3 = zk2; zk2 = zk1; zk1 = zk;
                qs[t * ML_QS + v] = cvq * sigmoid_f(cvq) * 0.08838834764831845f; ks[t * 128 + v] = cvk * sigmoid_f(cvk); vsb[t * 128 + v] = pr[2816 + cq]; }
            if (tid < 64) { const float* gr = A.gates + (row0 + tid) * 16; sig[tid] = gr[h] + igb; slf[tid] = log_sigmoid_f(gr[4 + h] + fgb); }
        }
        __syncthreads();
        if (tid < 64) { float bsum = 0.f; for (int s = 0; s <= tid; ++s) bsum += slf[s]; sb[tid] = bsum; }
        __syncthreads();
        const float b_last = sb[63];
        float gmax = -INFINITY; for (int s = 0; s < 64; ++s) gmax = fmaxf(gmax, b_last - sb[s] + sig[s]);
        const float m_new = fmaxf(b_last + m_run, gmax); const float keep = __expf(b_last + m_run - m_new);
        if (tid < 64) { const float bt = sb[tid]; float mx = -INFINITY; for (int s = 0; s <= tid; ++s) mx = fmaxf(mx, bt - sb[s] + sig[s]);
            const float mt = fmaxf(bt + m_run, mx); smt[tid] = mt; scarry[tid] = __expf(bt + m_run - mt); sws[tid] = __expf(b_last - bt + sig[tid] - m_new); }
        __syncthreads();
        { const int t = tid & 63, sh = tid >> 6; const float bt = sb[t], mt = smt[t]; float dsum = 0.f;
            for (int s = sh * 8; s < sh * 8 + 8; ++s) { float val = 0.f;
                if (s <= t) { float dot = 0.f;
#pragma unroll 8
                    for (int k = 0; k < 128; k += 4) { const float4 qa = *(const float4*)(qs + t * ML_QS + k), kb = *(const float4*)(ks + s * 128 + k); dot += (qa.x * kb.x + qa.y * kb.y) + (qa.z * kb.z + qa.w * kb.w); }
                    val = dot * __expf(bt - sb[s] + sig[s] - mt); }
                sc[t * 65 + s] = val; dsum += val; }
            sdenp[sh * 64 + t] = dsum; }
        __syncthreads();
        if (tid < 64) { float qn = 0.f; for (int k = 0; k < 128; ++k) qn += qs[tid * ML_QS + k] * sn[k];
            float den = scarry[tid] * qn;
#pragma unroll
            for (int p = 0; p < 8; ++p) den += sdenp[p * 64 + tid];
            sden[tid] = fmaxf(fabsf(den), __expf(-smt[tid])); }
        __syncthreads();
        for (int batch = 0; batch < 8; ++batch) {
#pragma unroll 2
            for (int tt = 0; tt < 8; ++tt) { const int t = batch * 8 + tt; float qc = 0.f;
#pragma unroll
                for (int k = 0; k < 32; k += 4) { const float4 qa = *(const float4*)(qs + t * ML_QS + part * 32 + k); qc += (qa.x * C[k] + qa.y * C[k + 1]) + (qa.z * C[k + 2] + qa.w * C[k + 3]); }
                red[(part * 8 + tt) * 128 + v] = qc; }
            __syncthreads();
#pragma unroll
            for (int j = 0; j < 2; ++j) { const int tt = part * 2 + j, t = batch * 8 + tt;
                const float qc = (red[(0 * 8 + tt) * 128 + v] + red[(1 * 8 + tt) * 128 + v]) + (red[(2 * 8 + tt) * 128 + v] + red[(3 * 8 + tt) * 128 + v]);
                float acc = 0.f; for (int s = 0; s <= t; ++s) acc += sc[t * 65 + s] * bf2f(vsb[s * 128 + v]);
                hs[t * ML_QS + v] = (acc + scarry[t] * qc) / sden[t]; }
            __syncthreads();
        }
        { const int t = tid >> 3, oc = tid & 7; float s1 = 0.f;
#pragma unroll
            for (int k = 0; k < 16; ++k) s1 += hs[t * ML_QS + oc * 16 + k];
            s1 += __shfl_xor(s1, 1); s1 += __shfl_xor(s1, 2); s1 += __shfl_xor(s1, 4); const float mean = s1 * (1.f / 128.f); float q = 0.f;
#pragma unroll
            for (int k = 0; k < 16; ++k) { const float d = hs[t * ML_QS + oc * 16 + k] - mean; q += d * d; }
            q += __shfl_xor(q, 1); q += __shfl_xor(q, 2); q += __shfl_xor(q, 4); if (oc == 0) { smean[t] = mean; srstd[t] = rsqrtf(q * (1.f / 128.f) + LN_EPS); } }
        __syncthreads();
        for (int t = part * 16; t < part * 16 + 16; ++t) { const float hn = (hs[t * ML_QS + v] - smean[t]) * srstd[t] * hng + hnb; const float og = bf2f(A.P0[(row0 + t) * L0_MAIN + 3328 + cq]);
            A.ycat[(row0 + t) * 1024 + 512 + cq] = (bf16_t)f2bf(hn * sigmoid_f(og)); }
#pragma unroll
        for (int k = 0; k < 32; ++k) C[k] *= keep;
        for (int s = 0; s < 64; ++s) { const float wv = sws[s] * bf2f(vsb[s * 128 + v]);
#pragma unroll
            for (int k = 0; k < 32; k += 4) { const float4 kb = *(const float4*)(ks + s * 128 + part * 32 + k); C[k] += kb.x * wv; C[k + 1] += kb.y * wv; C[k + 2] += kb.z * wv; C[k + 3] += kb.w * wv; } }
        if (tid < 128) { float nn = keep * sn[tid]; for (int s = 0; s < 64; ++s) nn += sws[s] * ks[s * 128 + tid]; sn[tid] = nn; }
        m_run = m_new;
        __syncthreads();
    }
}

struct AttnArgs { const bf16_t* P1; const float* cum; const float* qn_g; const float* kn_g; bf16_t* out; };
constexpr int AT_LDS_BYTES = (2 * 32 * 64 + 32) * 4;
__device__ __forceinline__ void attn_unit_valu(const AttnArgs& A, int bh, int qb, float* smem) {
    float* Ks = smem; float* Vs = Ks + 2048; float* cj = Vs + 2048;
    const int tid = opaque_tid(); const int b = bh >> 4, h = bh & 15; const int hf = tid & 1; const int i = qb * 256 + (tid >> 1); const size_t row = (size_t)b * SEQ + i;
    float q[32], o[32];
    { float ss = 0.f;
#pragma unroll
        for (int c = 0; c < 4; ++c) { const uint4 w = *(const uint4*)(A.P1 + row * L1_MAIN + h * 64 + hf * 32 + c * 8); unpack8(w, q + c * 8); }
#pragma unroll
        for (int d = 0; d < 32; ++d) ss += q[d] * q[d];
        ss += __shfl_xor(ss, 1);
        const float r = rsqrtf(ss * (1.f / 64.f) + 1e-6f) * 0.125f;
#pragma unroll
        for (int d = 0; d < 32; ++d) { q[d] = q[d] * r * A.qn_g[h * 64 + hf * 32 + d]; o[d] = 0.f; } }
    const float ci = A.cum[(size_t)bh * SEQ + i];
    float m = -INFINITY, l = 0.f;
    const int ntiles = (qb * 256 + 256) / 32;
    const int lkey = tid >> 4, ld4 = (tid & 15) * 4;
    float kg[4];
#pragma unroll
    for (int j = 0; j < 4; ++j) kg[j] = A.kn_g[h * 64 + ld4 + j];
    for (int kt = 0; kt < ntiles; ++kt) {
        { const size_t krow = (size_t)b * SEQ + kt * 32 + lkey; float fk[4], fv[4];
            unpack4(*(const uint2*)(A.P1 + krow * L1_MAIN + 1024 + h * 64 + ld4), fk); unpack4(*(const uint2*)(A.P1 + krow * L1_MAIN + 2048 + h * 64 + ld4), fv);
            float ss = (fk[0] * fk[0] + fk[1] * fk[1]) + (fk[2] * fk[2] + fk[3] * fk[3]);
            ss += __shfl_xor(ss, 1); ss += __shfl_xor(ss, 2); ss += __shfl_xor(ss, 4); ss += __shfl_xor(ss, 8);
            const float r = rsqrtf(ss * (1.f / 64.f) + 1e-6f);
#pragma unroll
            for (int j = 0; j < 4; ++j) { Ks[lkey * 64 + ld4 + j] = fk[j] * r * kg[j]; Vs[lkey * 64 + ld4 + j] = fv[j]; }
            if ((tid & 15) == 0) cj[lkey] = A.cum[(size_t)bh * SEQ + kt * 32 + lkey]; }
        __syncthreads();
#pragma unroll 1
        for (int sub = 0; sub < 8; ++sub) {
            float s[4]; float mx = -INFINITY;
#pragma unroll
            for (int jj = 0; jj < 4; ++jj) { const int j = sub * 4 + jj; float dot = 0.f;
#pragma unroll
                for (int d = 0; d < 32; d += 4) { const float4 kv = *(const float4*)(Ks + j * 64 + hf * 32 + d); dot += (q[d] * kv.x + q[d + 1] * kv.y) + (q[d + 2] * kv.z + q[d + 3] * kv.w); }
                dot += __shfl_xor(dot, 1);
                float sv_ = dot + ci - cj[j]; if (kt * 32 + j > i) sv_ = -INFINITY; s[jj] = sv_; mx = fmaxf(mx, sv_); }
            const float mnew = fmaxf(m, mx); const float scl = __expf(m - mnew); float psum = 0.f;
#pragma unroll
            for (int jj = 0; jj < 4; ++jj) { s[jj] = __expf(s[jj] - mnew); psum += s[jj]; }
            l = l * scl + psum; m = mnew;
#pragma unroll
            for (int d = 0; d < 32; ++d) o[d] *= scl;
#pragma unroll
            for (int jj = 0; jj < 4; ++jj) { const int j = sub * 4 + jj; const float p = s[jj];
#pragma unroll
                for (int d = 0; d < 32; d += 4) { const float4 vv = *(const float4*)(Vs + j * 64 + hf * 32 + d); o[d] += p * vv.x; o[d + 1] += p * vv.y; o[d + 2] += p * vv.z; o[d + 3] += p * vv.w; } }
        }
        __syncthreads();
    }
    const float il = 1.0f / l;
#pragma unroll
    for (int c = 0; c < 4; ++c) { float og[8]; unpack8(*(const uint4*)(A.P1 + row * L1_MAIN + 3072 + h * 64 + hf * 32 + c * 8), og);
        uint4 w; w.x = pk2(o[c * 8 + 0] * il * sigmoid_f(og[0]), o[c * 8 + 1] * il * sigmoid_f(og[1])); w.y = pk2(o[c * 8 + 2] * il * sigmoid_f(og[2]), o[c * 8 + 3] * il * sigmoid_f(og[3]));
        w.z = pk2(o[c * 8 + 4] * il * sigmoid_f(og[4]), o[c * 8 + 5] * il * sigmoid_f(og[5])); w.w = pk2(o[c * 8 + 6] * il * sigmoid_f(og[6]), o[c * 8 + 7] * il * sigmoid_f(og[7]));
        *(uint4*)(A.out + row * 1024 + h * 64 + hf * 32 + c * 8) = w; }
}
__device__ __forceinline__ void attn_valu_phase(const AttnArgs& A, int bid, int nblk, float* smem) {
    for (int su = bid; su < 256; su += nblk) { const int bh = su >> 1, pr = su & 1;
#pragma unroll 1
        for (int u = 0; u < 4; ++u) { const int qb = (u == 0) ? pr : (u == 1) ? 7 - pr : (u == 2) ? 2 + pr : 5 - pr; attn_unit_valu(A, bh, qb, smem); } }
}

struct PeerSArgs { const bf16_t* Q; const bf16_t* K1b; const bf16_t* K2b; int* eid; float* gate; };
constexpr int PS_QT = 0, PS_KB = 64 * 528, PS_KB2 = PS_KB + 128 * 272, PS_L1 = PS_KB + 2 * 128 * 272, PS_L2 = PS_L1 + 4096, PS_LDS_BYTES = PS_L2 + 4096;
__device__ __forceinline__ unsigned ord_f(float f) { const unsigned b = __float_as_uint(f); return b ^ ((b >> 31) ? 0xFFFFFFFFu : 0x80000000u); }
__device__ __forceinline__ float unord_f(unsigned u) { const unsigned b = (u & 0x80000000u) ? (u ^ 0x80000000u) : ~u; return __uint_as_float(b); }
#define TOPK_INSERT(L, x) do { unsigned x_ = (x); _Pragma("unroll") for (int q_ = 0; q_ < 16; ++q_) { const unsigned hi_ = max(L[q_], x_); x_ = min(L[q_], x_); L[q_] = hi_; } } while (0)

__device__ __forceinline__ void peer_scores_unit(const PeerSArgs& A, int tile, int h, unsigned char* smem) {
    const int tid = opaque_tid(), lane = tid & 63, wv = tid >> 6;
#pragma unroll
    for (int i = 0; i < 4; ++i) { const int idx = tid + 512 * i; const int row = idx >> 5, c = idx & 31;
        *(uint4*)(smem + PS_QT + row * 528 + c * 16) = *(const uint4*)(A.Q + (size_t)(tile * 64 + row) * 2048 + h * 256 + c * 8); }
#pragma unroll
    for (int i = 0; i < 4; ++i) { const int idx = tid + 512 * i; const int row = idx >> 4, c = idx & 15;
        *(uint4*)(smem + PS_KB + row * 272 + c * 16) = *(const uint4*)(A.K1b + (size_t)(h * 128 + row) * 128 + c * 8);
        *(uint4*)(smem + PS_KB2 + row * 272 + c * 16) = *(const uint4*)(A.K2b + (size_t)(h * 128 + row) * 128 + c * 8); }
    __syncthreads();
    const int half = wv >> 2, mt = wv & 3; const int fr = lane & 15, fq = lane >> 4;
    f32x4_t acc[8];
#pragma unroll
    for (int n = 0; n < 8; ++n) acc[n] = (f32x4_t){0.f, 0.f, 0.f, 0.f};
    { const unsigned char* qbase = smem + PS_QT + (16 * mt + fr) * 528 + (half * 128 + 8 * fq) * 2; const unsigned char* kbase = smem + (half ? PS_KB2 : PS_KB) + fr * 272 + (8 * fq) * 2;
#pragma unroll
        for (int ks = 0; ks < 4; ++ks) { const bf16x8_t qf = *(const bf16x8_t*)(qbase + ks * 64);
#pragma unroll
            for (int n = 0; n < 8; ++n) { const bf16x8_t kf = *(const bf16x8_t*)(kbase + n * 16 * 272 + ks * 64); acc[n] = __builtin_amdgcn_mfma_f32_16x16x32_bf16(kf, qf, acc[n], 0, 0, 0); } } }
    __syncthreads();
    { float* sT = (float*)(smem + PS_KB + half * 128 * 272);
#pragma unroll
        for (int n = 0; n < 8; ++n)
#pragma unroll
            for (int r = 0; r < 4; ++r) sT[(16 * n + 4 * fq + r) * 68 + 16 * mt + fr] = acc[n][r]; }
    __syncthreads();
    if (wv == 0 || wv == 4) { const float* sT = (const float*)(smem + PS_KB + half * 128 * 272); unsigned L[16];
#pragma unroll
        for (int j = 0; j < 16; ++j) L[j] = 0u;
        for (int key = 0; key < 128; ++key) { const unsigned u = (ord_f(sT[key * 68 + lane]) & ~0x7Fu) | (unsigned)(127 - key); TOPK_INSERT(L, u); }
        unsigned* lst = (unsigned*)(smem + (half ? PS_L2 : PS_L1));
#pragma unroll
        for (int j = 0; j < 16; ++j) lst[j * 64 + lane] = L[j]; }
    __syncthreads();
    if (wv == 0) { const unsigned* l1 = (const unsigned*)(smem + PS_L1); const unsigned* l2 = (const unsigned*)(smem + PS_L2);
        float v1[16], v2[16];
#pragma unroll
        for (int j = 0; j < 16; ++j) { v1[j] = unord_f(l1[j * 64 + lane]); v2[j] = unord_f(l2[j * 64 + lane]); }
        unsigned L[16];
#pragma unroll
        for (int j = 0; j < 16; ++j) L[j] = 0u;
#pragma unroll
        for (int i = 0; i < 16; ++i)
#pragma unroll
            for (int j = 0; j < 16; ++j) if ((i + 1) * (j + 1) <= 16) { const unsigned u = (ord_f(v1[i] + v2[j]) & ~0xFFu) | (unsigned)(255 - (i * 16 + j)); TOPK_INSERT(L, u); }
        float e[16]; float sum = 0.f; const float mx = unord_f(L[0]);
#pragma unroll
        for (int k = 0; k < 16; ++k) { e[k] = __expf(unord_f(L[k]) - mx); sum += e[k]; }
        const float inv = 1.0f / sum; const size_t ob = (size_t)(tile * 64 + lane) * 128 + h * 16;
#pragma unroll
        for (int k = 0; k < 16; ++k) { const int idx = 255 - (int)(L[k] & 0xFFu); const int i = idx >> 4, j = idx & 15;
            const int e1 = 127 - (int)(l1[i * 64 + lane] & 0x7Fu), e2 = 127 - (int)(l2[j * 64 + lane] & 0x7Fu);
            A.eid[ob + k] = e1 * 128 + e2; A.gate[ob + k] = e[k] * inv; } }
    __syncthreads();
}
__device__ __forceinline__ void peer_scores_phase(const PeerSArgs& A, int bid, int nblk, unsigned char* smem) {
    for (int u = bid; u < 256 * 8; u += nblk) peer_scores_unit(A, u >> 3, u & 7, smem);
}

typedef float f32x2_t __attribute__((ext_vector_type(2)));
__device__ __forceinline__ void cvt_fp8_rows_phase(const float* __restrict__ src, unsigned char* __restrict__ dst, float* __restrict__ inv_scale, int bid, int nblk) {
    const int tid = opaque_tid(); const int lane = tid & 63, wv = tid >> 6;
    for (int r = bid * 8 + wv; r < 16384; r += nblk * 8) {
        float f[16]; float mx = 0.f;
#pragma unroll
        for (int c = 0; c < 4; ++c) { const float4 v = *(const float4*)(src + (size_t)r * 1024 + 16 * lane + 4 * c); f[4 * c] = v.x; f[4 * c + 1] = v.y; f[4 * c + 2] = v.z; f[4 * c + 3] = v.w;
            mx = fmaxf(fmaxf(mx, fmaxf(fabsf(v.x), fabsf(v.y))), fmaxf(fabsf(v.z), fabsf(v.w))); }
#pragma unroll
        for (int o = 32; o >= 1; o >>= 1) mx = fmaxf(mx, __shfl_xor(mx, o));
        const float sc = (mx > 0.f) ? 240.0f / mx : 1.0f;
        unsigned w[4];
#pragma unroll
        for (int c = 0; c < 4; ++c) { int p = 0; p = __builtin_amdgcn_cvt_pk_fp8_f32(f[4 * c] * sc, f[4 * c + 1] * sc, p, false); p = __builtin_amdgcn_cvt_pk_fp8_f32(f[4 * c + 2] * sc, f[4 * c + 3] * sc, p, true); w[c] = (unsigned)p; }
        *(uint4*)(dst + (size_t)r * 1024 + 16 * lane) = make_uint4(w[0], w[1], w[2], w[3]);
        if (lane == 0) inv_scale[r] = (mx > 0.f) ? mx * (1.0f / 240.0f) : 1.0f;
    }
}
__device__ __forceinline__ void unpack_fp8x16(const uint4 w, float* f) {
    const unsigned ww[4] = {w.x, w.y, w.z, w.w};
#pragma unroll
    for (int c = 0; c < 4; ++c) { const f32x2_t lo = __builtin_amdgcn_cvt_pk_f32_fp8((int)ww[c], false), hi = __builtin_amdgcn_cvt_pk_f32_fp8((int)ww[c], true); f[4 * c] = lo[0]; f[4 * c + 1] = lo[1]; f[4 * c + 2] = hi[0]; f[4 * c + 3] = hi[1]; }
}
struct PeerGArgs { const float* X; float* Xo; const int* eid; const float* gate; const unsigned char* U; const unsigned char* V; const float* Us; const float* Vs; const float* lng; const float* lnb; bf16_t* xb; };
__device__ __forceinline__ void peer_gather_token(const PeerGArgs& A, int t, int lane) {
    float x[16];
#pragma unroll
    for (int c = 0; c < 4; ++c) { const float4 v = *(const float4*)(A.X + (size_t)t * 1024 + 16 * lane + 4 * c); x[4 * c] = v.x; x[4 * c + 1] = v.y; x[4 * c + 2] = v.z; x[4 * c + 3] = v.w; }
    const int e_lo = A.eid[(size_t)t * 128 + lane], e_hi = A.eid[(size_t)t * 128 + 64 + lane];
    const float g_lo = A.gate[(size_t)t * 128 + lane], g_hi = A.gate[(size_t)t * 128 + 64 + lane];
    const float us_lo = A.Us[e_lo], us_hi = A.Us[e_hi], vs_lo = A.Vs[e_lo], vs_hi = A.Vs[e_hi];
    float acc[16];
#pragma unroll
    for (int j = 0; j < 16; ++j) acc[j] = 0.f;
    for (int k0 = 0; k0 < 128; k0 += 8) {
        uint4 u[8], v[8]; float g[8], us[8];
#pragma unroll
        for (int i = 0; i < 8; ++i) { const int k = k0 + i; const int e = __shfl(k0 < 64 ? e_lo : e_hi, k & 63); g[i] = __shfl(k0 < 64 ? g_lo : g_hi, k & 63) * __shfl(k0 < 64 ? vs_lo : vs_hi, k & 63); us[i] = __shfl(k0 < 64 ? us_lo : us_hi, k & 63);
            u[i] = *(const uint4*)(A.U + (size_t)e * 1024 + 16 * lane); v[i] = *(const uint4*)(A.V + (size_t)e * 1024 + 16 * lane); }
#pragma unroll
        for (int i = 0; i < 8; ++i) { float f[16]; unpack_fp8x16(u[i], f); float dot = 0.f;
#pragma unroll
            for (int j = 0; j < 16; ++j) dot += x[j] * f[j];
            dot = wave_sum(dot) * us[i];
            const float c = g[i] * 0.5f * dot * (1.0f + erff(dot * 0.7071067811865476f));
            unpack_fp8x16(v[i], f);
#pragma unroll
            for (int j = 0; j < 16; ++j) acc[j] += c * f[j]; }
    }
    float s = 0.f;
#pragma unroll
    for (int j = 0; j < 16; ++j) { acc[j] += DN_ALPHA * x[j]; s += acc[j]; }
    const float mean = wave_sum(s) * (1.f / 1024.f); float q = 0.f;
#pragma unroll
    for (int j = 0; j < 16; ++j) { acc[j] -= mean; q += acc[j] * acc[j]; }
    const float rstd = rsqrtf(wave_sum(q) * (1.f / 1024.f) + LN_EPS);
    float ov[16];
#pragma unroll
    for (int c = 0; c < 4; ++c) { const float4 gg = *(const float4*)(A.lng + 16 * lane + 4 * c), bb = *(const float4*)(A.lnb + 16 * lane + 4 * c);
        ov[4 * c] = acc[4 * c] * rstd * gg.x + bb.x; ov[4 * c + 1] = acc[4 * c + 1] * rstd * gg.y + bb.y; ov[4 * c + 2] = acc[4 * c + 2] * rstd * gg.z + bb.z; ov[4 * c + 3] = acc[4 * c + 3] * rstd * gg.w + bb.w;
        *(float4*)(A.Xo + (size_t)t * 1024 + 16 * lane + 4 * c) = make_float4(ov[4 * c], ov[4 * c + 1], ov[4 * c + 2], ov[4 * c + 3]); }
    *(uint4*)(A.xb + (size_t)t * 1024 + 16 * lane) = make_uint4(pk2(ov[0], ov[1]), pk2(ov[2], ov[3]), pk2(ov[4], ov[5]), pk2(ov[6], ov[7]));
    *(uint4*)(A.xb + (size_t)t * 1024 + 16 * lane + 8) = make_uint4(pk2(ov[8], ov[9]), pk2(ov[10], ov[11]), pk2(ov[12], ov[13]), pk2(ov[14], ov[15]));
}
__device__ __forceinline__ void peer_gather_phase(const PeerGArgs& A, int bid, int nblk) {
    const int tid = opaque_tid(); const int lane = tid & 63, wv = tid >> 6;
    for (int t = bid * 8 + wv; t < T_TOK; t += nblk * 8) peer_gather_token(A, t, lane);
}

namespace mlm {
typedef __attribute__((address_space(3))) unsigned char lds_u8;
typedef short v4i16_t __attribute__((ext_vector_type(4)));
typedef unsigned u32x4_t __attribute__((ext_vector_type(4)));
typedef unsigned u32x2_t __attribute__((ext_vector_type(2)));
#define MLM_LDS(T, off) (*(__attribute__((address_space(3))) T*)(smem + (off)))
constexpr int RS = 136;
constexpr int OFF_QS = 0, OFF_KS = OFF_QS + 64 * RS * 2, OFF_VS = OFF_KS + 64 * RS * 2, OFF_OG = OFF_VS + 64 * RS * 2, OFF_CT = OFF_OG + 64 * RS * 2, OFF_SC = OFF_CT + 128 * RS * 2, OFF_F = OFF_SC + 64 * 72 * 2;
constexpr int F_SIG = 0, F_SLF = 64, F_SU = 128, F_SBM = 192, F_CARRY = 256, F_WS = 320, F_SEN = 384, F_SQN = 448, F_DENP = 512, F_STAT = 640, F_SN = 896, F_SCAL = 1024, F_CW = 1032, F_CB = 2056, F_HNG = 2312, F_HNB = 2440, F_END = 2568;
constexpr int LDS_BYTES = OFF_F + F_END * 4;
__device__ __forceinline__ bf16x8_t tr_frag(const lds_u8* p, int row_stride_bytes) {
    const v4i16_t lo = __builtin_amdgcn_ds_read_tr16_b64_v4i16((__attribute__((address_space(3))) v4i16_t*)p);
    const v4i16_t hi = __builtin_amdgcn_ds_read_tr16_b64_v4i16((__attribute__((address_space(3))) v4i16_t*)(p + 4 * row_stride_bytes));
    return (bf16x8_t){lo[0], lo[1], lo[2], lo[3], hi[0], hi[1], hi[2], hi[3]};
}
#define MLM_LOAD_RAW(chunk) do { const size_t r0_ = tok0 + (size_t)(chunk) * 64 + 2 * tp; const bf16_t* pb_ = A.P0 + r0_ * L0_MAIN + h * 128 + 8 * g; \
    _Pragma("unroll") for (int i_ = 0; i_ < 5; ++i_) { const int rr_ = (chunk) * 64 + 2 * tp - 3 + i_; \
        if (rr_ >= 0) { zq[i_] = *(const uint4*)(pb_ + (long)(i_ - 3) * L0_MAIN + 1792); zk[i_] = *(const uint4*)(pb_ + (long)(i_ - 3) * L0_MAIN + 2304); } else { zq[i_] = make_uint4(0u, 0u, 0u, 0u); zk[i_] = zq[i_]; } } \
    rv[0] = *(const uint4*)(pb_ + 2816); rv[1] = *(const uint4*)(pb_ + L0_MAIN + 2816); rog[0] = *(const uint4*)(pb_ + 3328); rog[1] = *(const uint4*)(pb_ + L0_MAIN + 3328); \
    if (tid < 64) { const float* gr_ = A.gates + (tok0 + (size_t)(chunk) * 64 + tid) * 16; rgi = gr_[h]; rgf = gr_[4 + h]; } } while (0)

__device__ __forceinline__ void mlstm_unit_mfma(const MlstmArgs& A, int bh, unsigned char* smem_g) {
    lds_u8* smem = (lds_u8*)smem_g;
    __attribute__((address_space(3))) float* F = (__attribute__((address_space(3))) float*)(smem + OFF_F);
    const int tid0 = opaque_tid(); const int b = bh >> 2, h = bh & 3;
    const size_t tok0 = (size_t)b * SEQ;
#define MLM_IDX() int tid = tid0; asm volatile("" : "+v"(tid)); const int lane = tid & 63, w = __builtin_amdgcn_readfirstlane(tid >> 6), fr = lane & 15, fq = lane >> 4; \
    const int g = tid & 15, tp = tid >> 4;   const int mt = w & 3, nh = w >> 2;   \
    (void)lane; (void)fr; (void)fq; (void)g; (void)tp; (void)mt; (void)nh
    {
    MLM_IDX();
    for (int i = tid; i < 1024; i += NTHR) { const int tap = i >> 8, c = i & 255; F[F_CW + i] = A.conv_w[tap * 1024 + (c < 128 ? h * 128 + c : 512 + h * 128 + (c - 128))]; }
    if (tid < 256) F[F_CB + tid] = A.conv_b[tid < 128 ? h * 128 + tid : 512 + h * 128 + (tid - 128)];
    for (int i = tid; i < 128 * RS / 2; i += NTHR) ((__attribute__((address_space(3))) unsigned*)(smem + OFF_CT))[i] = 0u;
    if (tid < 128) F[F_SN + tid] = 0.f;
    if (tid < 128) { F[F_HNG + tid] = A.hn_g[h * 128 + tid]; F[F_HNB + tid] = A.hn_b[h * 128 + tid]; }
    }
    const float igb = A.ig_b[h], fgb = A.fg_b[h];
    f32x4_t Cacc[8];
#pragma unroll
    for (int n = 0; n < 8; ++n) Cacc[n] = (f32x4_t){0.f, 0.f, 0.f, 0.f};
    float m_old = 0.f;
    uint4 zq[5], zk[5], rv[2], rog[2]; float rgi = 0.f, rgf = 0.f;
    { MLM_IDX(); MLM_LOAD_RAW(0); }
    __syncthreads();
    for (int chunk_ = 0; chunk_ < SEQ / 64; ++chunk_) {
        int chunk = chunk_; asm volatile("" : "+s"(chunk));
        MLM_IDX();
        const size_t row0 = tok0 + (size_t)chunk * 64;
        {
            float fz[5][8];
#pragma unroll
            for (int i = 0; i < 5; ++i) unpack8(zq[i], fz[i]);
#pragma unroll
            for (int r = 0; r < 2; ++r) { float o[8];
#pragma unroll
                for (int j = 0; j < 8; ++j) { const int c = 8 * g + j; float cv = F[F_CB + c];
#pragma unroll
                    for (int tap = 0; tap < 4; ++tap) cv += F[F_CW + tap * 256 + c] * fz[r + tap][j];
                    o[j] = cv * sigmoid_f(cv) * 0.08838834764831845f; }
                MLM_LDS(u32x4_t, OFF_QS + ((2 * tp + r) * RS + 8 * g) * 2) = (u32x4_t){pk2(o[0], o[1]), pk2(o[2], o[3]), pk2(o[4], o[5]), pk2(o[6], o[7])}; }
#pragma unroll
            for (int i = 0; i < 5; ++i) unpack8(zk[i], fz[i]);
#pragma unroll
            for (int r = 0; r < 2; ++r) { float o[8];
#pragma unroll
                for (int j = 0; j < 8; ++j) { const int c = 128 + 8 * g + j; float cv = F[F_CB + c];
#pragma unroll
                    for (int tap = 0; tap < 4; ++tap) cv += F[F_CW + tap * 256 + c] * fz[r + tap][j];
                    o[j] = cv * sigmoid_f(cv); }
                MLM_LDS(u32x4_t, OFF_KS + ((2 * tp + r) * RS + 8 * g) * 2) = (u32x4_t){pk2(o[0], o[1]), pk2(o[2], o[3]), pk2(o[4], o[5]), pk2(o[6], o[7])}; }
#pragma unroll
            for (int r = 0; r < 2; ++r) { MLM_LDS(u32x4_t, OFF_VS + ((2 * tp + r) * RS + 8 * g) * 2) = (u32x4_t){rv[r].x, rv[r].y, rv[r].z, rv[r].w};
                MLM_LDS(u32x4_t, OFF_OG + ((2 * tp + r) * RS + 8 * g) * 2) = (u32x4_t){rog[r].x, rog[r].y, rog[r].z, rog[r].w}; }
            if (tid < 64) { F[F_SIG + tid] = rgi + igb; F[F_SLF + tid] = log_sigmoid_f(rgf + fgb); }
        }
        __syncthreads();
        if (chunk + 1 < SEQ / 64) MLM_LOAD_RAW(chunk + 1);
        if (w == 0) {
            const float ig = F[F_SIG + lane], lf = F[F_SLF + lane];
            float bs = lf;
#pragma unroll
            for (int o = 1; o < 64; o <<= 1) { const float v = __shfl_up(bs, o); if (lane >= o) bs += v; }
            const float u = ig - bs; float pm = u;
#pragma unroll
            for (int o = 1; o < 64; o <<= 1) { const float v = __shfl_up(pm, o); if (lane >= o) pm = fmaxf(pm, v); }
            const float mtv = bs + fmaxf(m_old, pm);
            const float b_last = __shfl(bs, 63), pm_last = __shfl(pm, 63);
            const float m_new = fmaxf(b_last + m_old, b_last + pm_last);
            F[F_SU + lane] = u; F[F_SBM + lane] = bs - mtv; F[F_CARRY + lane] = __expf(bs + m_old - mtv); F[F_WS + lane] = __expf(b_last + u - m_new); F[F_SEN + lane] = __expf(-mtv);
            if (lane == 0) F[F_SCAL] = __expf(b_last + m_old - m_new);
            m_old = m_new;
        }
        bf16x8_t qf[4];
#pragma unroll
        for (int ks = 0; ks < 4; ++ks) qf[ks] = *(const __attribute__((address_space(3))) bf16x8_t*)(smem + OFF_QS + ((16 * mt + fr) * RS + 32 * ks + 8 * fq) * 2);
        f32x4_t sacc[2];
#pragma unroll
        for (int n2 = 0; n2 < 2; ++n2) { sacc[n2] = (f32x4_t){0.f, 0.f, 0.f, 0.f};
#pragma unroll
            for (int ks = 0; ks < 4; ++ks) { const bf16x8_t kf = *(const __attribute__((address_space(3))) bf16x8_t*)(smem + OFF_KS + ((16 * (2 * nh + n2) + fr) * RS + 32 * ks + 8 * fq) * 2);
                sacc[n2] = __builtin_amdgcn_mfma_f32_16x16x32_bf16(qf[ks], kf, sacc[n2], 0, 0, 0); } }
        { const int t = tid >> 3, p = tid & 7; float f16[16];
            { const u32x4_t a_ = MLM_LDS(u32x4_t, OFF_QS + (t * RS + 16 * p) * 2), b_ = MLM_LDS(u32x4_t, OFF_QS + (t * RS + 16 * p + 8) * 2);
              unpack8(make_uint4(a_[0], a_[1], a_[2], a_[3]), f16); unpack8(make_uint4(b_[0], b_[1], b_[2], b_[3]), f16 + 8); }
            float qn = 0.f;
#pragma unroll
            for (int k = 0; k < 16; ++k) qn += f16[k] * F[F_SN + 16 * p + k];
            qn += __shfl_xor(qn, 1); qn += __shfl_xor(qn, 2); qn += __shfl_xor(qn, 4); if (p == 0) F[F_SQN + t] = qn; }
        __syncthreads();
        {
            const f32x4_t bm = *(const __attribute__((address_space(3))) f32x4_t*)(F + F_SBM + 16 * mt + 4 * fq); float rs[4] = {0.f, 0.f, 0.f, 0.f};
#pragma unroll
            for (int n2 = 0; n2 < 2; ++n2) { const int s = 16 * (2 * nh + n2) + fr; const float us = F[F_SU + s];
#pragma unroll
                for (int r = 0; r < 4; ++r) { const int t = 16 * mt + 4 * fq + r; const float wgt = __expf(bm[r] + us); const float val = (s <= t) ? sacc[n2][r] * wgt : 0.f; rs[r] += val;
                    *(__attribute__((address_space(3))) bf16_t*)(smem + OFF_SC + (t * 72 + s) * 2) = (bf16_t)f2bf(val); } }
#pragma unroll
            for (int r = 0; r < 4; ++r) { float v = rs[r]; v += __shfl_xor(v, 1); v += __shfl_xor(v, 2); v += __shfl_xor(v, 4); v += __shfl_xor(v, 8); if (fr == 0) F[F_DENP + nh * 64 + 16 * mt + 4 * fq + r] = v; }
        }
        __syncthreads();
        f32x4_t nacc[4], qacc[4];
#pragma unroll
        for (int j = 0; j < 4; ++j) { nacc[j] = (f32x4_t){0.f, 0.f, 0.f, 0.f}; qacc[j] = (f32x4_t){0.f, 0.f, 0.f, 0.f}; }
#pragma unroll
        for (int ks = 0; ks < 2; ++ks) { const bf16x8_t af = *(const __attribute__((address_space(3))) bf16x8_t*)(smem + OFF_SC + ((16 * mt + fr) * 72 + 32 * ks + 8 * fq) * 2);
#pragma unroll
            for (int j = 0; j < 4; ++j) { const bf16x8_t vf = tr_frag(smem + OFF_VS + ((32 * ks + 8 * fq + (fr >> 2)) * RS + 16 * (4 * nh + j) + 4 * (fr & 3)) * 2, RS * 2);
                nacc[j] = __builtin_amdgcn_mfma_f32_16x16x32_bf16(af, vf, nacc[j], 0, 0, 0); }
            __builtin_amdgcn_sched_barrier(0); }
#pragma unroll
        for (int ks = 0; ks < 4; ++ks) { const bf16x8_t qf2 = *(const __attribute__((address_space(3))) bf16x8_t*)(smem + OFF_QS + ((16 * mt + fr) * RS + 32 * ks + 8 * fq) * 2);
#pragma unroll
            for (int j = 0; j < 4; ++j) { const bf16x8_t cf = *(const __attribute__((address_space(3))) bf16x8_t*)(smem + OFF_CT + ((16 * (4 * nh + j) + fr) * RS + 32 * ks + 8 * fq) * 2);
                qacc[j] = __builtin_amdgcn_mfma_f32_16x16x32_bf16(qf2, cf, qacc[j], 0, 0, 0); }
            __builtin_amdgcn_sched_barrier(0); }
        float hv[4][4];
        {
            const f32x4_t cy = *(const __attribute__((address_space(3))) f32x4_t*)(F + F_CARRY + 16 * mt + 4 * fq), d0 = *(const __attribute__((address_space(3))) f32x4_t*)(F + F_DENP + 16 * mt + 4 * fq),
                          d1 = *(const __attribute__((address_space(3))) f32x4_t*)(F + F_DENP + 64 + 16 * mt + 4 * fq), qn = *(const __attribute__((address_space(3))) f32x4_t*)(F + F_SQN + 16 * mt + 4 * fq),
                          en = *(const __attribute__((address_space(3))) f32x4_t*)(F + F_SEN + 16 * mt + 4 * fq);
#pragma unroll
            for (int r = 0; r < 4; ++r) { const float den = d0[r] + d1[r] + cy[r] * qn[r]; const float inv = 1.0f / fmaxf(fabsf(den), en[r]); float s1 = 0.f, s2 = 0.f;
#pragma unroll
                for (int j = 0; j < 4; ++j) { const float hh = (nacc[j][r] + cy[r] * qacc[j][r]) * inv; hv[j][r] = hh; s1 += hh; s2 += hh * hh; }
                s1 += __shfl_xor(s1, 1); s1 += __shfl_xor(s1, 2); s1 += __shfl_xor(s1, 4); s1 += __shfl_xor(s1, 8);
                s2 += __shfl_xor(s2, 1); s2 += __shfl_xor(s2, 2); s2 += __shfl_xor(s2, 4); s2 += __shfl_xor(s2, 8);
                if (fr == 0) { F[F_STAT + (nh * 64 + 16 * mt + 4 * fq + r) * 2] = s1; F[F_STAT + (nh * 64 + 16 * mt + 4 * fq + r) * 2 + 1] = s2; } }
        }
        __syncthreads();
        {
#pragma unroll
            for (int r = 0; r < 4; ++r) { const int t = 16 * mt + 4 * fq + r;
                const float s1 = F[F_STAT + t * 2] + F[F_STAT + (64 + t) * 2], s2 = F[F_STAT + t * 2 + 1] + F[F_STAT + (64 + t) * 2 + 1];
                const float mean = s1 * (1.f / 128.f); const float var = fmaxf(s2 * (1.f / 128.f) - mean * mean, 0.f); const float rstd = rsqrtf(var + LN_EPS);
#pragma unroll
                for (int j = 0; j < 4; ++j) { const int v = 16 * (4 * nh + j) + fr; const float og = bf2f(*(const __attribute__((address_space(3))) bf16_t*)(smem + OFF_OG + (t * RS + v) * 2));
                    const float o = ((hv[j][r] - mean) * rstd * F[F_HNG + v] + F[F_HNB + v]) * sigmoid_f(og);
                    A.ycat[(row0 + t) * 1024 + 512 + h * 128 + v] = (bf16_t)f2bf(o); } }
        }
        {
            const float keep = F[F_SCAL];
#pragma unroll
            for (int n = 0; n < 8; ++n) Cacc[n] = Cacc[n] * keep;
#pragma unroll
            for (int ks = 0; ks < 2; ++ks) {
                const bf16x8_t kraw = tr_frag(smem + OFF_KS + ((32 * ks + 8 * fq + (fr >> 2)) * RS + 16 * w + 4 * (fr & 3)) * 2, RS * 2);
                const f32x4_t w0 = *(const __attribute__((address_space(3))) f32x4_t*)(F + F_WS + 32 * ks + 8 * fq), w1 = *(const __attribute__((address_space(3))) f32x4_t*)(F + F_WS + 32 * ks + 8 * fq + 4);
                float kfv[8];
#pragma unroll
                for (int j = 0; j < 8; ++j) kfv[j] = bf2f((bf16_t)kraw[j]) * (j < 4 ? w0[j] : w1[j - 4]);
                const u32x4_t pk = (u32x4_t){pk2(kfv[0], kfv[1]), pk2(kfv[2], kfv[3]), pk2(kfv[4], kfv[5]), pk2(kfv[6], kfv[7])};
                const bf16x8_t af = __builtin_bit_cast(bf16x8_t, pk);
#pragma unroll
                for (int n = 0; n < 8; ++n) { const bf16x8_t vf = tr_frag(smem + OFF_VS + ((32 * ks + 8 * fq + (fr >> 2)) * RS + 16 * n + 4 * (fr & 3)) * 2, RS * 2);
                    Cacc[n] = __builtin_amdgcn_mfma_f32_16x16x32_bf16(af, vf, Cacc[n], 0, 0, 0); }
                __builtin_amdgcn_sched_barrier(0); }
#pragma unroll
            for (int n = 0; n < 8; ++n) MLM_LDS(u32x2_t, OFF_CT + ((16 * n + fr) * RS + 16 * w + 4 * fq) * 2) = (u32x2_t){pk2(Cacc[n][0], Cacc[n][1]), pk2(Cacc[n][2], Cacc[n][3])};
            if (tid < 128) { float nn = keep * F[F_SN + tid];
                for (int s = 0; s < 64; ++s) nn += F[F_WS + s] * bf2f(*(const __attribute__((address_space(3))) bf16_t*)(smem + OFF_KS + (s * RS + tid) * 2));
                F[F_SN + tid] = nn; }
        }
        __syncthreads();
    }
}
#undef MLM_LOAD_RAW
#undef MLM_IDX
#undef MLM_LDS
}

constexpr size_t MiB = 1u << 20;
constexpr size_t WS_CTL = 0, CTL_ZERO_BYTES = 64 * 1024, WS_W0IN = 1 * MiB, WS_WLR = 9 * MiB, WS_W0OUT = 10 * MiB, WS_WQ0 = 12 * MiB, WS_W1IN = 16 * MiB, WS_W1OUT = 24 * MiB, WS_WQ1 = 26 * MiB;
constexpr size_t WS_PK = 30 * MiB;
constexpr size_t WS_GATES = 31 * MiB, WS_CUM = 32 * MiB, WS_APP = 33 * MiB, WS_EID = 41 * MiB, WS_GATE = 49 * MiB, WS_ACTA = 57 * MiB;
constexpr size_t WS_TABU = 89 * MiB, WS_TABV = 121 * MiB, WS_P = 153 * MiB, WS_LRW = 281 * MiB, WS_LRA = 313 * MiB, WS_LRG = 329 * MiB, WS_END = 345 * MiB;
constexpr size_t WS_MIX = WS_P, WS_Q = WS_P + 64 * MiB;
constexpr int CW_BAR = 1024;
static_assert((CW_BAR + XCD_BAR_WORDS) * 4 <= (int)CTL_ZERO_BYTES, "barrier words inside the memset region");
constexpr int LDS_BYTES = 160 * 1024, LDS_MISC_OFF = LDS_BYTES - 256;
static_assert(mlm::LDS_BYTES <= LDS_MISC_OFF, "mlstm LDS");
static_assert(attn_body::LDS_BIAS_OFF + 8192 <= LDS_MISC_OFF && ML_LDS_BYTES <= LDS_MISC_OFF && PS_LDS_BYTES <= LDS_MISC_OFF && pg8::STAGE_BYTES <= LDS_MISC_OFF, "phase scratch below the LDS control words");

#if defined(MLSTM_VALU)
#define MLSTM_UNIT(ma, u) mlstm_unit(ma, u, (float*)lds)
#else
#define MLSTM_UNIT(ma, u) mlm::mlstm_unit_mfma(ma, u, lds)
#endif
#ifndef PROBE_DUP
#define PROBE_DUP 0
#endif
struct MegaArgs { const float* in[43]; float* out; unsigned char* ws; };

__global__ void __launch_bounds__(NTHR, 2) mega_kernel(MegaArgs a) {
    extern __shared__ __attribute__((aligned(16))) unsigned char lds[];
    const int tid = opaque_tid(); const int bid = (int)blockIdx.x, nblk = (int)gridDim.x;
#define WSP(T, off) ((T*)(opq_ptr(a.ws) + (off)))
#define INP(i) ((const float*)opq_ptr((unsigned char*)a.in[i]))
#define OUTP ((float*)opq_ptr((unsigned char*)a.out))
#define W0IN WSP(bf16_t, WS_W0IN)
#define WLR WSP(bf16_t, WS_WLR)
#define W0OUT WSP(bf16_t, WS_W0OUT)
#define WQ0 WSP(bf16_t, WS_WQ0)
#define W1IN WSP(bf16_t, WS_W1IN)
#define W1OUT WSP(bf16_t, WS_W1OUT)
#define WQ1 WSP(bf16_t, WS_WQ1)
#define PK WSP(bf16_t, WS_PK)
#define GATES WSP(float, WS_GATES)
#define CUM WSP(float, WS_CUM)
#define APP WSP(bf16_t, WS_APP)
#define EID WSP(int, WS_EID)
#define GATE WSP(float, WS_GATE)
#define ACTA WSP(bf16_t, WS_ACTA)
#define TABU WSP(unsigned char, WS_TABU)
#define TABV WSP(unsigned char, WS_TABV)
#define TABUS WSP(float, WS_TABU + 16 * MiB)
#define TABVS WSP(float, WS_TABV + 16 * MiB)
#define PBUF WSP(bf16_t, WS_P)
#define MIX WSP(float, WS_MIX)
#define QBUF WSP(bf16_t, WS_Q)
#define LRW WSP(float, WS_LRW)
#define LRA WSP(bf16_t, WS_LRA)
#define LRG WSP(bf16_t, WS_LRG)
    if (tid < 64) ((LAS unsigned*)((LAS unsigned char*)lds + LDS_MISC_OFF))[tid] = 0u;
    __syncthreads();
    XcdBarrier bar = xcd_barrier_post(WSP(unsigned, WS_CTL) + CW_BAR, (volatile LAS unsigned*)((LAS unsigned char*)lds + LDS_MISC_OFF + 32));
#define GRID_BAR() xcd_barrier(bar)
#define GEMM_PHASE(EpiT, Aop, Bop, Mv, Nv, Kv, Eobj) do { pg8::Gemm g_; g_.A = (Aop); g_.Bt = (Bop); g_.M = (Mv); g_.N = (Nv); g_.K = (Kv); pg8::StaticOrder S_; S_.init((Mv), (Nv), nblk, bid); \
        pg8::gemm_phase<EpiT, pg8::StaticOrder, true, true>((PG8_LAS unsigned char*)lds, g_, S_, (Eobj)); } while (0)

    {
        float* tile = (float*)lds;
        transpose_cvt_phase(INP(1), 1024, L0_COLS, 0, L0_MAIN, W0IN, bid, nblk, tile);
        transpose_cvt_phase(INP(19), 1024, 1024, 0, 1024, W0OUT, bid, nblk, tile);
        transpose_cvt_phase(INP(22), 1024, 2048, 0, 2048, WQ0, bid, nblk, tile);
        transpose_cvt_phase(INP(29), 1024, L1_COLS, 0, L1_MAIN, W1IN, bid, nblk, tile);
        transpose_cvt_phase(INP(33), 1024, 1024, 0, 1024, W1OUT, bid, nblk, tile);
        transpose_cvt_phase(INP(36), 1024, 2048, 0, 2048, WQ1, bid, nblk, tile);
        build_wlr_phase(INP(4), INP(6), INP(7), WLR, bid, nblk);
        cvt_bf16_phase(INP(23), PK, 131072 / 8, bid, nblk); cvt_bf16_phase(INP(24), PK + 131072, 131072 / 8, bid, nblk);
        cvt_bf16_phase(INP(37), PK + 262144, 131072 / 8, bid, nblk); cvt_bf16_phase(INP(38), PK + 393216, 131072 / 8, bid, nblk);
        cvt_bf16_phase(INP(0), ACTA, (size_t)T_TOK * 1024 / 8, bid, nblk);
        cvt_fp8_rows_phase(INP(25), TABU, TABUS, bid, nblk); cvt_fp8_rows_phase(INP(26), TABV, TABVS, bid, nblk);
    }
    GRID_BAR();
#if PROBE_DUP == 4
    for (int rep_ = 0; rep_ < 8; ++rep_) { GRID_BAR(); }
#endif
    { pg8::EpiBf16P E; E.O = PBUF; E.ldc = L0_MAIN; GEMM_PHASE(pg8::EpiBf16P, ACTA, W0IN, T_TOK, L0_MAIN, 1024, E); }
    gates_phase<8>(INP(0), INP(1), L0_COLS, L0_MAIN, GATES, bid, nblk, (float*)lds);
    GRID_BAR();
    rwkv_prep_phase(PBUF, INP(2), APP, bid, nblk);
    GRID_BAR();
    { pg8::EpiLowrank E; E.lrw = LRW; E.lra = LRA; E.lrg = LRG; E.w0 = INP(3); E.a0 = INP(5); GEMM_PHASE(pg8::EpiLowrank, APP, WLR, T_TOK, 1536, 256, E); }
    GRID_BAR();
    {
        RwkvArgs ra; ra.P0 = PBUF; ra.lrw = LRW; ra.lra = LRA; ra.lrg = LRG; ra.mu = INP(2); ra.k_k = INP(8); ra.k_a = INP(9); ra.r_k = INP(10); ra.ln_g = INP(11); ra.ln_b = INP(12); ra.ycat = ACTA;
        MlstmArgs ma; ma.P0 = PBUF; ma.gates = GATES; ma.conv_w = INP(13); ma.conv_b = INP(14); ma.ig_b = INP(15); ma.fg_b = INP(16); ma.hn_g = INP(17); ma.hn_b = INP(18); ma.ycat = ACTA;
        for (int u = bid; u < 96; u += nblk) { if (u < 64) rwkv_scan_unit(ra, u, (float*)lds); else MLSTM_UNIT(ma, u - 64); }
#if PROBE_DUP == 1
        GRID_BAR();
        for (int u = bid; u < 96; u += nblk) { if (u < 64) rwkv_scan_unit(ra, u, (float*)lds); else MLSTM_UNIT(ma, u - 64); }
#endif
    }
    GRID_BAR();
    { pg8::EpiF32 E; E.C = MIX; E.ldc = 1024; GEMM_PHASE(pg8::EpiF32, ACTA, W0OUT, T_TOK, 1024, 1024, E); }
    GRID_BAR();
    ln_phase(INP(0), MIX, INP(20), INP(21), OUTP, ACTA, bid, nblk);
    GRID_BAR();
    { pg8::EpiBf16P E; E.O = QBUF; E.ldc = 2048; GEMM_PHASE(pg8::EpiBf16P, ACTA, WQ0, T_TOK, 2048, 1024, E);
#if PROBE_DUP == 5
      GRID_BAR(); GEMM_PHASE(pg8::EpiBf16P, ACTA, WQ0, T_TOK, 2048, 1024, E); GRID_BAR(); GEMM_PHASE(pg8::EpiBf16P, ACTA, WQ0, T_TOK, 2048, 1024, E);
#endif
    }
    GRID_BAR();
    { PeerSArgs sa; sa.Q = QBUF; sa.K1b = PK; sa.K2b = PK + 131072; sa.eid = EID; sa.gate = GATE; peer_scores_phase(sa, bid, nblk, lds);
#if PROBE_DUP == 3
      GRID_BAR(); peer_scores_phase(sa, bid, nblk, lds);
#endif
    }
    GRID_BAR();
#if PROBE_DUP == 2
    { PeerGArgs ga; ga.X = OUTP; ga.Xo = MIX; ga.eid = EID; ga.gate = GATE; ga.U = TABU; ga.V = TABV; ga.Us = TABUS; ga.Vs = TABVS; ga.lng = INP(27); ga.lnb = INP(28); ga.xb = QBUF; peer_gather_phase(ga, bid, nblk); }
    GRID_BAR();
#endif
    { PeerGArgs ga; ga.X = OUTP; ga.Xo = OUTP; ga.eid = EID; ga.gate = GATE; ga.U = TABU; ga.V = TABV; ga.Us = TABUS; ga.Vs = TABVS; ga.lng = INP(27); ga.lnb = INP(28); ga.xb = ACTA; peer_gather_phase(ga, bid, nblk); }
    GRID_BAR();
    cvt_fp8_rows_phase(INP(39), TABU, TABUS, bid, nblk); cvt_fp8_rows_phase(INP(40), TABV, TABVS, bid, nblk);
    { pg8::EpiBf16P E; E.O = PBUF; E.ldc = L1_MAIN; GEMM_PHASE(pg8::EpiBf16P, ACTA, W1IN, T_TOK, L1_MAIN, 1024, E); }
    gates_phase<16>(OUTP, INP(29), L1_COLS, L1_MAIN, GATES, bid, nblk, (float*)lds);
    GRID_BAR();
    fox_cumsum_phase(GATES, INP(32), CUM, bid, nblk);
#if defined(ATTN_VALU)
    GRID_BAR();
    { AttnArgs aa; aa.P1 = PBUF; aa.cum = CUM; aa.qn_g = INP(30); aa.kn_g = INP(31); aa.out = ACTA; attn_valu_phase(aa, bid, nblk, (float*)lds); }
#else
    fox_qknorm_phase(PBUF, INP(30), INP(31), bid, nblk);
    GRID_BAR();
    { const attn_body::AttnTensors AT{(const attn_body::bf16*)PBUF, (const attn_body::bf16*)(PBUF + 1024), (const attn_body::bf16*)(PBUF + 2048), (const attn_body::bf16*)(PBUF + 3072), CUM, (attn_body::bf16*)ACTA};
      const attn_body::StaticOrder S_(nblk, bid); attn_body::attn_phase<attn_body::StaticOrder>((char*)lds, AT, S_);
#if PROBE_DUP == 6
      GRID_BAR(); attn_body::attn_phase<attn_body::StaticOrder>((char*)lds, AT, S_);
#endif
    }
#endif
    GRID_BAR();
    { pg8::EpiF32 E; E.C = MIX; E.ldc = 1024; GEMM_PHASE(pg8::EpiF32, ACTA, W1OUT, T_TOK, 1024, 1024, E); }
    GRID_BAR();
    ln_phase(OUTP, MIX, INP(34), INP(35), OUTP, ACTA, bid, nblk);
    GRID_BAR();
    { pg8::EpiBf16P E; E.O = QBUF; E.ldc = 2048; GEMM_PHASE(pg8::EpiBf16P, ACTA, WQ1, T_TOK, 2048, 1024, E); }
    GRID_BAR();
    { PeerSArgs sa; sa.Q = QBUF; sa.K1b = PK + 262144; sa.K2b = PK + 393216; sa.eid = EID; sa.gate = GATE; peer_scores_phase(sa, bid, nblk, lds); }
    GRID_BAR();
    { PeerGArgs ga; ga.X = OUTP; ga.Xo = OUTP; ga.eid = EID; ga.gate = GATE; ga.U = TABU; ga.V = TABV; ga.Us = TABUS; ga.Vs = TABVS; ga.lng = INP(41); ga.lnb = INP(42); ga.xb = ACTA; peer_gather_phase(ga, bid, nblk); }
#undef GRID_BAR
#undef GEMM_PHASE
#undef WSP
#undef INP
#undef OUTP
#undef W0IN
#undef WLR
#undef W0OUT
#undef WQ0
#undef W1IN
#undef W1OUT
#undef WQ1
#undef PK
#undef GATES
#undef CUM
#undef APP
#undef EID
#undef GATE
#undef ACTA
#undef TABU
#undef TABV
#undef TABUS
#undef TABVS
#undef PBUF
#undef MIX
#undef QBUF
#undef LRW
#undef LRA
#undef LRG
}

extern "C" void kernel_launch(void* const* d_in, const int* in_sizes, int n_in, void* d_out, int out_size, void* d_ws, size_t ws_size, hipStream_t stream) {
    static int grid = 0;
    if (grid == 0) {
        if (n_in != 43 || ws_size < WS_END) { fprintf(stderr, "kernel_launch: unexpected n_in %d or ws_size %zu (< %zu); nothing launched\n", n_in, ws_size, (size_t)WS_END); grid = -1; return; }
        int dev = 0, cus = 0;
        if (hipGetDevice(&dev) != hipSuccess || hipDeviceGetAttribute(&cus, hipDeviceAttributeMultiprocessorCount, dev) != hipSuccess) { fprintf(stderr, "kernel_launch: device query failed\n"); grid = -1; return; }
        if (hipFuncSetAttribute((const void*)mega_kernel, hipFuncAttributeMaxDynamicSharedMemorySize, LDS_BYTES) != hipSuccess) { fprintf(stderr, "kernel_launch: hipFuncSetAttribute failed\n"); grid = -1; return; }
        (void)hipGetLastError();
        grid = cus;
    }
    if (grid < 0) return;
    (void)hipMemsetAsync((char*)d_ws + WS_CTL, 0, CTL_ZERO_BYTES, stream);
    MegaArgs a; memset(&a, 0, sizeof(a));
    for (int i = 0; i < 43; ++i) a.in[i] = (const float*)d_in[i];
    a.out = (float*)d_out; a.ws = (unsigned char*)d_ws;
    hipLaunchKernelGGL(mega_kernel, dim3(grid), dim3(NTHR), LDS_BYTES, stream, a);
}
```

```cpp
#include <hip/hip_runtime.h>
#include <cstdio>
#include <cstdint>
#include <cmath>
#include <cstring>
__device__ __forceinline__ int opaque_tid() { int t = (int)threadIdx.x; asm volatile("" : "+v"(t)); return t; }
__device__ __forceinline__ unsigned char* opq_ptr(unsigned char* p) { return p; }
namespace pg8 {
#define PG8_LAS __attribute__((address_space(3)))
typedef unsigned short bf16_t;
typedef short bf16x8 __attribute__((ext_vector_type(8)));
typedef float f32x4 __attribute__((ext_vector_type(4)));
typedef unsigned u32x4 __attribute__((ext_vector_type(4)));
constexpr int BM = 256, BK = 64, HALF = 128, HTB = HALF * BK * 2  , STAGE_BYTES = 8 * HTB, NXCD = 8, WGM = 8;

__host__ __device__ __forceinline__ int lds_byte(int r, int c) { const int st = (r >> 4) * 2 + (c >> 5), rr = r & 15, cc = c & 31, ob = rr * 64 + cc * 2; return st * 1024 + (ob ^ (((ob >> 9) & 1) << 5)); }
__host__ __device__ __forceinline__ void stage_rc(int b, int& R, int& C) { const int st = b / 1024, sb = b % 1024, swz = sb ^ (((sb >> 9) & 1) << 5); R = (st >> 1) * 16 + swz / 64; C = (st & 1) * 32 + (swz % 64) / 2; }
__host__ __device__ __forceinline__ int perm32(int rho) { const int n = rho >> 4, i = rho & 15; return 8 * (i >> 2) + 4 * n + (i & 3); }

struct Unit { int pm, pn; };
struct Gemm { const bf16_t* A; const bf16_t* Bt; int M, N, K; };

struct StaticOrder {
    int nM, nN, nwg, G, c;
    __host__ __device__ void init(int M, int N, int G_, int c_) { nM = M / BM; nN = N / BM; nwg = nM * nN; G = G_; c = c_; }
    __host__ __device__ bool next(int i, Unit& u) const {
        const long L = (long)i * G + c; if (L >= nwg) return false;
        int wgid = (int)L; { const int q = nwg / NXCD, r = nwg % NXCD, xcd = wgid % NXCD, off = wgid / NXCD; wgid = (xcd < r ? xcd * (q + 1) : r * (q + 1) + (xcd - r) * q) + off; }
        const int nig = WGM * nN, gid = wgid / nig, fm = gid * WGM, gsz = (nM - fm) < WGM ? (nM - fm) : WGM;
        u.pm = fm + ((wgid % nig) % gsz); u.pn = (wgid % nig) / gsz; return true;
    }
    __device__ __forceinline__ void a_ready(const Unit&) const {}
    __device__ __forceinline__ void done(const Unit&) const {}
};

__device__ __forceinline__ unsigned cvt_pk_bf16(float lo, float hi) { unsigned r; asm volatile("v_cvt_pk_bf16_f32 %0, %1, %2" : "=v"(r) : "v"(lo), "v"(hi)); return r; }
typedef float f32x2 __attribute__((ext_vector_type(2)));
__device__ __forceinline__ f32x2 gelu_pk(f32x2 v) {
    const f32x2 av = __builtin_elementwise_abs(v), d = av * 0.2316418882f + 1.0f;
    f32x2 t; t.x = __builtin_amdgcn_rcpf(d.x); t.y = __builtin_amdgcn_rcpf(d.y);
    f32x2 q = t * 0.5307027145f + (-0.7265760135f); q = q * t + 0.7107068705f; q = q * t + (-0.142248368f); q = q * t + 0.127414796f; q = q * t;
    const f32x2 s = (v * v) * (-0.72134752044f);
    f32x2 e; e.x = __builtin_amdgcn_exp2f(s.x); e.y = __builtin_amdgcn_exp2f(s.y);
    const f32x2 m = v * (q * e), r = v - m;
    f32x2 o; o.x = v.x < 0.f ? m.x : r.x; o.y = v.y < 0.f ? m.y : r.y; return o;
}

template <int ACT  > struct EpiBf16 {
    static constexpr bool PERM = true, AFTER_DRAIN = false; static_assert(ACT == 0 || ACT == 1, "EpiBf16: ACT is 0 (none) or 1 (gelu_pk)");
    bf16_t* O; int ldc; const float* bias; int split_cols; size_t split_stride; float scale0;
    __device__ __forceinline__ void operator()(const f32x4 (&acc)[2][2][4][2], const Unit& u, int wr, int wc, int fr, int fq) const {
        const int row0 = u.pm * BM + wr * 64 + fr; int colt = u.pn * BM; bf16_t* base = O;
        float sc = 1.f; if (split_cols) { const int t = colt / split_cols; base += (size_t)t * split_stride; colt -= t * split_cols; if (t == 0) sc = scale0; }
        const int col0 = colt + wc * 32 + 8 * fq, bcol0 = u.pn * BM + wc * 32 + 8 * fq;
        f32x4 bv[2][2];
#pragma unroll
        for (int bj = 0; bj < 2; ++bj)
#pragma unroll
            for (int n = 0; n < 2; ++n) bv[bj][n] = bias ? *(const f32x4*)(bias + bcol0 + bj * HALF + 4 * n) : (f32x4){0.f, 0.f, 0.f, 0.f};
#pragma unroll
        for (int ai = 0; ai < 2; ++ai)
#pragma unroll
            for (int m = 0; m < 4; ++m) { bf16_t* rowp = base + (size_t)(row0 + ai * HALF + m * 16) * ldc + col0;
#pragma unroll
                for (int bj = 0; bj < 2; ++bj) { f32x4 v0 = acc[ai][bj][m][0] + bv[bj][0], v1 = acc[ai][bj][m][1] + bv[bj][1];
                    if (ACT == 1) { f32x2 a = gelu_pk((f32x2){v0[0], v0[1]}), b = gelu_pk((f32x2){v0[2], v0[3]}), c = gelu_pk((f32x2){v1[0], v1[1]}), d = gelu_pk((f32x2){v1[2], v1[3]});
                        v0 = (f32x4){a.x, a.y, b.x, b.y}; v1 = (f32x4){c.x, c.y, d.x, d.y}; }
                    v0 = v0 * sc; v1 = v1 * sc; u32x4 w; w.x = cvt_pk_bf16(v0[0], v0[1]); w.y = cvt_pk_bf16(v0[2], v0[3]); w.z = cvt_pk_bf16(v1[0], v1[1]); w.w = cvt_pk_bf16(v1[2], v1[3]);
                    *(u32x4*)(rowp + bj * HALF) = w; } }
    }
};

struct PanelStats {
    unsigned* xbuf;
    unsigned* cnt;
    unsigned* tmo;
    int ntn; float eps;
    unsigned code;
    __device__ __forceinline__ bool run(const f32x4 (&v)[2][2][4][2], const Unit& u, int wr, int wc, int fr, int fq, PG8_LAS unsigned char* lds, int wid, int lane) const {
        typedef float f32x2v __attribute__((ext_vector_type(2)));
        PG8_LAS f32x2v* P = (PG8_LAS f32x2v*)lds;
        PG8_LAS f32x2v* S = (PG8_LAS f32x2v*)(lds + 8192);
        PG8_LAS unsigned* flag = (PG8_LAS unsigned*)(lds + 8192 + 2048);
#pragma unroll
        for (int ai = 0; ai < 2; ++ai)
#pragma unroll
            for (int m = 0; m < 4; ++m) {
                float s = 0.f;
#pragma unroll
                for (int bj = 0; bj < 2; ++bj)
#pragma unroll
                    for (int n = 0; n < 2; ++n) { const f32x4 x = v[ai][bj][m][n]; s += (x[0] + x[1]) + (x[2] + x[3]); }
                s += __shfl_xor(s, 16); s += __shfl_xor(s, 32);
                const float mw = s * (1.0f / 64.0f); float q = 0.f;
#pragma unroll
                for (int bj = 0; bj < 2; ++bj)
#pragma unroll
                    for (int n = 0; n < 2; ++n) { const f32x4 d = v[ai][bj][m][n] - mw; q += (d[0] * d[0] + d[1] * d[1]) + (d[2] * d[2] + d[3] * d[3]); }
                q += __shfl_xor(q, 16); q += __shfl_xor(q, 32);
                if (fq == 0) P[(ai * HALF + wr * 64 + m * 16 + fr) * 4 + wc] = (f32x2v){mw, q};
            }
        asm volatile("s_waitcnt lgkmcnt(0)" ::: "memory"); __builtin_amdgcn_s_barrier(); asm volatile("" ::: "memory");
#if defined(BROKEN_EXCHANGE_NO_WAIT)
#warning BROKEN CONTROL BUILD: the row-statistics exchange does not wait; results are wrong by design
        if (blockIdx.x >= 64) { const long long t0_ = clock64(); while (clock64() - t0_ < 60000) __builtin_amdgcn_s_sleep(8); }
#endif
        const int row = wid * 32 + (lane & 31);
        if (lane < 32) {
            const f32x2v a = P[row * 4 + 0], b = P[row * 4 + 1], c = P[row * 4 + 2], d = P[row * 4 + 3];
            const float mt = (a.x + b.x + c.x + d.x) * 0.25f;
            const float da = a.x - mt, db = b.x - mt, dc = c.x - mt, dd = d.x - mt;
            const float m2 = (a.y + b.y) + (c.y + d.y) + 64.0f * ((da * da + db * db) + (dc * dc + dd * dd));
            unsigned long long* slot = (unsigned long long*)xbuf + ((size_t)(u.pm * BM + row) * 4 + u.pn);
            __hip_atomic_store(slot, ((unsigned long long)__float_as_uint(m2) << 32) | __float_as_uint(mt), __ATOMIC_RELAXED, __HIP_MEMORY_SCOPE_AGENT);
        }
        asm volatile("s_waitcnt vmcnt(0)" ::: "memory");
        if (lane == 0) __hip_atomic_fetch_add(cnt + 64 * u.pm, 1u, __ATOMIC_RELAXED, __HIP_MEMORY_SCOPE_AGENT);
        if (wid == 0) {
            bool dead = false; const unsigned long long t0 = __builtin_amdgcn_s_memrealtime(); const unsigned want = 8u * (unsigned)ntn;
            for (;;) {
#if defined(BROKEN_EXCHANGE_NO_WAIT)
                break;
#endif
                if ((unsigned)__builtin_amdgcn_readfirstlane(__hip_atomic_load(cnt + 64 * u.pm, __ATOMIC_RELAXED, __HIP_MEMORY_SCOPE_AGENT)) >= want) break;
                if (__builtin_amdgcn_s_memrealtime() - t0 > 2000000ull) {
                    if (lane == 0) { unsigned expect = 0u; __hip_atomic_compare_exchange_strong(tmo + 1, &expect, code | (unsigned)(u.pm & 0xff), __ATOMIC_RELAXED, __ATOMIC_RELAXED, __HIP_MEMORY_SCOPE_AGENT);
                                     __hip_atomic_store(tmo, 1u, __ATOMIC_RELAXED, __HIP_MEMORY_SCOPE_AGENT); }
                    dead = true; break; }
                __builtin_amdgcn_s_sleep(2);
            }
            __builtin_amdgcn_fence(__ATOMIC_ACQUIRE, "agent");
            if (lane == 0) flag[0] = dead ? 1u : 0u;
        }
        asm volatile("s_waitcnt vmcnt(0) lgkmcnt(0)" ::: "memory"); __builtin_amdgcn_s_barrier(); asm volatile("" ::: "memory");
        const bool bad = flag[0] != 0u;
        if (lane < 32) {
            const unsigned long long* slot = (const unsigned long long*)xbuf + (size_t)(u.pm * BM + row) * 4; float mt[4], m2[4]; float ms = 0.f;
#pragma unroll
            for (int t = 0; t < 4; ++t) { if (t < ntn) { const unsigned long long w = __hip_atomic_load(slot + t, __ATOMIC_RELAXED, __HIP_MEMORY_SCOPE_AGENT); mt[t] = __uint_as_float((unsigned)w); m2[t] = __uint_as_float((unsigned)(w >> 32)); } else { mt[t] = 0.f; m2[t] = 0.f; } ms += mt[t]; }
            const float mean = ms / (float)ntn; float q = 0.f;
#pragma unroll
            for (int t = 0; t < 4; ++t) if (t < ntn) { const float dm = mt[t] - mean; q += m2[t] + 256.0f * dm * dm; }
            S[row] = (f32x2v){mean, 1.0f / sqrtf(q / (256.0f * (float)ntn) + eps)};
        }
        asm volatile("s_waitcnt lgkmcnt(0)" ::: "memory"); __builtin_amdgcn_s_barrier(); asm volatile("" ::: "memory");
        return bad;
    }
};
struct EpiLnRes {
    static constexpr bool PERM = false, AFTER_DRAIN = true;
    const float* base; float* out; int ldc; const float* bias; PanelStats st; unsigned poison;
    __device__ __forceinline__ void fused(f32x4 (&acc)[2][2][4][2], const Unit& u, int wr, int wc, int fr, int fq, PG8_LAS unsigned char* lds, int wid, int lane) const {
        typedef float f32x2v __attribute__((ext_vector_type(2)));
        const PG8_LAS f32x2v* S = (const PG8_LAS f32x2v*)(lds + 8192);
        const int col0 = u.pn * BM + wc * 32 + 4 * fq;
#pragma unroll
        for (int bj = 0; bj < 2; ++bj)
#pragma unroll
            for (int n = 0; n < 2; ++n) { const f32x4 bv = bias ? *(const f32x4*)(bias + col0 + bj * HALF + n * 16) : (f32x4){0.f, 0.f, 0.f, 0.f};
#pragma unroll
                for (int ai = 0; ai < 2; ++ai)
#pragma unroll
                    for (int m = 0; m < 4; ++m) acc[ai][bj][m][n] += bv; }
        f32x4 pre[4][2][2];
#pragma unroll
        for (int m = 0; m < 4; ++m) { const size_t off = (size_t)(u.pm * BM + wr * 64 + m * 16 + fr) * ldc + col0;
#pragma unroll
            for (int bj = 0; bj < 2; ++bj)
#pragma unroll
                for (int n = 0; n < 2; ++n) pre[m][bj][n] = *(const f32x4*)(base + off + bj * HALF + n * 16); }
        const bool bad = st.run(acc, u, wr, wc, fr, fq, lds, wid, lane) || poison != 0u;
        const float qnan = __builtin_nanf("");
#pragma unroll
        for (int ai = 0; ai < 2; ++ai)
#pragma unroll
            for (int m = 0; m < 4; ++m) { const int r = ai * HALF + wr * 64 + m * 16 + fr; const f32x2v sr = S[r]; const size_t off = (size_t)(u.pm * BM + r) * ldc + col0;
#pragma unroll
                for (int bj = 0; bj < 2; ++bj)
#pragma unroll
                    for (int n = 0; n < 2; ++n) { const f32x4 bs = ai == 0 ? pre[m][bj][n] : *(const f32x4*)(base + off + bj * HALF + n * 16); f32x4 o = bs + (acc[ai][bj][m][n] - sr.x) * sr.y;
                        if (bad) o = (f32x4){qnan, qnan, qnan, qnan}; *(f32x4*)(out + off + bj * HALF + n * 16) = o; }
                if (m & 1) asm volatile("" ::: "memory"); }
    }
};
struct EpiLnResLn {
    static constexpr bool PERM = false, AFTER_DRAIN = true;
    const float* base; float* out; bf16_t* xn; int ldc; const float* bias; PanelStats st1, st2; unsigned poison;
    __device__ __forceinline__ void fused(f32x4 (&acc)[2][2][4][2], const Unit& u, int wr, int wc, int fr, int fq, PG8_LAS unsigned char* lds, int wid, int lane) const {
        typedef float f32x2v __attribute__((ext_vector_type(2))); typedef unsigned u32x2v __attribute__((ext_vector_type(2)));
        const PG8_LAS f32x2v* S = (const PG8_LAS f32x2v*)(lds + 8192);
        const int col0 = u.pn * BM + wc * 32 + 4 * fq;
#pragma unroll
        for (int bj = 0; bj < 2; ++bj)
#pragma unroll
            for (int n = 0; n < 2; ++n) { const f32x4 bv = bias ? *(const f32x4*)(bias + col0 + bj * HALF + n * 16) : (f32x4){0.f, 0.f, 0.f, 0.f};
#pragma unroll
                for (int ai = 0; ai < 2; ++ai)
#pragma unroll
                    for (int m = 0; m < 4; ++m) acc[ai][bj][m][n] += bv; }
        bool bad = st1.run(acc, u, wr, wc, fr, fq, lds, wid, lane) || poison != 0u;
        const float qnan = __builtin_nanf("");
#pragma unroll
        for (int ai = 0; ai < 2; ++ai)
#pragma unroll
            for (int m = 0; m < 4; ++m) { const int r = ai * HALF + wr * 64 + m * 16 + fr; const f32x2v sr = S[r]; const size_t off = (size_t)(u.pm * BM + r) * ldc + col0;
#pragma unroll
                for (int bj = 0; bj < 2; ++bj)
#pragma unroll
                    for (int n = 0; n < 2; ++n) { const f32x4 bs = *(const f32x4*)(base + off + bj * HALF + n * 16); acc[ai][bj][m][n] = bs + (acc[ai][bj][m][n] - sr.x) * sr.y; }
                asm volatile("" : "+v"(acc[ai][0][m][0]), "+v"(acc[ai][0][m][1]), "+v"(acc[ai][1][m][0]), "+v"(acc[ai][1][m][1]));
                if (m & 1) asm volatile("" ::: "memory"); }
        const bool bad1 = bad;
        bad = st2.run(acc, u, wr, wc, fr, fq, lds, wid, lane) || bad;
#pragma unroll
        for (int ai = 0; ai < 2; ++ai)
#pragma unroll
            for (int m = 0; m < 4; ++m) { const int r = ai * HALF + wr * 64 + m * 16 + fr; const f32x2v sr = S[r]; const size_t off = (size_t)(u.pm * BM + r) * ldc + col0;
#pragma unroll
                for (int bj = 0; bj < 2; ++bj)
#pragma unroll
                    for (int n = 0; n < 2; ++n) { const f32x4 x1 = acc[ai][bj][m][n]; *(f32x4*)(out + off + bj * HALF + n * 16) = bad1 ? (f32x4){qnan, qnan, qnan, qnan} : x1;
                        const f32x4 o = (x1 - sr.x) * sr.y; u32x2v w; w.x = cvt_pk_bf16(o[0], o[1]); w.y = cvt_pk_bf16(o[2], o[3]);
                        if (bad) { w.x = 0x7fc07fc0u; w.y = 0x7fc07fc0u; } *(u32x2v*)(xn + off + bj * HALF + n * 16) = w; }
                asm volatile("" ::: "memory"); }
    }
};

template <class Epi, class Sched, bool ALIGN_EPI = false, bool SP2 = false>
__device__ __forceinline__ void gemm_phase(PG8_LAS unsigned char* lds, const Gemm g, const Sched& S, const Epi& E) {
    const int tid = opaque_tid(), wid = __builtin_amdgcn_readfirstlane(tid >> 6), lane = tid & 63, wr = wid >> 2, wc = wid & 3, fr = lane & 15, fq = lane >> 4;
    const int K = g.K, nt = K / BK;
    unsigned voffA[2], voffB[2];
#pragma unroll
    for (int i = 0; i < 2; ++i) { int R, C; stage_rc(tid * 16 + i * 8192, R, C); const int Rb = Epi::PERM ? ((R & ~31) + perm32(R & 31)) : R;
        voffA[i] = (unsigned)(R * K + C) * 2u; voffB[i] = (unsigned)(Rb * K + C) * 2u; }
    const size_t kstep = (size_t)(BK * 2);
    const size_t hstep = (size_t)HALF * K * 2;
    const size_t tstep = 2 * hstep;
    const unsigned ldsw = (unsigned)wid * 1024u;
    const int aoff = lds_byte(wr * 64 + fr, fq * 8), boff = lds_byte(wc * 32 + fr, fq * 8);
#define PG8_SA(b, h) (((b) * 2 + (h)) * HTB)
#define PG8_SB(b, h) ((4 + (b) * 2 + (h)) * HTB)
#define PG8_STAGE(bufoff, gbase, voff) do { _Pragma("unroll") for (int _i = 0; _i < 2; ++_i) \
        __builtin_amdgcn_global_load_lds((const unsigned*)((const char*)(gbase) + (voff)[_i]), (PG8_LAS unsigned*)(lds + (bufoff) + ldsw + _i * 8192), 16, 0, 0); } while (0)
#define PG8_LDA(dst, b, h) do { _Pragma("unroll") for (int m = 0; m < 4; ++m) _Pragma("unroll") for (int k = 0; k < 2; ++k) dst[m][k] = *(const PG8_LAS bf16x8*)(lds + PG8_SA(b, h) + aoff + m * 2048 + k * 1024); } while (0)
#define PG8_LDB(dst, b, h) do { _Pragma("unroll") for (int n = 0; n < 2; ++n) _Pragma("unroll") for (int k = 0; k < 2; ++k) dst[n][k] = *(const PG8_LAS bf16x8*)(lds + PG8_SB(b, h) + boff + n * 2048 + k * 1024); } while (0)
#define PG8_MMA(ai, bj, At, Bt) do { __builtin_amdgcn_s_setprio(1); _Pragma("unroll") for (int m = 0; m < 4; ++m) _Pragma("unroll") for (int n = 0; n < 2; ++n) _Pragma("unroll") for (int k = 0; k < 2; ++k) \
        acc[ai][bj][m][n] = __builtin_amdgcn_mfma_f32_16x16x32_bf16(Bt[n][k], At[m][k], acc[ai][bj][m][n], 0, 0, 0); __builtin_amdgcn_s_setprio(0); } while (0)
#define PG8_WAIT_V(n) asm volatile("s_waitcnt vmcnt(" #n ")" ::: "memory")
#define PG8_WAIT_L(n) asm volatile("s_waitcnt lgkmcnt(" #n ")" ::: "memory")
#define PG8_BAR __builtin_amdgcn_s_barrier()
#define PG8_SCHED __builtin_amdgcn_sched_barrier(0)
    Unit cur, nxt; int ui = 0;
    if (!S.next(0, cur)) return;
    f32x4 acc[2][2][4][2];
#pragma unroll
    for (int a = 0; a < 2; ++a)
#pragma unroll
        for (int b = 0; b < 2; ++b)
#pragma unroll
            for (int m = 0; m < 4; ++m)
#pragma unroll
                for (int n = 0; n < 2; ++n) acc[a][b][m][n] = (f32x4){0.f, 0.f, 0.f, 0.f};
    bf16x8 At[4][2], B0[2][2], B1[2][2];
    const char* cA = (const char*)g.A + (size_t)cur.pm * tstep; const char* cB = (const char*)g.Bt + (size_t)cur.pn * tstep;
    S.a_ready(cur);
    if constexpr (SP2) {
        PG8_STAGE(PG8_SB(0, 0), cB, voffB); PG8_STAGE(PG8_SB(0, 1), cB + hstep, voffB); PG8_STAGE(PG8_SA(0, 0), cA, voffA); PG8_STAGE(PG8_SA(0, 1), cA + hstep, voffA);
        if (wr == 1) PG8_BAR;
        PG8_WAIT_V(2); PG8_BAR;
        PG8_STAGE(PG8_SB(1, 0), cB + kstep, voffB); PG8_STAGE(PG8_SA(1, 0), cA + kstep, voffA); PG8_STAGE(PG8_SB(1, 1), cB + hstep + kstep, voffB);
        PG8_WAIT_V(6); PG8_BAR;
    } else {
        PG8_STAGE(PG8_SB(0, 0), cB, voffB); PG8_STAGE(PG8_SA(0, 0), cA, voffA); PG8_STAGE(PG8_SB(0, 1), cB + hstep, voffB); PG8_STAGE(PG8_SA(0, 1), cA + hstep, voffA);
        if (wr == 1) PG8_BAR;
        PG8_WAIT_V(4); PG8_BAR;
        PG8_STAGE(PG8_SB(1, 0), cB + kstep, voffB); PG8_STAGE(PG8_SA(1, 0), cA + kstep, voffA); PG8_STAGE(PG8_SB(1, 1), cB + hstep + kstep, voffB);
        PG8_WAIT_V(6); PG8_BAR;
    }
    for (;;) {
        const bool has_next = S.next(ui + 1, nxt);
        const char* nA = has_next ? (const char*)g.A + (size_t)nxt.pm * tstep : cA; const char* nB = has_next ? (const char*)g.Bt + (size_t)nxt.pn * tstep : cB;
        for (int t = 0; t < nt; t += 2) {
            const bool last = (t == nt - 2);
            const char* a1 = cA + (size_t)(t + 1) * kstep;
            const char* a2 = last ? nA : cA + (size_t)(t + 2) * kstep; const char* b2 = last ? nB : cB + (size_t)(t + 2) * kstep;
            const char* a3 = a2 + kstep; const char* b3 = b2 + kstep;
            if (last && has_next) S.a_ready(nxt);
            if constexpr (SP2) {
            PG8_LDB(B0, 0, 0); PG8_LDB(B1, 0, 1); PG8_SCHED; PG8_LDA(At, 0, 0); PG8_STAGE(PG8_SA(1, 1), a1 + hstep, voffA);
            PG8_WAIT_V(8); PG8_WAIT_L(0); PG8_BAR; PG8_MMA(0, 0, At, B0); PG8_MMA(0, 1, At, B1); PG8_BAR; PG8_SCHED;
            PG8_LDA(At, 0, 1); PG8_STAGE(PG8_SB(0, 0), b2, voffB); PG8_STAGE(PG8_SB(0, 1), b2 + hstep, voffB); PG8_STAGE(PG8_SA(0, 0), a2, voffA);
            PG8_WAIT_V(8); PG8_WAIT_L(0); PG8_BAR; PG8_MMA(1, 0, At, B0); PG8_MMA(1, 1, At, B1); PG8_BAR; PG8_SCHED;
            PG8_LDB(B0, 1, 0); PG8_LDB(B1, 1, 1); PG8_SCHED; PG8_LDA(At, 1, 0); PG8_STAGE(PG8_SA(0, 1), a2 + hstep, voffA);
            PG8_WAIT_V(8); PG8_WAIT_L(0); PG8_BAR; PG8_MMA(0, 0, At, B0); PG8_MMA(0, 1, At, B1); PG8_BAR; PG8_SCHED;
            PG8_LDA(At, 1, 1); PG8_STAGE(PG8_SB(1, 0), b3, voffB); PG8_STAGE(PG8_SB(1, 1), b3 + hstep, voffB); PG8_STAGE(PG8_SA(1, 0), a3, voffA);
            PG8_WAIT_V(8); PG8_WAIT_L(0); PG8_BAR; PG8_MMA(1, 0, At, B0); PG8_MMA(1, 1, At, B1); PG8_BAR; PG8_SCHED;
            } else {
            PG8_LDB(B0, 0, 0); PG8_SCHED; PG8_LDA(At, 0, 0); PG8_STAGE(PG8_SA(1, 1), a1 + hstep, voffA);
            PG8_WAIT_L(8); PG8_BAR; PG8_WAIT_L(0); PG8_MMA(0, 0, At, B0); PG8_BAR; PG8_SCHED;
            PG8_LDB(B1, 0, 1); PG8_STAGE(PG8_SB(0, 0), b2, voffB);
            PG8_BAR; PG8_WAIT_L(0); PG8_MMA(0, 1, At, B1); PG8_BAR;
            PG8_LDA(At, 0, 1); PG8_STAGE(PG8_SA(0, 0), a2, voffA);
            PG8_BAR; PG8_WAIT_L(0); PG8_MMA(1, 0, At, B0); PG8_BAR; PG8_SCHED;
            PG8_STAGE(PG8_SB(0, 1), b2 + hstep, voffB);
            PG8_WAIT_V(6); PG8_BAR; PG8_MMA(1, 1, At, B1); PG8_BAR;
            PG8_LDB(B0, 1, 0); PG8_SCHED; PG8_LDA(At, 1, 0); PG8_STAGE(PG8_SA(0, 1), a2 + hstep, voffA);
            PG8_WAIT_L(8); PG8_BAR; PG8_WAIT_L(0); PG8_MMA(0, 0, At, B0); PG8_BAR; PG8_SCHED;
            PG8_LDB(B1, 1, 1); PG8_STAGE(PG8_SB(1, 0), b3, voffB);
            PG8_BAR; PG8_WAIT_L(0); PG8_MMA(0, 1, At, B1); PG8_BAR;
            PG8_LDA(At, 1, 1); PG8_STAGE(PG8_SA(1, 0), a3, voffA);
            PG8_BAR; PG8_WAIT_L(0); PG8_MMA(1, 0, At, B0); PG8_BAR; PG8_SCHED;
            PG8_STAGE(PG8_SB(1, 1), b3 + hstep, voffB);
            PG8_WAIT_V(6); PG8_BAR; PG8_MMA(1, 1, At, B1); PG8_BAR;
            }
        }
        if constexpr (ALIGN_EPI) { if (wr == 0) PG8_BAR; }
        if constexpr (!Epi::AFTER_DRAIN) { E(acc, cur, wr, wc, fr, fq); S.done(cur); }
        if (!has_next) break;
#pragma unroll
        for (int a = 0; a < 2; ++a)
#pragma unroll
            for (int b = 0; b < 2; ++b)
#pragma unroll
                for (int m = 0; m < 4; ++m)
#pragma unroll
                    for (int n = 0; n < 2; ++n) acc[a][b][m][n] = (f32x4){0.f, 0.f, 0.f, 0.f};
        cur = nxt; cA = nA; cB = nB; ++ui;
        if constexpr (ALIGN_EPI) { if (wr == 1) PG8_BAR; }
    }
    PG8_WAIT_V(0);
    if constexpr (!ALIGN_EPI) { if (wr == 0) PG8_BAR; }
    PG8_BAR;
    if constexpr (Epi::AFTER_DRAIN) { E.fused(acc, cur, wr, wc, fr, fq, lds, wid, lane); S.done(cur); }
#undef PG8_SA
#undef PG8_SB
#undef PG8_STAGE
#undef PG8_LDA
#undef PG8_LDB
#undef PG8_MMA
#undef PG8_WAIT_V
#undef PG8_WAIT_L
#undef PG8_BAR
#undef PG8_SCHED
}
}
#include <hip/hip_bf16.h>
#include <cmath>
namespace attn_body {
using bf16=__hip_bfloat16;
using bf16x8=__attribute__((ext_vector_type(8)))short;
using s16x4=__attribute__((ext_vector_type(4)))short;
using f32x16=__attribute__((ext_vector_type(16)))float;
using u32x4=__attribute__((ext_vector_type(4)))unsigned;
using f32x4b=__attribute__((ext_vector_type(4)))float;
constexpr int BATCH=8,NHEAD=16,SEQ=2048,D=64,DM=4096,DMO=1024;
constexpr int NW=8,QBLK=32,QB=QBLK*NW,KVBLK=64,NQB=SEQ/QB;
constexpr int ATTN_PITCH=DM, ATTN_UNIT_ROWS=QB;
constexpr int LDS_BIAS_OFF=86016;
__device__ __forceinline__ int crow(int r,int hi){return (r&3)+8*(r>>2)+4*hi;}
#define SBAR() __builtin_amdgcn_sched_barrier(0)
__device__ __forceinline__ void cmask(f32x16&p0,f32x16&p1,int jb,int qrel,int hi){
  const float NEG=-INFINITY; int kb=64*jb+4*hi;
  #pragma unroll
  for(int r=0;r<16;++r){int kv=kb+(r&3)+8*(r>>2); if(kv>qrel)p0[r]=NEG; if(kv+32>qrel)p1[r]=NEG;}
}

constexpr int NSLOT=3, SLOTB=8192;
constexpr int LDS_K=0, LDS_V=NSLOT*SLOTB, LDS_WS=2*NSLOT*SLOTB, LDS_OST=LDS_WS+NW*64*4, LDS_BYTES=LDS_OST+NW*4096;
constexpr float C2=0.125f*1.4426950408889634f;
__device__ __forceinline__ void glds16(const void*gsrc,unsigned lds_dst){unsigned keep;
  asm volatile("s_mov_b32 %0, m0\n\ts_mov_b32 m0, %2\n\ts_nop 0\n\tglobal_load_lds_dwordx4 %1, off\n\ts_mov_b32 m0, %0":"=&s"(keep):"v"(gsrc),"s"(lds_dst):"memory");}
__device__ __forceinline__ float max3f(float a,float b,float c){float r;asm("v_max3_f32 %0, %1, %2, %3":"=v"(r):"v"(a),"v"(b),"v"(c));return r;}
__device__ __forceinline__ float max2f(float a,float b){float r;asm("v_max_f32_e32 %0, %1, %2":"=v"(r):"v"(a),"v"(b));return r;}
__device__ __forceinline__ float fadd_s(float a,float b){float r;asm("v_add_f32_e32 %0, %1, %2":"=v"(r):"v"(a),"v"(b));return r;}
__device__ __forceinline__ float fsub_s(float a,float b){float r;asm("v_sub_f32_e32 %0, %1, %2":"=v"(r):"v"(a),"v"(b));return r;}
typedef float f32x2_t __attribute__((ext_vector_type(2))); typedef __bf16 bf16x2_t __attribute__((ext_vector_type(2)));
__device__ __forceinline__ unsigned cvtpk_s(float lo,float hi){f32x2_t v={lo,hi};bf16x2_t b=__builtin_convertvector(v,bf16x2_t);return __builtin_bit_cast(unsigned,b);}
#define WAIT_BAR(N) asm volatile("s_waitcnt vmcnt(" #N ") lgkmcnt(0)\n\ts_barrier":::"memory")

__device__ __forceinline__ void qkt(f32x16&p0,f32x16&p1,const char*Kslot,const bf16x8*qr,const f32x16&negm,int r32,int hi){
  const char*kb=Kslot+hi*1024+r32*16;
  #pragma unroll
  for(int d0=0;d0<4;++d0){
    const bf16x8 b0=*reinterpret_cast<const bf16x8*>(kb+d0*2048);
    const bf16x8 b1=*reinterpret_cast<const bf16x8*>(kb+d0*2048+512);
    if(d0==0){p0=__builtin_amdgcn_mfma_f32_32x32x16_bf16(b0,qr[0],negm,0,0,0);p1=__builtin_amdgcn_mfma_f32_32x32x16_bf16(b1,qr[0],negm,0,0,0);}
    else{p0=__builtin_amdgcn_mfma_f32_32x32x16_bf16(b0,qr[d0],p0,0,0,0);p1=__builtin_amdgcn_mfma_f32_32x32x16_bf16(b1,qr[d0],p1,0,0,0);}}
}
typedef __attribute__((address_space(3))) const char* lds_cptr;
typedef short v4i16_t __attribute__((ext_vector_type(4)));
__device__ __forceinline__ void kload8(bf16x8*kf,lds_cptr kp){
  kf[0]=*(const __attribute__((address_space(3))) bf16x8*)(kp);      kf[1]=*(const __attribute__((address_space(3))) bf16x8*)(kp+512);
  kf[2]=*(const __attribute__((address_space(3))) bf16x8*)(kp+2048); kf[3]=*(const __attribute__((address_space(3))) bf16x8*)(kp+2560);
  kf[4]=*(const __attribute__((address_space(3))) bf16x8*)(kp+4096); kf[5]=*(const __attribute__((address_space(3))) bf16x8*)(kp+4608);
  kf[6]=*(const __attribute__((address_space(3))) bf16x8*)(kp+6144); kf[7]=*(const __attribute__((address_space(3))) bf16x8*)(kp+6656);
}
__device__ __forceinline__ void kload2(bf16x8*kf,lds_cptr kp,int j){ kf[2*j]=*(const __attribute__((address_space(3))) bf16x8*)(kp+j*2048); kf[2*j+1]=*(const __attribute__((address_space(3))) bf16x8*)(kp+j*2048+512); }
__device__ __forceinline__ s16x4 vtr(lds_cptr p){ return __builtin_bit_cast(s16x4,__builtin_amdgcn_ds_read_tr16_b64_v4i16((__attribute__((address_space(3))) v4i16_t*)p)); }
__device__ __forceinline__ float rowmax(const f32x16&p0,const f32x16&p1){
  float a=max3f(p0[0],p0[1],p1[0]),b=max3f(p0[2],p0[3],p1[1]);a=max3f(a,p1[2],p1[3]);
  #pragma unroll
  for(int r=4;r<16;r+=4){a=max3f(a,p0[r],p0[r+1]);b=max3f(b,p0[r+2],p0[r+3]);a=max3f(a,p1[r],p1[r+1]);b=max3f(b,p1[r+2],p1[r+3]);}
  const float m=max2f(a,b);
  auto rr=__builtin_amdgcn_permlane32_swap(__float_as_uint(m),__float_as_uint(m),false,false);
  return max2f(__uint_as_float(rr[0]),__uint_as_float(rr[1]));
}
__device__ __forceinline__ void pv(f32x16*o,int vb,bf16x8 pa0,bf16x8 pa1,bf16x8 pa2,bf16x8 pa3){
  #pragma unroll
  for(int d0=0;d0<2;++d0){s16x4 lo[4],hi[4];
    #pragma unroll
    for(int ks=0;ks<4;++ks){
      asm volatile("ds_read_b64_tr_b16 %0,%1 offset:%c2":"=&v"(lo[ks]):"v"(vb),"i"(d0*4096+ks*1024):"memory");
      asm volatile("ds_read_b64_tr_b16 %0,%1 offset:%c2":"=&v"(hi[ks]):"v"(vb),"i"(d0*4096+ks*1024+512):"memory");}
    asm volatile("s_waitcnt lgkmcnt(0)":::"memory");SBAR();
    #define PK(k) (bf16x8){lo[k][0],lo[k][1],lo[k][2],lo[k][3],hi[k][0],hi[k][1],hi[k][2],hi[k][3]}
    o[d0]=__builtin_amdgcn_mfma_f32_32x32x16_bf16(pa0,PK(0),o[d0],0,0,0);
    o[d0]=__builtin_amdgcn_mfma_f32_32x32x16_bf16(pa1,PK(1),o[d0],0,0,0);
    o[d0]=__builtin_amdgcn_mfma_f32_32x32x16_bf16(pa2,PK(2),o[d0],0,0,0);
    o[d0]=__builtin_amdgcn_mfma_f32_32x32x16_bf16(pa3,PK(3),o[d0],0,0,0);
    #undef PK
  }
}

#ifndef ATTN_STORE16
#define ATTN_STORE16(p,v) (*(u32x4*)(p)=(v))
#endif
template<int THRL> __device__ __forceinline__ void attn_unit(int b,int h,int qb,const bf16*Q,const bf16*__restrict__ K,const bf16*__restrict__ V,const bf16*__restrict__ OG,const float*__restrict__ CUM,bf16*O,char*shm){
  const int tid=opaque_tid(),lane=tid&63,r32=lane&31,hi=lane>>5; const int wid=__builtin_amdgcn_readfirstlane(tid>>6);
  const long rowbase=(long)b*SEQ; const int q0=qb*QB;
  const bf16*Qw=Q+(rowbase+q0+wid*QBLK)*DM+h*D;
  const bf16*Kh=K+rowbase*DM+h*D,*Vh=V+rowbase*DM+h*D;
  const unsigned lds0=(unsigned)(uintptr_t)shm;
  float*wsf=(float*)(shm+LDS_WS)+wid*64;
  const bf16*ksrc=Kh+(long)lane*DM+wid*8;
  const bf16*vsrc=Vh+(long)(16*(wid&3)+(lane>>2))*DM+(wid>>2)*32+(lane&3)*8;
  const unsigned kdst=lds0+LDS_K+wid*1024, vdst=lds0+LDS_V+wid*1024;
  #define DMA_K(t,slot) glds16(ksrc+(long)(t)*KVBLK*DM,(unsigned)__builtin_amdgcn_readfirstlane(kdst+(slot)))
  #define DMA_V(t,slot) glds16(vsrc+(long)(t)*KVBLK*DM,(unsigned)__builtin_amdgcn_readfirstlane(vdst+(slot)))
  const int vb0=(int)(lds0+LDS_V)+((lane>>4)&1)*32+(lane&3)*8+(4*hi+((lane&15)>>2))*64;
  const char*Kbase=shm+LDS_K; bf16x8 kf[8];
  const lds_cptr shm3=(lds_cptr)shm; const lds_cptr kp0=shm3+LDS_K+hi*1024+r32*16; const lds_cptr vp0=shm3+LDS_V+((lane>>4)&1)*32+(lane&3)*8+(4*hi+((lane&15)>>2))*64;
  const int NT=(q0+QB)/KVBLK;
  { float*bl=(float*)(shm+LDS_BIAS_OFF); const float*cs=CUM+((long)b*NHEAD+h)*SEQ;
    for(int j=tid;j<q0+QB;j+=NW*64)bl[j]=cs[j]*(-1.4426950408889634f);
    asm volatile("s_waitcnt vmcnt(0) lgkmcnt(0)\n\ts_barrier":::"memory"); }
  const lds_cptr bp0=(lds_cptr)shm+LDS_BIAS_OFF+hi*16;
  #define BIAS(P0,P1,t) do{ const lds_cptr bp_=bp0+(t)*256; \
    _Pragma("unroll") for(int g_=0;g_<4;++g_){ const f32x4b b0_=*(const __attribute__((address_space(3))) f32x4b*)(bp_+g_*32); const f32x4b b1_=*(const __attribute__((address_space(3))) f32x4b*)(bp_+128+g_*32); \
      P0[4*g_]+=b0_[0];P0[4*g_+1]+=b0_[1];P0[4*g_+2]+=b0_[2];P0[4*g_+3]+=b0_[3]; P1[4*g_]+=b1_[0];P1[4*g_+1]+=b1_[1];P1[4*g_+2]+=b1_[2];P1[4*g_+3]+=b1_[3]; } }while(0)
  DMA_K(0,0);DMA_V(0,0);DMA_K(1,SLOTB);
  bf16x8 qr[4];
  #pragma unroll
  for(int d0=0;d0<4;++d0)qr[d0]=*reinterpret_cast<const bf16x8*>(&Qw[(long)r32*DM+d0*16+hi*8]);
  float mhat=0.f,l_reg=0.f;f32x16 o[2];o[0]=f32x16{};o[1]=f32x16{};f32x16 negm=f32x16{};asm volatile("":"+v"(negm));
  const int qrel=wid*QBLK+r32;
  #define CMASK(P0,P1,t) do{int jb_=(t)-(NT-4); if(jb_>=0)cmask(P0,P1,jb_,qrel,hi);}while(0)
  bool resc=false;
  #define START(P0,P1) do{ const float rm=rowmax(P0,P1); resc=false; \
    { const float dl=rm; mhat=fadd_s(mhat,dl); \
      _Pragma("unroll") for(int r=0;r<16;++r){P0[r]=fsub_s(P0[r],dl);P1[r]=fsub_s(P1[r],dl);} \
      _Pragma("unroll") for(int r=0;r<16;++r)negm[r]=-mhat; asm volatile("":"+v"(negm)); } \
    _Pragma("unroll") for(int r=0;r<16;++r)P0[r]=__builtin_amdgcn_exp2f(P0[r]); }while(0)
  #define RESC() do{ if(resc){ asm volatile("s_waitcnt lgkmcnt(0)":::"memory"); \
      _Pragma("unroll") for(int d_=0;d_<2;++d_) _Pragma("unroll") for(int r=0;r<16;++r)o[d_][r]*=wsf[crow(r,hi)]; } }while(0)
  f32x16 pA0,pA1,pB0,pB1;
  int sl_prev=0,sl_cur=0,sl_next=SLOTB;
  #define ROT() do{sl_prev=sl_cur;sl_cur=sl_next;sl_next=(sl_next==(NSLOT-1)*SLOTB)?0:sl_next+SLOTB;}while(0)
  DMA_K(2,2*SLOTB);
  WAIT_BAR(3);
  qkt(pA0,pA1,Kbase,qr,negm,r32,hi);asm volatile("s_nop 15\n\ts_nop 7":"+v"(pA0),"+v"(pA1));BIAS(pA0,pA1,0);CMASK(pA0,pA1,0);
  START(pA0,pA1);
  _Pragma("unroll") for(int r=0;r<16;++r)pA1[r]=__builtin_amdgcn_exp2f(pA1[r]);
  WAIT_BAR(0);
  DMA_K(3,0);DMA_V(1,SLOTB);
  ROT();
  kload8(kf,kp0+sl_cur);
  WAIT_BAR(2);
  s16x4 vlo[8],vhi[8]; u32x4 pw0,pw1,pw2,pw3;
  #define PKW(P,B) cvtpk_s(P[B],P[B+1])
  #define PAF(k) __builtin_bit_cast(bf16x8,pw##k)
  #define VFR(i) (bf16x8){vlo[i][0],vlo[i][1],vlo[i][2],vlo[i][3],vhi[i][0],vhi[i][1],vhi[i][2],vhi[i][3]}
  #define PIN(x) asm volatile("":"+v"(x))
  #define MX3(a,b,c) __builtin_fmaxf(__builtin_fmaxf((a),(b)),(c))
  #define GAPA(MF,A0,A1,A2,A3,W0,W1,PW) do{ MF; sacc+=A0; sacc+=A1; sacc+=A2; sacc+=A3; PIN(sacc); W0; W1; PIN(PW); SBAR(); }while(0)
  #define EX(v) __builtin_amdgcn_exp2f(v)
  #define GAPB(MF,X,B) do{ MF; X[B]=EX(X[B]); X[B+1]=EX(X[B+1]); X[B+2]=EX(X[B+2]); X[B+3]=EX(X[B+3]); PIN(X); SBAR(); }while(0)
  #define VRD(i) do{ vlo[i]=vtr(vp_+(((i)>>2)*4096+((i)&3)*1024)); vhi[i]=vtr(vp_+(((i)>>2)*4096+((i)&3)*1024+512)); }while(0)
  #define KRD(G,j) do{ if(G){ kload2(kf,kp0+sl_next,j); SBAR(); } }while(0)
  #define STEP(C0,C1,P0,P1,t,GK,GV,GL) do{ SBAR(); \
    const lds_cptr vp_=vp0+sl_prev; \
    VRD(0); SBAR(); float sacc=(P0[0]+P0[1]); \
    GAPA(C0=__builtin_amdgcn_mfma_f32_32x32x16_bf16(kf[0],qr[0],negm,0,0,0), P0[2],P0[3],P0[4],P0[5],     pw0[0]=PKW(P0,0), pw0[1]=PKW(P0,2), pw0); \
    VRD(4); SBAR(); GAPA(C1=__builtin_amdgcn_mfma_f32_32x32x16_bf16(kf[1],qr[0],negm,0,0,0), P0[6],P0[7],P0[8],P0[9],     pw0[2]=PKW(P0,4), pw0[3]=PKW(P0,6), pw0); \
    VRD(1); SBAR(); GAPA(C0=__builtin_amdgcn_mfma_f32_32x32x16_bf16(kf[2],qr[1],C0,0,0,0),   P0[10],P0[11],P0[12],P0[13], pw1[0]=PKW(P0,8), pw1[1]=PKW(P0,10), pw1); \
    VRD(5); SBAR(); GAPA(C1=__builtin_amdgcn_mfma_f32_32x32x16_bf16(kf[3],qr[1],C1,0,0,0),   P0[14],P0[15],P1[0],P1[1],   pw1[2]=PKW(P0,12),pw1[3]=PKW(P0,14), pw1); \
    VRD(2); SBAR(); GAPA(C0=__builtin_amdgcn_mfma_f32_32x32x16_bf16(kf[4],qr[2],C0,0,0,0),   P1[2],P1[3],P1[4],P1[5],     pw2[0]=PKW(P1,0), pw2[1]=PKW(P1,2), pw2); \
    VRD(6); SBAR(); GAPA(C1=__builtin_amdgcn_mfma_f32_32x32x16_bf16(kf[5],qr[2],C1,0,0,0),   P1[6],P1[7],P1[8],P1[9],     pw2[2]=PKW(P1,4), pw2[3]=PKW(P1,6), pw2); \
    VRD(3); SBAR(); GAPA(C0=__builtin_amdgcn_mfma_f32_32x32x16_bf16(kf[6],qr[3],C0,0,0,0),   P1[10],P1[11],P1[12],P1[13], pw3[0]=PKW(P1,8), pw3[1]=PKW(P1,10), pw3); \
    VRD(7); SBAR(); GAPA(C1=__builtin_amdgcn_mfma_f32_32x32x16_bf16(kf[7],qr[3],C1,0,0,0),   P1[14],P1[15],0.f,0.f,       pw3[2]=PKW(P1,12),pw3[3]=PKW(P1,14), pw3); \
    l_reg+=sacc; \
    if(GK){DMA_K((t)+3,sl_cur);} if(GV){DMA_V((t)+1,sl_next);} \
    BIAS(C0,C1,t); \
    CMASK(C0,C1,t); \
    { float a=MX3(C0[0],C0[1],C1[0]),b=MX3(C0[2],C0[3],C1[1]); a=MX3(a,C1[2],C1[3]); \
      _Pragma("unroll") for(int r=4;r<16;r+=4){a=MX3(a,C0[r],C0[r+1]);b=MX3(b,C0[r+2],C0[r+3]);a=MX3(a,C1[r],C1[r+1]);b=MX3(b,C1[r+2],C1[r+3]);} \
      float rm=__builtin_fmaxf(a,b); { auto rr=__builtin_amdgcn_permlane32_swap(__float_as_uint(rm),__float_as_uint(rm),false,false); rm=__builtin_fmaxf(__uint_as_float(rr[0]),__uint_as_float(rr[1])); } \
      resc=false; \
      if(__builtin_expect(__any(rm>(float)THRL),0)){ const float dl=__builtin_fmaxf(rm,0.f); mhat+=dl; \
        _Pragma("unroll") for(int r=0;r<16;++r){C0[r]-=dl;C1[r]-=dl;} \
        _Pragma("unroll") for(int r=0;r<16;++r)negm[r]=-mhat; asm volatile("":"+v"(negm)); \
        const float f=__builtin_amdgcn_exp2f(-dl); l_reg*=f; if(hi==0)wsf[r32]=f; resc=true; } } \
    SBAR(); \
    GAPB(o[0]=__builtin_amdgcn_mfma_f32_32x32x16_bf16(PAF(0),VFR(0),o[0],0,0,0), C0,0); \
    GAPB(o[1]=__builtin_amdgcn_mfma_f32_32x32x16_bf16(PAF(0),VFR(4),o[1],0,0,0), C0,4); \
    KRD(GL,0); GAPB(o[0]=__builtin_amdgcn_mfma_f32_32x32x16_bf16(PAF(1),VFR(1),o[0],0,0,0), C0,8); \
    KRD(GL,1); GAPB(o[1]=__builtin_amdgcn_mfma_f32_32x32x16_bf16(PAF(1),VFR(5),o[1],0,0,0), C0,12); \
    KRD(GL,2); GAPB(o[0]=__builtin_amdgcn_mfma_f32_32x32x16_bf16(PAF(2),VFR(2),o[0],0,0,0), C1,0); \
    KRD(GL,3); GAPB(o[1]=__builtin_amdgcn_mfma_f32_32x32x16_bf16(PAF(2),VFR(6),o[1],0,0,0), C1,4); \
    GAPB(o[0]=__builtin_amdgcn_mfma_f32_32x32x16_bf16(PAF(3),VFR(3),o[0],0,0,0), C1,8); \
    GAPB(o[1]=__builtin_amdgcn_mfma_f32_32x32x16_bf16(PAF(3),VFR(7),o[1],0,0,0), C1,12); \
    }while(0)
  int t=1;
  #undef CMASK
  #define CMASK(P0,P1,t) do{}while(0)
  for(;t+5<NT;t+=2){
    STEP(pB0,pB1,pA0,pA1,t,true,true,true);     WAIT_BAR(2); RESC(); ROT();
    STEP(pA0,pA1,pB0,pB1,t+1,true,true,true);   WAIT_BAR(2); RESC(); ROT();
  }
  #undef CMASK
  #define CMASK(P0,P1,t) do{int jb_=(t)-(NT-4); if(jb_>=0)cmask(P0,P1,jb_,qrel,hi);}while(0)
  #define ENDW(tt) do{ if((tt)+3<NT){WAIT_BAR(2);} else if((tt)+2<NT){WAIT_BAR(1);} else {WAIT_BAR(0);} }while(0)
  for(;t+1<NT;t+=2){
    STEP(pB0,pB1,pA0,pA1,t,(t+3<NT),(t+1<NT),(t+1<NT));       ENDW(t);   RESC(); ROT();
    STEP(pA0,pA1,pB0,pB1,t+1,(t+4<NT),(t+2<NT),(t+2<NT));     ENDW(t+1); RESC(); ROT();
  }
  STEP(pB0,pB1,pA0,pA1,NT-1,false,false,false); RESC();
  { float sacc=pB0[0]+pB0[1]; _Pragma("unroll") for(int r=2;r<16;++r)sacc+=pB0[r]; _Pragma("unroll") for(int r=0;r<16;++r)sacc+=pB1[r]; l_reg+=sacc;
    pw0=(u32x4){PKW(pB0,0),PKW(pB0,2),PKW(pB0,4),PKW(pB0,6)};pw1=(u32x4){PKW(pB0,8),PKW(pB0,10),PKW(pB0,12),PKW(pB0,14)};pw2=(u32x4){PKW(pB1,0),PKW(pB1,2),PKW(pB1,4),PKW(pB1,6)};pw3=(u32x4){PKW(pB1,8),PKW(pB1,10),PKW(pB1,12),PKW(pB1,14)};
    SBAR(); pv(o,vb0+sl_cur,PAF(0),PAF(1),PAF(2),PAF(3)); }
  #undef PKW
  #undef PAF
  #undef VFR
  #undef PIN
  #undef MX3
  #undef GAPA
  #undef GAPB
  #undef EX
  #undef VRD
  #undef KRD
  #undef STEP
  #undef ENDW
  {auto rr=__builtin_amdgcn_permlane32_swap(__float_as_uint(l_reg),__float_as_uint(l_reg),false,false);l_reg=__uint_as_float(rr[0])+__uint_as_float(rr[1]);}
  if(hi==0)wsf[32+r32]=l_reg;asm volatile("s_waitcnt lgkmcnt(0)":::"memory");
  float rli[16];
  #pragma unroll
  for(int r=0;r<16;++r)rli[r]=__builtin_amdgcn_rcpf(wsf[32+crow(r,hi)]);
  bf16*Ow=O+(rowbase+q0+wid*QBLK)*DMO+h*D; const bf16*Gw=OG+(rowbase+q0+wid*QBLK)*DM+h*D;
  { bf16*stg=(bf16*)(shm+LDS_OST)+wid*2048;
    #pragma unroll
    for(int r=0;r<16;++r){const int orow=crow(r,hi);
      #pragma unroll
      for(int d0=0;d0<2;++d0)stg[orow*64+d0*32+r32]=__float2bfloat16(o[d0][r]*rli[r]);}
    asm volatile("s_waitcnt lgkmcnt(0)":::"memory");
    #pragma unroll
    for(int i=0;i<4;++i){const int row=i*8+(lane>>3),ch=lane&7; u32x4 v=*(const u32x4*)(stg+row*64+ch*8); const u32x4 g=*(const u32x4*)(Gw+(long)row*DM+ch*8);
      #pragma unroll
      for(int e=0;e<4;++e){ const float o0=__uint_as_float(v[e]<<16),o1=__uint_as_float(v[e]&0xffff0000u),g0=__uint_as_float(g[e]<<16),g1=__uint_as_float(g[e]&0xffff0000u);
        v[e]=cvtpk_s(o0*__builtin_amdgcn_rcpf(1.0f+__builtin_amdgcn_exp2f(-1.4426950408889634f*g0)),o1*__builtin_amdgcn_rcpf(1.0f+__builtin_amdgcn_exp2f(-1.4426950408889634f*g1))); }
      ATTN_STORE16(Ow+(long)row*DMO+ch*8,v);} }
  asm volatile("s_waitcnt lgkmcnt(0)\n\ts_barrier":::"memory");
  #undef DMA_K
  #undef DMA_V
  #undef BIAS
  #undef CMASK
  #undef START
  #undef RESC
  #undef ROT
}
constexpr int ATTN_LDS_BYTES=LDS_BYTES;
struct AttnTensors { const bf16* Q; const bf16* K; const bf16* V; const bf16* OG; const float* CUM; bf16* O; };
struct AttnUnit { int bh; int qb; };
struct StaticOrder {
  int vcu, stride;
  __device__ __forceinline__ explicit StaticOrder(int grid,int block):vcu((grid%8==0)?(block%8)*(grid/8)+block/8:block),stride(grid){}
  __device__ __forceinline__ bool next(int i,AttnUnit&u)const{ const int su=vcu+(i>>2)*stride; if(su>=256)return false; const int p=su&1,k=i&3; u.bh=su>>1; u.qb=(k==0)?p:(k==1)?7-p:(k==2)?2+p:5-p; return true; }
  __device__ __forceinline__ void a_ready(const AttnUnit&)const{}
  __device__ __forceinline__ void done(const AttnUnit&)const{}
};
template<class Sched,int THRL=8> __device__ __forceinline__ void attn_phase(char*lds,const AttnTensors&T,const Sched&S){
  AttnUnit u;
  for(int i=0;S.next(i,u);++i){ S.a_ready(u); attn_unit<THRL>(u.bh/NHEAD,u.bh%NHEAD,u.qb,T.Q,T.K,T.V,T.OG,T.CUM,T.O,lds); S.done(u); }
}
#undef SBAR
#undef WAIT_BAR
}
#define GAS __attribute__((address_space(1)))
#define LAS __attribute__((address_space(3)))
typedef GAS unsigned gu32;
typedef GAS unsigned long long gu64;
#define RLX_AGENT __ATOMIC_RELAXED, __HIP_MEMORY_SCOPE_AGENT
#define XB_TMO      128
#define XB_XCNT(j)  (256  + 64 * (j))
#define XB_XSUB(j)  (1280 + 64 * (j))
#define XB_XGEN(j)  (2304 + 64 * (j))
#define XB_TOP      3328
#define XB_TOPGEN   3392
#define XCD_BAR_WORDS 3456
#define XB_SPIN_CAP (1u << 18)

__device__ __forceinline__ unsigned xb_ld(unsigned* p)              { return __hip_atomic_load(p, __ATOMIC_RELAXED, __HIP_MEMORY_SCOPE_AGENT); }
__device__ __forceinline__ unsigned xb_add(unsigned* p, unsigned v) { return __hip_atomic_fetch_add(p, v, __ATOMIC_RELAXED, __HIP_MEMORY_SCOPE_AGENT); }
__device__ __forceinline__ unsigned xb_xcc_id() { return (unsigned)__builtin_amdgcn_s_getreg((3 << 11) | 20) & 0xFu; }
#define XB_SPIN(cond, bar) do { unsigned _sp = 0; while (cond) { __builtin_amdgcn_s_sleep(1); \
    if ((++_sp & 255u) == 0u) { if (xb_ld(&(bar)[XB_TMO])) break; if (_sp > XB_SPIN_CAP) { atomicAdd(&(bar)[XB_TMO], 1u); break; } } } } while (0)

struct XcdBarrier {
    unsigned* bar; unsigned x;
    volatile LAS unsigned* st;
};

__device__ __forceinline__ XcdBarrier xcd_barrier_post(unsigned* bar, volatile LAS unsigned* st) {
    XcdBarrier b; b.bar = bar; b.x = xb_xcc_id(); b.st = st;
    if (threadIdx.x == 0) (void)xb_add(&bar[XB_XCNT(b.x)], 1u);
    return b;
}
__device__ __forceinline__ void xcd_barrier_complete(unsigned* bar, unsigned x, unsigned& nloc, unsigned& nx) {
    const unsigned G = gridDim.x * gridDim.y * gridDim.z;
    unsigned sum, cnt, mine, sp = 0u;
    for (;;) {
        sum = 0u; cnt = 0u; mine = 0u;
#pragma unroll
        for (unsigned j = 0; j < 16; ++j) { const unsigned c = xb_ld(&bar[XB_XCNT(j)]); sum += c; cnt += (c > 0u) ? 1u : 0u; mine = (j == x) ? c : mine; }
        if (sum == G) break;
        __builtin_amdgcn_s_sleep(1);
        if ((++sp & 255u) == 0u) { if (xb_ld(&bar[XB_TMO])) break; if (sp > XB_SPIN_CAP) { atomicAdd(&bar[XB_TMO], 1u); break; } }
    }
    nloc = mine > 0u ? mine : 1u; nx = cnt > 0u ? cnt : 1u;
}

__device__ __forceinline__ void xcd_barrier(const XcdBarrier& b) {
    asm volatile("s_waitcnt vmcnt(0)" ::: "memory");
    __syncthreads();
    if (threadIdx.x == 0) {
        unsigned* bar = b.bar;
        __builtin_amdgcn_s_waitcnt(0);
        unsigned nloc = b.st[0], nx = b.st[1];
        if (nloc == 0u) { xcd_barrier_complete(bar, b.x, nloc, nx); b.st[0] = nloc; b.st[1] = nx; }
        const unsigned old = xb_add(&bar[XB_XSUB(b.x)], 1u);
        const unsigned gen = old / nloc;
        if (old + 1u == (gen + 1u) * nloc) {
            __builtin_amdgcn_fence(__ATOMIC_RELEASE, "agent");
            asm volatile("s_waitcnt vmcnt(0)" ::: "memory");
            const unsigned og = xb_add(&bar[XB_TOP], 1u);
            const unsigned tg = og / nx;
            if (og + 1u == (tg + 1u) * nx) xb_add(&bar[XB_TOPGEN], 1u);
            else XB_SPIN(xb_ld(&bar[XB_TOPGEN]) == tg, bar);
            __builtin_amdgcn_fence(__ATOMIC_ACQUIRE, "agent");
            xb_add(&bar[XB_XGEN(b.x)], 1u);
            asm volatile("s_waitcnt vmcnt(0)" ::: "memory");
        } else {
            XB_SPIN(xb_ld(&bar[XB_XGEN(b.x)]) == gen, bar);
            __builtin_amdgcn_fence(__ATOMIC_ACQUIRE, "agent");
            asm volatile("s_waitcnt vmcnt(0)" ::: "memory");
        }
    }
    __syncthreads();
}

typedef unsigned short bf16_t;
typedef short bf16x8_t __attribute__((ext_vector_type(8)));
typedef float f32x4_t __attribute__((ext_vector_type(4)));
constexpr int T_TOK = 16384, DM = 1024, SEQ = 2048, NBATCH = 8;
constexpr int L0_COLS = 3848, L0_MAIN = 3840, L1_COLS = 4112, L1_MAIN = 4096;
constexpr float DN_ALPHA = 1.4142135623730951f;
constexpr float LN_EPS = 1e-5f;
constexpr int NTHR = 512;

__device__ __forceinline__ unsigned f2bf(float f) { unsigned u = __float_as_uint(f); return (u + 0x7fffu + ((u >> 16) & 1u)) >> 16; }
__device__ __forceinline__ unsigned pk2(float lo, float hi) { return f2bf(lo) | (f2bf(hi) << 16); }
__device__ __forceinline__ float bflo(unsigned w) { return __uint_as_float(w << 16); }
__device__ __forceinline__ float bfhi(unsigned w) { return __uint_as_float(w & 0xffff0000u); }
__device__ __forceinline__ float bf2f(bf16_t h) { return __uint_as_float(((unsigned)h) << 16); }
template <int CTRL, int RM> __device__ __forceinline__ float dpp_f(float x) { return __builtin_bit_cast(float, __builtin_amdgcn_update_dpp(0, __builtin_bit_cast(int, x), CTRL, RM, 0xF, true)); }
__device__ __forceinline__ float red4_sum(float x) { x += dpp_f<0xB1, 0xF>(x); x += dpp_f<0x4E, 0xF>(x); return x; }
__device__ __forceinline__ float red8_sum(float x) { x = red4_sum(x); x += dpp_f<0x141, 0xF>(x); return x; }
__device__ __forceinline__ float red16_sum(float x) { x = red8_sum(x); x += dpp_f<0x140, 0xF>(x); return x; }
__device__ __forceinline__ float wave_sum(float x) { x = red16_sum(x); x += dpp_f<0x142, 0xA>(x); x += dpp_f<0x143, 0xC>(x);
    return __builtin_bit_cast(float, __builtin_amdgcn_readlane(__builtin_bit_cast(int, x), 63)); }
__device__ __forceinline__ float wave_max(float x) { x = fmaxf(x, dpp_f<0xB1, 0xF>(x)); x = fmaxf(x, dpp_f<0x4E, 0xF>(x)); x = fmaxf(x, dpp_f<0x141, 0xF>(x)); x = fmaxf(x, dpp_f<0x140, 0xF>(x));
    x = fmaxf(x, __shfl_xor(x, 16)); x = fmaxf(x, __shfl_xor(x, 32)); return x; }
__device__ __forceinline__ float sigmoid_f(float x) { return 1.0f / (1.0f + __expf(-x)); }
__device__ __forceinline__ float log_sigmoid_f(float x) { return fminf(x, 0.f) - log1pf(__expf(-fabsf(x))); }
__device__ __forceinline__ void unpack8(const uint4 w, float* f) {
    f[0] = bflo(w.x); f[1] = bfhi(w.x); f[2] = bflo(w.y); f[3] = bfhi(w.y); f[4] = bflo(w.z); f[5] = bfhi(w.z); f[6] = bflo(w.w); f[7] = bfhi(w.w);
}
__device__ __forceinline__ void unpack4(const uint2 w, float* f) { f[0] = bflo(w.x); f[1] = bfhi(w.x); f[2] = bflo(w.y); f[3] = bfhi(w.y); }

__device__ __forceinline__ void transpose_cvt_phase(const float* __restrict__ W, int K, int ldw, int c0, int N, bf16_t* __restrict__ WT, int bid, int nblk, float* tile  ) {
    const int nb = N / 64, nunits = (K / 64) * nb;
    for (int u = bid; u < nunits; u += nblk) {
        const int kb = u / nb, nbi = u % nb; const int k0 = kb * 64, n0 = nbi * 64;
        for (int i = opaque_tid(); i < 4096; i += NTHR) { const int kk = i >> 6, nn = i & 63; tile[kk * 65 + nn] = W[(size_t)(k0 + kk) * ldw + c0 + n0 + nn]; }
        __syncthreads();
        for (int i = opaque_tid(); i < 2048; i += NTHR) { const int nn = i >> 5, kp = (i & 31) * 2;
            const unsigned v = pk2(tile[kp * 65 + nn], tile[(kp + 1) * 65 + nn]); *(unsigned*)(WT + (size_t)(n0 + nn) * K + k0 + kp) = v; }
        __syncthreads();
    }
}
__device__ __forceinline__ void cvt_bf16_phase(const float* __restrict__ src, bf16_t* __restrict__ dst, size_t n8, int bid, int nblk) {
    for (size_t i = (size_t)bid * NTHR + opaque_tid(); i < n8; i += (size_t)nblk * NTHR) {
        const float4 a = ((const float4*)src)[2 * i], b = ((const float4*)src)[2 * i + 1];
        uint4 o; o.x = pk2(a.x, a.y); o.y = pk2(a.z, a.w); o.z = pk2(b.x, b.y); o.w = pk2(b.z, b.w); ((uint4*)dst)[i] = o; }
}
__device__ __forceinline__ void build_wlr_phase(const float* __restrict__ w_up, const float* __restrict__ a_up, const float* __restrict__ g_up, bf16_t* __restrict__ WT, int bid, int nblk) {
    for (int i = bid * NTHR + opaque_tid(); i < 1536 * 256; i += nblk * NTHR) { const int n = i >> 8, k = i & 255; float v = 0.f;
        if (n < 512) { if (k < 64) v = w_up[k * 512 + n]; }
        else if (n < 1024) { if (k >= 64 && k < 128) v = a_up[(k - 64) * 512 + (n - 512)]; }
        else { if (k >= 128) v = g_up[(k - 128) * 512 + (n - 1024)]; }
        WT[i] = (bf16_t)f2bf(v); }
}

namespace pg8 {
struct EpiF32 {
    static constexpr bool PERM = false, AFTER_DRAIN = false;
    float* C; long ldc;
    __device__ __forceinline__ void operator()(const f32x4 (&acc)[2][2][4][2], const Unit& u, int wr, int wc, int fr, int fq) const {
        const int row0 = u.pm * BM + wr * 64 + fr, col0 = u.pn * BM + wc * 32 + 4 * fq;
#pragma unroll
        for (int ai = 0; ai < 2; ++ai)
#pragma unroll
            for (int m = 0; m < 4; ++m) { float* rowp = C + (size_t)(row0 + ai * HALF + m * 16) * ldc + col0;
#pragma unroll
                for (int bj = 0; bj < 2; ++bj)
#pragma unroll
                    for (int n = 0; n < 2; ++n) *(f32x4*)(rowp + bj * HALF + n * 16) = acc[ai][bj][m][n]; }
    }
};
struct EpiBf16P {
    static constexpr bool PERM = true, AFTER_DRAIN = false;
    bf16_t* O; long ldc;
    __device__ __forceinline__ void operator()(const f32x4 (&acc)[2][2][4][2], const Unit& u, int wr, int wc, int fr, int fq) const {
        const int row0 = u.pm * BM + wr * 64 + fr; const int col0 = u.pn * BM + wc * 32 + 8 * fq;
#pragma unroll
        for (int ai = 0; ai < 2; ++ai)
#pragma unroll
            for (int m = 0; m < 4; ++m) { bf16_t* rowp = O + (size_t)(row0 + ai * HALF + m * 16) * ldc + col0;
#pragma unroll
                for (int bj = 0; bj < 2; ++bj) { const f32x4 v0 = acc[ai][bj][m][0], v1 = acc[ai][bj][m][1];
                    u32x4 w; w.x = cvt_pk_bf16(v0[0], v0[1]); w.y = cvt_pk_bf16(v0[2], v0[3]); w.z = cvt_pk_bf16(v1[0], v1[1]); w.w = cvt_pk_bf16(v1[2], v1[3]);
                    *(u32x4*)(rowp + bj * HALF) = w; } }
    }
};
struct EpiLowrank {
    static constexpr bool PERM = false, AFTER_DRAIN = false;
    float* lrw; bf16_t* lra; bf16_t* lrg; const float* w0; const float* a0;
    __device__ __forceinline__ void operator()(const f32x4 (&acc)[2][2][4][2], const Unit& u, int wr, int wc, int fr, int fq) const {
        const int row0 = u.pm * BM + wr * 64 + fr; const int sel = u.pn >> 1; const int colb = (u.pn & 1) * BM + wc * 32 + 4 * fq;
#pragma unroll
        for (int ai = 0; ai < 2; ++ai)
#pragma unroll
            for (int m = 0; m < 4; ++m) { const size_t rowoff = (size_t)(row0 + ai * HALF + m * 16) * 512;
#pragma unroll
                for (int bj = 0; bj < 2; ++bj)
#pragma unroll
                    for (int n = 0; n < 2; ++n) { const int c = colb + bj * HALF + n * 16; f32x4 v = acc[ai][bj][m][n];
                        if (sel == 0) { const f32x4 bv = *(const f32x4*)(w0 + c); *(f32x4*)(lrw + rowoff + c) = v + bv; }
                        else if (sel == 1) { const f32x4 bv = *(const f32x4*)(a0 + c); v = v + bv; uint2 o; o.x = pk2(v[0], v[1]); o.y = pk2(v[2], v[3]); *(uint2*)(lra + rowoff + c) = o; }
                        else { uint2 o; o.x = pk2(v[0], v[1]); o.y = pk2(v[2], v[3]); *(uint2*)(lrg + rowoff + c) = o; } } }
    }
};
}

template <int NG>
__device__ __forceinline__ void gates_phase(const float* X, const float* __restrict__ W, int ldw, int c0, float* __restrict__ out, int bid, int nblk, float* wg  ) {
    for (int i = opaque_tid(); i < NG * 1024; i += NTHR) { const int k = i / NG, g = i % NG; wg[g * 1024 + k] = W[(size_t)k * ldw + c0 + g]; }
    __syncthreads();
    const int lane = opaque_tid() & 63, wv = opaque_tid() >> 6;
    for (int t = bid * 8 + wv; t < T_TOK; t += nblk * 8) {
        float x[16];
#pragma unroll
        for (int j = 0; j < 16; ++j) x[j] = X[(size_t)t * 1024 + lane + 64 * j];
#pragma unroll 1
        for (int g = 0; g < NG; ++g) { float p = 0.f;
#pragma unroll
            for (int j = 0; j < 16; ++j) p += x[j] * wg[g * 1024 + lane + 64 * j];
            p = wave_sum(p); if (lane == 0) out[(size_t)t * 16 + g] = p; }
    }
    __syncthreads();
}
__device__ __forceinline__ void rwkv_prep_phase(const bf16_t* __restrict__ P0, const float* __restrict__ mu, bf16_t* __restrict__ App, int bid, int nblk) {
    for (size_t i = (size_t)bid * NTHR + opaque_tid(); i < (size_t)T_TOK * 256; i += (size_t)nblk * NTHR) {
        const int t = (int)(i >> 8), c = (int)(i & 255), col = 1536 + c;
        const float cur = bf2f(P0[(size_t)t * L0_MAIN + col]); const float prev = (t % SEQ) ? bf2f(P0[(size_t)(t - 1) * L0_MAIN + col]) : 0.f;
        float v = cur + (prev - cur) * mu[col];
        if (c < 64) v = tanhf(v); else if (c >= 128) v = sigmoid_f(v);
        App[i] = (bf16_t)f2bf(v); }
}
__device__ __forceinline__ void ln_phase(const float* xin, const float* mix, const float* g, const float* b, float* xout, bf16_t* xb, int bid, int nblk) {
    const int lane = opaque_tid() & 63, wv = opaque_tid() >> 6;
    for (int t = bid * 8 + wv; t < T_TOK; t += nblk * 8) {
        float4 y[4]; float s = 0.f;
#pragma unroll
        for (int j = 0; j < 4; ++j) { const float4 a = *(const float4*)(xin + (size_t)t * 1024 + 4 * lane + 256 * j), m = *(const float4*)(mix + (size_t)t * 1024 + 4 * lane + 256 * j);
            y[j].x = DN_ALPHA * a.x + m.x; y[j].y = DN_ALPHA * a.y + m.y; y[j].z = DN_ALPHA * a.z + m.z; y[j].w = DN_ALPHA * a.w + m.w; s += (y[j].x + y[j].y) + (y[j].z + y[j].w); }
        const float mean = wave_sum(s) * (1.f / 1024.f); float q = 0.f;
#pragma unroll
        for (int j = 0; j < 4; ++j) { y[j].x -= mean; y[j].y -= mean; y[j].z -= mean; y[j].w -= mean; q += (y[j].x * y[j].x + y[j].y * y[j].y) + (y[j].z * y[j].z + y[j].w * y[j].w); }
        const float rstd = rsqrtf(wave_sum(q) * (1.f / 1024.f) + LN_EPS);
#pragma unroll
        for (int j = 0; j < 4; ++j) { const float4 gg = *(const float4*)(g + 4 * lane + 256 * j), bb = *(const float4*)(b + 4 * lane + 256 * j);
            float4 o; o.x = y[j].x * rstd * gg.x + bb.x; o.y = y[j].y * rstd * gg.y + bb.y; o.z = y[j].z * rstd * gg.z + bb.z; o.w = y[j].w * rstd * gg.w + bb.w;
            *(float4*)(xout + (size_t)t * 1024 + 4 * lane + 256 * j) = o; uint2 w; w.x = pk2(o.x, o.y); w.y = pk2(o.z, o.w); *(uint2*)(xb + (size_t)t * 1024 + 4 * lane + 256 * j) = w; }
    }
}
__device__ __forceinline__ void fox_cumsum_phase(const float* __restrict__ gates, const float* __restrict__ f_b, float* __restrict__ cum, int bid, int nblk) {
    const int lane = opaque_tid() & 63, wv = opaque_tid() >> 6;
    for (int bh = bid * 8 + wv; bh < 128; bh += nblk * 8) {
        const int b = bh >> 4, h = bh & 15; const float fb = f_b[h];
        float lf[32]; double run = 0.0;
#pragma unroll
        for (int j = 0; j < 32; ++j) { const int s = lane * 32 + j; lf[j] = log_sigmoid_f(gates[((size_t)b * SEQ + s) * 16 + h] + fb); run += (double)lf[j]; }
        double incl = run;
#pragma unroll
        for (int o = 1; o < 64; o <<= 1) { const double v = __shfl_up(incl, o); if (lane >= o) incl += v; }
        double acc = incl - run;
#pragma unroll
        for (int j = 0; j < 32; ++j) { acc += (double)lf[j]; cum[(size_t)bh * SEQ + lane * 32 + j] = (float)acc; }
    }
}

__device__ __forceinline__ void fox_qknorm_phase(bf16_t* P1, const float* __restrict__ qn_g, const float* __restrict__ kn_g, int bid, int nblk) {
    const int tid = opaque_tid(); const int lane = tid & 63, wv = tid >> 6;
    for (int t = bid * 8 + wv; t < T_TOK; t += nblk * 8) {
#pragma unroll
        for (int which = 0; which < 2; ++which) {
            bf16_t* p = P1 + (size_t)t * L1_MAIN + which * 1024 + lane * 16; const float* g = (which ? kn_g : qn_g) + lane * 16;
            float f[16]; unpack8(*(const uint4*)p, f); unpack8(*(const uint4*)(p + 8), f + 8);
            float ss = 0.f;
#pragma unroll
            for (int j = 0; j < 16; ++j) ss += f[j] * f[j];
            ss = red4_sum(ss);
            const float r = rsqrtf(ss * (1.f / 64.f) + 1e-6f) * (which ? 1.0f : 0.125f * 1.4426950408889634f);
#pragma unroll
            for (int j = 0; j < 16; ++j) f[j] = f[j] * r * g[j];
            uint4 w0, w1; w0.x = pk2(f[0], f[1]); w0.y = pk2(f[2], f[3]); w0.z = pk2(f[4], f[5]); w0.w = pk2(f[6], f[7]); w1.x = pk2(f[8], f[9]); w1.y = pk2(f[10], f[11]); w1.z = pk2(f[12], f[13]); w1.w = pk2(f[14], f[15]);
            *(uint4*)p = w0; *(uint4*)(p + 8) = w1; }
    }
}

struct RwkvArgs { const bf16_t* P0; const float* lrw; const bf16_t* lra; const bf16_t* lrg; const float* mu; const float* k_k; const float* k_a; const float* r_k; const float* ln_g; const float* ln_b; bf16_t* ycat; };
constexpr int RW_CS = 32;
constexpr int RW_LDS_BYTES = 8 * RW_CS * 64 * 4;

#define RW_LOAD_RAW(chunk) do { const int sg_ = (chunk) * RW_CS + ls; const size_t row_ = tok0 + sg_; \
    const bf16_t* pc_ = A.P0 + row_ * L0_MAIN + hc; \
    rc = *(const uint2*)(pc_); kc = *(const uint2*)(pc_ + 512); vc = *(const uint2*)(pc_ + 1024); \
    if (sg_ > 0) { const bf16_t* pp_ = pc_ - L0_MAIN; rp = *(const uint2*)(pp_); kp = *(const uint2*)(pp_ + 512); vp = *(const uint2*)(pp_ + 1024); } \
    else { rp = make_uint2(0u, 0u); kp = rp; vp = rp; } \
    rwl = *(const float4*)(A.lrw + row_ * 512 + hc); ra = *(const uint2*)(A.lra + row_ * 512 + hc); rg = *(const uint2*)(A.lrg + row_ * 512 + hc); } while (0)

__device__ __forceinline__ void rwkv_scan_unit(const RwkvArgs& A, int bh, float* smem) {
    const int tid = opaque_tid(); const int b = bh >> 3, h = bh & 7;
    float* sr = smem; float* sw = sr + 2048; float* sk = sw + 2048; float* skk = sk + 2048; float* snb = skk + 2048; float* sv = snb + 2048; float* sg = sv + 2048; float* sy = sg + 2048;
    const int ls = tid >> 4, lc = (tid & 15) * 4; const int hc = h * 64 + lc;
    float c_mur[4], c_muk[4], c_muv[4], c_kk[4], c_ka[4], c_rk[4], c_lng[4], c_lnb[4];
#pragma unroll
    for (int j = 0; j < 4; ++j) { c_mur[j] = A.mu[hc + j]; c_muk[j] = A.mu[512 + hc + j]; c_muv[j] = A.mu[1024 + hc + j]; c_kk[j] = A.k_k[hc + j]; c_ka[j] = A.k_a[hc + j];
        c_rk[j] = A.r_k[hc + j]; c_lng[j] = A.ln_g[hc + j]; c_lnb[j] = A.ln_b[hc + j]; }
    const int srow = tid >> 3, sq = (tid & 7) * 8;
    float S[8];
#pragma unroll
    for (int j = 0; j < 8; ++j) S[j] = 0.f;
    const size_t tok0 = (size_t)b * SEQ;
    uint2 rc, kc, vc, rp, kp, vp, ra, rg; float4 rwl;
    RW_LOAD_RAW(0);
    for (int chunk = 0; chunk < SEQ / RW_CS; ++chunk) {
        {
            float frc[4], fkc[4], fvc[4], frp[4], fkp[4], fvp[4], fa[4], fg[4];
            unpack4(rc, frc); unpack4(kc, fkc); unpack4(vc, fvc); unpack4(rp, frp); unpack4(kp, fkp); unpack4(vp, fvp); unpack4(ra, fa); unpack4(rg, fg);
            const float zw[4] = {rwl.x, rwl.y, rwl.z, rwl.w};
            float r_l[4], k_l[4], v_l[4], w_[4], a_[4], kkr[4]; float ss = 0.f;
#pragma unroll
            for (int j = 0; j < 4; ++j) {
                r_l[j] = frc[j] + (frp[j] - frc[j]) * c_mur[j]; k_l[j] = fkc[j] + (fkp[j] - fkc[j]) * c_muk[j]; v_l[j] = fvc[j] + (fvp[j] - fvc[j]) * c_muv[j];
                const float sig = sigmoid_f(zw[j]); w_[j] = __expf(-0.6065306597126334f * sig); a_[j] = sigmoid_f(fa[j]);
                kkr[j] = k_l[j] * c_kk[j]; ss += kkr[j] * kkr[j]; }
            ss = red16_sum(ss);
            const float inv = 1.0f / fmaxf(sqrtf(ss), 1e-12f);
            const int o = ls * 64 + lc;
#pragma unroll
            for (int j = 0; j < 4; ++j) { const float kk = kkr[j] * inv;
                sr[o + j] = r_l[j]; sw[o + j] = w_[j]; sk[o + j] = k_l[j] * (1.0f + (a_[j] - 1.0f) * c_ka[j]); skk[o + j] = kk; snb[o + j] = -kk * a_[j]; sv[o + j] = v_l[j]; sg[o + j] = fg[j]; }
        }
        __syncthreads();
        if (chunk + 1 < SEQ / RW_CS) RW_LOAD_RAW(chunk + 1);
        for (int s = 0; s < RW_CS; ++s) {
            const float4 kk0 = *(const float4*)(skk + s * 64 + sq), kk1 = *(const float4*)(skk + s * 64 + sq + 4);
            const float4 w0 = *(const float4*)(sw + s * 64 + sq), w1 = *(const float4*)(sw + s * 64 + sq + 4);
            const float4 nb0 = *(const float4*)(snb + s * 64 + sq), nb1 = *(const float4*)(snb + s * 64 + sq + 4);
            const float4 k0 = *(const float4*)(sk + s * 64 + sq), k1 = *(const float4*)(sk + s * 64 + sq + 4);
            const float4 r0 = *(const float4*)(sr + s * 64 + sq), r1 = *(const float4*)(sr + s * 64 + sq + 4);
            const float vv = sv[s * 64 + srow];
            float sa = (S[0] * kk0.x + S[1] * kk0.y) + (S[2] * kk0.z + S[3] * kk0.w) + (S[4] * kk1.x + S[5] * kk1.y) + (S[6] * kk1.z + S[7] * kk1.w);
            sa = red8_sum(sa);
            S[0] = S[0] * w0.x + sa * nb0.x + vv * k0.x; S[1] = S[1] * w0.y + sa * nb0.y + vv * k0.y; S[2] = S[2] * w0.z + sa * nb0.z + vv * k0.z; S[3] = S[3] * w0.w + sa * nb0.w + vv * k0.w;
            S[4] = S[4] * w1.x + sa * nb1.x + vv * k1.x; S[5] = S[5] * w1.y + sa * nb1.y + vv * k1.y; S[6] = S[6] * w1.z + sa * nb1.z + vv * k1.z; S[7] = S[7] * w1.w + sa * nb1.w + vv * k1.w;
            float y = (S[0] * r0.x + S[1] * r0.y) + (S[2] * r0.z + S[3] * r0.w) + (S[4] * r1.x + S[5] * r1.y) + (S[6] * r1.z + S[7] * r1.w);
            y = red8_sum(y);
            if ((tid & 7) == 0) sy[s * 64 + srow] = y;
        }
        __syncthreads();
        {
            const int o = ls * 64 + lc; float y4[4]; float s1 = 0.f, bp = 0.f;
#pragma unroll
            for (int j = 0; j < 4; ++j) { y4[j] = sy[o + j]; s1 += y4[j]; bp += sr[o + j] * sk[o + j] * c_rk[j]; }
            s1 = red16_sum(s1);
            bp = red16_sum(bp);
            const float mean = s1 * (1.f / 64.f); float q = 0.f;
#pragma unroll
            for (int j = 0; j < 4; ++j) { y4[j] -= mean; q += y4[j] * y4[j]; }
            q = red16_sum(q);
            const float rstd = rsqrtf(q * (1.f / 64.f) + 64.0f * 1e-5f);
            float ov[4];
#pragma unroll
            for (int j = 0; j < 4; ++j) ov[j] = (y4[j] * rstd * c_lng[j] + c_lnb[j] + bp * sv[o + j]) * sg[o + j];
            uint2 w; w.x = pk2(ov[0], ov[1]); w.y = pk2(ov[2], ov[3]);
            *(uint2*)(A.ycat + (tok0 + (size_t)chunk * RW_CS + ls) * 1024 + hc) = w;
        }
        __syncthreads();
    }
}
struct MlstmArgs { const bf16_t* P0; const float* gates; const float* conv_w; const float* conv_b; const float* ig_b; const float* fg_b; const float* hn_g; const float* hn_b; bf16_t* ycat; };
constexpr int ML_QS = 132;
constexpr int ML_LDS_FLOATS = 64 * ML_QS + 64 * 128 + 64 * 64 + 64 * 65 + 64 * ML_QS + 4 * 8 * 128 + 64 * 10 + 512 + 128;
constexpr int ML_LDS_BYTES = ML_LDS_FLOATS * 4;

__device__ __forceinline__ void mlstm_unit(const MlstmArgs& A, int bh, float* smem) {
    float* qs = smem; float* ks = qs + 64 * ML_QS; bf16_t* vsb = (bf16_t*)(ks + 64 * 128); float* sc = ks + 64 * 128 + 64 * 64; float* hs = sc + 64 * 65; float* red = hs + 64 * ML_QS;
    float* sig = red + 4 * 8 * 128; float* slf = sig + 64; float* sb = slf + 64; float* smt = sb + 64; float* scarry = smt + 64; float* sden = scarry + 64; float* sws = sden + 64;
    float* smean = sws + 64; float* srstd = smean + 64; float* spad = srstd + 64; float* sdenp = spad + 64;   float* sn = sdenp + 512;
    const int tid = opaque_tid(); const int v = tid & 127, part = tid >> 7; const int b = bh >> 2, h = bh & 3;
    const size_t tok0 = (size_t)b * SEQ;
    const int cq = h * 128 + v;
    float wq[4], wk[4];
#pragma unroll
    for (int j = 0; j < 4; ++j) { wq[j] = A.conv_w[j * 1024 + cq]; wk[j] = A.conv_w[j * 1024 + 512 + cq]; }
    const float bq = A.conv_b[cq], bk = A.conv_b[512 + cq];
    const float igb = A.ig_b[h], fgb = A.fg_b[h];
    const float hng = A.hn_g[cq], hnb = A.hn_b[cq];
    float zq1 = 0.f, zq2 = 0.f, zq3 = 0.f, zk1 = 0.f, zk2 = 0.f, zk3 = 0.f;
    float C[32];
#pragma unroll
    for (int k = 0; k < 32; ++k) C[k] = 0.f;
    if (tid < 128) sn[tid] = 0.f;
    float m_run = 0.f;
    for (int chunk = 0; chunk < SEQ / 64; ++chunk) {
        const size_t row0 = tok0 + (size_t)chunk * 64;
        if (part == 0) {
            for (int t = 0; t < 64; ++t) { const bf16_t* pr = A.P0 + (row0 + t) * L0_MAIN;
                const float zq = bf2f(pr[1792 + cq]), zk = bf2f(pr[2304 + cq]);
                const float cvq = wq[3] * zq + wq[2] * zq1 + wq[1] * zq2 + wq[0] * zq3 + bq; const float cvk = wk[3] * zk + wk[2] * zk1 + wk[1] * zk2 + wk[0] * zk3 + bk;
                zq3 = zq2; zq2 = zq1; zq1 = zq; zk3 = zk2; zk2 = zk1; zk1 = zk;
                qs[t * ML_QS + v] = cvq * sigmoid_f(cvq) * 0.08838834764831845f; ks[t * 128 + v] = cvk * sigmoid_f(cvk); vsb[t * 128 + v] = pr[2816 + cq]; }
            if (tid < 64) { const float* gr = A.gates + (row0 + tid) * 16; sig[tid] = gr[h] + igb; slf[tid] = log_sigmoid_f(gr[4 + h] + fgb); }
        }
        __syncthreads();
        if (tid < 64) { float bsum = 0.f; for (int s = 0; s <= tid; ++s) bsum += slf[s]; sb[tid] = bsum; }
        __syncthreads();
        const float b_last = sb[63];
        float gmax = -INFINITY; for (int s = 0; s < 64; ++s) gmax = fmaxf(gmax, b_last - sb[s] + sig[s]);
        const float m_new = fmaxf(b_last + m_run, gmax); const float keep = __expf(b_last + m_run - m_new);
        if (tid < 64) { const float bt = sb[tid]; float mx = -INFINITY; for (int s = 0; s <= tid; ++s) mx = fmaxf(mx, bt - sb[s] + sig[s]);
            const float mt = fmaxf(bt + m_run, mx); smt[tid] = mt; scarry[tid] = __expf(bt + m_run - mt); sws[tid] = __expf(b_last - bt + sig[tid] - m_new); }
        __syncthreads();
        { const int t = tid & 63, sh = tid >> 6; const float bt = sb[t], mt = smt[t]; float dsum = 0.f;
            for (int s = sh * 8; s < sh * 8 + 8; ++s) { float val = 0.f;
                if (s <= t) { float dot = 0.f;
#pragma unroll 8
                    for (int k = 0; k < 128; k += 4) { const float4 qa = *(const float4*)(qs + t * ML_QS + k), kb = *(const float4*)(ks + s * 128 + k); dot += (qa.x * kb.x + qa.y * kb.y) + (qa.z * kb.z + qa.w * kb.w); }
                    val = dot * __expf(bt - sb[s] + sig[s] - mt); }
                sc[t * 65 + s] = val; dsum += val; }
            sdenp[sh * 64 + t] = dsum; }
        __syncthreads();
        if (tid < 64) { float qn = 0.f; for (int k = 0; k < 128; ++k) qn += qs[tid * ML_QS + k] * sn[k];
            float den = scarry[tid] * qn;
#pragma unroll
            for (int p = 0; p < 8; ++p) den += sdenp[p * 64 + tid];
            sden[tid] = fmaxf(fabsf(den), __expf(-smt[tid])); }
        __syncthreads();
        for (int batch = 0; batch < 8; ++batch) {
#pragma unroll 2
            for (int tt = 0; tt < 8; ++tt) { const int t = batch * 8 + tt; float qc = 0.f;
#pragma unroll
                for (int k = 0; k < 32; k += 4) { const float4 qa = *(const float4*)(qs + t * ML_QS + part * 32 + k); qc += (qa.x * C[k] + qa.y * C[k + 1]) + (qa.z * C[k + 2] + qa.w * C[k + 3]); }
                red[(part * 8 + tt) * 128 + v] = qc; }
            __syncthreads();
#pragma unroll
            for (int j = 0; j < 2; ++j) { const int tt = part * 2 + j, t = batch * 8 + tt;
                const float qc = (red[(0 * 8 + tt) * 128 + v] + red[(1 * 8 + tt) * 128 + v]) + (red[(2 * 8 + tt) * 128 + v] + red[(3 * 8 + tt) * 128 + v]);
                float acc = 0.f; for (int s = 0; s <= t; ++s) acc += sc[t * 65 + s] * bf2f(vsb[s * 128 + v]);
                hs[t * ML_QS + v] = (acc + scarry[t] * qc) / sden[t]; }
            __syncthreads();
        }
        { const int t = tid >> 3, oc = tid & 7; float s1 = 0.f;
#pragma unroll
            for (int k = 0; k < 16; ++k) s1 += hs[t * ML_QS + oc * 16 + k];
            s1 = red8_sum(s1); const float mean = s1 * (1.f / 128.f); float q = 0.f;
#pragma unroll
            for (int k = 0; k < 16; ++k) { const float d = hs[t * ML_QS + oc * 16 + k] - mean; q += d * d; }
            q = red8_sum(q); if (oc == 0) { smean[t] = mean; srstd[t] = rsqrtf(q * (1.f / 128.f) + LN_EPS); } }
        __syncthreads();
        for (int t = part * 16; t < part * 16 + 16; ++t) { const float hn = (hs[t * ML_QS + v] - smean[t]) * srstd[t] * hng + hnb; const float og = bf2f(A.P0[(row0 + t) * L0_MAIN + 3328 + cq]);
            A.ycat[(row0 + t) * 1024 + 512 + cq] = (bf16_t)f2bf(hn * sigmoid_f(og)); }
#pragma unroll
        for (int k = 0; k < 32; ++k) C[k] *= keep;
        for (int s = 0; s < 64; ++s) { const float wv = sws[s] * bf2f(vsb[s * 128 + v]);
#pragma unroll
            for (int k = 0; k < 32; k += 4) { const float4 kb = *(const float4*)(ks + s * 128 + part * 32 + k); C[k] += kb.x * wv; C[k + 1] += kb.y * wv; C[k + 2] += kb.z * wv; C[k + 3] += kb.w * wv; } }
        if (tid < 128) { float nn = keep * sn[tid]; for (int s = 0; s < 64; ++s) nn += sws[s] * ks[s * 128 + tid]; sn[tid] = nn; }
        m_run = m_new;
        __syncthreads();
    }
}

struct AttnArgs { const bf16_t* P1; const float* cum; const float* qn_g; const float* kn_g; bf16_t* out; };
constexpr int AT_LDS_BYTES = (2 * 32 * 64 + 32) * 4;
__device__ __forceinline__ void attn_unit_valu(const AttnArgs& A, int bh, int qb, float* smem) {
    float* Ks = smem; float* Vs = Ks + 2048; float* cj = Vs + 2048;
    const int tid = opaque_tid(); const int b = bh >> 4, h = bh & 15; const int hf = tid & 1; const int i = qb * 256 + (tid >> 1); const size_t row = (size_t)b * SEQ + i;
    float q[32], o[32];
    { float ss = 0.f;
#pragma unroll
        for (int c = 0; c < 4; ++c) { const uint4 w = *(const uint4*)(A.P1 + row * L1_MAIN + h * 64 + hf * 32 + c * 8); unpack8(w, q + c * 8); }
#pragma unroll
        for (int d = 0; d < 32; ++d) ss += q[d] * q[d];
        ss += __shfl_xor(ss, 1);
        const float r = rsqrtf(ss * (1.f / 64.f) + 1e-6f) * 0.125f;
#pragma unroll
        for (int d = 0; d < 32; ++d) { q[d] = q[d] * r * A.qn_g[h * 64 + hf * 32 + d]; o[d] = 0.f; } }
    const float ci = A.cum[(size_t)bh * SEQ + i];
    float m = -INFINITY, l = 0.f;
    const int ntiles = (qb * 256 + 256) / 32;
    const int lkey = tid >> 4, ld4 = (tid & 15) * 4;
    float kg[4];
#pragma unroll
    for (int j = 0; j < 4; ++j) kg[j] = A.kn_g[h * 64 + ld4 + j];
    for (int kt = 0; kt < ntiles; ++kt) {
        { const size_t krow = (size_t)b * SEQ + kt * 32 + lkey; float fk[4], fv[4];
            unpack4(*(const uint2*)(A.P1 + krow * L1_MAIN + 1024 + h * 64 + ld4), fk); unpack4(*(const uint2*)(A.P1 + krow * L1_MAIN + 2048 + h * 64 + ld4), fv);
            float ss = (fk[0] * fk[0] + fk[1] * fk[1]) + (fk[2] * fk[2] + fk[3] * fk[3]);
            ss = red16_sum(ss);
            const float r = rsqrtf(ss * (1.f / 64.f) + 1e-6f);
#pragma unroll
            for (int j = 0; j < 4; ++j) { Ks[lkey * 64 + ld4 + j] = fk[j] * r * kg[j]; Vs[lkey * 64 + ld4 + j] = fv[j]; }
            if ((tid & 15) == 0) cj[lkey] = A.cum[(size_t)bh * SEQ + kt * 32 + lkey]; }
        __syncthreads();
#pragma unroll 1
        for (int sub = 0; sub < 8; ++sub) {
            float s[4]; float mx = -INFINITY;
#pragma unroll
            for (int jj = 0; jj < 4; ++jj) { const int j = sub * 4 + jj; float dot = 0.f;
#pragma unroll
                for (int d = 0; d < 32; d += 4) { const float4 kv = *(const float4*)(Ks + j * 64 + hf * 32 + d); dot += (q[d] * kv.x + q[d + 1] * kv.y) + (q[d + 2] * kv.z + q[d + 3] * kv.w); }
                dot += __shfl_xor(dot, 1);
                float sv_ = dot + ci - cj[j]; if (kt * 32 + j > i) sv_ = -INFINITY; s[jj] = sv_; mx = fmaxf(mx, sv_); }
            const float mnew = fmaxf(m, mx); const float scl = __expf(m - mnew); float psum = 0.f;
#pragma unroll
            for (int jj = 0; jj < 4; ++jj) { s[jj] = __expf(s[jj] - mnew); psum += s[jj]; }
            l = l * scl + psum; m = mnew;
#pragma unroll
            for (int d = 0; d < 32; ++d) o[d] *= scl;
#pragma unroll
            for (int jj = 0; jj < 4; ++jj) { const int j = sub * 4 + jj; const float p = s[jj];
#pragma unroll
                for (int d = 0; d < 32; d += 4) { const float4 vv = *(const float4*)(Vs + j * 64 + hf * 32 + d); o[d] += p * vv.x; o[d + 1] += p * vv.y; o[d + 2] += p * vv.z; o[d + 3] += p * vv.w; } }
        }
        __syncthreads();
    }
    const float il = 1.0f / l;
#pragma unroll
    for (int c = 0; c < 4; ++c) { float og[8]; unpack8(*(const uint4*)(A.P1 + row * L1_MAIN + 3072 + h * 64 + hf * 32 + c * 8), og);
        uint4 w; w.x = pk2(o[c * 8 + 0] * il * sigmoid_f(og[0]), o[c * 8 + 1] * il * sigmoid_f(og[1])); w.y = pk2(o[c * 8 + 2] * il * sigmoid_f(og[2]), o[c * 8 + 3] * il * sigmoid_f(og[3]));
        w.z = pk2(o[c * 8 + 4] * il * sigmoid_f(og[4]), o[c * 8 + 5] * il * sigmoid_f(og[5])); w.w = pk2(o[c * 8 + 6] * il * sigmoid_f(og[6]), o[c * 8 + 7] * il * sigmoid_f(og[7]));
        *(uint4*)(A.out + row * 1024 + h * 64 + hf * 32 + c * 8) = w; }
}
__device__ __forceinline__ void attn_valu_phase(const AttnArgs& A, int bid, int nblk, float* smem) {
    for (int su = bid; su < 256; su += nblk) { const int bh = su >> 1, pr = su & 1;
#pragma unroll 1
        for (int u = 0; u < 4; ++u) { const int qb = (u == 0) ? pr : (u == 1) ? 7 - pr : (u == 2) ? 2 + pr : 5 - pr; attn_unit_valu(A, bh, qb, smem); } }
}

struct PeerSArgs { const bf16_t* Q; const bf16_t* K1b; const bf16_t* K2b; int* eid; float* gate; };
constexpr int PS_QT = 0, PS_KB = 64 * 528, PS_KB2 = PS_KB + 128 * 272, PS_L1 = PS_KB + 2 * 128 * 272, PS_L2 = PS_L1 + 4096, PS_LDS_BYTES = PS_L2 + 4096;
__device__ __forceinline__ unsigned ord_f(float f) { const unsigned b = __float_as_uint(f); return b ^ ((b >> 31) ? 0xFFFFFFFFu : 0x80000000u); }
__device__ __forceinline__ float unord_f(unsigned u) { const unsigned b = (u & 0x80000000u) ? (u ^ 0x80000000u) : ~u; return __uint_as_float(b); }
#define TOPK_INSERT(L, x) do { unsigned x_ = (x); _Pragma("unroll") for (int q_ = 0; q_ < 16; ++q_) { const unsigned hi_ = max(L[q_], x_); x_ = min(L[q_], x_); L[q_] = hi_; } } while (0)

__device__ __forceinline__ void peer_scores_unit(const PeerSArgs& A, int tile, int h, unsigned char* smem) {
    const int tid = opaque_tid(), lane = tid & 63, wv = tid >> 6;
#pragma unroll
    for (int i = 0; i < 4; ++i) { const int idx = tid + 512 * i; const int row = idx >> 5, c = idx & 31;
        *(uint4*)(smem + PS_QT + row * 528 + c * 16) = *(const uint4*)(A.Q + (size_t)(tile * 64 + row) * 2048 + h * 256 + c * 8); }
#pragma unroll
    for (int i = 0; i < 4; ++i) { const int idx = tid + 512 * i; const int row = idx >> 4, c = idx & 15;
        *(uint4*)(smem + PS_KB + row * 272 + c * 16) = *(const uint4*)(A.K1b + (size_t)(h * 128 + row) * 128 + c * 8);
        *(uint4*)(smem + PS_KB2 + row * 272 + c * 16) = *(const uint4*)(A.K2b + (size_t)(h * 128 + row) * 128 + c * 8); }
    __syncthreads();
    const int half = wv >> 2, mt = wv & 3; const int fr = lane & 15, fq = lane >> 4;
    f32x4_t acc[8];
#pragma unroll
    for (int n = 0; n < 8; ++n) acc[n] = (f32x4_t){0.f, 0.f, 0.f, 0.f};
    { const unsigned char* qbase = smem + PS_QT + (16 * mt + fr) * 528 + (half * 128 + 8 * fq) * 2; const unsigned char* kbase = smem + (half ? PS_KB2 : PS_KB) + fr * 272 + (8 * fq) * 2;
#pragma unroll
        for (int ks = 0; ks < 4; ++ks) { const bf16x8_t qf = *(const bf16x8_t*)(qbase + ks * 64);
#pragma unroll
            for (int n = 0; n < 8; ++n) { const bf16x8_t kf = *(const bf16x8_t*)(kbase + n * 16 * 272 + ks * 64); acc[n] = __builtin_amdgcn_mfma_f32_16x16x32_bf16(kf, qf, acc[n], 0, 0, 0); } } }
    __syncthreads();
    { float* sT = (float*)(smem + PS_KB + half * 128 * 272);
#pragma unroll
        for (int n = 0; n < 8; ++n)
#pragma unroll
            for (int r = 0; r < 4; ++r) sT[(16 * n + 4 * fq + r) * 68 + 16 * mt + fr] = acc[n][r]; }
    __syncthreads();
    unsigned* part = (unsigned*)(smem + PS_QT);
    { const int qt = wv & 3; const float* sT = (const float*)(smem + PS_KB + half * 128 * 272); unsigned L[16];
#pragma unroll
        for (int j = 0; j < 16; ++j) L[j] = 0u;
#pragma unroll 4
        for (int kk = 0; kk < 32; ++kk) { const int key = 32 * qt + kk; const unsigned u = (ord_f(sT[key * 68 + lane]) & ~0x7Fu) | (unsigned)(127 - key); TOPK_INSERT(L, u); }
        unsigned* dst = part + (half * 4 + qt) * 1024;
#pragma unroll
        for (int j = 0; j < 16; ++j) dst[j * 64 + lane] = L[j]; }
    __syncthreads();
#pragma unroll 1
    for (int round = 0; round < 2; ++round) { const int qt = wv & 3; const int step = 1 << round;
        if ((qt & (2 * step - 1)) == 0) { unsigned* pa = part + (half * 4 + qt) * 1024; const unsigned* pb = part + (half * 4 + qt + step) * 1024; unsigned C[16];
#pragma unroll
            for (int j = 0; j < 16; ++j) C[j] = max(pa[j * 64 + lane], pb[(15 - j) * 64 + lane]);
#pragma unroll
            for (int d = 8; d >= 1; d >>= 1)
#pragma unroll
                for (int j = 0; j < 16; ++j) if ((j & d) == 0) { const unsigned hi_ = max(C[j], C[j + d]), lo_ = min(C[j], C[j + d]); C[j] = hi_; C[j + d] = lo_; }
            unsigned* dst = (round == 1) ? (unsigned*)(smem + (half ? PS_L2 : PS_L1)) : pa;
#pragma unroll
            for (int j = 0; j < 16; ++j) dst[j * 64 + lane] = C[j]; }
        __syncthreads(); }
    if (wv == 0) { const unsigned* l1 = (const unsigned*)(smem + PS_L1); const unsigned* l2 = (const unsigned*)(smem + PS_L2);
        float v1[16], v2[16];
#pragma unroll
        for (int j = 0; j < 16; ++j) { v1[j] = unord_f(l1[j * 64 + lane]); v2[j] = unord_f(l2[j * 64 + lane]); }
        unsigned L[16];
#pragma unroll
        for (int j = 0; j < 16; ++j) L[j] = (ord_f(v1[0] + v2[j]) & ~0xFFu) | (unsigned)(255 - j);
#pragma unroll
        for (int i = 1; i < 16; ++i)
#pragma unroll
            for (int j = 0; j < 16; ++j) if ((i + 1) * (j + 1) <= 16) { const unsigned u = (ord_f(v1[i] + v2[j]) & ~0xFFu) | (unsigned)(255 - (i * 16 + j)); TOPK_INSERT(L, u); }
        float e[16]; float sum = 0.f; const float mx = unord_f(L[0]);
#pragma unroll
        for (int k = 0; k < 16; ++k) { e[k] = __expf(unord_f(L[k]) - mx); sum += e[k]; }
        const float inv = 1.0f / sum; const size_t ob = (size_t)(tile * 64 + lane) * 128 + h * 16;
        int eo[16];
#pragma unroll
        for (int k = 0; k < 16; ++k) { const int idx = 255 - (int)(L[k] & 0xFFu); const int i = idx >> 4, j = idx & 15;
            const int e1 = 127 - (int)(l1[i * 64 + lane] & 0x7Fu), e2 = 127 - (int)(l2[j * 64 + lane] & 0x7Fu); eo[k] = e1 * 128 + e2; }
#pragma unroll
        for (int c = 0; c < 4; ++c) { *(int4*)(A.eid + ob + 4 * c) = make_int4(eo[4 * c], eo[4 * c + 1], eo[4 * c + 2], eo[4 * c + 3]);
            *(float4*)(A.gate + ob + 4 * c) = make_float4(e[4 * c] * inv, e[4 * c + 1] * inv, e[4 * c + 2] * inv, e[4 * c + 3] * inv); } }
    __syncthreads();
}
__device__ __forceinline__ void peer_scores_phase(const PeerSArgs& A, int bid, int nblk, unsigned char* smem) {
    for (int u = bid; u < 256 * 8; u += nblk) peer_scores_unit(A, u >> 3, u & 7, smem);
}

typedef float f32x2_t __attribute__((ext_vector_type(2)));
__device__ __forceinline__ void cvt_fp8_rows_phase(const float* __restrict__ src, unsigned char* __restrict__ dst, float* __restrict__ inv_scale, int bid, int nblk) {
    const int tid = opaque_tid(); const int lane = tid & 63, wv = tid >> 6;
    for (int r = bid * 8 + wv; r < 16384; r += nblk * 8) {
        float f[16]; float mx = 0.f;
#pragma unroll
        for (int c = 0; c < 4; ++c) { const float4 v = *(const float4*)(src + (size_t)r * 1024 + 16 * lane + 4 * c); f[4 * c] = v.x; f[4 * c + 1] = v.y; f[4 * c + 2] = v.z; f[4 * c + 3] = v.w;
            mx = fmaxf(fmaxf(mx, fmaxf(fabsf(v.x), fabsf(v.y))), fmaxf(fabsf(v.z), fabsf(v.w))); }
        mx = wave_max(mx);
        const float sc = (mx > 0.f) ? 240.0f / mx : 1.0f;
        unsigned w[4];
#pragma unroll
        for (int c = 0; c < 4; ++c) { int p = 0; p = __builtin_amdgcn_cvt_pk_fp8_f32(f[4 * c] * sc, f[4 * c + 1] * sc, p, false); p = __builtin_amdgcn_cvt_pk_fp8_f32(f[4 * c + 2] * sc, f[4 * c + 3] * sc, p, true); w[c] = (unsigned)p; }
        *(uint4*)(dst + (size_t)r * 1024 + 16 * lane) = make_uint4(w[0], w[1], w[2], w[3]);
        if (lane == 0) inv_scale[r] = (mx > 0.f) ? mx * (1.0f / 240.0f) : 1.0f;
    }
}
__device__ __forceinline__ void unpack_fp8x16(const uint4 w, float* f) {
    const unsigned ww[4] = {w.x, w.y, w.z, w.w};
#pragma unroll
    for (int c = 0; c < 4; ++c) { const f32x2_t lo = __builtin_amdgcn_cvt_pk_f32_fp8((int)ww[c], false), hi = __builtin_amdgcn_cvt_pk_f32_fp8((int)ww[c], true); f[4 * c] = lo[0]; f[4 * c + 1] = lo[1]; f[4 * c + 2] = hi[0]; f[4 * c + 3] = hi[1]; }
}
struct PeerGArgs { const float* X; float* Xo; const int* eid; const float* gate; const unsigned char* U; const unsigned char* V; const float* Us; const float* Vs; const float* lng; const float* lnb; bf16_t* xb; };
__device__ __forceinline__ void peer_gather_token(const PeerGArgs& A, int t, int lane) {
    float x[16];
#pragma unroll
    for (int c = 0; c < 4; ++c) { const float4 v = *(const float4*)(A.X + (size_t)t * 1024 + 16 * lane + 4 * c); x[4 * c] = v.x; x[4 * c + 1] = v.y; x[4 * c + 2] = v.z; x[4 * c + 3] = v.w; }
    const int e_lo = A.eid[(size_t)t * 128 + lane], e_hi = A.eid[(size_t)t * 128 + 64 + lane];
    const float g_lo = A.gate[(size_t)t * 128 + lane], g_hi = A.gate[(size_t)t * 128 + 64 + lane];
    const float us_lo = A.Us[e_lo], us_hi = A.Us[e_hi], vs_lo = A.Vs[e_lo], vs_hi = A.Vs[e_hi];
    float acc[16];
#pragma unroll
    for (int j = 0; j < 16; ++j) acc[j] = 0.f;
    for (int k0 = 0; k0 < 128; k0 += 8) {
        uint4 u[8], v[8]; float g[8], us[8];
#pragma unroll
        for (int i = 0; i < 8; ++i) { const int k = k0 + i; const int e = __shfl(k0 < 64 ? e_lo : e_hi, k & 63); g[i] = __shfl(k0 < 64 ? g_lo : g_hi, k & 63) * __shfl(k0 < 64 ? vs_lo : vs_hi, k & 63); us[i] = __shfl(k0 < 64 ? us_lo : us_hi, k & 63);
            u[i] = *(const uint4*)(A.U + (size_t)e * 1024 + 16 * lane); v[i] = *(const uint4*)(A.V + (size_t)e * 1024 + 16 * lane); }
#pragma unroll
        for (int i = 0; i < 8; ++i) { float f[16]; unpack_fp8x16(u[i], f); float dot = 0.f;
#pragma unroll
            for (int j = 0; j < 16; ++j) dot += x[j] * f[j];
            dot = wave_sum(dot) * us[i];
            const float c = g[i] * 0.5f * dot * (1.0f + erff(dot * 0.7071067811865476f));
            unpack_fp8x16(v[i], f);
#pragma unroll
            for (int j = 0; j < 16; ++j) acc[j] += c * f[j]; }
    }
    float s = 0.f;
#pragma unroll
    for (int j = 0; j < 16; ++j) { acc[j] += DN_ALPHA * x[j]; s += acc[j]; }
    const float mean = wave_sum(s) * (1.f / 1024.f); float q = 0.f;
#pragma unroll
    for (int j = 0; j < 16; ++j) { acc[j] -= mean; q += acc[j] * acc[j]; }
    const float rstd = rsqrtf(wave_sum(q) * (1.f / 1024.f) + LN_EPS);
    float ov[16];
#pragma unroll
    for (int c = 0; c < 4; ++c) { const float4 gg = *(const float4*)(A.lng + 16 * lane + 4 * c), bb = *(const float4*)(A.lnb + 16 * lane + 4 * c);
        ov[4 * c] = acc[4 * c] * rstd * gg.x + bb.x; ov[4 * c + 1] = acc[4 * c + 1] * rstd * gg.y + bb.y; ov[4 * c + 2] = acc[4 * c + 2] * rstd * gg.z + bb.z; ov[4 * c + 3] = acc[4 * c + 3] * rstd * gg.w + bb.w;
        *(float4*)(A.Xo + (size_t)t * 1024 + 16 * lane + 4 * c) = make_float4(ov[4 * c], ov[4 * c + 1], ov[4 * c + 2], ov[4 * c + 3]); }
    *(uint4*)(A.xb + (size_t)t * 1024 + 16 * lane) = make_uint4(pk2(ov[0], ov[1]), pk2(ov[2], ov[3]), pk2(ov[4], ov[5]), pk2(ov[6], ov[7]));
    *(uint4*)(A.xb + (size_t)t * 1024 + 16 * lane + 8) = make_uint4(pk2(ov[8], ov[9]), pk2(ov[10], ov[11]), pk2(ov[12], ov[13]), pk2(ov[14], ov[15]));
}
__device__ __forceinline__ void peer_gather_phase(const PeerGArgs& A, int bid, int nblk) {
    const int tid = opaque_tid(); const int lane = tid & 63, wv = tid >> 6;
    for (int t = bid * 8 + wv; t < T_TOK; t += nblk * 8) peer_gather_token(A, t, lane);
}

namespace mlm {
typedef __attribute__((address_space(3))) unsigned char lds_u8;
typedef short v4i16_t __attribute__((ext_vector_type(4)));
typedef unsigned u32x4_t __attribute__((ext_vector_type(4)));
typedef unsigned u32x2_t __attribute__((ext_vector_type(2)));
#define MLM_LDS(T, off) (*(__attribute__((address_space(3))) T*)(smem + (off)))
constexpr int RS = 136;
constexpr int OFF_QS = 0, OFF_KS = OFF_QS + 64 * RS * 2, OFF_VS = OFF_KS + 64 * RS * 2, OFF_OG = OFF_VS + 64 * RS * 2, OFF_CT = OFF_OG + 64 * RS * 2, OFF_SC = OFF_CT + 128 * RS * 2, OFF_F = OFF_SC + 64 * 72 * 2;
constexpr int F_SIG = 0, F_SLF = 64, F_SU = 128, F_SBM = 192, F_CARRY = 256, F_WS = 320, F_SEN = 384, F_SQN = 448, F_DENP = 512, F_STAT = 640, F_SN = 896, F_SCAL = 1024, F_CW = 1032, F_CB = 2056, F_HNG = 2312, F_HNB = 2440, F_END = 2568;
constexpr int LDS_BYTES = OFF_F + F_END * 4;
__device__ __forceinline__ bf16x8_t tr_frag(const lds_u8* p, int row_stride_bytes) {
    const v4i16_t lo = __builtin_amdgcn_ds_read_tr16_b64_v4i16((__attribute__((address_space(3))) v4i16_t*)p);
    const v4i16_t hi = __builtin_amdgcn_ds_read_tr16_b64_v4i16((__attribute__((address_space(3))) v4i16_t*)(p + 4 * row_stride_bytes));
    return (bf16x8_t){lo[0], lo[1], lo[2], lo[3], hi[0], hi[1], hi[2], hi[3]};
}
#define MLM_LOAD_RAW(chunk) do { const size_t r0_ = tok0 + (size_t)(chunk) * 64 + 2 * tp; const bf16_t* pb_ = A.P0 + r0_ * L0_MAIN + h * 128 + 8 * g; \
    _Pragma("unroll") for (int i_ = 0; i_ < 5; ++i_) { const int rr_ = (chunk) * 64 + 2 * tp - 3 + i_; \
        if (rr_ >= 0) { zq[i_] = *(const uint4*)(pb_ + (long)(i_ - 3) * L0_MAIN + 1792); zk[i_] = *(const uint4*)(pb_ + (long)(i_ - 3) * L0_MAIN + 2304); } else { zq[i_] = make_uint4(0u, 0u, 0u, 0u); zk[i_] = zq[i_]; } } \
    rv[0] = *(const uint4*)(pb_ + 2816); rv[1] = *(const uint4*)(pb_ + L0_MAIN + 2816); rog[0] = *(const uint4*)(pb_ + 3328); rog[1] = *(const uint4*)(pb_ + L0_MAIN + 3328); \
    if (tid < 64) { const float* gr_ = A.gates + (tok0 + (size_t)(chunk) * 64 + tid) * 16; rgi = gr_[h]; rgf = gr_[4 + h]; } } while (0)

__device__ __forceinline__ void mlstm_unit_mfma(const MlstmArgs& A, int bh, unsigned char* smem_g) {
    lds_u8* smem = (lds_u8*)smem_g;
    __attribute__((address_space(3))) float* F = (__attribute__((address_space(3))) float*)(smem + OFF_F);
    const int tid0 = opaque_tid(); const int b = bh >> 2, h = bh & 3;
    const size_t tok0 = (size_t)b * SEQ;
#define MLM_IDX() int tid = tid0; asm volatile("" : "+v"(tid)); const int lane = tid & 63, w = __builtin_amdgcn_readfirstlane(tid >> 6), fr = lane & 15, fq = lane >> 4; \
    const int g = tid & 15, tp = tid >> 4;   const int mt = w & 3, nh = w >> 2;   \
    (void)lane; (void)fr; (void)fq; (void)g; (void)tp; (void)mt; (void)nh
    {
    MLM_IDX();
    for (int i = tid; i < 1024; i += NTHR) { const int tap = i >> 8, c = i & 255; F[F_CW + i] = A.conv_w[tap * 1024 + (c < 128 ? h * 128 + c : 512 + h * 128 + (c - 128))]; }
    if (tid < 256) F[F_CB + tid] = A.conv_b[tid < 128 ? h * 128 + tid : 512 + h * 128 + (tid - 128)];
    for (int i = tid; i < 128 * RS / 2; i += NTHR) ((__attribute__((address_space(3))) unsigned*)(smem + OFF_CT))[i] = 0u;
    if (tid < 128) F[F_SN + tid] = 0.f;
    if (tid < 128) { F[F_HNG + tid] = A.hn_g[h * 128 + tid]; F[F_HNB + tid] = A.hn_b[h * 128 + tid]; }
    }
    const float igb = A.ig_b[h], fgb = A.fg_b[h];
    f32x4_t Cacc[8];
#pragma unroll
    for (int n = 0; n < 8; ++n) Cacc[n] = (f32x4_t){0.f, 0.f, 0.f, 0.f};
    float m_old = 0.f;
    uint4 zq[5], zk[5], rv[2], rog[2]; float rgi = 0.f, rgf = 0.f;
    { MLM_IDX(); MLM_LOAD_RAW(0); }
    __syncthreads();
    for (int chunk_ = 0; chunk_ < SEQ / 64; ++chunk_) {
        int chunk = chunk_; asm volatile("" : "+s"(chunk));
        MLM_IDX();
        const size_t row0 = tok0 + (size_t)chunk * 64;
        {
            float fz[5][8];
#pragma unroll
            for (int i = 0; i < 5; ++i) unpack8(zq[i], fz[i]);
#pragma unroll
            for (int r = 0; r < 2; ++r) { float o[8];
#pragma unroll
                for (int j = 0; j < 8; ++j) { const int c = 8 * g + j; float cv = F[F_CB + c];
#pragma unroll
                    for (int tap = 0; tap < 4; ++tap) cv += F[F_CW + tap * 256 + c] * fz[r + tap][j];
                    o[j] = cv * sigmoid_f(cv) * 0.08838834764831845f; }
                MLM_LDS(u32x4_t, OFF_QS + ((2 * tp + r) * RS + 8 * g) * 2) = (u32x4_t){pk2(o[0], o[1]), pk2(o[2], o[3]), pk2(o[4], o[5]), pk2(o[6], o[7])}; }
#pragma unroll
            for (int i = 0; i < 5; ++i) unpack8(zk[i], fz[i]);
#pragma unroll
            for (int r = 0; r < 2; ++r) { float o[8];
#pragma unroll
                for (int j = 0; j < 8; ++j) { const int c = 128 + 8 * g + j; float cv = F[F_CB + c];
#pragma unroll
                    for (int tap = 0; tap < 4; ++tap) cv += F[F_CW + tap * 256 + c] * fz[r + tap][j];
                    o[j] = cv * sigmoid_f(cv); }
                MLM_LDS(u32x4_t, OFF_KS + ((2 * tp + r) * RS + 8 * g) * 2) = (u32x4_t){pk2(o[0], o[1]), pk2(o[2], o[3]), pk2(o[4], o[5]), pk2(o[6], o[7])}; }
#pragma unroll
            for (int r = 0; r < 2; ++r) { MLM_LDS(u32x4_t, OFF_VS + ((2 * tp + r) * RS + 8 * g) * 2) = (u32x4_t){rv[r].x, rv[r].y, rv[r].z, rv[r].w};
                MLM_LDS(u32x4_t, OFF_OG + ((2 * tp + r) * RS + 8 * g) * 2) = (u32x4_t){rog[r].x, rog[r].y, rog[r].z, rog[r].w}; }
            if (tid < 64) { F[F_SIG + tid] = rgi + igb; F[F_SLF + tid] = log_sigmoid_f(rgf + fgb); }
        }
        __syncthreads();
        if (chunk + 1 < SEQ / 64) MLM_LOAD_RAW(chunk + 1);
        if (w == 0) {
            const float ig = F[F_SIG + lane], lf = F[F_SLF + lane];
            float bs = lf;
#pragma unroll
            for (int o = 1; o < 64; o <<= 1) { const float v = __shfl_up(bs, o); if (lane >= o) bs += v; }
            const float u = ig - bs; float pm = u;
#pragma unroll
            for (int o = 1; o < 64; o <<= 1) { const float v = __shfl_up(pm, o); if (lane >= o) pm = fmaxf(pm, v); }
            const float mtv = bs + fmaxf(m_old, pm);
            const float b_last = __shfl(bs, 63), pm_last = __shfl(pm, 63);
            const float m_new = fmaxf(b_last + m_old, b_last + pm_last);
            F[F_SU + lane] = u; F[F_SBM + lane] = bs - mtv; F[F_CARRY + lane] = __expf(bs + m_old - mtv); F[F_WS + lane] = __expf(b_last + u - m_new); F[F_SEN + lane] = __expf(-mtv);
            if (lane == 0) F[F_SCAL] = __expf(b_last + m_old - m_new);
            m_old = m_new;
        }
        bf16x8_t qf[4];
#pragma unroll
        for (int ks = 0; ks < 4; ++ks) qf[ks] = *(const __attribute__((address_space(3))) bf16x8_t*)(smem + OFF_QS + ((16 * mt + fr) * RS + 32 * ks + 8 * fq) * 2);
        f32x4_t sacc[2];
#pragma unroll
        for (int n2 = 0; n2 < 2; ++n2) { sacc[n2] = (f32x4_t){0.f, 0.f, 0.f, 0.f};
#pragma unroll
            for (int ks = 0; ks < 4; ++ks) { const bf16x8_t kf = *(const __attribute__((address_space(3))) bf16x8_t*)(smem + OFF_KS + ((16 * (2 * nh + n2) + fr) * RS + 32 * ks + 8 * fq) * 2);
                sacc[n2] = __builtin_amdgcn_mfma_f32_16x16x32_bf16(qf[ks], kf, sacc[n2], 0, 0, 0); } }
        { const int t = tid >> 3, p = tid & 7; float f16[16];
            { const u32x4_t a_ = MLM_LDS(u32x4_t, OFF_QS + (t * RS + 16 * p) * 2), b_ = MLM_LDS(u32x4_t, OFF_QS + (t * RS + 16 * p + 8) * 2);
              unpack8(make_uint4(a_[0], a_[1], a_[2], a_[3]), f16); unpack8(make_uint4(b_[0], b_[1], b_[2], b_[3]), f16 + 8); }
            float qn = 0.f;
#pragma unroll
            for (int k = 0; k < 16; ++k) qn += f16[k] * F[F_SN + 16 * p + k];
            qn = red8_sum(qn); if (p == 0) F[F_SQN + t] = qn; }
        __syncthreads();
        {
            const f32x4_t bm = *(const __attribute__((address_space(3))) f32x4_t*)(F + F_SBM + 16 * mt + 4 * fq); float rs[4] = {0.f, 0.f, 0.f, 0.f};
#pragma unroll
            for (int n2 = 0; n2 < 2; ++n2) { const int s = 16 * (2 * nh + n2) + fr; const float us = F[F_SU + s];
#pragma unroll
                for (int r = 0; r < 4; ++r) { const int t = 16 * mt + 4 * fq + r; const float wgt = __expf(bm[r] + us); const float val = (s <= t) ? sacc[n2][r] * wgt : 0.f; rs[r] += val;
                    *(__attribute__((address_space(3))) bf16_t*)(smem + OFF_SC + (t * 72 + s) * 2) = (bf16_t)f2bf(val); } }
#pragma unroll
            for (int r = 0; r < 4; ++r) { float v = rs[r]; v = red16_sum(v); if (fr == 0) F[F_DENP + nh * 64 + 16 * mt + 4 * fq + r] = v; }
        }
        __syncthreads();
        f32x4_t nacc[4], qacc[4];
#pragma unroll
        for (int j = 0; j < 4; ++j) { nacc[j] = (f32x4_t){0.f, 0.f, 0.f, 0.f}; qacc[j] = (f32x4_t){0.f, 0.f, 0.f, 0.f}; }
#pragma unroll
        for (int ks = 0; ks < 2; ++ks) { const bf16x8_t af = *(const __attribute__((address_space(3))) bf16x8_t*)(smem + OFF_SC + ((16 * mt + fr) * 72 + 32 * ks + 8 * fq) * 2);
#pragma unroll
            for (int j = 0; j < 4; ++j) { const bf16x8_t vf = tr_frag(smem + OFF_VS + ((32 * ks + 8 * fq + (fr >> 2)) * RS + 16 * (4 * nh + j) + 4 * (fr & 3)) * 2, RS * 2);
                nacc[j] = __builtin_amdgcn_mfma_f32_16x16x32_bf16(af, vf, nacc[j], 0, 0, 0); }
            __builtin_amdgcn_sched_barrier(0); }
#pragma unroll
        for (int ks = 0; ks < 4; ++ks) { const bf16x8_t qf2 = *(const __attribute__((address_space(3))) bf16x8_t*)(smem + OFF_QS + ((16 * mt + fr) * RS + 32 * ks + 8 * fq) * 2);
#pragma unroll
            for (int j = 0; j < 4; ++j) { const bf16x8_t cf = *(const __attribute__((address_space(3))) bf16x8_t*)(smem + OFF_CT + ((16 * (4 * nh + j) + fr) * RS + 32 * ks + 8 * fq) * 2);
                qacc[j] = __builtin_amdgcn_mfma_f32_16x16x32_bf16(qf2, cf, qacc[j], 0, 0, 0); }
            __builtin_amdgcn_sched_barrier(0); }
        float hv[4][4];
        {
            const f32x4_t cy = *(const __attribute__((address_space(3))) f32x4_t*)(F + F_CARRY + 16 * mt + 4 * fq), d0 = *(const __attribute__((address_space(3))) f32x4_t*)(F + F_DENP + 16 * mt + 4 * fq),
                          d1 = *(const __attribute__((address_space(3))) f32x4_t*)(F + F_DENP + 64 + 16 * mt + 4 * fq), qn = *(const __attribute__((address_space(3))) f32x4_t*)(F + F_SQN + 16 * mt + 4 * fq),
                          en = *(const __attribute__((address_space(3))) f32x4_t*)(F + F_SEN + 16 * mt + 4 * fq);
#pragma unroll
            for (int r = 0; r < 4; ++r) { const float den = d0[r] + d1[r] + cy[r] * qn[r]; const float inv = 1.0f / fmaxf(fabsf(den), en[r]); float s1 = 0.f, s2 = 0.f;
#pragma unroll
                for (int j = 0; j < 4; ++j) { const float hh = (nacc[j][r] + cy[r] * qacc[j][r]) * inv; hv[j][r] = hh; s1 += hh; s2 += hh * hh; }
                s1 = red16_sum(s1);
                s2 = red16_sum(s2);
                if (fr == 0) { F[F_STAT + (nh * 64 + 16 * mt + 4 * fq + r) * 2] = s1; F[F_STAT + (nh * 64 + 16 * mt + 4 * fq + r) * 2 + 1] = s2; } }
        }
        __syncthreads();
        {
#pragma unroll
            for (int r = 0; r < 4; ++r) { const int t = 16 * mt + 4 * fq + r;
                const float s1 = F[F_STAT + t * 2] + F[F_STAT + (64 + t) * 2], s2 = F[F_STAT + t * 2 + 1] + F[F_STAT + (64 + t) * 2 + 1];
                const float mean = s1 * (1.f / 128.f); const float var = fmaxf(s2 * (1.f / 128.f) - mean * mean, 0.f); const float rstd = rsqrtf(var + LN_EPS);
#pragma unroll
                for (int j = 0; j < 4; ++j) { const int v = 16 * (4 * nh + j) + fr; const float og = bf2f(*(const __attribute__((address_space(3))) bf16_t*)(smem + OFF_OG + (t * RS + v) * 2));
                    const float o = ((hv[j][r] - mean) * rstd * F[F_HNG + v] + F[F_HNB + v]) * sigmoid_f(og);
                    A.ycat[(row0 + t) * 1024 + 512 + h * 128 + v] = (bf16_t)f2bf(o); } }
        }
        {
            const float keep = F[F_SCAL];
#pragma unroll
            for (int n = 0; n < 8; ++n) Cacc[n] = Cacc[n] * keep;
#pragma unroll
            for (int ks = 0; ks < 2; ++ks) {
                const bf16x8_t kraw = tr_frag(smem + OFF_KS + ((32 * ks + 8 * fq + (fr >> 2)) * RS + 16 * w + 4 * (fr & 3)) * 2, RS * 2);
                const f32x4_t w0 = *(const __attribute__((address_space(3))) f32x4_t*)(F + F_WS + 32 * ks + 8 * fq), w1 = *(const __attribute__((address_space(3))) f32x4_t*)(F + F_WS + 32 * ks + 8 * fq + 4);
                float kfv[8];
#pragma unroll
                for (int j = 0; j < 8; ++j) kfv[j] = bf2f((bf16_t)kraw[j]) * (j < 4 ? w0[j] : w1[j - 4]);
                const u32x4_t pk = (u32x4_t){pk2(kfv[0], kfv[1]), pk2(kfv[2], kfv[3]), pk2(kfv[4], kfv[5]), pk2(kfv[6], kfv[7])};
                const bf16x8_t af = __builtin_bit_cast(bf16x8_t, pk);
#pragma unroll
                for (int n = 0; n < 8; ++n) { const bf16x8_t vf = tr_frag(smem + OFF_VS + ((32 * ks + 8 * fq + (fr >> 2)) * RS + 16 * n + 4 * (fr & 3)) * 2, RS * 2);
                    Cacc[n] = __builtin_amdgcn_mfma_f32_16x16x32_bf16(af, vf, Cacc[n], 0, 0, 0); }
                __builtin_amdgcn_sched_barrier(0); }
#pragma unroll
            for (int n = 0; n < 8; ++n) MLM_LDS(u32x2_t, OFF_CT + ((16 * n + fr) * RS + 16 * w + 4 * fq) * 2) = (u32x2_t){pk2(Cacc[n][0], Cacc[n][1]), pk2(Cacc[n][2], Cacc[n][3])};
            if (tid < 128) { float nn = keep * F[F_SN + tid];
#pragma unroll 16
                for (int s = 0; s < 64; ++s) nn += F[F_WS + s] * bf2f(*(const __attribute__((address_space(3))) bf16_t*)(smem + OFF_KS + (s * RS + tid) * 2));
                F[F_SN + tid] = nn; }
        }
        __syncthreads();
    }
}
#undef MLM_LOAD_RAW
#undef MLM_IDX
#undef MLM_LDS
}

constexpr size_t MiB = 1u << 20;
constexpr size_t WS_CTL = 0, CTL_ZERO_BYTES = 64 * 1024, WS_W0IN = 1 * MiB, WS_WLR = 9 * MiB, WS_W0OUT = 10 * MiB, WS_WQ0 = 12 * MiB, WS_W1IN = 16 * MiB, WS_W1OUT = 24 * MiB, WS_WQ1 = 26 * MiB;
constexpr size_t WS_PK = 30 * MiB;
constexpr size_t WS_GATES = 31 * MiB, WS_CUM = 32 * MiB, WS_APP = 33 * MiB, WS_EID = 41 * MiB, WS_GATE = 49 * MiB, WS_ACTA = 57 * MiB;
constexpr size_t WS_TABU = 89 * MiB, WS_TABV = 121 * MiB, WS_P = 153 * MiB, WS_LRW = 281 * MiB, WS_LRA = 313 * MiB, WS_LRG = 329 * MiB, WS_END = 345 * MiB;
constexpr size_t WS_MIX = WS_P, WS_Q = WS_P + 64 * MiB;
constexpr int CW_BAR = 1024;
static_assert((CW_BAR + XCD_BAR_WORDS) * 4 <= (int)CTL_ZERO_BYTES, "barrier words inside the memset region");
constexpr int LDS_BYTES = 160 * 1024, LDS_MISC_OFF = LDS_BYTES - 256;
static_assert(mlm::LDS_BYTES <= LDS_MISC_OFF, "mlstm LDS");
static_assert(attn_body::LDS_BIAS_OFF + 8192 <= LDS_MISC_OFF && ML_LDS_BYTES <= LDS_MISC_OFF && PS_LDS_BYTES <= LDS_MISC_OFF && pg8::STAGE_BYTES <= LDS_MISC_OFF, "phase scratch below the LDS control words");

#if defined(MLSTM_VALU)
#define MLSTM_UNIT(ma, u) mlstm_unit(ma, u, (float*)lds)
#else
#define MLSTM_UNIT(ma, u) mlm::mlstm_unit_mfma(ma, u, lds)
#endif
#ifndef PROBE_DUP
#define PROBE_DUP 0
#endif
struct MegaArgs { const float* in[43]; float* out; unsigned char* ws; };

__global__ void __launch_bounds__(NTHR, 2) mega_kernel(MegaArgs a) {
    extern __shared__ __attribute__((aligned(16))) unsigned char lds[];
    const int tid = opaque_tid(); const int bid = (int)blockIdx.x, nblk = (int)gridDim.x;
#define WSP(T, off) ((T*)(opq_ptr(a.ws) + (off)))
#define INP(i) ((const float*)opq_ptr((unsigned char*)a.in[i]))
#define OUTP ((float*)opq_ptr((unsigned char*)a.out))
#define W0IN WSP(bf16_t, WS_W0IN)
#define WLR WSP(bf16_t, WS_WLR)
#define W0OUT WSP(bf16_t, WS_W0OUT)
#define WQ0 WSP(bf16_t, WS_WQ0)
#define W1IN WSP(bf16_t, WS_W1IN)
#define W1OUT WSP(bf16_t, WS_W1OUT)
#define WQ1 WSP(bf16_t, WS_WQ1)
#define PK WSP(bf16_t, WS_PK)
#define GATES WSP(float, WS_GATES)
#define CUM WSP(float, WS_CUM)
#define APP WSP(bf16_t, WS_APP)
#define EID WSP(int, WS_EID)
#define GATE WSP(float, WS_GATE)
#define ACTA WSP(bf16_t, WS_ACTA)
#define TABU WSP(unsigned char, WS_TABU)
#define TABV WSP(unsigned char, WS_TABV)
#define TABUS WSP(float, WS_TABU + 16 * MiB)
#define TABVS WSP(float, WS_TABV + 16 * MiB)
#define PBUF WSP(bf16_t, WS_P)
#define MIX WSP(float, WS_MIX)
#define QBUF WSP(bf16_t, WS_Q)
#define LRW WSP(float, WS_LRW)
#define LRA WSP(bf16_t, WS_LRA)
#define LRG WSP(bf16_t, WS_LRG)
    if (tid < 64) ((LAS unsigned*)((LAS unsigned char*)lds + LDS_MISC_OFF))[tid] = 0u;
    __syncthreads();
    XcdBarrier bar = xcd_barrier_post(WSP(unsigned, WS_CTL) + CW_BAR, (volatile LAS unsigned*)((LAS unsigned char*)lds + LDS_MISC_OFF + 32));
#define GRID_BAR() xcd_barrier(bar)
#define GEMM_PHASE(EpiT, Aop, Bop, Mv, Nv, Kv, Eobj) do { pg8::Gemm g_; g_.A = (Aop); g_.Bt = (Bop); g_.M = (Mv); g_.N = (Nv); g_.K = (Kv); pg8::StaticOrder S_; S_.init((Mv), (Nv), nblk, bid); \
        pg8::gemm_phase<EpiT, pg8::StaticOrder, true, true>((PG8_LAS unsigned char*)lds, g_, S_, (Eobj)); } while (0)

#if PROBE_DUP == 9
    for (int rep_ = 0; rep_ < 2; ++rep_)
#endif
    {
        float* tile = (float*)lds;
        transpose_cvt_phase(INP(1), 1024, L0_COLS, 0, L0_MAIN, W0IN, bid, nblk, tile);
        transpose_cvt_phase(INP(19), 1024, 1024, 0, 1024, W0OUT, bid, nblk, tile);
        transpose_cvt_phase(INP(22), 1024, 2048, 0, 2048, WQ0, bid, nblk, tile);
        transpose_cvt_phase(INP(29), 1024, L1_COLS, 0, L1_MAIN, W1IN, bid, nblk, tile);
        transpose_cvt_phase(INP(33), 1024, 1024, 0, 1024, W1OUT, bid, nblk, tile);
        transpose_cvt_phase(INP(36), 1024, 2048, 0, 2048, WQ1, bid, nblk, tile);
        build_wlr_phase(INP(4), INP(6), INP(7), WLR, bid, nblk);
        cvt_bf16_phase(INP(23), PK, 131072 / 8, bid, nblk); cvt_bf16_phase(INP(24), PK + 131072, 131072 / 8, bid, nblk);
        cvt_bf16_phase(INP(37), PK + 262144, 131072 / 8, bid, nblk); cvt_bf16_phase(INP(38), PK + 393216, 131072 / 8, bid, nblk);
        cvt_bf16_phase(INP(0), ACTA, (size_t)T_TOK * 1024 / 8, bid, nblk);
        cvt_fp8_rows_phase(INP(25), TABU, TABUS, bid, nblk); cvt_fp8_rows_phase(INP(26), TABV, TABVS, bid, nblk);
    }
    GRID_BAR();
#if PROBE_DUP == 4
    for (int rep_ = 0; rep_ < 8; ++rep_) { GRID_BAR(); }
#endif
    { pg8::EpiBf16P E; E.O = PBUF; E.ldc = L0_MAIN; GEMM_PHASE(pg8::EpiBf16P, ACTA, W0IN, T_TOK, L0_MAIN, 1024, E); }
    gates_phase<8>(INP(0), INP(1), L0_COLS, L0_MAIN, GATES, bid, nblk, (float*)lds);
    GRID_BAR();
    rwkv_prep_phase(PBUF, INP(2), APP, bid, nblk);
    GRID_BAR();
    { pg8::EpiLowrank E; E.lrw = LRW; E.lra = LRA; E.lrg = LRG; E.w0 = INP(3); E.a0 = INP(5); GEMM_PHASE(pg8::EpiLowrank, APP, WLR, T_TOK, 1536, 256, E); }
    GRID_BAR();
    {
        RwkvArgs ra; ra.P0 = PBUF; ra.lrw = LRW; ra.lra = LRA; ra.lrg = LRG; ra.mu = INP(2); ra.k_k = INP(8); ra.k_a = INP(9); ra.r_k = INP(10); ra.ln_g = INP(11); ra.ln_b = INP(12); ra.ycat = ACTA;
        MlstmArgs ma; ma.P0 = PBUF; ma.gates = GATES; ma.conv_w = INP(13); ma.conv_b = INP(14); ma.ig_b = INP(15); ma.fg_b = INP(16); ma.hn_g = INP(17); ma.hn_b = INP(18); ma.ycat = ACTA;
        for (int u = bid; u < 96; u += nblk) { if (u < 64) rwkv_scan_unit(ra, u, (float*)lds); else MLSTM_UNIT(ma, u - 64); }
#if PROBE_DUP == 1
        GRID_BAR();
        for (int u = bid; u < 96; u += nblk) { if (u < 64) rwkv_scan_unit(ra, u, (float*)lds); else MLSTM_UNIT(ma, u - 64); }
#endif
#if PROBE_DUP == 7
        GRID_BAR();
        for (int u = bid; u < 64; u += nblk) { rwkv_scan_unit(ra, u, (float*)lds); }
#endif
#if PROBE_DUP == 8
        GRID_BAR();
        for (int u = bid; u < 32; u += nblk) { MLSTM_UNIT(ma, u); }
#endif
    }
    GRID_BAR();
    { pg8::EpiF32 E; E.C = MIX; E.ldc = 1024; GEMM_PHASE(pg8::EpiF32, ACTA, W0OUT, T_TOK, 1024, 1024, E); }
    GRID_BAR();
    ln_phase(INP(0), MIX, INP(20), INP(21), OUTP, ACTA, bid, nblk);
    GRID_BAR();
    { pg8::EpiBf16P E; E.O = QBUF; E.ldc = 2048; GEMM_PHASE(pg8::EpiBf16P, ACTA, WQ0, T_TOK, 2048, 1024, E);
#if PROBE_DUP == 5
      GRID_BAR(); GEMM_PHASE(pg8::EpiBf16P, ACTA, WQ0, T_TOK, 2048, 1024, E); GRID_BAR(); GEMM_PHASE(pg8::EpiBf16P, ACTA, WQ0, T_TOK, 2048, 1024, E);
#endif
    }
    GRID_BAR();
    { PeerSArgs sa; sa.Q = QBUF; sa.K1b = PK; sa.K2b = PK + 131072; sa.eid = EID; sa.gate = GATE; peer_scores_phase(sa, bid, nblk, lds);
#if PROBE_DUP == 3
      GRID_BAR(); peer_scores_phase(sa, bid, nblk, lds);
#endif
    }
    GRID_BAR();
#if PROBE_DUP == 2
    { PeerGArgs ga; ga.X = OUTP; ga.Xo = MIX; ga.eid = EID; ga.gate = GATE; ga.U = TABU; ga.V = TABV; ga.Us = TABUS; ga.Vs = TABVS; ga.lng = INP(27); ga.lnb = INP(28); ga.xb = QBUF; peer_gather_phase(ga, bid, nblk); }
    GRID_BAR();
#endif
    { PeerGArgs ga; ga.X = OUTP; ga.Xo = OUTP; ga.eid = EID; ga.gate = GATE; ga.U = TABU; ga.V = TABV; ga.Us = TABUS; ga.Vs = TABVS; ga.lng = INP(27); ga.lnb = INP(28); ga.xb = ACTA; peer_gather_phase(ga, bid, nblk); }
    GRID_BAR();
    cvt_fp8_rows_phase(INP(39), TABU, TABUS, bid, nblk); cvt_fp8_rows_phase(INP(40), TABV, TABVS, bid, nblk);
    { pg8::EpiBf16P E; E.O = PBUF; E.ldc = L1_MAIN; GEMM_PHASE(pg8::EpiBf16P, ACTA, W1IN, T_TOK, L1_MAIN, 1024, E); }
    gates_phase<16>(OUTP, INP(29), L1_COLS, L1_MAIN, GATES, bid, nblk, (float*)lds);
    GRID_BAR();
    fox_cumsum_phase(GATES, INP(32), CUM, bid, nblk);
#if defined(ATTN_VALU)
    GRID_BAR();
    { AttnArgs aa; aa.P1 = PBUF; aa.cum = CUM; aa.qn_g = INP(30); aa.kn_g = INP(31); aa.out = ACTA; attn_valu_phase(aa, bid, nblk, (float*)lds); }
#else
    fox_qknorm_phase(PBUF, INP(30), INP(31), bid, nblk);
    GRID_BAR();
    { const attn_body::AttnTensors AT{(const attn_body::bf16*)PBUF, (const attn_body::bf16*)(PBUF + 1024), (const attn_body::bf16*)(PBUF + 2048), (const attn_body::bf16*)(PBUF + 3072), CUM, (attn_body::bf16*)ACTA};
      const attn_body::StaticOrder S_(nblk, bid); attn_body::attn_phase<attn_body::StaticOrder>((char*)lds, AT, S_);
#if PROBE_DUP == 6
      GRID_BAR(); attn_body::attn_phase<attn_body::StaticOrder>((char*)lds, AT, S_);
#endif
    }
#endif
    GRID_BAR();
    { pg8::EpiF32 E; E.C = MIX; E.ldc = 1024; GEMM_PHASE(pg8::EpiF32, ACTA, W1OUT, T_TOK, 1024, 1024, E); }
    GRID_BAR();
    ln_phase(OUTP, MIX, INP(34), INP(35), OUTP, ACTA, bid, nblk);
    GRID_BAR();
    { pg8::EpiBf16P E; E.O = QBUF; E.ldc = 2048; GEMM_PHASE(pg8::EpiBf16P, ACTA, WQ1, T_TOK, 2048, 1024, E); }
    GRID_BAR();
    { PeerSArgs sa; sa.Q = QBUF; sa.K1b = PK + 262144; sa.K2b = PK + 393216; sa.eid = EID; sa.gate = GATE; peer_scores_phase(sa, bid, nblk, lds); }
    GRID_BAR();
    { PeerGArgs ga; ga.X = OUTP; ga.Xo = OUTP; ga.eid = EID; ga.gate = GATE; ga.U = TABU; ga.V = TABV; ga.Us = TABUS; ga.Vs = TABVS; ga.lng = INP(41); ga.lnb = INP(42); ga.xb = ACTA; peer_gather_phase(ga, bid, nblk); }
#undef GRID_BAR
#undef GEMM_PHASE
#undef WSP
#undef INP
#undef OUTP
#undef W0IN
#undef WLR
#undef W0OUT
#undef WQ0
#undef W1IN
#undef W1OUT
#undef WQ1
#undef PK
#undef GATES
#undef CUM
#undef APP
#undef EID
#undef GATE
#undef ACTA
#undef TABU
#undef TABV
#undef TABUS
#undef TABVS
#undef PBUF
#undef MIX
#undef QBUF
#undef LRW
#undef LRA
#undef LRG
}

extern "C" void kernel_launch(void* const* d_in, const int* in_sizes, int n_in, void* d_out, int out_size, void* d_ws, size_t ws_size, hipStream_t stream) {
    static int grid = 0;
    if (grid == 0) {
        if (n_in != 43 || ws_size < WS_END) { fprintf(stderr, "kernel_launch: unexpected n_in %d or ws_size %zu (< %zu); nothing launched\n", n_in, ws_size, (size_t)WS_END); grid = -1; return; }
        int dev = 0, cus = 0;
        if (hipGetDevice(&dev) != hipSuccess || hipDeviceGetAttribute(&cus, hipDeviceAttributeMultiprocessorCount, dev) != hipSuccess) { fprintf(stderr, "kernel_launch: device query failed\n"); grid = -1; return; }
        if (hipFuncSetAttribute((const void*)mega_kernel, hipFuncAttributeMaxDynamicSharedMemorySize, LDS_BYTES) != hipSuccess) { fprintf(stderr, "kernel_launch: hipFuncSetAttribute failed\n"); grid = -1; return; }
        (void)hipGetLastError();
        grid = cus;
    }
    if (grid < 0) return;
    (void)hipMemsetAsync((char*)d_ws + WS_CTL, 0, CTL_ZERO_BYTES, stream);
    MegaArgs a; memset(&a, 0, sizeof(a));
    for (int i = 0; i < 43; ++i) a.in[i] = (const float*)d_in[i];
    a.out = (float*)d_out; a.ws = (unsigned char*)d_ws;
    hipLaunchKernelGGL(mega_kernel, dim3(grid), dim3(NTHR), LDS_BYTES, stream, a);
}
```

```cpp
#include <hip/hip_runtime.h>
#include <cstdio>
#include <cstdint>
#include <cmath>
#include <cstring>
__device__ __forceinline__ int opaque_tid() { int t = (int)threadIdx.x; asm volatile("" : "+v"(t)); return t; }
__device__ __forceinline__ unsigned char* opq_ptr(unsigned char* p) { return p; }
namespace pg8 {
#define PG8_LAS __attribute__((address_space(3)))
typedef unsigned short bf16_t;
typedef short bf16x8 __attribute__((ext_vector_type(8)));
typedef float f32x4 __attribute__((ext_vector_type(4)));
typedef unsigned u32x4 __attribute__((ext_vector_type(4)));
constexpr int BM = 256, BK = 64, HALF = 128, HTB = HALF * BK * 2  , STAGE_BYTES = 8 * HTB, NXCD = 8, WGM = 8;

__host__ __device__ __forceinline__ int lds_byte(int r, int c) { const int st = (r >> 4) * 2 + (c >> 5), rr = r & 15, cc = c & 31, ob = rr * 64 + cc * 2; return st * 1024 + (ob ^ (((ob >> 9) & 1) << 5)); }
__host__ __device__ __forceinline__ void stage_rc(int b, int& R, int& C) { const int st = b / 1024, sb = b % 1024, swz = sb ^ (((sb >> 9) & 1) << 5); R = (st >> 1) * 16 + swz / 64; C = (st & 1) * 32 + (swz % 64) / 2; }
__host__ __device__ __forceinline__ int perm32(int rho) { const int n = rho >> 4, i = rho & 15; return 8 * (i >> 2) + 4 * n + (i & 3); }

struct Unit { int pm, pn; };
struct Gemm { const bf16_t* A; const bf16_t* Bt; int M, N, K; };

struct StaticOrder {
    int nM, nN, nwg, G, c;
    __host__ __device__ void init(int M, int N, int G_, int c_) { nM = M / BM; nN = N / BM; nwg = nM * nN; G = G_; c = c_; }
    __host__ __device__ bool next(int i, Unit& u) const {
        const long L = (long)i * G + c; if (L >= nwg) return false;
        int wgid = (int)L; { const int q = nwg / NXCD, r = nwg % NXCD, xcd = wgid % NXCD, off = wgid / NXCD; wgid = (xcd < r ? xcd * (q + 1) : r * (q + 1) + (xcd - r) * q) + off; }
        const int nig = WGM * nN, gid = wgid / nig, fm = gid * WGM, gsz = (nM - fm) < WGM ? (nM - fm) : WGM;
        u.pm = fm + ((wgid % nig) % gsz); u.pn = (wgid % nig) / gsz; return true;
    }
    __device__ __forceinline__ void a_ready(const Unit&) const {}
    __device__ __forceinline__ void done(const Unit&) const {}
};

__device__ __forceinline__ unsigned cvt_pk_bf16(float lo, float hi) { unsigned r; asm volatile("v_cvt_pk_bf16_f32 %0, %1, %2" : "=v"(r) : "v"(lo), "v"(hi)); return r; }
typedef float f32x2 __attribute__((ext_vector_type(2)));
__device__ __forceinline__ f32x2 gelu_pk(f32x2 v) {
    const f32x2 av = __builtin_elementwise_abs(v), d = av * 0.2316418882f + 1.0f;
    f32x2 t; t.x = __builtin_amdgcn_rcpf(d.x); t.y = __builtin_amdgcn_rcpf(d.y);
    f32x2 q = t * 0.5307027145f + (-0.7265760135f); q = q * t + 0.7107068705f; q = q * t + (-0.142248368f); q = q * t + 0.127414796f; q = q * t;
    const f32x2 s = (v * v) * (-0.72134752044f);
    f32x2 e; e.x = __builtin_amdgcn_exp2f(s.x); e.y = __builtin_amdgcn_exp2f(s.y);
    const f32x2 m = v * (q * e), r = v - m;
    f32x2 o; o.x = v.x < 0.f ? m.x : r.x; o.y = v.y < 0.f ? m.y : r.y; return o;
}

template <int ACT  > struct EpiBf16 {
    static constexpr bool PERM = true, AFTER_DRAIN = false; static_assert(ACT == 0 || ACT == 1, "EpiBf16: ACT is 0 (none) or 1 (gelu_pk)");
    bf16_t* O; int ldc; const float* bias; int split_cols; size_t split_stride; float scale0;
    __device__ __forceinline__ void operator()(const f32x4 (&acc)[2][2][4][2], const Unit& u, int wr, int wc, int fr, int fq) const {
        const int row0 = u.pm * BM + wr * 64 + fr; int colt = u.pn * BM; bf16_t* base = O;
        float sc = 1.f; if (split_cols) { const int t = colt / split_cols; base += (size_t)t * split_stride; colt -= t * split_cols; if (t == 0) sc = scale0; }
        const int col0 = colt + wc * 32 + 8 * fq, bcol0 = u.pn * BM + wc * 32 + 8 * fq;
        f32x4 bv[2][2];
#pragma unroll
        for (int bj = 0; bj < 2; ++bj)
#pragma unroll
            for (int n = 0; n < 2; ++n) bv[bj][n] = bias ? *(const f32x4*)(bias + bcol0 + bj * HALF + 4 * n) : (f32x4){0.f, 0.f, 0.f, 0.f};
#pragma unroll
        for (int ai = 0; ai < 2; ++ai)
#pragma unroll
            for (int m = 0; m < 4; ++m) { bf16_t* rowp = base + (size_t)(row0 + ai * HALF + m * 16) * ldc + col0;
#pragma unroll
                for (int bj = 0; bj < 2; ++bj) { f32x4 v0 = acc[ai][bj][m][0] + bv[bj][0], v1 = acc[ai][bj][m][1] + bv[bj][1];
                    if (ACT == 1) { f32x2 a = gelu_pk((f32x2){v0[0], v0[1]}), b = gelu_pk((f32x2){v0[2], v0[3]}), c = gelu_pk((f32x2){v1[0], v1[1]}), d = gelu_pk((f32x2){v1[2], v1[3]});
                        v0 = (f32x4){a.x, a.y, b.x, b.y}; v1 = (f32x4){c.x, c.y, d.x, d.y}; }
                    v0 = v0 * sc; v1 = v1 * sc; u32x4 w; w.x = cvt_pk_bf16(v0[0], v0[1]); w.y = cvt_pk_bf16(v0[2], v0[3]); w.z = cvt_pk_bf16(v1[0], v1[1]); w.w = cvt_pk_bf16(v1[2], v1[3]);
                    *(u32x4*)(rowp + bj * HALF) = w; } }
    }
};

struct PanelStats {
    unsigned* xbuf;
    unsigned* cnt;
    unsigned* tmo;
    int ntn; float eps;
    unsigned code;
    __device__ __forceinline__ bool run(const f32x4 (&v)[2][2][4][2], const Unit& u, int wr, int wc, int fr, int fq, PG8_LAS unsigned char* lds, int wid, int lane) const {
        typedef float f32x2v __attribute__((ext_vector_type(2)));
        PG8_LAS f32x2v* P = (PG8_LAS f32x2v*)lds;
        PG8_LAS f32x2v* S = (PG8_LAS f32x2v*)(lds + 8192);
        PG8_LAS unsigned* flag = (PG8_LAS unsigned*)(lds + 8192 + 2048);
#pragma unroll
        for (int ai = 0; ai < 2; ++ai)
#pragma unroll
            for (int m = 0; m < 4; ++m) {
                float s = 0.f;
#pragma unroll
                for (int bj = 0; bj < 2; ++bj)
#pragma unroll
                    for (int n = 0; n < 2; ++n) { const f32x4 x = v[ai][bj][m][n]; s += (x[0] + x[1]) + (x[2] + x[3]); }
                s += __shfl_xor(s, 16); s += __shfl_xor(s, 32);
                const float mw = s * (1.0f / 64.0f); float q = 0.f;
#pragma unroll
                for (int bj = 0; bj < 2; ++bj)
#pragma unroll
                    for (int n = 0; n < 2; ++n) { const f32x4 d = v[ai][bj][m][n] - mw; q += (d[0] * d[0] + d[1] * d[1]) + (d[2] * d[2] + d[3] * d[3]); }
                q += __shfl_xor(q, 16); q += __shfl_xor(q, 32);
                if (fq == 0) P[(ai * HALF + wr * 64 + m * 16 + fr) * 4 + wc] = (f32x2v){mw, q};
            }
        asm volatile("s_waitcnt lgkmcnt(0)" ::: "memory"); __builtin_amdgcn_s_barrier(); asm volatile("" ::: "memory");
#if defined(BROKEN_EXCHANGE_NO_WAIT)
#warning BROKEN CONTROL BUILD: the row-statistics exchange does not wait; results are wrong by design
        if (blockIdx.x >= 64) { const long long t0_ = clock64(); while (clock64() - t0_ < 60000) __builtin_amdgcn_s_sleep(8); }
#endif
        const int row = wid * 32 + (lane & 31);
        if (lane < 32) {
            const f32x2v a = P[row * 4 + 0], b = P[row * 4 + 1], c = P[row * 4 + 2], d = P[row * 4 + 3];
            const float mt = (a.x + b.x + c.x + d.x) * 0.25f;
            const float da = a.x - mt, db = b.x - mt, dc = c.x - mt, dd = d.x - mt;
            const float m2 = (a.y + b.y) + (c.y + d.y) + 64.0f * ((da * da + db * db) + (dc * dc + dd * dd));
            unsigned long long* slot = (unsigned long long*)xbuf + ((size_t)(u.pm * BM + row) * 4 + u.pn);
            __hip_atomic_store(slot, ((unsigned long long)__float_as_uint(m2) << 32) | __float_as_uint(mt), __ATOMIC_RELAXED, __HIP_MEMORY_SCOPE_AGENT);
        }
        asm volatile("s_waitcnt vmcnt(0)" ::: "memory");
        if (lane == 0) __hip_atomic_fetch_add(cnt + 64 * u.pm, 1u, __ATOMIC_RELAXED, __HIP_MEMORY_SCOPE_AGENT);
        if (wid == 0) {
            bool dead = false; const unsigned long long t0 = __builtin_amdgcn_s_memrealtime(); const unsigned want = 8u * (unsigned)ntn;
            for (;;) {
#if defined(BROKEN_EXCHANGE_NO_WAIT)
                break;
#endif
                if ((unsigned)__builtin_amdgcn_readfirstlane(__hip_atomic_load(cnt + 64 * u.pm, __ATOMIC_RELAXED, __HIP_MEMORY_SCOPE_AGENT)) >= want) break;
                if (__builtin_amdgcn_s_memrealtime() - t0 > 2000000ull) {
                    if (lane == 0) { unsigned expect = 0u; __hip_atomic_compare_exchange_strong(tmo + 1, &expect, code | (unsigned)(u.pm & 0xff), __ATOMIC_RELAXED, __ATOMIC_RELAXED, __HIP_MEMORY_SCOPE_AGENT);
                                     __hip_atomic_store(tmo, 1u, __ATOMIC_RELAXED, __HIP_MEMORY_SCOPE_AGENT); }
                    dead = true; break; }
                __builtin_amdgcn_s_sleep(2);
            }
            __builtin_amdgcn_fence(__ATOMIC_ACQUIRE, "agent");
            if (lane == 0) flag[0] = dead ? 1u : 0u;
        }
        asm volatile("s_waitcnt vmcnt(0) lgkmcnt(0)" ::: "memory"); __builtin_amdgcn_s_barrier(); asm volatile("" ::: "memory");
        const bool bad = flag[0] != 0u;
        if (lane < 32) {
            const unsigned long long* slot = (const unsigned long long*)xbuf + (size_t)(u.pm * BM + row) * 4; float mt[4], m2[4]; float ms = 0.f;
#pragma unroll
            for (int t = 0; t < 4; ++t) { if (t < ntn) { const unsigned long long w = __hip_atomic_load(slot + t, __ATOMIC_RELAXED, __HIP_MEMORY_SCOPE_AGENT); mt[t] = __uint_as_float((unsigned)w); m2[t] = __uint_as_float((unsigned)(w >> 32)); } else { mt[t] = 0.f; m2[t] = 0.f; } ms += mt[t]; }
            const float mean = ms / (float)ntn; float q = 0.f;
#pragma unroll
            for (int t = 0; t < 4; ++t) if (t < ntn) { const float dm = mt[t] - mean; q += m2[t] + 256.0f * dm * dm; }
            S[row] = (f32x2v){mean, 1.0f / sqrtf(q / (256.0f * (float)ntn) + eps)};
        }
        asm volatile("s_waitcnt lgkmcnt(0)" ::: "memory"); __builtin_amdgcn_s_barrier(); asm volatile("" ::: "memory");
        return bad;
    }
};
struct EpiLnRes {
    static constexpr bool PERM = false, AFTER_DRAIN = true;
    const float* base; float* out; int ldc; const float* bias; PanelStats st; unsigned poison;
    __device__ __forceinline__ void fused(f32x4 (&acc)[2][2][4][2], const Unit& u, int wr, int wc, int fr, int fq, PG8_LAS unsigned char* lds, int wid, int lane) const {
        typedef float f32x2v __attribute__((ext_vector_type(2)));
        const PG8_LAS f32x2v* S = (const PG8_LAS f32x2v*)(lds + 8192);
        const int col0 = u.pn * BM + wc * 32 + 4 * fq;
#pragma unroll
        for (int bj = 0; bj < 2; ++bj)
#pragma unroll
            for (int n = 0; n < 2; ++n) { const f32x4 bv = bias ? *(const f32x4*)(bias + col0 + bj * HALF + n * 16) : (f32x4){0.f, 0.f, 0.f, 0.f};
#pragma unroll
                for (int ai = 0; ai < 2; ++ai)
#pragma unroll
                    for (int m = 0; m < 4; ++m) acc[ai][bj][m][n] += bv; }
        f32x4 pre[4][2][2];
#pragma unroll
        for (int m = 0; m < 4; ++m) { const size_t off = (size_t)(u.pm * BM + wr * 64 + m * 16 + fr) * ldc + col0;
#pragma unroll
            for (int bj = 0; bj < 2; ++bj)
#pragma unroll
                for (int n = 0; n < 2; ++n) pre[m][bj][n] = *(const f32x4*)(base + off + bj * HALF + n * 16); }
        const bool bad = st.run(acc, u, wr, wc, fr, fq, lds, wid, lane) || poison != 0u;
        const float qnan = __builtin_nanf("");
#pragma unroll
        for (int ai = 0; ai < 2; ++ai)
#pragma unroll
            for (int m = 0; m < 4; ++m) { const int r = ai * HALF + wr * 64 + m * 16 + fr; const f32x2v sr = S[r]; const size_t off = (size_t)(u.pm * BM + r) * ldc + col0;
#pragma unroll
                for (int bj = 0; bj < 2; ++bj)
#pragma unroll
                    for (int n = 0; n < 2; ++n) { const f32x4 bs = ai == 0 ? pre[m][bj][n] : *(const f32x4*)(base + off + bj * HALF + n * 16); f32x4 o = bs + (acc[ai][bj][m][n] - sr.x) * sr.y;
                        if (bad) o = (f32x4){qnan, qnan, qnan, qnan}; *(f32x4*)(out + off + bj * HALF + n * 16) = o; }
                if (m & 1) asm volatile("" ::: "memory"); }
    }
};
struct EpiLnResLn {
    static constexpr bool PERM = false, AFTER_DRAIN = true;
    const float* base; float* out; bf16_t* xn; int ldc; const float* bias; PanelStats st1, st2; unsigned poison;
    __device__ __forceinline__ void fused(f32x4 (&acc)[2][2][4][2], const Unit& u, int wr, int wc, int fr, int fq, PG8_LAS unsigned char* lds, int wid, int lane) const {
        typedef float f32x2v __attribute__((ext_vector_type(2))); typedef unsigned u32x2v __attribute__((ext_vector_type(2)));
        const PG8_LAS f32x2v* S = (const PG8_LAS f32x2v*)(lds + 8192);
        const int col0 = u.pn * BM + wc * 32 + 4 * fq;
#pragma unroll
        for (int bj = 0; bj < 2; ++bj)
#pragma unroll
            for (int n = 0; n < 2; ++n) { const f32x4 bv = bias ? *(const f32x4*)(bias + col0 + bj * HALF + n * 16) : (f32x4){0.f, 0.f, 0.f, 0.f};
#pragma unroll
                for (int ai = 0; ai < 2; ++ai)
#pragma unroll
                    for (int m = 0; m < 4; ++m) acc[ai][bj][m][n] += bv; }
        bool bad = st1.run(acc, u, wr, wc, fr, fq, lds, wid, lane) || poison != 0u;
        const float qnan = __builtin_nanf("");
#pragma unroll
        for (int ai = 0; ai < 2; ++ai)
#pragma unroll
            for (int m = 0; m < 4; ++m) { const int r = ai * HALF + wr * 64 + m * 16 + fr; const f32x2v sr = S[r]; const size_t off = (size_t)(u.pm * BM + r) * ldc + col0;
#pragma unroll
                for (int bj = 0; bj < 2; ++bj)
#pragma unroll
                    for (int n = 0; n < 2; ++n) { const f32x4 bs = *(const f32x4*)(base + off + bj * HALF + n * 16); acc[ai][bj][m][n] = bs + (acc[ai][bj][m][n] - sr.x) * sr.y; }
                asm volatile("" : "+v"(acc[ai][0][m][0]), "+v"(acc[ai][0][m][1]), "+v"(acc[ai][1][m][0]), "+v"(acc[ai][1][m][1]));
                if (m & 1) asm volatile("" ::: "memory"); }
        const bool bad1 = bad;
        bad = st2.run(acc, u, wr, wc, fr, fq, lds, wid, lane) || bad;
#pragma unroll
        for (int ai = 0; ai < 2; ++ai)
#pragma unroll
            for (int m = 0; m < 4; ++m) { const int r = ai * HALF + wr * 64 + m * 16 + fr; const f32x2v sr = S[r]; const size_t off = (size_t)(u.pm * BM + r) * ldc + col0;
#pragma unroll
                for (int bj = 0; bj < 2; ++bj)
#pragma unroll
                    for (int n = 0; n < 2; ++n) { const f32x4 x1 = acc[ai][bj][m][n]; *(f32x4*)(out + off + bj * HALF + n * 16) = bad1 ? (f32x4){qnan, qnan, qnan, qnan} : x1;
                        const f32x4 o = (x1 - sr.x) * sr.y; u32x2v w; w.x = cvt_pk_bf16(o[0], o[1]); w.y = cvt_pk_bf16(o[2], o[3]);
                        if (bad) { w.x = 0x7fc07fc0u; w.y = 0x7fc07fc0u; } *(u32x2v*)(xn + off + bj * HALF + n * 16) = w; }
                asm volatile("" ::: "memory"); }
    }
};

template <class Epi, class Sched, bool ALIGN_EPI = false, bool SP2 = false>
__device__ __forceinline__ void gemm_phase(PG8_LAS unsigned char* lds, const Gemm g, const Sched& S, const Epi& E) {
    const int tid = opaque_tid(), wid = __builtin_amdgcn_readfirstlane(tid >> 6), lane = tid & 63, wr = wid >> 2, wc = wid & 3, fr = lane & 15, fq = lane >> 4;
    const int K = g.K, nt = K / BK;
    unsigned voffA[2], voffB[2];
#pragma unroll
    for (int i = 0; i < 2; ++i) { int R, C; stage_rc(tid * 16 + i * 8192, R, C); const int Rb = Epi::PERM ? ((R & ~31) + perm32(R & 31)) : R;
        voffA[i] = (unsigned)(R * K + C) * 2u; voffB[i] = (unsigned)(Rb * K + C) * 2u; }
    const size_t kstep = (size_t)(BK * 2);
    const size_t hstep = (size_t)HALF * K * 2;
    const size_t tstep = 2 * hstep;
    const unsigned ldsw = (unsigned)wid * 1024u;
    const int aoff = lds_byte(wr * 64 + fr, fq * 8), boff = lds_byte(wc * 32 + fr, fq * 8);
#define PG8_SA(b, h) (((b) * 2 + (h)) * HTB)
#define PG8_SB(b, h) ((4 + (b) * 2 + (h)) * HTB)
#define PG8_STAGE(bufoff, gbase, voff) do { _Pragma("unroll") for (int _i = 0; _i < 2; ++_i) \
        __builtin_amdgcn_global_load_lds((const unsigned*)((const char*)(gbase) + (voff)[_i]), (PG8_LAS unsigned*)(lds + (bufoff) + ldsw + _i * 8192), 16, 0, 0); } while (0)
#define PG8_LDA(dst, b, h) do { _Pragma("unroll") for (int m = 0; m < 4; ++m) _Pragma("unroll") for (int k = 0; k < 2; ++k) dst[m][k] = *(const PG8_LAS bf16x8*)(lds + PG8_SA(b, h) + aoff + m * 2048 + k * 1024); } while (0)
#define PG8_LDB(dst, b, h) do { _Pragma("unroll") for (int n = 0; n < 2; ++n) _Pragma("unroll") for (int k = 0; k < 2; ++k) dst[n][k] = *(const PG8_LAS bf16x8*)(lds + PG8_SB(b, h) + boff + n * 2048 + k * 1024); } while (0)
#define PG8_MMA(ai, bj, At, Bt) do { __builtin_amdgcn_s_setprio(1); _Pragma("unroll") for (int m = 0; m < 4; ++m) _Pragma("unroll") for (int n = 0; n < 2; ++n) _Pragma("unroll") for (int k = 0; k < 2; ++k) \
        acc[ai][bj][m][n] = __builtin_amdgcn_mfma_f32_16x16x32_bf16(Bt[n][k], At[m][k], acc[ai][bj][m][n], 0, 0, 0); __builtin_amdgcn_s_setprio(0); } while (0)
#define PG8_WAIT_V(n) asm volatile("s_waitcnt vmcnt(" #n ")" ::: "memory")
#define PG8_WAIT_L(n) asm volatile("s_waitcnt lgkmcnt(" #n ")" ::: "memory")
#define PG8_BAR __builtin_amdgcn_s_barrier()
#define PG8_SCHED __builtin_amdgcn_sched_barrier(0)
    Unit cur, nxt; int ui = 0;
    if (!S.next(0, cur)) return;
    f32x4 acc[2][2][4][2];
#pragma unroll
    for (int a = 0; a < 2; ++a)
#pragma unroll
        for (int b = 0; b < 2; ++b)
#pragma unroll
            for (int m = 0; m < 4; ++m)
#pragma unroll
                for (int n = 0; n < 2; ++n) acc[a][b][m][n] = (f32x4){0.f, 0.f, 0.f, 0.f};
    bf16x8 At[4][2], B0[2][2], B1[2][2];
    const char* cA = (const char*)g.A + (size_t)cur.pm * tstep; const char* cB = (const char*)g.Bt + (size_t)cur.pn * tstep;
    S.a_ready(cur);
    if constexpr (SP2) {
        PG8_STAGE(PG8_SB(0, 0), cB, voffB); PG8_STAGE(PG8_SB(0, 1), cB + hstep, voffB); PG8_STAGE(PG8_SA(0, 0), cA, voffA); PG8_STAGE(PG8_SA(0, 1), cA + hstep, voffA);
        if (wr == 1) PG8_BAR;
        PG8_WAIT_V(2); PG8_BAR;
        PG8_STAGE(PG8_SB(1, 0), cB + kstep, voffB); PG8_STAGE(PG8_SA(1, 0), cA + kstep, voffA); PG8_STAGE(PG8_SB(1, 1), cB + hstep + kstep, voffB);
        PG8_WAIT_V(6); PG8_BAR;
    } else {
        PG8_STAGE(PG8_SB(0, 0), cB, voffB); PG8_STAGE(PG8_SA(0, 0), cA, voffA); PG8_STAGE(PG8_SB(0, 1), cB + hstep, voffB); PG8_STAGE(PG8_SA(0, 1), cA + hstep, voffA);
        if (wr == 1) PG8_BAR;
        PG8_WAIT_V(4); PG8_BAR;
        PG8_STAGE(PG8_SB(1, 0), cB + kstep, voffB); PG8_STAGE(PG8_SA(1, 0), cA + kstep, voffA); PG8_STAGE(PG8_SB(1, 1), cB + hstep + kstep, voffB);
        PG8_WAIT_V(6); PG8_BAR;
    }
    for (;;) {
        const bool has_next = S.next(ui + 1, nxt);
        const char* nA = has_next ? (const char*)g.A + (size_t)nxt.pm * tstep : cA; const char* nB = has_next ? (const char*)g.Bt + (size_t)nxt.pn * tstep : cB;
        for (int t = 0; t < nt; t += 2) {
            const bool last = (t == nt - 2);
            const char* a1 = cA + (size_t)(t + 1) * kstep;
            const char* a2 = last ? nA : cA + (size_t)(t + 2) * kstep; const char* b2 = last ? nB : cB + (size_t)(t + 2) * kstep;
            const char* a3 = a2 + kstep; const char* b3 = b2 + kstep;
            if (last && has_next) S.a_ready(nxt);
            if constexpr (SP2) {
            PG8_LDB(B0, 0, 0); PG8_LDB(B1, 0, 1); PG8_SCHED; PG8_LDA(At, 0, 0); PG8_STAGE(PG8_SA(1, 1), a1 + hstep, voffA);
            PG8_WAIT_V(8); PG8_WAIT_L(0); PG8_BAR; PG8_MMA(0, 0, At, B0); PG8_MMA(0, 1, At, B1); PG8_BAR; PG8_SCHED;
            PG8_LDA(At, 0, 1); PG8_STAGE(PG8_SB(0, 0), b2, voffB); PG8_STAGE(PG8_SB(0, 1), b2 + hstep, voffB); PG8_STAGE(PG8_SA(0, 0), a2, voffA);
            PG8_WAIT_V(8); PG8_WAIT_L(0); PG8_BAR; PG8_MMA(1, 0, At, B0); PG8_MMA(1, 1, At, B1); PG8_BAR; PG8_SCHED;
            PG8_LDB(B0, 1, 0); PG8_LDB(B1, 1, 1); PG8_SCHED; PG8_LDA(At, 1, 0); PG8_STAGE(PG8_SA(0, 1), a2 + hstep, voffA);
            PG8_WAIT_V(8); PG8_WAIT_L(0); PG8_BAR; PG8_MMA(0, 0, At, B0); PG8_MMA(0, 1, At, B1); PG8_BAR; PG8_SCHED;
            PG8_LDA(At, 1, 1); PG8_STAGE(PG8_SB(1, 0), b3, voffB); PG8_STAGE(PG8_SB(1, 1), b3 + hstep, voffB); PG8_STAGE(PG8_SA(1, 0), a3, voffA);
            PG8_WAIT_V(8); PG8_WAIT_L(0); PG8_BAR; PG8_MMA(1, 0, At, B0); PG8_MMA(1, 1, At, B1); PG8_BAR; PG8_SCHED;
            } else {
            PG8_LDB(B0, 0, 0); PG8_SCHED; PG8_LDA(At, 0, 0); PG8_STAGE(PG8_SA(1, 1), a1 + hstep, voffA);
            PG8_WAIT_L(8); PG8_BAR; PG8_WAIT_L(0); PG8_MMA(0, 0, At, B0); PG8_BAR; PG8_SCHED;
            PG8_LDB(B1, 0, 1); PG8_STAGE(PG8_SB(0, 0), b2, voffB);
            PG8_BAR; PG8_WAIT_L(0); PG8_MMA(0, 1, At, B1); PG8_BAR;
            PG8_LDA(At, 0, 1); PG8_STAGE(PG8_SA(0, 0), a2, voffA);
            PG8_BAR; PG8_WAIT_L(0); PG8_MMA(1, 0, At, B0); PG8_BAR; PG8_SCHED;
            PG8_STAGE(PG8_SB(0, 1), b2 + hstep, voffB);
            PG8_WAIT_V(6); PG8_BAR; PG8_MMA(1, 1, At, B1); PG8_BAR;
            PG8_LDB(B0, 1, 0); PG8_SCHED; PG8_LDA(At, 1, 0); PG8_STAGE(PG8_SA(0, 1), a2 + hstep, voffA);
            PG8_WAIT_L(8); PG8_BAR; PG8_WAIT_L(0); PG8_MMA(0, 0, At, B0); PG8_BAR; PG8_SCHED;
            PG8_LDB(B1, 1, 1); PG8_STAGE(PG8_SB(1, 0), b3, voffB);
            PG8_BAR; PG8_WAIT_L(0); PG8_MMA(0, 1, At, B1); PG8_BAR;
            PG8_LDA(At, 1, 1); PG8_STAGE(PG8_SA(1, 0), a3, voffA);
            PG8_BAR; PG8_WAIT_L(0); PG8_MMA(1, 0, At, B0); PG8_BAR; PG8_SCHED;
            PG8_STAGE(PG8_SB(1, 1), b3 + hstep, voffB);
            PG8_WAIT_V(6); PG8_BAR; PG8_MMA(1, 1, At, B1); PG8_BAR;
            }
        }
        if constexpr (ALIGN_EPI) { if (wr == 0) PG8_BAR; }
        if constexpr (!Epi::AFTER_DRAIN) { E(acc, cur, wr, wc, fr, fq); S.done(cur); }
        if (!has_next) break;
#pragma unroll
        for (int a = 0; a < 2; ++a)
#pragma unroll
            for (int b = 0; b < 2; ++b)
#pragma unroll
                for (int m = 0; m < 4; ++m)
#pragma unroll
                    for (int n = 0; n < 2; ++n) acc[a][b][m][n] = (f32x4){0.f, 0.f, 0.f, 0.f};
        cur = nxt; cA = nA; cB = nB; ++ui;
        if constexpr (ALIGN_EPI) { if (wr == 1) PG8_BAR; }
    }
    PG8_WAIT_V(0);
    if constexpr (!ALIGN_EPI) { if (wr == 0) PG8_BAR; }
    PG8_BAR;
    if constexpr (Epi::AFTER_DRAIN) { E.fused(acc, cur, wr, wc, fr, fq, lds, wid, lane); S.done(cur); }
#undef PG8_SA
#undef PG8_SB
#undef PG8_STAGE
#undef PG8_LDA
#undef PG8_LDB
#undef PG8_MMA
#undef PG8_WAIT_V
#undef PG8_WAIT_L
#undef PG8_BAR
#undef PG8_SCHED
}
}
#include <hip/hip_bf16.h>
#include <cmath>
namespace attn_body {
using bf16=__hip_bfloat16;
using bf16x8=__attribute__((ext_vector_type(8)))short;
using s16x4=__attribute__((ext_vector_type(4)))short;
using f32x16=__attribute__((ext_vector_type(16)))float;
using u32x4=__attribute__((ext_vector_type(4)))unsigned;
using f32x4b=__attribute__((ext_vector_type(4)))float;
constexpr int BATCH=8,NHEAD=16,SEQ=2048,D=64,DM=4096,DMO=1024;
constexpr int NW=8,QBLK=32,QB=QBLK*NW,KVBLK=64,NQB=SEQ/QB;
constexpr int ATTN_PITCH=DM, ATTN_UNIT_ROWS=QB;
constexpr int LDS_BIAS_OFF=86016;
__device__ __forceinline__ int crow(int r,int hi){return (r&3)+8*(r>>2)+4*hi;}
#define SBAR() __builtin_amdgcn_sched_barrier(0)
__device__ __forceinline__ void cmask(f32x16&p0,f32x16&p1,int jb,int qrel,int hi){
  const float NEG=-INFINITY; int kb=64*jb+4*hi;
  #pragma unroll
  for(int r=0;r<16;++r){int kv=kb+(r&3)+8*(r>>2); if(kv>qrel)p0[r]=NEG; if(kv+32>qrel)p1[r]=NEG;}
}

constexpr int NSLOT=3, SLOTB=8192;
constexpr int LDS_K=0, LDS_V=NSLOT*SLOTB, LDS_WS=2*NSLOT*SLOTB, LDS_OST=LDS_WS+NW*64*4, LDS_BYTES=LDS_OST+NW*4096;
constexpr float C2=0.125f*1.4426950408889634f;
__device__ __forceinline__ void glds16(const void*gsrc,unsigned lds_dst){unsigned keep;
  asm volatile("s_mov_b32 %0, m0\n\ts_mov_b32 m0, %2\n\ts_nop 0\n\tglobal_load_lds_dwordx4 %1, off\n\ts_mov_b32 m0, %0":"=&s"(keep):"v"(gsrc),"s"(lds_dst):"memory");}
__device__ __forceinline__ float max3f(float a,float b,float c){float r;asm("v_max3_f32 %0, %1, %2, %3":"=v"(r):"v"(a),"v"(b),"v"(c));return r;}
__device__ __forceinline__ float max2f(float a,float b){float r;asm("v_max_f32_e32 %0, %1, %2":"=v"(r):"v"(a),"v"(b));return r;}
__device__ __forceinline__ float fadd_s(float a,float b){float r;asm("v_add_f32_e32 %0, %1, %2":"=v"(r):"v"(a),"v"(b));return r;}
__device__ __forceinline__ float fsub_s(float a,float b){float r;asm("v_sub_f32_e32 %0, %1, %2":"=v"(r):"v"(a),"v"(b));return r;}
typedef float f32x2_t __attribute__((ext_vector_type(2))); typedef __bf16 bf16x2_t __attribute__((ext_vector_type(2)));
__device__ __forceinline__ unsigned cvtpk_s(float lo,float hi){f32x2_t v={lo,hi};bf16x2_t b=__builtin_convertvector(v,bf16x2_t);return __builtin_bit_cast(unsigned,b);}
#define WAIT_BAR(N) asm volatile("s_waitcnt vmcnt(" #N ") lgkmcnt(0)\n\ts_barrier":::"memory")

__device__ __forceinline__ void qkt(f32x16&p0,f32x16&p1,const char*Kslot,const bf16x8*qr,const f32x16&negm,int r32,int hi){
  const char*kb=Kslot+hi*1024+r32*16;
  #pragma unroll
  for(int d0=0;d0<4;++d0){
    const bf16x8 b0=*reinterpret_cast<const bf16x8*>(kb+d0*2048);
    const bf16x8 b1=*reinterpret_cast<const bf16x8*>(kb+d0*2048+512);
    if(d0==0){p0=__builtin_amdgcn_mfma_f32_32x32x16_bf16(b0,qr[0],negm,0,0,0);p1=__builtin_amdgcn_mfma_f32_32x32x16_bf16(b1,qr[0],negm,0,0,0);}
    else{p0=__builtin_amdgcn_mfma_f32_32x32x16_bf16(b0,qr[d0],p0,0,0,0);p1=__builtin_amdgcn_mfma_f32_32x32x16_bf16(b1,qr[d0],p1,0,0,0);}}
}
typedef __attribute__((address_space(3))) const char* lds_cptr;
typedef short v4i16_t __attribute__((ext_vector_type(4)));
__device__ __forceinline__ void kload8(bf16x8*kf,lds_cptr kp){
  kf[0]=*(const __attribute__((address_space(3))) bf16x8*)(kp);      kf[1]=*(const __attribute__((address_space(3))) bf16x8*)(kp+512);
  kf[2]=*(const __attribute__((address_space(3))) bf16x8*)(kp+2048); kf[3]=*(const __attribute__((address_space(3))) bf16x8*)(kp+2560);
  kf[4]=*(const __attribute__((address_space(3))) bf16x8*)(kp+4096); kf[5]=*(const __attribute__((address_space(3))) bf16x8*)(kp+4608);
  kf[6]=*(const __attribute__((address_space(3))) bf16x8*)(kp+6144); kf[7]=*(const __attribute__((address_space(3))) bf16x8*)(kp+6656);
}
__device__ __forceinline__ void kload2(bf16x8*kf,lds_cptr kp,int j){ kf[2*j]=*(const __attribute__((address_space(3))) bf16x8*)(kp+j*2048); kf[2*j+1]=*(const __attribute__((address_space(3))) bf16x8*)(kp+j*2048+512); }
__device__ __forceinline__ s16x4 vtr(lds_cptr p){ return __builtin_bit_cast(s16x4,__builtin_amdgcn_ds_read_tr16_b64_v4i16((__attribute__((address_space(3))) v4i16_t*)p)); }
__device__ __forceinline__ float rowmax(const f32x16&p0,const f32x16&p1){
  float a=max3f(p0[0],p0[1],p1[0]),b=max3f(p0[2],p0[3],p1[1]);a=max3f(a,p1[2],p1[3]);
  #pragma unroll
  for(int r=4;r<16;r+=4){a=max3f(a,p0[r],p0[r+1]);b=max3f(b,p0[r+2],p0[r+3]);a=max3f(a,p1[r],p1[r+1]);b=max3f(b,p1[r+2],p1[r+3]);}
  const float m=max2f(a,b);
  auto rr=__builtin_amdgcn_permlane32_swap(__float_as_uint(m),__float_as_uint(m),false,false);
  return max2f(__uint_as_float(rr[0]),__uint_as_float(rr[1]));
}
__device__ __forceinline__ void pv(f32x16*o,int vb,bf16x8 pa0,bf16x8 pa1,bf16x8 pa2,bf16x8 pa3){
  #pragma unroll
  for(int d0=0;d0<2;++d0){s16x4 lo[4],hi[4];
    #pragma unroll
    for(int ks=0;ks<4;++ks){
      asm volatile("ds_read_b64_tr_b16 %0,%1 offset:%c2":"=&v"(lo[ks]):"v"(vb),"i"(d0*4096+ks*1024):"memory");
      asm volatile("ds_read_b64_tr_b16 %0,%1 offset:%c2":"=&v"(hi[ks]):"v"(vb),"i"(d0*4096+ks*1024+512):"memory");}
    asm volatile("s_waitcnt lgkmcnt(0)":::"memory");SBAR();
    #define PK(k) (bf16x8){lo[k][0],lo[k][1],lo[k][2],lo[k][3],hi[k][0],hi[k][1],hi[k][2],hi[k][3]}
    o[d0]=__builtin_amdgcn_mfma_f32_32x32x16_bf16(pa0,PK(0),o[d0],0,0,0);
    o[d0]=__builtin_amdgcn_mfma_f32_32x32x16_bf16(pa1,PK(1),o[d0],0,0,0);
    o[d0]=__builtin_amdgcn_mfma_f32_32x32x16_bf16(pa2,PK(2),o[d0],0,0,0);
    o[d0]=__builtin_amdgcn_mfma_f32_32x32x16_bf16(pa3,PK(3),o[d0],0,0,0);
    #undef PK
  }
}

#ifndef ATTN_STORE16
#define ATTN_STORE16(p,v) (*(u32x4*)(p)=(v))
#endif
template<int THRL> __device__ __forceinline__ void attn_unit(int b,int h,int qb,const bf16*Q,const bf16*__restrict__ K,const bf16*__restrict__ V,const bf16*__restrict__ OG,const float*__restrict__ CUM,bf16*O,char*shm){
  const int tid=opaque_tid(),lane=tid&63,r32=lane&31,hi=lane>>5; const int wid=__builtin_amdgcn_readfirstlane(tid>>6);
  const long rowbase=(long)b*SEQ; const int q0=qb*QB;
  const bf16*Qw=Q+(rowbase+q0+wid*QBLK)*DM+h*D;
  const bf16*Kh=K+rowbase*DM+h*D,*Vh=V+rowbase*DM+h*D;
  const unsigned lds0=(unsigned)(uintptr_t)shm;
  float*wsf=(float*)(shm+LDS_WS)+wid*64;
  const bf16*ksrc=Kh+(long)lane*DM+wid*8;
  const bf16*vsrc=Vh+(long)(16*(wid&3)+(lane>>2))*DM+(wid>>2)*32+(lane&3)*8;
  const unsigned kdst=lds0+LDS_K+wid*1024, vdst=lds0+LDS_V+wid*1024;
  #define DMA_K(t,slot) glds16(ksrc+(long)(t)*KVBLK*DM,(unsigned)__builtin_amdgcn_readfirstlane(kdst+(slot)))
  #define DMA_V(t,slot) glds16(vsrc+(long)(t)*KVBLK*DM,(unsigned)__builtin_amdgcn_readfirstlane(vdst+(slot)))
  const int vb0=(int)(lds0+LDS_V)+((lane>>4)&1)*32+(lane&3)*8+(4*hi+((lane&15)>>2))*64;
  const char*Kbase=shm+LDS_K; bf16x8 kf[8];
  const lds_cptr shm3=(lds_cptr)shm; const lds_cptr kp0=shm3+LDS_K+hi*1024+r32*16; const lds_cptr vp0=shm3+LDS_V+((lane>>4)&1)*32+(lane&3)*8+(4*hi+((lane&15)>>2))*64;
  const int NT=(q0+QB)/KVBLK;
  { float*bl=(float*)(shm+LDS_BIAS_OFF); const float*cs=CUM+((long)b*NHEAD+h)*SEQ;
    for(int j=tid;j<q0+QB;j+=NW*64)bl[j]=cs[j]*(-1.4426950408889634f);
    asm volatile("s_waitcnt vmcnt(0) lgkmcnt(0)\n\ts_barrier":::"memory"); }
  const lds_cptr bp0=(lds_cptr)shm+LDS_BIAS_OFF+hi*16;
  #define BIAS(P0,P1,t) do{ const lds_cptr bp_=bp0+(t)*256; \
    _Pragma("unroll") for(int g_=0;g_<4;++g_){ const f32x4b b0_=*(const __attribute__((address_space(3))) f32x4b*)(bp_+g_*32); const f32x4b b1_=*(const __attribute__((address_space(3))) f32x4b*)(bp_+128+g_*32); \
      P0[4*g_]+=b0_[0];P0[4*g_+1]+=b0_[1];P0[4*g_+2]+=b0_[2];P0[4*g_+3]+=b0_[3]; P1[4*g_]+=b1_[0];P1[4*g_+1]+=b1_[1];P1[4*g_+2]+=b1_[2];P1[4*g_+3]+=b1_[3]; } }while(0)
  DMA_K(0,0);DMA_V(0,0);DMA_K(1,SLOTB);
  bf16x8 qr[4];
  #pragma unroll
  for(int d0=0;d0<4;++d0)qr[d0]=*reinterpret_cast<const bf16x8*>(&Qw[(long)r32*DM+d0*16+hi*8]);
  float mhat=0.f,l_reg=0.f;f32x16 o[2];o[0]=f32x16{};o[1]=f32x16{};f32x16 negm=f32x16{};asm volatile("":"+v"(negm));
  const int qrel=wid*QBLK+r32;
  #define CMASK(P0,P1,t) do{int jb_=(t)-(NT-4); if(jb_>=0)cmask(P0,P1,jb_,qrel,hi);}while(0)
  bool resc=false;
  #define START(P0,P1) do{ const float rm=rowmax(P0,P1); resc=false; \
    { const float dl=rm; mhat=fadd_s(mhat,dl); \
      _Pragma("unroll") for(int r=0;r<16;++r){P0[r]=fsub_s(P0[r],dl);P1[r]=fsub_s(P1[r],dl);} \
      _Pragma("unroll") for(int r=0;r<16;++r)negm[r]=-mhat; asm volatile("":"+v"(negm)); } \
    _Pragma("unroll") for(int r=0;r<16;++r)P0[r]=__builtin_amdgcn_exp2f(P0[r]); }while(0)
  #define RESC() do{ if(resc){ asm volatile("s_waitcnt lgkmcnt(0)":::"memory"); \
      _Pragma("unroll") for(int d_=0;d_<2;++d_) _Pragma("unroll") for(int r=0;r<16;++r)o[d_][r]*=wsf[crow(r,hi)]; } }while(0)
  f32x16 pA0,pA1,pB0,pB1;
  int sl_prev=0,sl_cur=0,sl_next=SLOTB;
  #define ROT() do{sl_prev=sl_cur;sl_cur=sl_next;sl_next=(sl_next==(NSLOT-1)*SLOTB)?0:sl_next+SLOTB;}while(0)
  DMA_K(2,2*SLOTB);
  WAIT_BAR(3);
  qkt(pA0,pA1,Kbase,qr,negm,r32,hi);asm volatile("s_nop 15\n\ts_nop 7":"+v"(pA0),"+v"(pA1));BIAS(pA0,pA1,0);CMASK(pA0,pA1,0);
  START(pA0,pA1);
  _Pragma("unroll") for(int r=0;r<16;++r)pA1[r]=__builtin_amdgcn_exp2f(pA1[r]);
  WAIT_BAR(0);
  DMA_K(3,0);DMA_V(1,SLOTB);
  ROT();
  kload8(kf,kp0+sl_cur);
  WAIT_BAR(2);
  s16x4 vlo[8],vhi[8]; u32x4 pw0,pw1,pw2,pw3;
  #define PKW(P,B) cvtpk_s(P[B],P[B+1])
  #define PAF(k) __builtin_bit_cast(bf16x8,pw##k)
  #define VFR(i) (bf16x8){vlo[i][0],vlo[i][1],vlo[i][2],vlo[i][3],vhi[i][0],vhi[i][1],vhi[i][2],vhi[i][3]}
  #define PIN(x) asm volatile("":"+v"(x))
  #define MX3(a,b,c) __builtin_fmaxf(__builtin_fmaxf((a),(b)),(c))
  #define GAPA(MF,A0,A1,A2,A3,W0,W1,PW) do{ MF; sacc+=A0; sacc+=A1; sacc+=A2; sacc+=A3; PIN(sacc); W0; W1; PIN(PW); SBAR(); }while(0)
  #define EX(v) __builtin_amdgcn_exp2f(v)
  #define GAPB(MF,X,B) do{ MF; X[B]=EX(X[B]); X[B+1]=EX(X[B+1]); X[B+2]=EX(X[B+2]); X[B+3]=EX(X[B+3]); PIN(X); SBAR(); }while(0)
  #define VRD(i) do{ vlo[i]=vtr(vp_+(((i)>>2)*4096+((i)&3)*1024)); vhi[i]=vtr(vp_+(((i)>>2)*4096+((i)&3)*1024+512)); }while(0)
  #define KRD(G,j) do{ if(G){ kload2(kf,kp0+sl_next,j); SBAR(); } }while(0)
  #define STEP(C0,C1,P0,P1,t,GK,GV,GL) do{ SBAR(); \
    const lds_cptr vp_=vp0+sl_prev; \
    VRD(0); SBAR(); float sacc=(P0[0]+P0[1]); \
    GAPA(C0=__builtin_amdgcn_mfma_f32_32x32x16_bf16(kf[0],qr[0],negm,0,0,0), P0[2],P0[3],P0[4],P0[5],     pw0[0]=PKW(P0,0), pw0[1]=PKW(P0,2), pw0); \
    VRD(4); SBAR(); GAPA(C1=__builtin_amdgcn_mfma_f32_32x32x16_bf16(kf[1],qr[0],negm,0,0,0), P0[6],P0[7],P0[8],P0[9],     pw0[2]=PKW(P0,4), pw0[3]=PKW(P0,6), pw0); \
    VRD(1); SBAR(); GAPA(C0=__builtin_amdgcn_mfma_f32_32x32x16_bf16(kf[2],qr[1],C0,0,0,0),   P0[10],P0[11],P0[12],P0[13], pw1[0]=PKW(P0,8), pw1[1]=PKW(P0,10), pw1); \
    VRD(5); SBAR(); GAPA(C1=__builtin_amdgcn_mfma_f32_32x32x16_bf16(kf[3],qr[1],C1,0,0,0),   P0[14],P0[15],P1[0],P1[1],   pw1[2]=PKW(P0,12),pw1[3]=PKW(P0,14), pw1); \
    VRD(2); SBAR(); GAPA(C0=__builtin_amdgcn_mfma_f32_32x32x16_bf16(kf[4],qr[2],C0,0,0,0),   P1[2],P1[3],P1[4],P1[5],     pw2[0]=PKW(P1,0), pw2[1]=PKW(P1,2), pw2); \
    VRD(6); SBAR(); GAPA(C1=__builtin_amdgcn_mfma_f32_32x32x16_bf16(kf[5],qr[2],C1,0,0,0),   P1[6],P1[7],P1[8],P1[9],     pw2[2]=PKW(P1,4), pw2[3]=PKW(P1,6), pw2); \
    VRD(3); SBAR(); GAPA(C0=__builtin_amdgcn_mfma_f32_32x32x16_bf16(kf[6],qr[3],C0,0,0,0),   P1[10],P1[11],P1[12],P1[13], pw3[0]=PKW(P1,8), pw3[1]=PKW(P1,10), pw3); \
    VRD(7); SBAR(); GAPA(C1=__builtin_amdgcn_mfma_f32_32x32x16_bf16(kf[7],qr[3],C1,0,0,0),   P1[14],P1[15],0.f,0.f,       pw3[2]=PKW(P1,12),pw3[3]=PKW(P1,14), pw3); \
    l_reg+=sacc; \
    if(GK){DMA_K((t)+3,sl_cur);} if(GV){DMA_V((t)+1,sl_next);} \
    BIAS(C0,C1,t); \
    CMASK(C0,C1,t); \
    { float a=MX3(C0[0],C0[1],C1[0]),b=MX3(C0[2],C0[3],C1[1]); a=MX3(a,C1[2],C1[3]); \
      _Pragma("unroll") for(int r=4;r<16;r+=4){a=MX3(a,C0[r],C0[r+1]);b=MX3(b,C0[r+2],C0[r+3]);a=MX3(a,C1[r],C1[r+1]);b=MX3(b,C1[r+2],C1[r+3]);} \
      float rm=__builtin_fmaxf(a,b); { auto rr=__builtin_amdgcn_permlane32_swap(__float_as_uint(rm),__float_as_uint(rm),false,false); rm=__builtin_fmaxf(__uint_as_float(rr[0]),__uint_as_float(rr[1])); } \
      resc=false; \
      if(__builtin_expect(__any(rm>(float)THRL),0)){ const float dl=__builtin_fmaxf(rm,0.f); mhat+=dl; \
        _Pragma("unroll") for(int r=0;r<16;++r){C0[r]-=dl;C1[r]-=dl;} \
        _Pragma("unroll") for(int r=0;r<16;++r)negm[r]=-mhat; asm volatile("":"+v"(negm)); \
        const float f=__builtin_amdgcn_exp2f(-dl); l_reg*=f; if(hi==0)wsf[r32]=f; resc=true; } } \
    SBAR(); \
    GAPB(o[0]=__builtin_amdgcn_mfma_f32_32x32x16_bf16(PAF(0),VFR(0),o[0],0,0,0), C0,0); \
    GAPB(o[1]=__builtin_amdgcn_mfma_f32_32x32x16_bf16(PAF(0),VFR(4),o[1],0,0,0), C0,4); \
    KRD(GL,0); GAPB(o[0]=__builtin_amdgcn_mfma_f32_32x32x16_bf16(PAF(1),VFR(1),o[0],0,0,0), C0,8); \
    KRD(GL,1); GAPB(o[1]=__builtin_amdgcn_mfma_f32_32x32x16_bf16(PAF(1),VFR(5),o[1],0,0,0), C0,12); \
    KRD(GL,2); GAPB(o[0]=__builtin_amdgcn_mfma_f32_32x32x16_bf16(PAF(2),VFR(2),o[0],0,0,0), C1,0); \
    KRD(GL,3); GAPB(o[1]=__builtin_amdgcn_mfma_f32_32x32x16_bf16(PAF(2),VFR(6),o[1],0,0,0), C1,4); \
    GAPB(o[0]=__builtin_amdgcn_mfma_f32_32x32x16_bf16(PAF(3),VFR(3),o[0],0,0,0), C1,8); \
    GAPB(o[1]=__builtin_amdgcn_mfma_f32_32x32x16_bf16(PAF(3),VFR(7),o[1],0,0,0), C1,12); \
    }while(0)
  int t=1;
  #undef CMASK
  #define CMASK(P0,P1,t) do{}while(0)
  for(;t+5<NT;t+=2){
    STEP(pB0,pB1,pA0,pA1,t,true,true,true);     WAIT_BAR(2); RESC(); ROT();
    STEP(pA0,pA1,pB0,pB1,t+1,true,true,true);   WAIT_BAR(2); RESC(); ROT();
  }
  #undef CMASK
  #define CMASK(P0,P1,t) do{int jb_=(t)-(NT-4); if(jb_>=0)cmask(P0,P1,jb_,qrel,hi);}while(0)
  #define ENDW(tt) do{ if((tt)+3<NT){WAIT_BAR(2);} else if((tt)+2<NT){WAIT_BAR(1);} else {WAIT_BAR(0);} }while(0)
  for(;t+1<NT;t+=2){
    STEP(pB0,pB1,pA0,pA1,t,(t+3<NT),(t+1<NT),(t+1<NT));       ENDW(t);   RESC(); ROT();
    STEP(pA0,pA1,pB0,pB1,t+1,(t+4<NT),(t+2<NT),(t+2<NT));     ENDW(t+1); RESC(); ROT();
  }
  STEP(pB0,pB1,pA0,pA1,NT-1,false,false,false); RESC();
  { float sacc=pB0[0]+pB0[1]; _Pragma("unroll") for(int r=2;r<16;++r)sacc+=pB0[r]; _Pragma("unroll") for(int r=0;r<16;++r)sacc+=pB1[r]; l_reg+=sacc;
    pw0=(u32x4){PKW(pB0,0),PKW(pB0,2),PKW(pB0,4),PKW(pB0,6)};pw1=(u32x4){PKW(pB0,8),PKW(pB0,10),PKW(pB0,12),PKW(pB0,14)};pw2=(u32x4){PKW(pB1,0),PKW(pB1,2),PKW(pB1,4),PKW(pB1,6)};pw3=(u32x4){PKW(pB1,8),PKW(pB1,10),PKW(pB1,12),PKW(pB1,14)};
    SBAR(); pv(o,vb0+sl_cur,PAF(0),PAF(1),PAF(2),PAF(3)); }
  #undef PKW
  #undef PAF
  #undef VFR
  #undef PIN
  #undef MX3
  #undef GAPA
  #undef GAPB
  #undef EX
  #undef VRD
  #undef KRD
  #undef STEP
  #undef ENDW
  {auto rr=__builtin_amdgcn_permlane32_swap(__float_as_uint(l_reg),__float_as_uint(l_reg),false,false);l_reg=__uint_as_float(rr[0])+__uint_as_float(rr[1]);}
  if(hi==0)wsf[32+r32]=l_reg;asm volatile("s_waitcnt lgkmcnt(0)":::"memory");
  float rli[16];
  #pragma unroll
  for(int r=0;r<16;++r)rli[r]=__builtin_amdgcn_rcpf(wsf[32+crow(r,hi)]);
  bf16*Ow=O+(rowbase+q0+wid*QBLK)*DMO+h*D; const bf16*Gw=OG+(rowbase+q0+wid*QBLK)*DM+h*D;
  { bf16*stg=(bf16*)(shm+LDS_OST)+wid*2048;
    #pragma unroll
    for(int r=0;r<16;++r){const int orow=crow(r,hi);
      #pragma unroll
      for(int d0=0;d0<2;++d0)stg[orow*64+d0*32+r32]=__float2bfloat16(o[d0][r]*rli[r]);}
    asm volatile("s_waitcnt lgkmcnt(0)":::"memory");
    #pragma unroll
    for(int i=0;i<4;++i){const int row=i*8+(lane>>3),ch=lane&7; u32x4 v=*(const u32x4*)(stg+row*64+ch*8); const u32x4 g=*(const u32x4*)(Gw+(long)row*DM+ch*8);
      #pragma unroll
      for(int e=0;e<4;++e){ const float o0=__uint_as_float(v[e]<<16),o1=__uint_as_float(v[e]&0xffff0000u),g0=__uint_as_float(g[e]<<16),g1=__uint_as_float(g[e]&0xffff0000u);
        v[e]=cvtpk_s(o0*__builtin_amdgcn_rcpf(1.0f+__builtin_amdgcn_exp2f(-1.4426950408889634f*g0)),o1*__builtin_amdgcn_rcpf(1.0f+__builtin_amdgcn_exp2f(-1.4426950408889634f*g1))); }
      ATTN_STORE16(Ow+(long)row*DMO+ch*8,v);} }
  asm volatile("s_waitcnt lgkmcnt(0)\n\ts_barrier":::"memory");
  #undef DMA_K
  #undef DMA_V
  #undef BIAS
  #undef CMASK
  #undef START
  #undef RESC
  #undef ROT
}
constexpr int ATTN_LDS_BYTES=LDS_BYTES;
struct AttnTensors { const bf16* Q; const bf16* K; const bf16* V; const bf16* OG; const float* CUM; bf16* O; };
struct AttnUnit { int bh; int qb; };
struct StaticOrder {
  int vcu, stride;
  __device__ __forceinline__ explicit StaticOrder(int grid,int block):vcu((grid%8==0)?(block%8)*(grid/8)+block/8:block),stride(grid){}
  __device__ __forceinline__ bool next(int i,AttnUnit&u)const{ const int su=vcu+(i>>2)*stride; if(su>=256)return false; const int p=su&1,k=i&3; u.bh=su>>1; u.qb=(k==0)?p:(k==1)?7-p:(k==2)?2+p:5-p; return true; }
  __device__ __forceinline__ void a_ready(const AttnUnit&)const{}
  __device__ __forceinline__ void done(const AttnUnit&)const{}
};
template<class Sched,int THRL=8> __device__ __forceinline__ void attn_phase(char*lds,const AttnTensors&T,const Sched&S){
  AttnUnit u;
  for(int i=0;S.next(i,u);++i){ S.a_ready(u); attn_unit<THRL>(u.bh/NHEAD,u.bh%NHEAD,u.qb,T.Q,T.K,T.V,T.OG,T.CUM,T.O,lds); S.done(u); }
}
#undef SBAR
#undef WAIT_BAR
}
#define GAS __attribute__((address_space(1)))
#define LAS __attribute__((address_space(3)))
typedef GAS unsigned gu32;
typedef GAS unsigned long long gu64;
#define RLX_AGENT __ATOMIC_RELAXED, __HIP_MEMORY_SCOPE_AGENT
#define XB_TMO      128
#define XB_XCNT(j)  (256  + 64 * (j))
#define XB_XSUB(j)  (1280 + 64 * (j))
#define XB_XGEN(j)  (2304 + 64 * (j))
#define XB_TOP      3328
#define XB_TOPGEN   3392
#define XCD_BAR_WORDS 3456
#define XB_SPIN_CAP (1u << 18)

__device__ __forceinline__ unsigned xb_ld(unsigned* p)              { return __hip_atomic_load(p, __ATOMIC_RELAXED, __HIP_MEMORY_SCOPE_AGENT); }
__device__ __forceinline__ unsigned xb_add(unsigned* p, unsigned v) { return __hip_atomic_fetch_add(p, v, __ATOMIC_RELAXED, __HIP_MEMORY_SCOPE_AGENT); }
__device__ __forceinline__ unsigned xb_xcc_id() { return (unsigned)__builtin_amdgcn_s_getreg((3 << 11) | 20) & 0xFu; }
#define XB_SPIN(cond, bar) do { unsigned _sp = 0; while (cond) { __builtin_amdgcn_s_sleep(1); \
    if ((++_sp & 255u) == 0u) { if (xb_ld(&(bar)[XB_TMO])) break; if (_sp > XB_SPIN_CAP) { atomicAdd(&(bar)[XB_TMO], 1u); break; } } } } while (0)

struct XcdBarrier {
    unsigned* bar; unsigned x;
    volatile LAS unsigned* st;
};

__device__ __forceinline__ XcdBarrier xcd_barrier_post(unsigned* bar, volatile LAS unsigned* st) {
    XcdBarrier b; b.bar = bar; b.x = xb_xcc_id(); b.st = st;
    if (threadIdx.x == 0) (void)xb_add(&bar[XB_XCNT(b.x)], 1u);
    return b;
}
__device__ __forceinline__ void xcd_barrier_complete(unsigned* bar, unsigned x, unsigned& nloc, unsigned& nx) {
    const unsigned G = gridDim.x * gridDim.y * gridDim.z;
    unsigned sum, cnt, mine, sp = 0u;
    for (;;) {
        sum = 0u; cnt = 0u; mine = 0u;
#pragma unroll
        for (unsigned j = 0; j < 16; ++j) { const unsigned c = xb_ld(&bar[XB_XCNT(j)]); sum += c; cnt += (c > 0u) ? 1u : 0u; mine = (j == x) ? c : mine; }
        if (sum == G) break;
        __builtin_amdgcn_s_sleep(1);
        if ((++sp & 255u) == 0u) { if (xb_ld(&bar[XB_TMO])) break; if (sp > XB_SPIN_CAP) { atomicAdd(&bar[XB_TMO], 1u); break; } }
    }
    nloc = mine > 0u ? mine : 1u; nx = cnt > 0u ? cnt : 1u;
}

__device__ __forceinline__ void xcd_barrier(const XcdBarrier& b) {
    asm volatile("s_waitcnt vmcnt(0)" ::: "memory");
    __syncthreads();
    if (threadIdx.x == 0) {
        unsigned* bar = b.bar;
        __builtin_amdgcn_s_waitcnt(0);
        unsigned nloc = b.st[0], nx = b.st[1];
        if (nloc == 0u) { xcd_barrier_complete(bar, b.x, nloc, nx); b.st[0] = nloc; b.st[1] = nx; }
        const unsigned old = xb_add(&bar[XB_XSUB(b.x)], 1u);
        const unsigned gen = old / nloc;
        if (old + 1u == (gen + 1u) * nloc) {
            __builtin_amdgcn_fence(__ATOMIC_RELEASE, "agent");
            asm volatile("s_waitcnt vmcnt(0)" ::: "memory");
            const unsigned og = xb_add(&bar[XB_TOP], 1u);
            const unsigned tg = og / nx;
            if (og + 1u == (tg + 1u) * nx) xb_add(&bar[XB_TOPGEN], 1u);
            else XB_SPIN(xb_ld(&bar[XB_TOPGEN]) == tg, bar);
            __builtin_amdgcn_fence(__ATOMIC_ACQUIRE, "agent");
            xb_add(&bar[XB_XGEN(b.x)], 1u);
            asm volatile("s_waitcnt vmcnt(0)" ::: "memory");
        } else {
            XB_SPIN(xb_ld(&bar[XB_XGEN(b.x)]) == gen, bar);
            __builtin_amdgcn_fence(__ATOMIC_ACQUIRE, "agent");
            asm volatile("s_waitcnt vmcnt(0)" ::: "memory");
        }
    }
    __syncthreads();
}

typedef unsigned short bf16_t;
typedef short bf16x8_t __attribute__((ext_vector_type(8)));
typedef float f32x4_t __attribute__((ext_vector_type(4)));
constexpr int T_TOK = 16384, DM = 1024, SEQ = 2048, NBATCH = 8;
constexpr int L0_COLS = 3848, L0_MAIN = 3840, L1_COLS = 4112, L1_MAIN = 4096;
constexpr float DN_ALPHA = 1.4142135623730951f;
constexpr float LN_EPS = 1e-5f;
constexpr int NTHR = 512;

__device__ __forceinline__ unsigned f2bf(float f) { return (unsigned)__builtin_bit_cast(unsigned short, (__bf16)f); }
typedef float pk_f32x2_t __attribute__((ext_vector_type(2))); typedef __bf16 pk_bf16x2_t __attribute__((ext_vector_type(2)));
__device__ __forceinline__ unsigned pk2(float lo, float hi) { const pk_f32x2_t v = {lo, hi}; return __builtin_bit_cast(unsigned, __builtin_convertvector(v, pk_bf16x2_t)); }
__device__ __forceinline__ float bflo(unsigned w) { return __uint_as_float(w << 16); }
__device__ __forceinline__ float bfhi(unsigned w) { return __uint_as_float(w & 0xffff0000u); }
__device__ __forceinline__ float bf2f(bf16_t h) { return __uint_as_float(((unsigned)h) << 16); }
#define LDS_BARRIER() do { asm volatile("s_waitcnt lgkmcnt(0)" ::: "memory"); __builtin_amdgcn_s_barrier(); asm volatile("" ::: "memory"); } while (0)
template <int CTRL, int RM> __device__ __forceinline__ float dpp_f(float x) { return __builtin_bit_cast(float, __builtin_amdgcn_update_dpp(0, __builtin_bit_cast(int, x), CTRL, RM, 0xF, true)); }
__device__ __forceinline__ float red4_sum(float x) { x += dpp_f<0xB1, 0xF>(x); x += dpp_f<0x4E, 0xF>(x); return x; }
__device__ __forceinline__ float red8_sum(float x) { x = red4_sum(x); x += dpp_f<0x141, 0xF>(x); return x; }
__device__ __forceinline__ float red16_sum(float x) { x = red8_sum(x); x += dpp_f<0x140, 0xF>(x); return x; }
__device__ __forceinline__ float wave_sum(float x) { x = red16_sum(x); x += dpp_f<0x142, 0xA>(x); x += dpp_f<0x143, 0xC>(x);
    return __builtin_bit_cast(float, __builtin_amdgcn_readlane(__builtin_bit_cast(int, x), 63)); }
template <int CTRL, int RM> __device__ __forceinline__ float dpp_id(float x, float ident) { return __builtin_bit_cast(float, __builtin_amdgcn_update_dpp(__builtin_bit_cast(int, ident), __builtin_bit_cast(int, x), CTRL, RM, 0xF, false)); }
__device__ __forceinline__ float wave_scan_sum(float x) { x += dpp_id<0x111, 0xF>(x, 0.f); x += dpp_id<0x112, 0xF>(x, 0.f); x += dpp_id<0x114, 0xF>(x, 0.f); x += dpp_id<0x118, 0xF>(x, 0.f);
    x += dpp_id<0x142, 0xA>(x, 0.f); x += dpp_id<0x143, 0xC>(x, 0.f); return x; }
__device__ __forceinline__ float wave_scan_max(float x) { const float ni = -INFINITY; x = fmaxf(x, dpp_id<0x111, 0xF>(x, ni)); x = fmaxf(x, dpp_id<0x112, 0xF>(x, ni)); x = fmaxf(x, dpp_id<0x114, 0xF>(x, ni)); x = fmaxf(x, dpp_id<0x118, 0xF>(x, ni));
    x = fmaxf(x, dpp_id<0x142, 0xA>(x, ni)); x = fmaxf(x, dpp_id<0x143, 0xC>(x, ni)); return x; }
__device__ __forceinline__ float wave_max(float x) { x = fmaxf(x, dpp_f<0xB1, 0xF>(x)); x = fmaxf(x, dpp_f<0x4E, 0xF>(x)); x = fmaxf(x, dpp_f<0x141, 0xF>(x)); x = fmaxf(x, dpp_f<0x140, 0xF>(x));
    x = fmaxf(x, __shfl_xor(x, 16)); x = fmaxf(x, __shfl_xor(x, 32)); return x; }
__device__ __forceinline__ float sigmoid_f(float x) { return 1.0f / (1.0f + __expf(-x)); }
__device__ __forceinline__ float log_sigmoid_f(float x) { return fminf(x, 0.f) - log1pf(__expf(-fabsf(x))); }
__device__ __forceinline__ void unpack8(const uint4 w, float* f) {
    f[0] = bflo(w.x); f[1] = bfhi(w.x); f[2] = bflo(w.y); f[3] = bfhi(w.y); f[4] = bflo(w.z); f[5] = bfhi(w.z); f[6] = bflo(w.w); f[7] = bfhi(w.w);
}
__device__ __forceinline__ void unpack4(const uint2 w, float* f) { f[0] = bflo(w.x); f[1] = bfhi(w.x); f[2] = bflo(w.y); f[3] = bfhi(w.y); }

__device__ __forceinline__ void transpose_cvt_phase(const float* __restrict__ W, int K, int ldw, int c0, int N, bf16_t* __restrict__ WT, int bid, int nblk, float* tile  ) {
    const int nb = N / 64, nunits = (K / 64) * nb;
    for (int u = bid; u < nunits; u += nblk) {
        const int kb = u / nb, nbi = u % nb; const int k0 = kb * 64, n0 = nbi * 64;
        for (int i = opaque_tid(); i < 4096; i += NTHR) { const int kk = i >> 6, nn = i & 63; tile[kk * 65 + nn] = W[(size_t)(k0 + kk) * ldw + c0 + n0 + nn]; }
        __syncthreads();
        for (int i = opaque_tid(); i < 2048; i += NTHR) { const int nn = i >> 5, kp = (i & 31) * 2;
            const unsigned v = pk2(tile[kp * 65 + nn], tile[(kp + 1) * 65 + nn]); *(unsigned*)(WT + (size_t)(n0 + nn) * K + k0 + kp) = v; }
        __syncthreads();
    }
}
__device__ __forceinline__ void cvt_bf16_phase(const float* __restrict__ src, bf16_t* __restrict__ dst, size_t n8, int bid, int nblk) {
    for (size_t i = (size_t)bid * NTHR + opaque_tid(); i < n8; i += (size_t)nblk * NTHR) {
        const float4 a = ((const float4*)src)[2 * i], b = ((const float4*)src)[2 * i + 1];
        uint4 o; o.x = pk2(a.x, a.y); o.y = pk2(a.z, a.w); o.z = pk2(b.x, b.y); o.w = pk2(b.z, b.w); ((uint4*)dst)[i] = o; }
}
__device__ __forceinline__ void build_wlr_phase(const float* __restrict__ w_up, const float* __restrict__ a_up, const float* __restrict__ g_up, bf16_t* __restrict__ WT, int bid, int nblk) {
    for (int i = bid * NTHR + opaque_tid(); i < 1536 * 256; i += nblk * NTHR) { const int n = i >> 8, k = i & 255; float v = 0.f;
        if (n < 512) { if (k < 64) v = w_up[k * 512 + n]; }
        else if (n < 1024) { if (k >= 64 && k < 128) v = a_up[(k - 64) * 512 + (n - 512)]; }
        else { if (k >= 128) v = g_up[(k - 128) * 512 + (n - 1024)]; }
        WT[i] = (bf16_t)f2bf(v); }
}

namespace pg8 {
struct EpiF32 {
    static constexpr bool PERM = false, AFTER_DRAIN = false;
    float* C; long ldc;
    __device__ __forceinline__ void operator()(const f32x4 (&acc)[2][2][4][2], const Unit& u, int wr, int wc, int fr, int fq) const {
        const int row0 = u.pm * BM + wr * 64 + fr, col0 = u.pn * BM + wc * 32 + 4 * fq;
#pragma unroll
        for (int ai = 0; ai < 2; ++ai)
#pragma unroll
            for (int m = 0; m < 4; ++m) { float* rowp = C + (size_t)(row0 + ai * HALF + m * 16) * ldc + col0;
#pragma unroll
                for (int bj = 0; bj < 2; ++bj)
#pragma unroll
                    for (int n = 0; n < 2; ++n) *(f32x4*)(rowp + bj * HALF + n * 16) = acc[ai][bj][m][n]; }
    }
};
struct EpiBf16P {
    static constexpr bool PERM = true, AFTER_DRAIN = false;
    bf16_t* O; long ldc;
    __device__ __forceinline__ void operator()(const f32x4 (&acc)[2][2][4][2], const Unit& u, int wr, int wc, int fr, int fq) const {
        const int row0 = u.pm * BM + wr * 64 + fr; const int col0 = u.pn * BM + wc * 32 + 8 * fq;
#pragma unroll
        for (int ai = 0; ai < 2; ++ai)
#pragma unroll
            for (int m = 0; m < 4; ++m) { bf16_t* rowp = O + (size_t)(row0 + ai * HALF + m * 16) * ldc + col0;
#pragma unroll
                for (int bj = 0; bj < 2; ++bj) { const f32x4 v0 = acc[ai][bj][m][0], v1 = acc[ai][bj][m][1];
                    u32x4 w; w.x = cvt_pk_bf16(v0[0], v0[1]); w.y = cvt_pk_bf16(v0[2], v0[3]); w.z = cvt_pk_bf16(v1[0], v1[1]); w.w = cvt_pk_bf16(v1[2], v1[3]);
                    *(u32x4*)(rowp + bj * HALF) = w; } }
    }
};
struct EpiLowrank {
    static constexpr bool PERM = false, AFTER_DRAIN = false;
    float* lrw; bf16_t* lra; bf16_t* lrg; const float* w0; const float* a0;
    __device__ __forceinline__ void operator()(const f32x4 (&acc)[2][2][4][2], const Unit& u, int wr, int wc, int fr, int fq) const {
        const int row0 = u.pm * BM + wr * 64 + fr; const int sel = u.pn >> 1; const int colb = (u.pn & 1) * BM + wc * 32 + 4 * fq;
#pragma unroll
        for (int ai = 0; ai < 2; ++ai)
#pragma unroll
            for (int m = 0; m < 4; ++m) { const size_t rowoff = (size_t)(row0 + ai * HALF + m * 16) * 512;
#pragma unroll
                for (int bj = 0; bj < 2; ++bj)
#pragma unroll
                    for (int n = 0; n < 2; ++n) { const int c = colb + bj * HALF + n * 16; f32x4 v = acc[ai][bj][m][n];
                        if (sel == 0) { const f32x4 bv = *(const f32x4*)(w0 + c); *(f32x4*)(lrw + rowoff + c) = v + bv; }
                        else if (sel == 1) { const f32x4 bv = *(const f32x4*)(a0 + c); v = v + bv; uint2 o; o.x = pk2(v[0], v[1]); o.y = pk2(v[2], v[3]); *(uint2*)(lra + rowoff + c) = o; }
                        else { uint2 o; o.x = pk2(v[0], v[1]); o.y = pk2(v[2], v[3]); *(uint2*)(lrg + rowoff + c) = o; } } }
    }
};
}

template <int NG>
__device__ __forceinline__ void gates_phase(const float* X, const float* __restrict__ W, int ldw, int c0, float* __restrict__ out, int bid, int nblk, float* wg  ) {
    for (int i = opaque_tid(); i < NG * 1024; i += NTHR) { const int k = i / NG, g = i % NG; wg[g * 1024 + k] = W[(size_t)k * ldw + c0 + g]; }
    __syncthreads();
    const int lane = opaque_tid() & 63, wv = opaque_tid() >> 6;
    for (int t = bid * 8 + wv; t < T_TOK; t += nblk * 8) {
        float x[16];
#pragma unroll
        for (int j = 0; j < 16; ++j) x[j] = X[(size_t)t * 1024 + lane + 64 * j];
#pragma unroll 1
        for (int g = 0; g < NG; ++g) { float p = 0.f;
#pragma unroll
            for (int j = 0; j < 16; ++j) p += x[j] * wg[g * 1024 + lane + 64 * j];
            p = wave_sum(p); if (lane == 0) out[(size_t)t * 16 + g] = p; }
    }
    __syncthreads();
}
__device__ __forceinline__ void rwkv_prep_phase(const bf16_t* __restrict__ P0, const float* __restrict__ mu, bf16_t* __restrict__ App, int bid, int nblk) {
    for (size_t i = (size_t)bid * NTHR + opaque_tid(); i < (size_t)T_TOK * 256; i += (size_t)nblk * NTHR) {
        const int t = (int)(i >> 8), c = (int)(i & 255), col = 1536 + c;
        const float cur = bf2f(P0[(size_t)t * L0_MAIN + col]); const float prev = (t % SEQ) ? bf2f(P0[(size_t)(t - 1) * L0_MAIN + col]) : 0.f;
        float v = cur + (prev - cur) * mu[col];
        if (c < 64) v = tanhf(v); else if (c >= 128) v = sigmoid_f(v);
        App[i] = (bf16_t)f2bf(v); }
}
__device__ __forceinline__ void ln_phase(const float* xin, const float* mix, const float* g, const float* b, float* xout, bf16_t* xb, int bid, int nblk) {
    const int lane = opaque_tid() & 63, wv = opaque_tid() >> 6;
    for (int t = bid * 8 + wv; t < T_TOK; t += nblk * 8) {
        float4 y[4]; float s = 0.f;
#pragma unroll
        for (int j = 0; j < 4; ++j) { const float4 a = *(const float4*)(xin + (size_t)t * 1024 + 4 * lane + 256 * j), m = *(const float4*)(mix + (size_t)t * 1024 + 4 * lane + 256 * j);
            y[j].x = DN_ALPHA * a.x + m.x; y[j].y = DN_ALPHA * a.y + m.y; y[j].z = DN_ALPHA * a.z + m.z; y[j].w = DN_ALPHA * a.w + m.w; s += (y[j].x + y[j].y) + (y[j].z + y[j].w); }
        const float mean = wave_sum(s) * (1.f / 1024.f); float q = 0.f;
#pragma unroll
        for (int j = 0; j < 4; ++j) { y[j].x -= mean; y[j].y -= mean; y[j].z -= mean; y[j].w -= mean; q += (y[j].x * y[j].x + y[j].y * y[j].y) + (y[j].z * y[j].z + y[j].w * y[j].w); }
        const float rstd = rsqrtf(wave_sum(q) * (1.f / 1024.f) + LN_EPS);
#pragma unroll
        for (int j = 0; j < 4; ++j) { const float4 gg = *(const float4*)(g + 4 * lane + 256 * j), bb = *(const float4*)(b + 4 * lane + 256 * j);
            float4 o; o.x = y[j].x * rstd * gg.x + bb.x; o.y = y[j].y * rstd * gg.y + bb.y; o.z = y[j].z * rstd * gg.z + bb.z; o.w = y[j].w * rstd * gg.w + bb.w;
            *(float4*)(xout + (size_t)t * 1024 + 4 * lane + 256 * j) = o; uint2 w; w.x = pk2(o.x, o.y); w.y = pk2(o.z, o.w); *(uint2*)(xb + (size_t)t * 1024 + 4 * lane + 256 * j) = w; }
    }
}
__device__ __forceinline__ void fox_cumsum_phase(const float* __restrict__ gates, const float* __restrict__ f_b, float* __restrict__ cum, int bid, int nblk) {
    const int lane = opaque_tid() & 63, wv = opaque_tid() >> 6;
    for (int bh = bid * 8 + wv; bh < 128; bh += nblk * 8) {
        const int b = bh >> 4, h = bh & 15; const float fb = f_b[h];
        float lf[32]; double run = 0.0;
#pragma unroll
        for (int j = 0; j < 32; ++j) { const int s = lane * 32 + j; lf[j] = log_sigmoid_f(gates[((size_t)b * SEQ + s) * 16 + h] + fb); run += (double)lf[j]; }
        double incl = run;
#pragma unroll
        for (int o = 1; o < 64; o <<= 1) { const double v = __shfl_up(incl, o); if (lane >= o) incl += v; }
        double acc = incl - run;
#pragma unroll
        for (int j = 0; j < 32; ++j) { acc += (double)lf[j]; cum[(size_t)bh * SEQ + lane * 32 + j] = (float)acc; }
    }
}

__device__ __forceinline__ void fox_qknorm_phase(bf16_t* P1, const float* __restrict__ qn_g, const float* __restrict__ kn_g, int bid, int nblk) {
    const int tid = opaque_tid(); const int lane = tid & 63, wv = tid >> 6;
    for (int t = bid * 8 + wv; t < T_TOK; t += nblk * 8) {
#pragma unroll
        for (int which = 0; which < 2; ++which) {
            bf16_t* p = P1 + (size_t)t * L1_MAIN + which * 1024 + lane * 16; const float* g = (which ? kn_g : qn_g) + lane * 16;
            float f[16]; unpack8(*(const uint4*)p, f); unpack8(*(const uint4*)(p + 8), f + 8);
            float ss = 0.f;
#pragma unroll
            for (int j = 0; j < 16; ++j) ss += f[j] * f[j];
            ss = red4_sum(ss);
            const float r = rsqrtf(ss * (1.f / 64.f) + 1e-6f) * (which ? 1.0f : 0.125f * 1.4426950408889634f);
#pragma unroll
            for (int j = 0; j < 16; ++j) f[j] = f[j] * r * g[j];
            uint4 w0, w1; w0.x = pk2(f[0], f[1]); w0.y = pk2(f[2], f[3]); w0.z = pk2(f[4], f[5]); w0.w = pk2(f[6], f[7]); w1.x = pk2(f[8], f[9]); w1.y = pk2(f[10], f[11]); w1.z = pk2(f[12], f[13]); w1.w = pk2(f[14], f[15]);
            *(uint4*)p = w0; *(uint4*)(p + 8) = w1; }
    }
}

__device__ __forceinline__ void mlstm_prepass_phase(bf16_t* P0, const float* __restrict__ conv_w, const float* __restrict__ conv_b, int bid, int nblk) {
    const int tid = opaque_tid(); const int ch = tid & 63, seg = tid >> 6;
    for (int u = bid; u < NBATCH * 16; u += nblk) {
        const int b = u >> 4, c = (u & 15) * 64 + ch;
        const float w0 = conv_w[c], w1 = conv_w[1024 + c], w2 = conv_w[2048 + c], w3 = conv_w[3072 + c], bs = conv_b[c]; const float scl = (c < 512) ? 0.08838834764831845f : 1.0f;
        bf16_t* base = P0 + ((size_t)b * SEQ + seg * 256) * L0_MAIN + 1792 + c;
        float z1 = 0.f, z2 = 0.f, z3 = 0.f;
        if (seg > 0) { z1 = bf2f(base[-(long)L0_MAIN]); z2 = bf2f(base[-2 * (long)L0_MAIN]); z3 = bf2f(base[-3 * (long)L0_MAIN]); }
        __syncthreads();
#pragma unroll 1
        for (int t0 = 0; t0 < 256; t0 += 16) { float zz[16];
#pragma unroll
            for (int i = 0; i < 16; ++i) zz[i] = bf2f(base[(size_t)(t0 + i) * L0_MAIN]);
#pragma unroll
            for (int i = 0; i < 16; ++i) { const float cv = w3 * zz[i] + w2 * z1 + w1 * z2 + w0 * z3 + bs; z3 = z2; z2 = z1; z1 = zz[i]; zz[i] = cv * sigmoid_f(cv) * scl; }
#pragma unroll
            for (int i = 0; i < 16; ++i) base[(size_t)(t0 + i) * L0_MAIN] = (bf16_t)f2bf(zz[i]); }
        __syncthreads();
    }
    for (size_t i = (size_t)bid * NTHR + tid; i < (size_t)T_TOK * 64; i += (size_t)nblk * NTHR) { bf16_t* p = P0 + (i >> 6) * L0_MAIN + 3328 + (i & 63) * 8; float f[8]; unpack8(*(const uint4*)p, f);
        *(uint4*)p = make_uint4(pk2(sigmoid_f(f[0]), sigmoid_f(f[1])), pk2(sigmoid_f(f[2]), sigmoid_f(f[3])), pk2(sigmoid_f(f[4]), sigmoid_f(f[5])), pk2(sigmoid_f(f[6]), sigmoid_f(f[7]))); }
}

struct RwkvArgs { const bf16_t* P0; const float* lrw; const bf16_t* lra; const bf16_t* lrg; const float* mu; const float* k_k; const float* k_a; const float* r_k; const float* ln_g; const float* ln_b; bf16_t* ycat; };
constexpr int RW_CS = 32;
constexpr int RW_LDS_BYTES = 8 * RW_CS * 64 * 4;

#define RW_LOAD_RAW(chunk) do { const int sg_ = (chunk) * RW_CS + ls; const size_t row_ = tok0 + sg_; \
    const bf16_t* pc_ = A.P0 + row_ * L0_MAIN + hc; \
    rc = *(const uint2*)(pc_); kc = *(const uint2*)(pc_ + 512); vc = *(const uint2*)(pc_ + 1024); \
    if (sg_ > 0) { const bf16_t* pp_ = pc_ - L0_MAIN; rp = *(const uint2*)(pp_); kp = *(const uint2*)(pp_ + 512); vp = *(const uint2*)(pp_ + 1024); } \
    else { rp = make_uint2(0u, 0u); kp = rp; vp = rp; } \
    rwl = *(const float4*)(A.lrw + row_ * 512 + hc); ra = *(const uint2*)(A.lra + row_ * 512 + hc); rg = *(const uint2*)(A.lrg + row_ * 512 + hc); } while (0)

__device__ __forceinline__ void rwkv_scan_unit(const RwkvArgs& A, int bh, float* smem) {
    const int tid = opaque_tid(); const int b = bh >> 3, h = bh & 7;
    float* sr = smem; float* sw = sr + 2048; float* sk = sw + 2048; float* skk = sk + 2048; float* snb = skk + 2048; float* sv = snb + 2048; float* sg = sv + 2048; float* sy = sg + 2048;
    const int ls = tid >> 4, lc = (tid & 15) * 4; const int hc = h * 64 + lc;
    float c_mur[4], c_muk[4], c_muv[4], c_kk[4], c_ka[4], c_rk[4], c_lng[4], c_lnb[4];
#pragma unroll
    for (int j = 0; j < 4; ++j) { c_mur[j] = A.mu[hc + j]; c_muk[j] = A.mu[512 + hc + j]; c_muv[j] = A.mu[1024 + hc + j]; c_kk[j] = A.k_k[hc + j]; c_ka[j] = A.k_a[hc + j];
        c_rk[j] = A.r_k[hc + j]; c_lng[j] = A.ln_g[hc + j]; c_lnb[j] = A.ln_b[hc + j]; }
    const int srow = tid >> 3, sq = (tid & 7) * 8;
    float S[8];
#pragma unroll
    for (int j = 0; j < 8; ++j) S[j] = 0.f;
    const size_t tok0 = (size_t)b * SEQ;
    uint2 rc, kc, vc, rp, kp, vp, ra, rg; float4 rwl;
    RW_LOAD_RAW(0);
    for (int chunk = 0; chunk < SEQ / RW_CS; ++chunk) {
        {
            float frc[4], fkc[4], fvc[4], frp[4], fkp[4], fvp[4], fa[4], fg[4];
            unpack4(rc, frc); unpack4(kc, fkc); unpack4(vc, fvc); unpack4(rp, frp); unpack4(kp, fkp); unpack4(vp, fvp); unpack4(ra, fa); unpack4(rg, fg);
            const float zw[4] = {rwl.x, rwl.y, rwl.z, rwl.w};
            float r_l[4], k_l[4], v_l[4], w_[4], a_[4], kkr[4]; float ss = 0.f;
#pragma unroll
            for (int j = 0; j < 4; ++j) {
                r_l[j] = frc[j] + (frp[j] - frc[j]) * c_mur[j]; k_l[j] = fkc[j] + (fkp[j] - fkc[j]) * c_muk[j]; v_l[j] = fvc[j] + (fvp[j] - fvc[j]) * c_muv[j];
                const float sig = sigmoid_f(zw[j]); w_[j] = __expf(-0.6065306597126334f * sig); a_[j] = sigmoid_f(fa[j]);
                kkr[j] = k_l[j] * c_kk[j]; ss += kkr[j] * kkr[j]; }
            ss = red16_sum(ss);
            const float inv = 1.0f / fmaxf(sqrtf(ss), 1e-12f);
            const int o = ls * 64 + lc;
#pragma unroll
            for (int j = 0; j < 4; ++j) { const float kk = kkr[j] * inv;
                sr[o + j] = r_l[j]; sw[o + j] = w_[j]; sk[o + j] = k_l[j] * (1.0f + (a_[j] - 1.0f) * c_ka[j]); skk[o + j] = kk; snb[o + j] = -kk * a_[j]; sv[o + j] = v_l[j]; sg[o + j] = fg[j]; }
        }
        __syncthreads();
        if (chunk + 1 < SEQ / RW_CS) RW_LOAD_RAW(chunk + 1);
        for (int s = 0; s < RW_CS; ++s) {
            const float4 kk0 = *(const float4*)(skk + s * 64 + sq), kk1 = *(const float4*)(skk + s * 64 + sq + 4);
            const float4 w0 = *(const float4*)(sw + s * 64 + sq), w1 = *(const float4*)(sw + s * 64 + sq + 4);
            const float4 nb0 = *(const float4*)(snb + s * 64 + sq), nb1 = *(const float4*)(snb + s * 64 + sq + 4);
            const float4 k0 = *(const float4*)(sk + s * 64 + sq), k1 = *(const float4*)(sk + s * 64 + sq + 4);
            const float4 r0 = *(const float4*)(sr + s * 64 + sq), r1 = *(const float4*)(sr + s * 64 + sq + 4);
            const float vv = sv[s * 64 + srow];
            float sa = (S[0] * kk0.x + S[1] * kk0.y) + (S[2] * kk0.z + S[3] * kk0.w) + (S[4] * kk1.x + S[5] * kk1.y) + (S[6] * kk1.z + S[7] * kk1.w);
            sa = red8_sum(sa);
            S[0] = S[0] * w0.x + sa * nb0.x + vv * k0.x; S[1] = S[1] * w0.y + sa * nb0.y + vv * k0.y; S[2] = S[2] * w0.z + sa * nb0.z + vv * k0.z; S[3] = S[3] * w0.w + sa * nb0.w + vv * k0.w;
            S[4] = S[4] * w1.x + sa * nb1.x + vv * k1.x; S[5] = S[5] * w1.y + sa * nb1.y + vv * k1.y; S[6] = S[6] * w1.z + sa * nb1.z + vv * k1.z; S[7] = S[7] * w1.w + sa * nb1.w + vv * k1.w;
            float y = (S[0] * r0.x + S[1] * r0.y) + (S[2] * r0.z + S[3] * r0.w) + (S[4] * r1.x + S[5] * r1.y) + (S[6] * r1.z + S[7] * r1.w);
            y = red8_sum(y);
            if ((tid & 7) == 0) sy[s * 64 + srow] = y;
        }
        __syncthreads();
        {
            const int o = ls * 64 + lc; float y4[4]; float s1 = 0.f, bp = 0.f;
#pragma unroll
            for (int j = 0; j < 4; ++j) { y4[j] = sy[o + j]; s1 += y4[j]; bp += sr[o + j] * sk[o + j] * c_rk[j]; }
            s1 = red16_sum(s1);
            bp = red16_sum(bp);
            const float mean = s1 * (1.f / 64.f); float q = 0.f;
#pragma unroll
            for (int j = 0; j < 4; ++j) { y4[j] -= mean; q += y4[j] * y4[j]; }
            q = red16_sum(q);
            const float rstd = rsqrtf(q * (1.f / 64.f) + 64.0f * 1e-5f);
            float ov[4];
#pragma unroll
            for (int j = 0; j < 4; ++j) ov[j] = (y4[j] * rstd * c_lng[j] + c_lnb[j] + bp * sv[o + j]) * sg[o + j];
            uint2 w; w.x = pk2(ov[0], ov[1]); w.y = pk2(ov[2], ov[3]);
            *(uint2*)(A.ycat + (tok0 + (size_t)chunk * RW_CS + ls) * 1024 + hc) = w;
        }
        __syncthreads();
    }
}
struct MlstmArgs { const bf16_t* P0; const float* gates; const float* conv_w; const float* conv_b; const float* ig_b; const float* fg_b; const float* hn_g; const float* hn_b; bf16_t* ycat; };
constexpr int ML_QS = 132;
constexpr int ML_LDS_FLOATS = 64 * ML_QS + 64 * 128 + 64 * 64 + 64 * 65 + 64 * ML_QS + 4 * 8 * 128 + 64 * 10 + 512 + 128;
constexpr int ML_LDS_BYTES = ML_LDS_FLOATS * 4;

__device__ __forceinline__ void mlstm_unit(const MlstmArgs& A, int bh, float* smem) {
    float* qs = smem; float* ks = qs + 64 * ML_QS; bf16_t* vsb = (bf16_t*)(ks + 64 * 128); float* sc = ks + 64 * 128 + 64 * 64; float* hs = sc + 64 * 65; float* red = hs + 64 * ML_QS;
    float* sig = red + 4 * 8 * 128; float* slf = sig + 64; float* sb = slf + 64; float* smt = sb + 64; float* scarry = smt + 64; float* sden = scarry + 64; float* sws = sden + 64;
    float* smean = sws + 64; float* srstd = smean + 64; float* spad = srstd + 64; float* sdenp = spad + 64;   float* sn = sdenp + 512;
    const int tid = opaque_tid(); const int v = tid & 127, part = tid >> 7; const int b = bh >> 2, h = bh & 3;
    const size_t tok0 = (size_t)b * SEQ;
    const int cq = h * 128 + v;
    float wq[4], wk[4];
#pragma unroll
    for (int j = 0; j < 4; ++j) { wq[j] = A.conv_w[j * 1024 + cq]; wk[j] = A.conv_w[j * 1024 + 512 + cq]; }
    const float bq = A.conv_b[cq], bk = A.conv_b[512 + cq];
    const float igb = A.ig_b[h], fgb = A.fg_b[h];
    const float hng = A.hn_g[cq], hnb = A.hn_b[cq];
    float zq1 = 0.f, zq2 = 0.f, zq3 = 0.f, zk1 = 0.f, zk2 = 0.f, zk3 = 0.f;
    float C[32];
#pragma unroll
    for (int k = 0; k < 32; ++k) C[k] = 0.f;
    if (tid < 128) sn[tid] = 0.f;
    float m_run = 0.f;
    for (int chunk = 0; chunk < SEQ / 64; ++chunk) {
        const size_t row0 = tok0 + (size_t)chunk * 64;
        if (part == 0) {
            for (int t = 0; t < 64; ++t) { const bf16_t* pr = A.P0 + (row0 + t) * L0_MAIN;
                const float zq = bf2f(pr[1792 + cq]), zk = bf2f(pr[2304 + cq]);
                const float cvq = wq[3] * zq + wq[2] * zq1 + wq[1] * zq2 + wq[0] * zq3 + bq; const float cvk = wk[3] * zk + wk[2] * zk1 + wk[1] * zk2 + wk[0] * zk3 + bk;
                zq3 = zq2; zq2 = zq1; zq1 = zq; zk3 = zk2; zk2 = zk1; zk1 = zk;
                qs[t * ML_QS + v] = cvq * sigmoid_f(cvq) * 0.08838834764831845f; ks[t * 128 + v] = cvk * sigmoid_f(cvk); vsb[t * 128 + v] = pr[2816 + cq]; }
            if (tid < 64) { const float* gr = A.gates + (row0 + tid) * 16; sig[tid] = gr[h] + igb; slf[tid] = log_sigmoid_f(gr[4 + h] + fgb); }
        }
        __syncthreads();
        if (tid < 64) { float bsum = 0.f; for (int s = 0; s <= tid; ++s) bsum += slf[s]; sb[tid] = bsum; }
        __syncthreads();
        const float b_last = sb[63];
        float gmax = -INFINITY; for (int s = 0; s < 64; ++s) gmax = fmaxf(gmax, b_last - sb[s] + sig[s]);
        const float m_new = fmaxf(b_last + m_run, gmax); const float keep = __expf(b_last + m_run - m_new);
        if (tid < 64) { const float bt = sb[tid]; float mx = -INFINITY; for (int s = 0; s <= tid; ++s) mx = fmaxf(mx, bt - sb[s] + sig[s]);
            const float mt = fmaxf(bt + m_run, mx); smt[tid] = mt; scarry[tid] = __expf(bt + m_run - mt); sws[tid] = __expf(b_last - bt + sig[tid] - m_new); }
        __syncthreads();
        { const int t = tid & 63, sh = tid >> 6; const float bt = sb[t], mt = smt[t]; float dsum = 0.f;
            for (int s = sh * 8; s < sh * 8 + 8; ++s) { float val = 0.f;
                if (s <= t) { float dot = 0.f;
#pragma unroll 8
                    for (int k = 0; k < 128; k += 4) { const float4 qa = *(const float4*)(qs + t * ML_QS + k), kb = *(const float4*)(ks + s * 128 + k); dot += (qa.x * kb.x + qa.y * kb.y) + (qa.z * kb.z + qa.w * kb.w); }
                    val = dot * __expf(bt - sb[s] + sig[s] - mt); }
                sc[t * 65 + s] = val; dsum += val; }
            sdenp[sh * 64 + t] = dsum; }
        __syncthreads();
        if (tid < 64) { float qn = 0.f; for (int k = 0; k < 128; ++k) qn += qs[tid * ML_QS + k] * sn[k];
            float den = scarry[tid] * qn;
#pragma unroll
            for (int p = 0; p < 8; ++p) den += sdenp[p * 64 + tid];
            sden[tid] = fmaxf(fabsf(den), __expf(-smt[tid])); }
        __syncthreads();
        for (int batch = 0; batch < 8; ++batch) {
#pragma unroll 2
            for (int tt = 0; tt < 8; ++tt) { const int t = batch * 8 + tt; float qc = 0.f;
#pragma unroll
                for (int k = 0; k < 32; k += 4) { const float4 qa = *(const float4*)(qs + t * ML_QS + part * 32 + k); qc += (qa.x * C[k] + qa.y * C[k + 1]) + (qa.z * C[k + 2] + qa.w * C[k + 3]); }
                red[(part * 8 + tt) * 128 + v] = qc; }
            __syncthreads();
#pragma unroll
            for (int j = 0; j < 2; ++j) { const int tt = part * 2 + j, t = batch * 8 + tt;
                const float qc = (red[(0 * 8 + tt) * 128 + v] + red[(1 * 8 + tt) * 128 + v]) + (red[(2 * 8 + tt) * 128 + v] + red[(3 * 8 + tt) * 128 + v]);
                float acc = 0.f; for (int s = 0; s <= t; ++s) acc += sc[t * 65 + s] * bf2f(vsb[s * 128 + v]);
                hs[t * ML_QS + v] = (acc + scarry[t] * qc) / sden[t]; }
            __syncthreads();
        }
        { const int t = tid >> 3, oc = tid & 7; float s1 = 0.f;
#pragma unroll
            for (int k = 0; k < 16; ++k) s1 += hs[t * ML_QS + oc * 16 + k];
            s1 = red8_sum(s1); const float mean = s1 * (1.f / 128.f); float q = 0.f;
#pragma unroll
            for (int k = 0; k < 16; ++k) { const float d = hs[t * ML_QS + oc * 16 + k] - mean; q += d * d; }
            q = red8_sum(q); if (oc == 0) { smean[t] = mean; srstd[t] = rsqrtf(q * (1.f / 128.f) + LN_EPS); } }
        __syncthreads();
        for (int t = part * 16; t < part * 16 + 16; ++t) { const float hn = (hs[t * ML_QS + v] - smean[t]) * srstd[t] * hng + hnb; const float og = bf2f(A.P0[(row0 + t) * L0_MAIN + 3328 + cq]);
            A.ycat[(row0 + t) * 1024 + 512 + cq] = (bf16_t)f2bf(hn * sigmoid_f(og)); }
#pragma unroll
        for (int k = 0; k < 32; ++k) C[k] *= keep;
        for (int s = 0; s < 64; ++s) { const float wv = sws[s] * bf2f(vsb[s * 128 + v]);
#pragma unroll
            for (int k = 0; k < 32; k += 4) { const float4 kb = *(const float4*)(ks + s * 128 + part * 32 + k); C[k] += kb.x * wv; C[k + 1] += kb.y * wv; C[k + 2] += kb.z * wv; C[k + 3] += kb.w * wv; } }
        if (tid < 128) { float nn = keep * sn[tid]; for (int s = 0; s < 64; ++s) nn += sws[s] * ks[s * 128 + tid]; sn[tid] = nn; }
        m_run = m_new;
        __syncthreads();
    }
}

struct AttnArgs { const bf16_t* P1; const float* cum; const float* qn_g; const float* kn_g; bf16_t* out; };
constexpr int AT_LDS_BYTES = (2 * 32 * 64 + 32) * 4;
__device__ __forceinline__ void attn_unit_valu(const AttnArgs& A, int bh, int qb, float* smem) {
    float* Ks = smem; float* Vs = Ks + 2048; float* cj = Vs + 2048;
    const int tid = opaque_tid(); const int b = bh >> 4, h = bh & 15; const int hf = tid & 1; const int i = qb * 256 + (tid >> 1); const size_t row = (size_t)b * SEQ + i;
    float q[32], o[32];
    { float ss = 0.f;
#pragma unroll
        for (int c = 0; c < 4; ++c) { const uint4 w = *(const uint4*)(A.P1 + row * L1_MAIN + h * 64 + hf * 32 + c * 8); unpack8(w, q + c * 8); }
#pragma unroll
        for (int d = 0; d < 32; ++d) ss += q[d] * q[d];
        ss += __shfl_xor(ss, 1);
        const float r = rsqrtf(ss * (1.f / 64.f) + 1e-6f) * 0.125f;
#pragma unroll
        for (int d = 0; d < 32; ++d) { q[d] = q[d] * r * A.qn_g[h * 64 + hf * 32 + d]; o[d] = 0.f; } }
    const float ci = A.cum[(size_t)bh * SEQ + i];
    float m = -INFINITY, l = 0.f;
    const int ntiles = (qb * 256 + 256) / 32;
    const int lkey = tid >> 4, ld4 = (tid & 15) * 4;
    float kg[4];
#pragma unroll
    for (int j = 0; j < 4; ++j) kg[j] = A.kn_g[h * 64 + ld4 + j];
    for (int kt = 0; kt < ntiles; ++kt) {
        { const size_t krow = (size_t)b * SEQ + kt * 32 + lkey; float fk[4], fv[4];
            unpack4(*(const uint2*)(A.P1 + krow * L1_MAIN + 1024 + h * 64 + ld4), fk); unpack4(*(const uint2*)(A.P1 + krow * L1_MAIN + 2048 + h * 64 + ld4), fv);
            float ss = (fk[0] * fk[0] + fk[1] * fk[1]) + (fk[2] * fk[2] + fk[3] * fk[3]);
            ss = red16_sum(ss);
            const float r = rsqrtf(ss * (1.f / 64.f) + 1e-6f);
#pragma unroll
            for (int j = 0; j < 4; ++j) { Ks[lkey * 64 + ld4 + j] = fk[j] * r * kg[j]; Vs[lkey * 64 + ld4 + j] = fv[j]; }
            if ((tid & 15) == 0) cj[lkey] = A.cum[(size_t)bh * SEQ + kt * 32 + lkey]; }
        __syncthreads();
#pragma unroll 1
        for (int sub = 0; sub < 8; ++sub) {
            float s[4]; float mx = -INFINITY;
#pragma unroll
            for (int jj = 0; jj < 4; ++jj) { const int j = sub * 4 + jj; float dot = 0.f;
#pragma unroll
                for (int d = 0; d < 32; d += 4) { const float4 kv = *(const float4*)(Ks + j * 64 + hf * 32 + d); dot += (q[d] * kv.x + q[d + 1] * kv.y) + (q[d + 2] * kv.z + q[d + 3] * kv.w); }
                dot += __shfl_xor(dot, 1);
                float sv_ = dot + ci - cj[j]; if (kt * 32 + j > i) sv_ = -INFINITY; s[jj] = sv_; mx = fmaxf(mx, sv_); }
            const float mnew = fmaxf(m, mx); const float scl = __expf(m - mnew); float psum = 0.f;
#pragma unroll
            for (int jj = 0; jj < 4; ++jj) { s[jj] = __expf(s[jj] - mnew); psum += s[jj]; }
            l = l * scl + psum; m = mnew;
#pragma unroll
            for (int d = 0; d < 32; ++d) o[d] *= scl;
#pragma unroll
            for (int jj = 0; jj < 4; ++jj) { const int j = sub * 4 + jj; const float p = s[jj];
#pragma unroll
                for (int d = 0; d < 32; d += 4) { const float4 vv = *(const float4*)(Vs + j * 64 + hf * 32 + d); o[d] += p * vv.x; o[d + 1] += p * vv.y; o[d + 2] += p * vv.z; o[d + 3] += p * vv.w; } }
        }
        __syncthreads();
    }
    const float il = 1.0f / l;
#pragma unroll
    for (int c = 0; c < 4; ++c) { float og[8]; unpack8(*(const uint4*)(A.P1 + row * L1_MAIN + 3072 + h * 64 + hf * 32 + c * 8), og);
        uint4 w; w.x = pk2(o[c * 8 + 0] * il * sigmoid_f(og[0]), o[c * 8 + 1] * il * sigmoid_f(og[1])); w.y = pk2(o[c * 8 + 2] * il * sigmoid_f(og[2]), o[c * 8 + 3] * il * sigmoid_f(og[3]));
        w.z = pk2(o[c * 8 + 4] * il * sigmoid_f(og[4]), o[c * 8 + 5] * il * sigmoid_f(og[5])); w.w = pk2(o[c * 8 + 6] * il * sigmoid_f(og[6]), o[c * 8 + 7] * il * sigmoid_f(og[7]));
        *(uint4*)(A.out + row * 1024 + h * 64 + hf * 32 + c * 8) = w; }
}
__device__ __forceinline__ void attn_valu_phase(const AttnArgs& A, int bid, int nblk, float* smem) {
    for (int su = bid; su < 256; su += nblk) { const int bh = su >> 1, pr = su & 1;
#pragma unroll 1
        for (int u = 0; u < 4; ++u) { const int qb = (u == 0) ? pr : (u == 1) ? 7 - pr : (u == 2) ? 2 + pr : 5 - pr; attn_unit_valu(A, bh, qb, smem); } }
}

struct PeerSArgs { const bf16_t* Q; const bf16_t* K1b; const bf16_t* K2b; int* eid; float* gate; };
constexpr int PS_QT = 0, PS_KB = 64 * 528, PS_KB2 = PS_KB + 128 * 272, PS_L1 = PS_KB + 2 * 128 * 272, PS_L2 = PS_L1 + 4096, PS_LDS_BYTES = PS_L2 + 4096;
__device__ __forceinline__ unsigned ord_f(float f) { const unsigned b = __float_as_uint(f); return b ^ ((b >> 31) ? 0xFFFFFFFFu : 0x80000000u); }
__device__ __forceinline__ float unord_f(unsigned u) { const unsigned b = (u & 0x80000000u) ? (u ^ 0x80000000u) : ~u; return __uint_as_float(b); }
#define TOPK_INSERT(L, x) do { unsigned x_ = (x); _Pragma("unroll") for (int q_ = 0; q_ < 16; ++q_) { const unsigned hi_ = max(L[q_], x_); x_ = min(L[q_], x_); L[q_] = hi_; } } while (0)

__device__ __forceinline__ void peer_scores_unit(const PeerSArgs& A, int tile, int h, unsigned char* smem) {
    const int tid = opaque_tid(), lane = tid & 63, wv = tid >> 6;
#pragma unroll
    for (int i = 0; i < 4; ++i) { const int idx = tid + 512 * i; const int row = idx >> 5, c = idx & 31;
        *(uint4*)(smem + PS_QT + row * 528 + c * 16) = *(const uint4*)(A.Q + (size_t)(tile * 64 + row) * 2048 + h * 256 + c * 8); }
#pragma unroll
    for (int i = 0; i < 4; ++i) { const int idx = tid + 512 * i; const int row = idx >> 4, c = idx & 15;
        *(uint4*)(smem + PS_KB + row * 272 + c * 16) = *(const uint4*)(A.K1b + (size_t)(h * 128 + row) * 128 + c * 8);
        *(uint4*)(smem + PS_KB2 + row * 272 + c * 16) = *(const uint4*)(A.K2b + (size_t)(h * 128 + row) * 128 + c * 8); }
    __syncthreads();
    const int half = wv >> 2, mt = wv & 3; const int fr = lane & 15, fq = lane >> 4;
    f32x4_t acc[8];
#pragma unroll
    for (int n = 0; n < 8; ++n) acc[n] = (f32x4_t){0.f, 0.f, 0.f, 0.f};
    { const unsigned char* qbase = smem + PS_QT + (16 * mt + fr) * 528 + (half * 128 + 8 * fq) * 2; const unsigned char* kbase = smem + (half ? PS_KB2 : PS_KB) + fr * 272 + (8 * fq) * 2;
#pragma unroll
        for (int ks = 0; ks < 4; ++ks) { const bf16x8_t qf = *(const bf16x8_t*)(qbase + ks * 64);
#pragma unroll
            for (int n = 0; n < 8; ++n) { const bf16x8_t kf = *(const bf16x8_t*)(kbase + n * 16 * 272 + ks * 64); acc[n] = __builtin_amdgcn_mfma_f32_16x16x32_bf16(kf, qf, acc[n], 0, 0, 0); } } }
    __syncthreads();
    { float* sT = (float*)(smem + PS_KB + half * 128 * 272);
#pragma unroll
        for (int n = 0; n < 8; ++n)
#pragma unroll
            for (int r = 0; r < 4; ++r) sT[(16 * n + 4 * fq + r) * 68 + 16 * mt + fr] = acc[n][r]; }
    __syncthreads();
    unsigned* part = (unsigned*)(smem + PS_QT);
    { const int qt = wv & 3; const float* sT = (const float*)(smem + PS_KB + half * 128 * 272); unsigned L[16];
#pragma unroll
        for (int j = 0; j < 16; ++j) L[j] = 0u;
#pragma unroll 4
        for (int kk = 0; kk < 32; ++kk) { const int key = 32 * qt + kk; const unsigned u = (ord_f(sT[key * 68 + lane]) & ~0x7Fu) | (unsigned)(127 - key); TOPK_INSERT(L, u); }
        unsigned* dst = part + (half * 4 + qt) * 1024;
#pragma unroll
        for (int j = 0; j < 16; ++j) dst[j * 64 + lane] = L[j]; }
    __syncthreads();
#pragma unroll 1
    for (int round = 0; round < 2; ++round) { const int qt = wv & 3; const int step = 1 << round;
        if ((qt & (2 * step - 1)) == 0) { unsigned* pa = part + (half * 4 + qt) * 1024; const unsigned* pb = part + (half * 4 + qt + step) * 1024; unsigned C[16];
#pragma unroll
            for (int j = 0; j < 16; ++j) C[j] = max(pa[j * 64 + lane], pb[(15 - j) * 64 + lane]);
#pragma unroll
            for (int d = 8; d >= 1; d >>= 1)
#pragma unroll
                for (int j = 0; j < 16; ++j) if ((j & d) == 0) { const unsigned hi_ = max(C[j], C[j + d]), lo_ = min(C[j], C[j + d]); C[j] = hi_; C[j + d] = lo_; }
            unsigned* dst = (round == 1) ? (unsigned*)(smem + (half ? PS_L2 : PS_L1)) : pa;
#pragma unroll
            for (int j = 0; j < 16; ++j) dst[j * 64 + lane] = C[j]; }
        __syncthreads(); }
    if (wv == 0) { const unsigned* l1 = (const unsigned*)(smem + PS_L1); const unsigned* l2 = (const unsigned*)(smem + PS_L2);
        float v1[16], v2[16];
#pragma unroll
        for (int j = 0; j < 16; ++j) { v1[j] = unord_f(l1[j * 64 + lane]); v2[j] = unord_f(l2[j * 64 + lane]); }
        unsigned L[16];
#pragma unroll
        for (int j = 0; j < 16; ++j) L[j] = (ord_f(v1[0] + v2[j]) & ~0xFFu) | (unsigned)(255 - j);
#pragma unroll
        for (int i = 1; i < 16; ++i)
#pragma unroll
            for (int j = 0; j < 16; ++j) if ((i + 1) * (j + 1) <= 16) { const unsigned u = (ord_f(v1[i] + v2[j]) & ~0xFFu) | (unsigned)(255 - (i * 16 + j)); TOPK_INSERT(L, u); }
        float e[16]; float sum = 0.f; const float mx = unord_f(L[0]);
#pragma unroll
        for (int k = 0; k < 16; ++k) { e[k] = __expf(unord_f(L[k]) - mx); sum += e[k]; }
        const float inv = 1.0f / sum; const size_t ob = (size_t)(tile * 64 + lane) * 128 + h * 16;
        int eo[16];
#pragma unroll
        for (int k = 0; k < 16; ++k) { const int idx = 255 - (int)(L[k] & 0xFFu); const int i = idx >> 4, j = idx & 15;
            const int e1 = 127 - (int)(l1[i * 64 + lane] & 0x7Fu), e2 = 127 - (int)(l2[j * 64 + lane] & 0x7Fu); eo[k] = e1 * 128 + e2; }
#pragma unroll
        for (int c = 0; c < 4; ++c) { *(int4*)(A.eid + ob + 4 * c) = make_int4(eo[4 * c], eo[4 * c + 1], eo[4 * c + 2], eo[4 * c + 3]);
            *(float4*)(A.gate + ob + 4 * c) = make_float4(e[4 * c] * inv, e[4 * c + 1] * inv, e[4 * c + 2] * inv, e[4 * c + 3] * inv); } }
    __syncthreads();
}
__device__ __forceinline__ void peer_scores_phase(const PeerSArgs& A, int bid, int nblk, unsigned char* smem) {
    for (int u = bid; u < 256 * 8; u += nblk) peer_scores_unit(A, u >> 3, u & 7, smem);
}

typedef float f32x2_t __attribute__((ext_vector_type(2)));
__device__ __forceinline__ void cvt_fp8_rows_phase(const float* __restrict__ src, unsigned char* __restrict__ dst, float* __restrict__ inv_scale, int bid, int nblk) {
    const int tid = opaque_tid(); const int lane = tid & 63, wv = tid >> 6;
    for (int r = bid * 8 + wv; r < 16384; r += nblk * 8) {
        float f[16]; float mx = 0.f;
#pragma unroll
        for (int c = 0; c < 4; ++c) { const float4 v = *(const float4*)(src + (size_t)r * 1024 + 16 * lane + 4 * c); f[4 * c] = v.x; f[4 * c + 1] = v.y; f[4 * c + 2] = v.z; f[4 * c + 3] = v.w;
            mx = fmaxf(fmaxf(mx, fmaxf(fabsf(v.x), fabsf(v.y))), fmaxf(fabsf(v.z), fabsf(v.w))); }
        mx = wave_max(mx);
        const float sc = (mx > 0.f) ? 240.0f / mx : 1.0f;
        unsigned w[4];
#pragma unroll
        for (int c = 0; c < 4; ++c) { int p = 0; p = __builtin_amdgcn_cvt_pk_fp8_f32(f[4 * c] * sc, f[4 * c + 1] * sc, p, false); p = __builtin_amdgcn_cvt_pk_fp8_f32(f[4 * c + 2] * sc, f[4 * c + 3] * sc, p, true); w[c] = (unsigned)p; }
        *(uint4*)(dst + (size_t)r * 1024 + 16 * lane) = make_uint4(w[0], w[1], w[2], w[3]);
        if (lane == 0) inv_scale[r] = (mx > 0.f) ? mx * (1.0f / 240.0f) : 1.0f;
    }
}
__device__ __forceinline__ void unpack_fp8x16(const uint4 w, float* f) {
    const unsigned ww[4] = {w.x, w.y, w.z, w.w};
#pragma unroll
    for (int c = 0; c < 4; ++c) { const f32x2_t lo = __builtin_amdgcn_cvt_pk_f32_fp8((int)ww[c], false), hi = __builtin_amdgcn_cvt_pk_f32_fp8((int)ww[c], true); f[4 * c] = lo[0]; f[4 * c + 1] = lo[1]; f[4 * c + 2] = hi[0]; f[4 * c + 3] = hi[1]; }
}
struct PeerGArgs { const float* X; float* Xo; const int* eid; const float* gate; const unsigned char* U; const unsigned char* V; const float* Us; const float* Vs; const float* lng; const float* lnb; bf16_t* xb; };
__device__ __forceinline__ void peer_gather_token(const PeerGArgs& A, int t, int lane) {
    float x[16];
#pragma unroll
    for (int c = 0; c < 4; ++c) { const float4 v = *(const float4*)(A.X + (size_t)t * 1024 + 16 * lane + 4 * c); x[4 * c] = v.x; x[4 * c + 1] = v.y; x[4 * c + 2] = v.z; x[4 * c + 3] = v.w; }
    const int e_lo = A.eid[(size_t)t * 128 + lane], e_hi = A.eid[(size_t)t * 128 + 64 + lane];
    const float g_lo = A.gate[(size_t)t * 128 + lane], g_hi = A.gate[(size_t)t * 128 + 64 + lane];
    const float us_lo = A.Us[e_lo], us_hi = A.Us[e_hi], vs_lo = A.Vs[e_lo], vs_hi = A.Vs[e_hi];
    float acc[16];
#pragma unroll
    for (int j = 0; j < 16; ++j) acc[j] = 0.f;
    for (int k0 = 0; k0 < 128; k0 += 8) {
        uint4 u[8], v[8]; float g[8], us[8];
#pragma unroll
        for (int i = 0; i < 8; ++i) { const int k = k0 + i; const int e = __shfl(k0 < 64 ? e_lo : e_hi, k & 63); g[i] = __shfl(k0 < 64 ? g_lo : g_hi, k & 63) * __shfl(k0 < 64 ? vs_lo : vs_hi, k & 63); us[i] = __shfl(k0 < 64 ? us_lo : us_hi, k & 63);
            u[i] = *(const uint4*)(A.U + (size_t)e * 1024 + 16 * lane); v[i] = *(const uint4*)(A.V + (size_t)e * 1024 + 16 * lane); }
#pragma unroll
        for (int i = 0; i < 8; ++i) { float f[16]; unpack_fp8x16(u[i], f); float dot = 0.f;
#pragma unroll
            for (int j = 0; j < 16; ++j) dot += x[j] * f[j];
            dot = wave_sum(dot) * us[i];
            const float c = g[i] * 0.5f * dot * (1.0f + erff(dot * 0.7071067811865476f));
            unpack_fp8x16(v[i], f);
#pragma unroll
            for (int j = 0; j < 16; ++j) acc[j] += c * f[j]; }
    }
    float s = 0.f;
#pragma unroll
    for (int j = 0; j < 16; ++j) { acc[j] += DN_ALPHA * x[j]; s += acc[j]; }
    const float mean = wave_sum(s) * (1.f / 1024.f); float q = 0.f;
#pragma unroll
    for (int j = 0; j < 16; ++j) { acc[j] -= mean; q += acc[j] * acc[j]; }
    const float rstd = rsqrtf(wave_sum(q) * (1.f / 1024.f) + LN_EPS);
    float ov[16];
#pragma unroll
    for (int c = 0; c < 4; ++c) { const float4 gg = *(const float4*)(A.lng + 16 * lane + 4 * c), bb = *(const float4*)(A.lnb + 16 * lane + 4 * c);
        ov[4 * c] = acc[4 * c] * rstd * gg.x + bb.x; ov[4 * c + 1] = acc[4 * c + 1] * rstd * gg.y + bb.y; ov[4 * c + 2] = acc[4 * c + 2] * rstd * gg.z + bb.z; ov[4 * c + 3] = acc[4 * c + 3] * rstd * gg.w + bb.w;
        *(float4*)(A.Xo + (size_t)t * 1024 + 16 * lane + 4 * c) = make_float4(ov[4 * c], ov[4 * c + 1], ov[4 * c + 2], ov[4 * c + 3]); }
    *(uint4*)(A.xb + (size_t)t * 1024 + 16 * lane) = make_uint4(pk2(ov[0], ov[1]), pk2(ov[2], ov[3]), pk2(ov[4], ov[5]), pk2(ov[6], ov[7]));
    *(uint4*)(A.xb + (size_t)t * 1024 + 16 * lane + 8) = make_uint4(pk2(ov[8], ov[9]), pk2(ov[10], ov[11]), pk2(ov[12], ov[13]), pk2(ov[14], ov[15]));
}
__device__ __forceinline__ void peer_gather_phase(const PeerGArgs& A, int bid, int nblk) {
    const int tid = opaque_tid(); const int lane = tid & 63, wv = tid >> 6;
    for (int t = bid * 8 + wv; t < T_TOK; t += nblk * 8) peer_gather_token(A, t, lane);
}

namespace mlm {
typedef __attribute__((address_space(3))) unsigned char lds_u8;
typedef short v4i16_t __attribute__((ext_vector_type(4)));
typedef unsigned u32x4_t __attribute__((ext_vector_type(4)));
typedef unsigned u32x2_t __attribute__((ext_vector_type(2)));
#define MLM_LDS(T, off) (*(__attribute__((address_space(3))) T*)(smem + (off)))
constexpr int RS = 136;
constexpr int OFF_QS = 0, OFF_KS = OFF_QS + 64 * RS * 2, OFF_VS = OFF_KS + 64 * RS * 2, OFF_OG = OFF_VS + 64 * RS * 2, OFF_CT = OFF_OG + 64 * RS * 2, OFF_SC = OFF_CT + 128 * RS * 2, OFF_F = OFF_SC + 64 * 72 * 2;
constexpr int F_SIG = 0, F_SLF = 64, F_SU = 128, F_SBM = 192, F_CARRY = 256, F_WS = 320, F_SEN = 384, F_SQN = 448, F_DENP = 512, F_STAT = 640, F_SN = 896, F_SCAL = 1024, F_HNG = 1032, F_HNB = 1160, F_END = 1288;
constexpr int LDS_BYTES = OFF_F + F_END * 4;
__device__ __forceinline__ bf16x8_t tr_frag(const lds_u8* p, int row_stride_bytes) {
    const v4i16_t lo = __builtin_amdgcn_ds_read_tr16_b64_v4i16((__attribute__((address_space(3))) v4i16_t*)p);
    const v4i16_t hi = __builtin_amdgcn_ds_read_tr16_b64_v4i16((__attribute__((address_space(3))) v4i16_t*)(p + 4 * row_stride_bytes));
    return (bf16x8_t){lo[0], lo[1], lo[2], lo[3], hi[0], hi[1], hi[2], hi[3]};
}
#define MLM_LOAD_RAW(chunk) do { const size_t r0_ = tok0 + (size_t)(chunk) * 64 + 2 * tp; const bf16_t* pb_ = A.P0 + r0_ * L0_MAIN + h * 128 + 8 * g; \
    rq[0] = *(const uint4*)(pb_ + 1792); rq[1] = *(const uint4*)(pb_ + L0_MAIN + 1792); rk[0] = *(const uint4*)(pb_ + 2304); rk[1] = *(const uint4*)(pb_ + L0_MAIN + 2304); \
    rv[0] = *(const uint4*)(pb_ + 2816); rv[1] = *(const uint4*)(pb_ + L0_MAIN + 2816); rog[0] = *(const uint4*)(pb_ + 3328); rog[1] = *(const uint4*)(pb_ + L0_MAIN + 3328); \
    if (tid < 64) { const float* gr_ = A.gates + (tok0 + (size_t)(chunk) * 64 + tid) * 16; rgi = gr_[h]; rgf = gr_[4 + h]; } } while (0)

struct MlState { f32x4_t Cacc[8]; float m_old; };
__device__ __forceinline__ void mlstm_unit_mfma(const MlstmArgs& A, int bh, unsigned char* smem_g, int c_begin, int c_end, MlState& st) {
    lds_u8* smem = (lds_u8*)smem_g;
    __attribute__((address_space(3))) float* F = (__attribute__((address_space(3))) float*)(smem + OFF_F);
    const int tid0 = opaque_tid(); const int b = bh >> 2, h = bh & 3;
    const size_t tok0 = (size_t)b * SEQ;
#define MLM_IDX() int tid = tid0; asm volatile("" : "+v"(tid)); const int lane = tid & 63, w = __builtin_amdgcn_readfirstlane(tid >> 6), fr = lane & 15, fq = lane >> 4; \
    const int g = tid & 15, tp = tid >> 4;   const int mt = w & 3, nh = w >> 2;   \
    (void)lane; (void)fr; (void)fq; (void)g; (void)tp; (void)mt; (void)nh
    if (c_begin == 0) {
    MLM_IDX();
    for (int i = tid; i < 128 * RS / 2; i += NTHR) ((__attribute__((address_space(3))) unsigned*)(smem + OFF_CT))[i] = 0u;
    if (tid < 128) F[F_SN + tid] = 0.f;
    if (tid < 128) { F[F_HNG + tid] = A.hn_g[h * 128 + tid]; F[F_HNB + tid] = A.hn_b[h * 128 + tid]; }
#pragma unroll
    for (int n = 0; n < 8; ++n) st.Cacc[n] = (f32x4_t){0.f, 0.f, 0.f, 0.f};
    st.m_old = 0.f;
    }
    const float igb = A.ig_b[h], fgb = A.fg_b[h];
    f32x4_t Cacc[8];
#pragma unroll
    for (int n = 0; n < 8; ++n) Cacc[n] = st.Cacc[n];
    float m_old = st.m_old;
    uint4 rq[2], rk[2], rv[2], rog[2]; float rgi = 0.f, rgf = 0.f;
    { MLM_IDX(); MLM_LOAD_RAW(c_begin); }
    __syncthreads();
    for (int chunk_ = c_begin; chunk_ < c_end; ++chunk_) {
        int chunk = chunk_; asm volatile("" : "+s"(chunk));
        MLM_IDX();
        const size_t row0 = tok0 + (size_t)chunk * 64;
        {
#pragma unroll
            for (int r = 0; r < 2; ++r) { const int off = ((2 * tp + r) * RS + 8 * g) * 2;
                MLM_LDS(u32x4_t, OFF_QS + off) = (u32x4_t){rq[r].x, rq[r].y, rq[r].z, rq[r].w}; MLM_LDS(u32x4_t, OFF_KS + off) = (u32x4_t){rk[r].x, rk[r].y, rk[r].z, rk[r].w};
                MLM_LDS(u32x4_t, OFF_VS + off) = (u32x4_t){rv[r].x, rv[r].y, rv[r].z, rv[r].w}; MLM_LDS(u32x4_t, OFF_OG + off) = (u32x4_t){rog[r].x, rog[r].y, rog[r].z, rog[r].w}; }
            if (tid < 64) { F[F_SIG + tid] = rgi + igb; F[F_SLF + tid] = log_sigmoid_f(rgf + fgb); }
        }
        LDS_BARRIER();
        if (chunk + 1 < c_end) MLM_LOAD_RAW(chunk + 1);
        if (w == 0) {
            const float ig = F[F_SIG + lane], lf = F[F_SLF + lane];
            const float bs = wave_scan_sum(lf);
            const float u = ig - bs; const float pm = wave_scan_max(u);
            const float mtv = bs + fmaxf(m_old, pm);
            const float b_last = __shfl(bs, 63), pm_last = __shfl(pm, 63);
            const float m_new = fmaxf(b_last + m_old, b_last + pm_last);
            F[F_SU + lane] = u; F[F_SBM + lane] = bs - mtv; F[F_CARRY + lane] = __expf(bs + m_old - mtv); F[F_WS + lane] = __expf(b_last + u - m_new); F[F_SEN + lane] = __expf(-mtv);
            if (lane == 0) F[F_SCAL] = __expf(b_last + m_old - m_new);
            m_old = m_new;
        }
        bf16x8_t qf[4];
#pragma unroll
        for (int ks = 0; ks < 4; ++ks) qf[ks] = *(const __attribute__((address_space(3))) bf16x8_t*)(smem + OFF_QS + ((16 * mt + fr) * RS + 32 * ks + 8 * fq) * 2);
        f32x4_t sacc[2];
#pragma unroll
        for (int n2 = 0; n2 < 2; ++n2) { sacc[n2] = (f32x4_t){0.f, 0.f, 0.f, 0.f};
#pragma unroll
            for (int ks = 0; ks < 4; ++ks) { const bf16x8_t kf = *(const __attribute__((address_space(3))) bf16x8_t*)(smem + OFF_KS + ((16 * (2 * nh + n2) + fr) * RS + 32 * ks + 8 * fq) * 2);
                sacc[n2] = __builtin_amdgcn_mfma_f32_16x16x32_bf16(qf[ks], kf, sacc[n2], 0, 0, 0); } }
        { const int t = tid >> 3, p = tid & 7; float f16[16];
            { const u32x4_t a_ = MLM_LDS(u32x4_t, OFF_QS + (t * RS + 16 * p) * 2), b_ = MLM_LDS(u32x4_t, OFF_QS + (t * RS + 16 * p + 8) * 2);
              unpack8(make_uint4(a_[0], a_[1], a_[2], a_[3]), f16); unpack8(make_uint4(b_[0], b_[1], b_[2], b_[3]), f16 + 8); }
            float qn = 0.f;
#pragma unroll
            for (int k = 0; k < 16; ++k) qn += f16[k] * F[F_SN + 16 * p + k];
            qn = red8_sum(qn); if (p == 0) F[F_SQN + t] = qn; }
        LDS_BARRIER();
        {
            const f32x4_t bm = *(const __attribute__((address_space(3))) f32x4_t*)(F + F_SBM + 16 * mt + 4 * fq); float rs[4] = {0.f, 0.f, 0.f, 0.f};
#pragma unroll
            for (int n2 = 0; n2 < 2; ++n2) { const int s = 16 * (2 * nh + n2) + fr; const float us = F[F_SU + s];
#pragma unroll
                for (int r = 0; r < 4; ++r) { const int t = 16 * mt + 4 * fq + r; const float wgt = __expf(bm[r] + us); const float val = (s <= t) ? sacc[n2][r] * wgt : 0.f; rs[r] += val;
                    *(__attribute__((address_space(3))) bf16_t*)(smem + OFF_SC + (t * 72 + s) * 2) = (bf16_t)f2bf(val); } }
#pragma unroll
            for (int r = 0; r < 4; ++r) { float v = rs[r]; v = red16_sum(v); if (fr == 0) F[F_DENP + nh * 64 + 16 * mt + 4 * fq + r] = v; }
        }
        LDS_BARRIER();
        f32x4_t nacc[4], qacc[4];
#pragma unroll
        for (int j = 0; j < 4; ++j) { nacc[j] = (f32x4_t){0.f, 0.f, 0.f, 0.f}; qacc[j] = (f32x4_t){0.f, 0.f, 0.f, 0.f}; }
#pragma unroll
        for (int ks = 0; ks < 2; ++ks) { const bf16x8_t af = *(const __attribute__((address_space(3))) bf16x8_t*)(smem + OFF_SC + ((16 * mt + fr) * 72 + 32 * ks + 8 * fq) * 2);
#pragma unroll
            for (int j = 0; j < 4; ++j) { const bf16x8_t vf = tr_frag(smem + OFF_VS + ((32 * ks + 8 * fq + (fr >> 2)) * RS + 16 * (4 * nh + j) + 4 * (fr & 3)) * 2, RS * 2);
                nacc[j] = __builtin_amdgcn_mfma_f32_16x16x32_bf16(af, vf, nacc[j], 0, 0, 0); }
            __builtin_amdgcn_sched_barrier(0); }
#pragma unroll
        for (int ks = 0; ks < 4; ++ks) { const bf16x8_t qf2 = *(const __attribute__((address_space(3))) bf16x8_t*)(smem + OFF_QS + ((16 * mt + fr) * RS + 32 * ks + 8 * fq) * 2);
#pragma unroll
            for (int j = 0; j < 4; ++j) { const bf16x8_t cf = *(const __attribute__((address_space(3))) bf16x8_t*)(smem + OFF_CT + ((16 * (4 * nh + j) + fr) * RS + 32 * ks + 8 * fq) * 2);
                qacc[j] = __builtin_amdgcn_mfma_f32_16x16x32_bf16(qf2, cf, qacc[j], 0, 0, 0); }
            __builtin_amdgcn_sched_barrier(0); }
        float hv[4][4];
        {
            const f32x4_t cy = *(const __attribute__((address_space(3))) f32x4_t*)(F + F_CARRY + 16 * mt + 4 * fq), d0 = *(const __attribute__((address_space(3))) f32x4_t*)(F + F_DENP + 16 * mt + 4 * fq),
                          d1 = *(const __attribute__((address_space(3))) f32x4_t*)(F + F_DENP + 64 + 16 * mt + 4 * fq), qn = *(const __attribute__((address_space(3))) f32x4_t*)(F + F_SQN + 16 * mt + 4 * fq),
                          en = *(const __attribute__((address_space(3))) f32x4_t*)(F + F_SEN + 16 * mt + 4 * fq);
#pragma unroll
            for (int r = 0; r < 4; ++r) { const float den = d0[r] + d1[r] + cy[r] * qn[r]; const float inv = 1.0f / fmaxf(fabsf(den), en[r]); float s1 = 0.f, s2 = 0.f;
#pragma unroll
                for (int j = 0; j < 4; ++j) { const float hh = (nacc[j][r] + cy[r] * qacc[j][r]) * inv; hv[j][r] = hh; s1 += hh; s2 += hh * hh; }
                s1 = red16_sum(s1);
                s2 = red16_sum(s2);
                if (fr == 0) { F[F_STAT + (nh * 64 + 16 * mt + 4 * fq + r) * 2] = s1; F[F_STAT + (nh * 64 + 16 * mt + 4 * fq + r) * 2 + 1] = s2; } }
        }
        LDS_BARRIER();
        {
#pragma unroll
            for (int r = 0; r < 4; ++r) { const int t = 16 * mt + 4 * fq + r;
                const float s1 = F[F_STAT + t * 2] + F[F_STAT + (64 + t) * 2], s2 = F[F_STAT + t * 2 + 1] + F[F_STAT + (64 + t) * 2 + 1];
                const float mean = s1 * (1.f / 128.f); const float var = fmaxf(s2 * (1.f / 128.f) - mean * mean, 0.f); const float rstd = rsqrtf(var + LN_EPS);
#pragma unroll
                for (int j = 0; j < 4; ++j) { const int v = 16 * (4 * nh + j) + fr; const float og = bf2f(*(const __attribute__((address_space(3))) bf16_t*)(smem + OFF_OG + (t * RS + v) * 2));
                    const float o = ((hv[j][r] - mean) * rstd * F[F_HNG + v] + F[F_HNB + v]) * og;
                    A.ycat[(row0 + t) * 1024 + 512 + h * 128 + v] = (bf16_t)f2bf(o); } }
        }
        {
            const float keep = F[F_SCAL];
#pragma unroll
            for (int n = 0; n < 8; ++n) Cacc[n] = Cacc[n] * keep;
#pragma unroll
            for (int ks = 0; ks < 2; ++ks) {
                const bf16x8_t kraw = tr_frag(smem + OFF_KS + ((32 * ks + 8 * fq + (fr >> 2)) * RS + 16 * w + 4 * (fr & 3)) * 2, RS * 2);
                const f32x4_t w0 = *(const __attribute__((address_space(3))) f32x4_t*)(F + F_WS + 32 * ks + 8 * fq), w1 = *(const __attribute__((address_space(3))) f32x4_t*)(F + F_WS + 32 * ks + 8 * fq + 4);
                float kfv[8];
#pragma unroll
                for (int j = 0; j < 8; ++j) kfv[j] = bf2f((bf16_t)kraw[j]) * (j < 4 ? w0[j] : w1[j - 4]);
                const u32x4_t pk = (u32x4_t){pk2(kfv[0], kfv[1]), pk2(kfv[2], kfv[3]), pk2(kfv[4], kfv[5]), pk2(kfv[6], kfv[7])};
                const bf16x8_t af = __builtin_bit_cast(bf16x8_t, pk);
#pragma unroll
                for (int n = 0; n < 8; ++n) { const bf16x8_t vf = tr_frag(smem + OFF_VS + ((32 * ks + 8 * fq + (fr >> 2)) * RS + 16 * n + 4 * (fr & 3)) * 2, RS * 2);
                    Cacc[n] = __builtin_amdgcn_mfma_f32_16x16x32_bf16(af, vf, Cacc[n], 0, 0, 0); }
                __builtin_amdgcn_sched_barrier(0); }
#pragma unroll
            for (int n = 0; n < 8; ++n) MLM_LDS(u32x2_t, OFF_CT + ((16 * n + fr) * RS + 16 * w + 4 * fq) * 2) = (u32x2_t){pk2(Cacc[n][0], Cacc[n][1]), pk2(Cacc[n][2], Cacc[n][3])};
            if (tid < 128) { float nn = keep * F[F_SN + tid];
#pragma unroll 16
                for (int s = 0; s < 64; ++s) nn += F[F_WS + s] * bf2f(*(const __attribute__((address_space(3))) bf16_t*)(smem + OFF_KS + (s * RS + tid) * 2));
                F[F_SN + tid] = nn; }
        }
        LDS_BARRIER();
    }
#pragma unroll
    for (int n = 0; n < 8; ++n) st.Cacc[n] = Cacc[n];
    st.m_old = m_old;
}
#undef MLM_LOAD_RAW
#undef MLM_IDX
#undef MLM_LDS
}

namespace rwc {
typedef __attribute__((address_space(3))) unsigned char lds_u8;
typedef short v4i16_t __attribute__((ext_vector_type(4)));
typedef unsigned u32x4_t __attribute__((ext_vector_type(4)));
constexpr int MS = 72, SLOT = 64 * MS * 2;
struct Args { const bf16_t* P0; const float* lrw; const bf16_t* lra; const bf16_t* lrg; const float* mu; const float* k_k; const float* k_a; const float* r_k; const float* ln_g; const float* ln_b;
              bf16_t* Gm; bf16_t* P1m; bf16_t* Hm; bf16_t* P2m; float* bonus; bf16_t* ycat; };
#define RWC_LDS(T, off) (*(__attribute__((address_space(3))) T*)(smem + (off)))
__device__ __forceinline__ bf16x8_t ldf(const lds_u8* smem, int slot, int row, int kcol) { return RWC_LDS(bf16x8_t, slot * SLOT + (row * MS + kcol) * 2); }
__device__ __forceinline__ bf16x8_t trf(const lds_u8* smem, int slot, int krow, int col) {
    const lds_u8* p = smem + slot * SLOT + (krow * MS + col) * 2;
    const v4i16_t lo = __builtin_amdgcn_ds_read_tr16_b64_v4i16((__attribute__((address_space(3))) v4i16_t*)p);
    const v4i16_t hi = __builtin_amdgcn_ds_read_tr16_b64_v4i16((__attribute__((address_space(3))) v4i16_t*)(p + 4 * MS * 2));
    return (bf16x8_t){lo[0], lo[1], lo[2], lo[3], hi[0], hi[1], hi[2], hi[3]};
}
__device__ __forceinline__ float ldb(const lds_u8* smem, int slot, int row, int col) { return bf2f(RWC_LDS(bf16_t, slot * SLOT + (row * MS + col) * 2)); }
__device__ __forceinline__ void stb(lds_u8* smem, int slot, int row, int col, float v) { RWC_LDS(bf16_t, slot * SLOT + (row * MS + col) * 2) = (bf16_t)f2bf(v); }
#define RWC_IDX() int tid = tid0; asm volatile("" : "+v"(tid)); const int lane = tid & 63, w = __builtin_amdgcn_readfirstlane(tid >> 6), fr = lane & 15, fq = lane >> 4; \
    const int et = tid >> 3, ec = (tid & 7) * 8; (void)lane; (void)fr; (void)fq; (void)et; (void)ec; (void)w
#define RWC_MFMA(a, b, c) __builtin_amdgcn_mfma_f32_16x16x32_bf16((a), (b), (c), 0, 0, 0)

constexpr int A_FOFF = 14 * SLOT;
constexpr int A_LDS_BYTES = A_FOFF + (8 * 64 + 64) * 4;
__device__ __forceinline__ void prep_unit(const Args& A, int unit, unsigned char* smem_g) {
    lds_u8* smem = (lds_u8*)smem_g;
    __attribute__((address_space(3))) float* Lg = (__attribute__((address_space(3))) float*)(smem + 12 * SLOT);
    __attribute__((address_space(3))) float* FA = (__attribute__((address_space(3))) float*)(smem + A_FOFF);
    const int tid0 = opaque_tid();
    const int bh = unit >> 5, c = unit & 31, b = bh >> 3, h = bh & 7;
    float r_l[8], kp[8], v_l[8], al[8], be[8];
    {
        RWC_IDX(); const int hc = h * 64 + ec; const int sg = c * 64 + et; const size_t row = (size_t)b * SEQ + sg;
        const bf16_t* pc = A.P0 + row * L0_MAIN + hc;
        float frc[8], fkc[8], fvc[8], frp[8], fkp[8], fvp[8], fa[8];
        unpack8(*(const uint4*)pc, frc); unpack8(*(const uint4*)(pc + 512), fkc); unpack8(*(const uint4*)(pc + 1024), fvc);
        if (sg > 0) { unpack8(*(const uint4*)(pc - L0_MAIN), frp); unpack8(*(const uint4*)(pc - L0_MAIN + 512), fkp); unpack8(*(const uint4*)(pc - L0_MAIN + 1024), fvp); }
        else {
#pragma unroll
            for (int j = 0; j < 8; ++j) { frp[j] = 0.f; fkp[j] = 0.f; fvp[j] = 0.f; } }
        const float4 z0 = *(const float4*)(A.lrw + row * 512 + hc), z1 = *(const float4*)(A.lrw + row * 512 + hc + 4); const float zw[8] = {z0.x, z0.y, z0.z, z0.w, z1.x, z1.y, z1.z, z1.w};
        unpack8(*(const uint4*)(A.lra + row * 512 + hc), fa);
        float kkr[8], ss = 0.f, bp = 0.f;
#pragma unroll
        for (int j = 0; j < 8; ++j) { r_l[j] = frc[j] + (frp[j] - frc[j]) * A.mu[hc + j]; const float k_l = fkc[j] + (fkp[j] - fkc[j]) * A.mu[512 + hc + j]; v_l[j] = fvc[j] + (fvp[j] - fvc[j]) * A.mu[1024 + hc + j];
            const float a_ = sigmoid_f(fa[j]); kkr[j] = k_l * A.k_k[hc + j]; ss += kkr[j] * kkr[j]; kp[j] = k_l * (1.0f + (a_ - 1.0f) * A.k_a[hc + j]); be[j] = a_;
            bp += r_l[j] * kp[j] * A.r_k[hc + j];
            Lg[et * 64 + ec + j] = -0.6065306597126334f * sigmoid_f(zw[j]); }
        ss = red8_sum(ss); bp = red8_sum(bp);
        const float inv = 1.0f / fmaxf(sqrtf(ss), 1e-12f);
#pragma unroll
        for (int j = 0; j < 8; ++j) { const float kk = kkr[j] * inv; al[j] = -kk; be[j] = kk * be[j]; }
        if ((tid & 7) == 0) A.bonus[(size_t)unit * 64 + et] = bp;
    }
    __syncthreads();
    {
        RWC_IDX(); const int ch = tid & 63, part = tid >> 6; float x[8]; float run = 0.f;
#pragma unroll
        for (int i = 0; i < 8; ++i) { run += Lg[(8 * part + i) * 64 + ch]; x[i] = run; }
        FA[part * 64 + ch] = run;
        __syncthreads();
        float off = 0.f;
#pragma unroll
        for (int p = 0; p < 7; ++p) off += (p < part) ? FA[p * 64 + ch] : 0.f;
#pragma unroll
        for (int i = 0; i < 8; ++i) Lg[(8 * part + i) * 64 + ch] = x[i] + off;
    }
    __syncthreads();
    {
        RWC_IDX(); float o0[8], o1[8], o2[8], o3[8], o4[8], o5[8];
#pragma unroll
        for (int j = 0; j < 8; ++j) { const float lt = Lg[et * 64 + ec + j], lm = (et > 0) ? Lg[(et - 1) * 64 + ec + j] : 0.f, lL = Lg[63 * 64 + ec + j];
            const float em1 = __expf(lm), en = __expf(-lt), e_t = __expf(lt), eh = __expf(lL - lt);
            o0[j] = al[j] * em1; o1[j] = be[j] * en; o2[j] = kp[j] * en; o3[j] = r_l[j] * e_t; o4[j] = be[j] * eh; o5[j] = kp[j] * eh;
            if (et == 63) FA[512 + ec + j] = __expf(lL); }
        const int off = (et * MS + ec) * 2;
        RWC_LDS(u32x4_t, 0 * SLOT + off) = (u32x4_t){pk2(o0[0], o0[1]), pk2(o0[2], o0[3]), pk2(o0[4], o0[5]), pk2(o0[6], o0[7])};
        RWC_LDS(u32x4_t, 1 * SLOT + off) = (u32x4_t){pk2(o1[0], o1[1]), pk2(o1[2], o1[3]), pk2(o1[4], o1[5]), pk2(o1[6], o1[7])};
        RWC_LDS(u32x4_t, 2 * SLOT + off) = (u32x4_t){pk2(o2[0], o2[1]), pk2(o2[2], o2[3]), pk2(o2[4], o2[5]), pk2(o2[6], o2[7])};
        RWC_LDS(u32x4_t, 3 * SLOT + off) = (u32x4_t){pk2(o3[0], o3[1]), pk2(o3[2], o3[3]), pk2(o3[4], o3[5]), pk2(o3[6], o3[7])};
        RWC_LDS(u32x4_t, 4 * SLOT + off) = (u32x4_t){pk2(o4[0], o4[1]), pk2(o4[2], o4[3]), pk2(o4[4], o4[5]), pk2(o4[6], o4[7])};
        RWC_LDS(u32x4_t, 5 * SLOT + off) = (u32x4_t){pk2(o5[0], o5[1]), pk2(o5[2], o5[3]), pk2(o5[4], o5[5]), pk2(o5[6], o5[7])};
        RWC_LDS(u32x4_t, 6 * SLOT + off) = (u32x4_t){pk2(v_l[0], v_l[1]), pk2(v_l[2], v_l[3]), pk2(v_l[4], v_l[5]), pk2(v_l[6], v_l[7])};
    }
    __syncthreads();
    {
        RWC_IDX(); const int m = w >> 1, mt0 = 2 * (w & 1); const int X = (m < 2) ? 0 : 3, Y = (m & 1) ? 2 : 1;
        f32x4_t acc[2][4];
#pragma unroll
        for (int i = 0; i < 2; ++i)
#pragma unroll
            for (int n = 0; n < 4; ++n) acc[i][n] = (f32x4_t){0.f, 0.f, 0.f, 0.f};
#pragma unroll
        for (int ks = 0; ks < 2; ++ks) { const bf16x8_t a0 = ldf(smem, X, 16 * mt0 + fr, 32 * ks + 8 * fq), a1 = ldf(smem, X, 16 * (mt0 + 1) + fr, 32 * ks + 8 * fq);
#pragma unroll
            for (int n = 0; n < 4; ++n) { const bf16x8_t bb = ldf(smem, Y, 16 * n + fr, 32 * ks + 8 * fq); acc[0][n] = RWC_MFMA(a0, bb, acc[0][n]); acc[1][n] = RWC_MFMA(a1, bb, acc[1][n]); } }
        const bool incl = (m >= 2); const int dst = (m == 0) ? 10 : 6 + m;
#pragma unroll
        for (int i = 0; i < 2; ++i)
#pragma unroll
            for (int n = 0; n < 4; ++n)
#pragma unroll
                for (int r = 0; r < 4; ++r) { const int tt = 16 * (mt0 + i) + 4 * fq + r, s = 16 * n + fr; const float val = (s < tt || (incl && s == tt)) ? acc[i][n][r] : 0.f;
                    stb(smem, dst, tt, s, val); if (m == 0) stb(smem, 12, tt, s, val + ((s == tt) ? 1.0f : 0.f)); }
    }
    __syncthreads();
    int Qc = 10, Qn = 11, Tc = 12, Tn = 13;
#pragma unroll 1
    for (int round = 0; round < 6; ++round) {
        { RWC_IDX(); const int mt = w & 3;
            if (w >= 4) { if (round < 5) { f32x4_t acc[4];
#pragma unroll
                    for (int n = 0; n < 4; ++n) acc[n] = (f32x4_t){0.f, 0.f, 0.f, 0.f};
#pragma unroll
                    for (int ks = 0; ks < 2; ++ks) { const bf16x8_t a = ldf(smem, Qc, 16 * mt + fr, 32 * ks + 8 * fq);
#pragma unroll
                        for (int n = 0; n < 4; ++n) { const bf16x8_t bb = trf(smem, Qc, 32 * ks + 8 * fq + (fr >> 2), 16 * n + 4 * (fr & 3)); acc[n] = RWC_MFMA(a, bb, acc[n]); } }
#pragma unroll
                    for (int n = 0; n < 4; ++n)
#pragma unroll
                        for (int r = 0; r < 4; ++r) stb(smem, Qn, 16 * mt + 4 * fq + r, 16 * n + fr, acc[n][r]); } }
            else { if (round >= 1) { f32x4_t acc[4];
#pragma unroll
                    for (int n = 0; n < 4; ++n)
#pragma unroll
                        for (int r = 0; r < 4; ++r) acc[n][r] = ldb(smem, Tc, 16 * mt + 4 * fq + r, 16 * n + fr);
#pragma unroll
                    for (int ks = 0; ks < 2; ++ks) { const bf16x8_t a = ldf(smem, Tc, 16 * mt + fr, 32 * ks + 8 * fq);
#pragma unroll
                        for (int n = 0; n < 4; ++n) { const bf16x8_t bb = trf(smem, Qc, 32 * ks + 8 * fq + (fr >> 2), 16 * n + 4 * (fr & 3)); acc[n] = RWC_MFMA(a, bb, acc[n]); } }
#pragma unroll
                    for (int n = 0; n < 4; ++n)
#pragma unroll
                        for (int r = 0; r < 4; ++r) stb(smem, Tn, 16 * mt + 4 * fq + r, 16 * n + fr, acc[n][r]); } }
        }
        __syncthreads();
        if (round < 5) { const int t_ = Qc; Qc = Qn; Qn = t_; }
        if (round >= 1) { const int t_ = Tc; Tc = Tn; Tn = t_; }
    }
    {
        RWC_IDX(); const int mt = w & 3; const int X = (w < 4) ? Tc : 7, Y = (w < 4) ? 0 : 6; f32x4_t acc[4];
#pragma unroll
        for (int n = 0; n < 4; ++n) acc[n] = (f32x4_t){0.f, 0.f, 0.f, 0.f};
#pragma unroll
        for (int ks = 0; ks < 2; ++ks) { const bf16x8_t a = ldf(smem, X, 16 * mt + fr, 32 * ks + 8 * fq);
#pragma unroll
            for (int n = 0; n < 4; ++n) { const bf16x8_t bb = trf(smem, Y, 32 * ks + 8 * fq + (fr >> 2), 16 * n + 4 * (fr & 3)); acc[n] = RWC_MFMA(a, bb, acc[n]); } }
#pragma unroll
        for (int n = 0; n < 4; ++n)
#pragma unroll
            for (int r = 0; r < 4; ++r) stb(smem, (w < 4) ? 1 : 2, 16 * mt + 4 * fq + r, 16 * n + fr, acc[n][r]);
    }
    __syncthreads();
    {
        RWC_IDX(); const int mt = w >> 1, n0 = 2 * (w & 1); f32x4_t acc[2];
#pragma unroll
        for (int i = 0; i < 2; ++i) acc[i] = (f32x4_t){0.f, 0.f, 0.f, 0.f};
#pragma unroll
        for (int ks = 0; ks < 2; ++ks) { const bf16x8_t a = ldf(smem, Tc, 16 * mt + fr, 32 * ks + 8 * fq);
#pragma unroll
            for (int i = 0; i < 2; ++i) { const bf16x8_t bb = trf(smem, 2, 32 * ks + 8 * fq + (fr >> 2), 16 * (n0 + i) + 4 * (fr & 3)); acc[i] = RWC_MFMA(a, bb, acc[i]); } }
#pragma unroll
        for (int i = 0; i < 2; ++i)
#pragma unroll
            for (int r = 0; r < 4; ++r) stb(smem, 10, 16 * mt + 4 * fq + r, 16 * (n0 + i) + fr, acc[i][r]);
    }
    __syncthreads();
    {
        RWC_IDX(); const int mt = w & 3; f32x4_t a1[4], a2[4];
        if (w < 4) {
#pragma unroll
            for (int n = 0; n < 4; ++n)
#pragma unroll
                for (int r = 0; r < 4; ++r) { a1[n][r] = ldb(smem, 3, 16 * mt + 4 * fq + r, 16 * n + fr); a2[n][r] = 0.f; }
#pragma unroll
            for (int ks = 0; ks < 2; ++ks) { const bf16x8_t xb = ldf(smem, 8, 16 * mt + fr, 32 * ks + 8 * fq), xk = ldf(smem, 9, 16 * mt + fr, 32 * ks + 8 * fq);
#pragma unroll
                for (int n = 0; n < 4; ++n) { const int kr = 32 * ks + 8 * fq + (fr >> 2), cc = 16 * n + 4 * (fr & 3);
                    a1[n] = RWC_MFMA(xb, trf(smem, 1, kr, cc), a1[n]); a2[n] = RWC_MFMA(xb, trf(smem, 10, kr, cc), a2[n]); a2[n] = RWC_MFMA(xk, trf(smem, 6, kr, cc), a2[n]); } }
        } else {
#pragma unroll
            for (int n = 0; n < 4; ++n)
#pragma unroll
                for (int r = 0; r < 4; ++r) { const int k = 16 * mt + 4 * fq + r; a1[n][r] = (k == 16 * n + fr) ? FA[512 + k] : 0.f; a2[n][r] = 0.f; }
#pragma unroll
            for (int ks = 0; ks < 2; ++ks) { const int kr = 32 * ks + 8 * fq + (fr >> 2); const bf16x8_t xb = trf(smem, 4, kr, 16 * mt + 4 * (fr & 3)), xk = trf(smem, 5, kr, 16 * mt + 4 * (fr & 3));
#pragma unroll
                for (int n = 0; n < 4; ++n) { const int cc = 16 * n + 4 * (fr & 3);
                    a1[n] = RWC_MFMA(xb, trf(smem, 1, kr, cc), a1[n]); a2[n] = RWC_MFMA(xb, trf(smem, 10, kr, cc), a2[n]); a2[n] = RWC_MFMA(xk, trf(smem, 6, kr, cc), a2[n]); } }
        }
        __syncthreads();
#pragma unroll
        for (int n = 0; n < 4; ++n)
#pragma unroll
            for (int r = 0; r < 4; ++r) { stb(smem, (w < 4) ? 3 : 7, 16 * mt + 4 * fq + r, 16 * n + fr, a1[n][r]); stb(smem, (w < 4) ? 0 : 11, 16 * mt + 4 * fq + r, 16 * n + fr, a2[n][r]); }
    }
    __syncthreads();
    {
        RWC_IDX(); const size_t go = ((size_t)unit * 64 + et) * 64 + ec; const int off = (et * MS + ec) * 2;
        { const u32x4_t v = RWC_LDS(u32x4_t, 3 * SLOT + off); *(uint4*)(A.P1m + go) = make_uint4(v[0], v[1], v[2], v[3]); }
        { const u32x4_t v = RWC_LDS(u32x4_t, 0 * SLOT + off); *(uint4*)(A.P2m + go) = make_uint4(v[0], v[1], v[2], v[3]); }
        { const u32x4_t v = RWC_LDS(u32x4_t, 7 * SLOT + off); *(uint4*)(A.Gm + go) = make_uint4(v[0], v[1], v[2], v[3]); }
        { const u32x4_t v = RWC_LDS(u32x4_t, 11 * SLOT + off); *(uint4*)(A.Hm + go) = make_uint4(v[0], v[1], v[2], v[3]); }
    }
    __syncthreads();
}

constexpr int B_FOFF = 8 * SLOT;
constexpr int B_LDS_BYTES = B_FOFF + (256 + 64) * 4;
#define RWC_PREFETCH(cc) do { const size_t go_ = ((size_t)(bh * 32 + (cc)) * 64 + et) * 64 + ec; pg = *(const uint4*)(A.Gm + go_); p1 = *(const uint4*)(A.P1m + go_); ph = *(const uint4*)(A.Hm + go_); p2 = *(const uint4*)(A.P2m + go_); \
        const int sg_ = (cc) * 64 + et; const size_t row_ = (size_t)b * SEQ + sg_; pgg = *(const uint4*)(A.lrg + row_ * 512 + h * 64 + ec); \
        const bf16_t* pv_ = A.P0 + row_ * L0_MAIN + 1024 + h * 64 + ec; pvc = *(const uint4*)pv_; if (sg_ > 0) pvp = *(const uint4*)(pv_ - L0_MAIN); else pvp = make_uint4(0u, 0u, 0u, 0u); \
        if (tid < 64) pbn = A.bonus[(size_t)(bh * 32 + (cc)) * 64 + tid]; } while (0)
__device__ __forceinline__ void scan_unit(const Args& A, int bh, unsigned char* smem_g) {
    lds_u8* smem = (lds_u8*)smem_g;
    __attribute__((address_space(3))) float* FB = (__attribute__((address_space(3))) float*)(smem + B_FOFF);
    const int tid0 = opaque_tid(); const int b = bh >> 3, h = bh & 7;
    f32x4_t Z[2]; Z[0] = (f32x4_t){0.f, 0.f, 0.f, 0.f}; Z[1] = Z[0];
    uint4 pg, p1, ph, p2, pgg, pvc, pvp; float pbn = 0.f;
    { RWC_IDX(); RWC_PREFETCH(0); }
#pragma unroll 1
    for (int c_ = 0; c_ < SEQ / 64; ++c_) {
        int c = c_; asm volatile("" : "+s"(c));
        RWC_IDX(); const int mt = w >> 1, n0 = 2 * (w & 1);
        {
            const int off = (et * MS + ec) * 2;
            RWC_LDS(u32x4_t, 2 * SLOT + off) = (u32x4_t){pg.x, pg.y, pg.z, pg.w}; RWC_LDS(u32x4_t, 3 * SLOT + off) = (u32x4_t){p1.x, p1.y, p1.z, p1.w};
            RWC_LDS(u32x4_t, 4 * SLOT + off) = (u32x4_t){ph.x, ph.y, ph.z, ph.w}; RWC_LDS(u32x4_t, 5 * SLOT + off) = (u32x4_t){p2.x, p2.y, p2.z, p2.w};
            RWC_LDS(u32x4_t, 6 * SLOT + off) = (u32x4_t){pgg.x, pgg.y, pgg.z, pgg.w};
            float fc[8], fp[8], vl[8]; unpack8(pvc, fc); unpack8(pvp, fp);
#pragma unroll
            for (int j = 0; j < 8; ++j) vl[j] = fc[j] + (fp[j] - fc[j]) * A.mu[1024 + h * 64 + ec + j];
            RWC_LDS(u32x4_t, 7 * SLOT + off) = (u32x4_t){pk2(vl[0], vl[1]), pk2(vl[2], vl[3]), pk2(vl[4], vl[5]), pk2(vl[6], vl[7])};
            if (tid < 64) FB[256 + tid] = pbn;
#pragma unroll
            for (int i = 0; i < 2; ++i)
#pragma unroll
                for (int r = 0; r < 4; ++r) stb(smem, 0, 16 * mt + 4 * fq + r, 16 * (n0 + i) + fr, Z[i][r]);
        }
        LDS_BARRIER();
        if (c + 1 < SEQ / 64) RWC_PREFETCH(c + 1);
        f32x4_t ya[2], zn[2];
#pragma unroll
        for (int i = 0; i < 2; ++i)
#pragma unroll
            for (int r = 0; r < 4; ++r) { ya[i][r] = ldb(smem, 5, 16 * mt + 4 * fq + r, 16 * (n0 + i) + fr); zn[i][r] = ldb(smem, 4, 16 * mt + 4 * fq + r, 16 * (n0 + i) + fr); }
#pragma unroll
        for (int ks = 0; ks < 2; ++ks) { const bf16x8_t ap = ldf(smem, 3, 16 * mt + fr, 32 * ks + 8 * fq), ag = ldf(smem, 2, 16 * mt + fr, 32 * ks + 8 * fq);
#pragma unroll
            for (int i = 0; i < 2; ++i) { const bf16x8_t bz = trf(smem, 0, 32 * ks + 8 * fq + (fr >> 2), 16 * (n0 + i) + 4 * (fr & 3)); ya[i] = RWC_MFMA(ap, bz, ya[i]); zn[i] = RWC_MFMA(ag, bz, zn[i]); } }
        Z[0] = zn[0]; Z[1] = zn[1];
#pragma unroll
        for (int r = 0; r < 4; ++r) { float s1 = ya[0][r] + ya[1][r], s2 = ya[0][r] * ya[0][r] + ya[1][r] * ya[1][r]; s1 = red16_sum(s1); s2 = red16_sum(s2);
            if (fr == 0) { FB[((w & 1) * 64 + 16 * mt + 4 * fq + r) * 2] = s1; FB[((w & 1) * 64 + 16 * mt + 4 * fq + r) * 2 + 1] = s2; } }
        LDS_BARRIER();
#pragma unroll
        for (int r = 0; r < 4; ++r) { const int t = 16 * mt + 4 * fq + r; const float s1 = FB[t * 2] + FB[(64 + t) * 2], s2 = FB[t * 2 + 1] + FB[(64 + t) * 2 + 1];
            const float mean = s1 * (1.f / 64.f); const float rstd = rsqrtf(fmaxf(s2 * (1.f / 64.f) - mean * mean, 0.f) + 64.0f * 1e-5f); const float bn = FB[256 + t];
#pragma unroll
            for (int i = 0; i < 2; ++i) { const int v = 16 * (n0 + i) + fr; const float o = ((ya[i][r] - mean) * rstd * A.ln_g[h * 64 + v] + A.ln_b[h * 64 + v] + bn * ldb(smem, 7, t, v)) * ldb(smem, 6, t, v);
                stb(smem, 1, t, v, o); } }
        LDS_BARRIER();
        { const u32x4_t v = RWC_LDS(u32x4_t, 1 * SLOT + (et * MS + ec) * 2); *(uint4*)(A.ycat + ((size_t)b * SEQ + c * 64 + et) * 1024 + h * 64 + ec) = make_uint4(v[0], v[1], v[2], v[3]); }
    }
}
#undef RWC_PREFETCH
#undef RWC_IDX
#undef RWC_MFMA
#undef RWC_LDS
}

constexpr size_t MiB = 1u << 20;
constexpr size_t WS_CTL = 0, CTL_ZERO_BYTES = 64 * 1024, WS_W0IN = 1 * MiB, WS_WLR = 9 * MiB, WS_W0OUT = 10 * MiB, WS_WQ0 = 12 * MiB, WS_W1IN = 16 * MiB, WS_W1OUT = 24 * MiB, WS_WQ1 = 26 * MiB;
constexpr size_t WS_PK = 30 * MiB;
constexpr size_t WS_GATES = 31 * MiB, WS_CUM = 32 * MiB, WS_APP = 33 * MiB, WS_EID = 41 * MiB, WS_GATE = 49 * MiB, WS_ACTA = 57 * MiB;
constexpr size_t WS_TABU = 89 * MiB, WS_TABV = 121 * MiB, WS_P = 153 * MiB, WS_LRW = 281 * MiB, WS_LRA = 313 * MiB, WS_LRG = 329 * MiB, WS_END = 345 * MiB;
constexpr size_t WS_MIX = WS_P, WS_Q = WS_P + 64 * MiB;
constexpr int CW_BAR = 1024;
static_assert((CW_BAR + XCD_BAR_WORDS) * 4 <= (int)CTL_ZERO_BYTES, "barrier words inside the memset region");
constexpr int LDS_BYTES = 160 * 1024, LDS_MISC_OFF = LDS_BYTES - 256;
static_assert(mlm::LDS_BYTES <= LDS_MISC_OFF && rwc::A_LDS_BYTES <= LDS_MISC_OFF && rwc::B_LDS_BYTES <= LDS_MISC_OFF, "mlstm / rwkv LDS");
static_assert(attn_body::LDS_BIAS_OFF + 8192 <= LDS_MISC_OFF && ML_LDS_BYTES <= LDS_MISC_OFF && PS_LDS_BYTES <= LDS_MISC_OFF && pg8::STAGE_BYTES <= LDS_MISC_OFF, "phase scratch below the LDS control words");

#if defined(MLSTM_VALU)
#define MLSTM_UNIT(ma, u, c0, c1, st) mlstm_unit(ma, u, (float*)lds)
#else
#define MLSTM_UNIT(ma, u, c0, c1, st) mlm::mlstm_unit_mfma(ma, u, lds, c0, c1, st)
#endif
#ifndef PROBE_DUP
#define PROBE_DUP 0
#endif
struct MegaArgs { const float* in[43]; float* out; unsigned char* ws; };

__global__ void __launch_bounds__(NTHR, 2) mega_kernel(MegaArgs a) {
    extern __shared__ __attribute__((aligned(16))) unsigned char lds[];
    const int tid = opaque_tid(); const int bid = (int)blockIdx.x, nblk = (int)gridDim.x;
#define WSP(T, off) ((T*)(opq_ptr(a.ws) + (off)))
#define INP(i) ((const float*)opq_ptr((unsigned char*)a.in[i]))
#define OUTP ((float*)opq_ptr((unsigned char*)a.out))
#define W0IN WSP(bf16_t, WS_W0IN)
#define WLR WSP(bf16_t, WS_WLR)
#define W0OUT WSP(bf16_t, WS_W0OUT)
#define WQ0 WSP(bf16_t, WS_WQ0)
#define W1IN WSP(bf16_t, WS_W1IN)
#define W1OUT WSP(bf16_t, WS_W1OUT)
#define WQ1 WSP(bf16_t, WS_WQ1)
#define PK WSP(bf16_t, WS_PK)
#define GATES WSP(float, WS_GATES)
#define CUM WSP(float, WS_CUM)
#define APP WSP(bf16_t, WS_APP)
#define EID WSP(int, WS_EID)
#define GATE WSP(float, WS_GATE)
#define ACTA WSP(bf16_t, WS_ACTA)
#define TABU WSP(unsigned char, WS_TABU)
#define TABV WSP(unsigned char, WS_TABV)
#define TABUS WSP(float, WS_TABU + 16 * MiB)
#define TABVS WSP(float, WS_TABV + 16 * MiB)
#define PBUF WSP(bf16_t, WS_P)
#define MIX WSP(float, WS_MIX)
#define QBUF WSP(bf16_t, WS_Q)
#define LRW WSP(float, WS_LRW)
#define LRA WSP(bf16_t, WS_LRA)
#define LRG WSP(bf16_t, WS_LRG)
    if (tid < 64) ((LAS unsigned*)((LAS unsigned char*)lds + LDS_MISC_OFF))[tid] = 0u;
    __syncthreads();
    XcdBarrier bar = xcd_barrier_post(WSP(unsigned, WS_CTL) + CW_BAR, (volatile LAS unsigned*)((LAS unsigned char*)lds + LDS_MISC_OFF + 32));
#define GRID_BAR() xcd_barrier(bar)
#define GEMM_PHASE(EpiT, Aop, Bop, Mv, Nv, Kv, Eobj) do { pg8::Gemm g_; g_.A = (Aop); g_.Bt = (Bop); g_.M = (Mv); g_.N = (Nv); g_.K = (Kv); pg8::StaticOrder S_; S_.init((Mv), (Nv), nblk, bid); \
        pg8::gemm_phase<EpiT, pg8::StaticOrder, true, true>((PG8_LAS unsigned char*)lds, g_, S_, (Eobj)); } while (0)

#if PROBE_DUP == 9
    for (int rep_ = 0; rep_ < 2; ++rep_)
#endif
    {
        float* tile = (float*)lds;
        transpose_cvt_phase(INP(1), 1024, L0_COLS, 0, L0_MAIN, W0IN, bid, nblk, tile);
        transpose_cvt_phase(INP(19), 1024, 1024, 0, 1024, W0OUT, bid, nblk, tile);
        transpose_cvt_phase(INP(22), 1024, 2048, 0, 2048, WQ0, bid, nblk, tile);
        transpose_cvt_phase(INP(29), 1024, L1_COLS, 0, L1_MAIN, W1IN, bid, nblk, tile);
        transpose_cvt_phase(INP(33), 1024, 1024, 0, 1024, W1OUT, bid, nblk, tile);
        transpose_cvt_phase(INP(36), 1024, 2048, 0, 2048, WQ1, bid, nblk, tile);
        build_wlr_phase(INP(4), INP(6), INP(7), WLR, bid, nblk);
        cvt_bf16_phase(INP(23), PK, 131072 / 8, bid, nblk); cvt_bf16_phase(INP(24), PK + 131072, 131072 / 8, bid, nblk);
        cvt_bf16_phase(INP(37), PK + 262144, 131072 / 8, bid, nblk); cvt_bf16_phase(INP(38), PK + 393216, 131072 / 8, bid, nblk);
        cvt_bf16_phase(INP(0), ACTA, (size_t)T_TOK * 1024 / 8, bid, nblk);
    }
    GRID_BAR();
#if PROBE_DUP == 4
    for (int rep_ = 0; rep_ < 8; ++rep_) { GRID_BAR(); }
#endif
    { pg8::EpiBf16P E; E.O = PBUF; E.ldc = L0_MAIN; GEMM_PHASE(pg8::EpiBf16P, ACTA, W0IN, T_TOK, L0_MAIN, 1024, E); }
    gates_phase<8>(INP(0), INP(1), L0_COLS, L0_MAIN, GATES, bid, nblk, (float*)lds);
    GRID_BAR();
    rwkv_prep_phase(PBUF, INP(2), APP, bid, nblk);
    mlstm_prepass_phase(PBUF, INP(13), INP(14), bid, nblk);
    GRID_BAR();
    { pg8::EpiLowrank E; E.lrw = LRW; E.lra = LRA; E.lrg = LRG; E.w0 = INP(3); E.a0 = INP(5); GEMM_PHASE(pg8::EpiLowrank, APP, WLR, T_TOK, 1536, 256, E); }
    GRID_BAR();
    {
        MlstmArgs ma; ma.P0 = PBUF; ma.gates = GATES; ma.conv_w = INP(13); ma.conv_b = INP(14); ma.ig_b = INP(15); ma.fg_b = INP(16); ma.hn_g = INP(17); ma.hn_b = INP(18); ma.ycat = ACTA;
#if defined(RWKV_SEQ)
        RwkvArgs ra; ra.P0 = PBUF; ra.lrw = LRW; ra.lra = LRA; ra.lrg = LRG; ra.mu = INP(2); ra.k_k = INP(8); ra.k_a = INP(9); ra.r_k = INP(10); ra.ln_g = INP(11); ra.ln_b = INP(12); ra.ycat = ACTA;
        { mlm::MlState mst; for (int u = bid; u < 96; u += nblk) { if (u < 64) rwkv_scan_unit(ra, u, (float*)lds); else MLSTM_UNIT(ma, u - 64, 0, SEQ / 64, mst); } }
#else
        rwc::Args ra; ra.P0 = PBUF; ra.lrw = LRW; ra.lra = LRA; ra.lrg = LRG; ra.mu = INP(2); ra.k_k = INP(8); ra.k_a = INP(9); ra.r_k = INP(10); ra.ln_g = INP(11); ra.ln_b = INP(12);
        ra.Gm = WSP(bf16_t, WS_TABU); ra.P1m = WSP(bf16_t, WS_TABU + 16 * MiB); ra.Hm = WSP(bf16_t, WS_TABV); ra.P2m = WSP(bf16_t, WS_TABV + 16 * MiB); ra.bonus = CUM; ra.ycat = ACTA;
        constexpr int ML_SPLIT = 20;
        mlm::MlState mst;
        if (bid < 32) MLSTM_UNIT(ma, bid, 0, ML_SPLIT, mst);
        else { for (int u = bid - 32; u < 64 * 32; u += nblk - 32) rwc::prep_unit(ra, u, lds); }
        GRID_BAR();
        if (bid < 32) MLSTM_UNIT(ma, bid, ML_SPLIT, SEQ / 64, mst);
        else { for (int u = bid - 32; u < 64; u += nblk - 32) rwc::scan_unit(ra, u, lds); }
#endif
    }
    GRID_BAR();
    cvt_fp8_rows_phase(INP(25), TABU, TABUS, bid, nblk); cvt_fp8_rows_phase(INP(26), TABV, TABVS, bid, nblk);
    { pg8::EpiF32 E; E.C = MIX; E.ldc = 1024; GEMM_PHASE(pg8::EpiF32, ACTA, W0OUT, T_TOK, 1024, 1024, E); }
    GRID_BAR();
    ln_phase(INP(0), MIX, INP(20), INP(21), OUTP, ACTA, bid, nblk);
    GRID_BAR();
    { pg8::EpiBf16P E; E.O = QBUF; E.ldc = 2048; GEMM_PHASE(pg8::EpiBf16P, ACTA, WQ0, T_TOK, 2048, 1024, E);
#if PROBE_DUP == 5
      GRID_BAR(); GEMM_PHASE(pg8::EpiBf16P, ACTA, WQ0, T_TOK, 2048, 1024, E); GRID_BAR(); GEMM_PHASE(pg8::EpiBf16P, ACTA, WQ0, T_TOK, 2048, 1024, E);
#endif
    }
    GRID_BAR();
    { PeerSArgs sa; sa.Q = QBUF; sa.K1b = PK; sa.K2b = PK + 131072; sa.eid = EID; sa.gate = GATE; peer_scores_phase(sa, bid, nblk, lds);
#if PROBE_DUP == 3
      GRID_BAR(); peer_scores_phase(sa, bid, nblk, lds);
#endif
    }
    GRID_BAR();
#if PROBE_DUP == 2
    { PeerGArgs ga; ga.X = OUTP; ga.Xo = MIX; ga.eid = EID; ga.gate = GATE; ga.U = TABU; ga.V = TABV; ga.Us = TABUS; ga.Vs = TABVS; ga.lng = INP(27); ga.lnb = INP(28); ga.xb = QBUF; peer_gather_phase(ga, bid, nblk); }
    GRID_BAR();
#endif
    { PeerGArgs ga; ga.X = OUTP; ga.Xo = OUTP; ga.eid = EID; ga.gate = GATE; ga.U = TABU; ga.V = TABV; ga.Us = TABUS; ga.Vs = TABVS; ga.lng = INP(27); ga.lnb = INP(28); ga.xb = ACTA; peer_gather_phase(ga, bid, nblk); }
    GRID_BAR();
    cvt_fp8_rows_phase(INP(39), TABU, TABUS, bid, nblk); cvt_fp8_rows_phase(INP(40), TABV, TABVS, bid, nblk);
    { pg8::EpiBf16P E; E.O = PBUF; E.ldc = L1_MAIN; GEMM_PHASE(pg8::EpiBf16P, ACTA, W1IN, T_TOK, L1_MAIN, 1024, E); }
    gates_phase<16>(OUTP, INP(29), L1_COLS, L1_MAIN, GATES, bid, nblk, (float*)lds);
    GRID_BAR();
    fox_cumsum_phase(GATES, INP(32), CUM, bid, nblk);
#if defined(ATTN_VALU)
    GRID_BAR();
    { AttnArgs aa; aa.P1 = PBUF; aa.cum = CUM; aa.qn_g = INP(30); aa.kn_g = INP(31); aa.out = ACTA; attn_valu_phase(aa, bid, nblk, (float*)lds); }
#else
    fox_qknorm_phase(PBUF, INP(30), INP(31), bid, nblk);
    GRID_BAR();
    { const attn_body::AttnTensors AT{(const attn_body::bf16*)PBUF, (const attn_body::bf16*)(PBUF + 1024), (const attn_body::bf16*)(PBUF + 2048), (const attn_body::bf16*)(PBUF + 3072), CUM, (attn_body::bf16*)ACTA};
      const attn_body::StaticOrder S_(nblk, bid); attn_body::attn_phase<attn_body::StaticOrder>((char*)lds, AT, S_);
#if PROBE_DUP == 6
      GRID_BAR(); attn_body::attn_phase<attn_body::StaticOrder>((char*)lds, AT, S_);
#endif
    }
#endif
    GRID_BAR();
    { pg8::EpiF32 E; E.C = MIX; E.ldc = 1024; GEMM_PHASE(pg8::EpiF32, ACTA, W1OUT, T_TOK, 1024, 1024, E); }
    GRID_BAR();
    ln_phase(OUTP, MIX, INP(34), INP(35), OUTP, ACTA, bid, nblk);
    GRID_BAR();
    { pg8::EpiBf16P E; E.O = QBUF; E.ldc = 2048; GEMM_PHASE(pg8::EpiBf16P, ACTA, WQ1, T_TOK, 2048, 1024, E); }
    GRID_BAR();
    { PeerSArgs sa; sa.Q = QBUF; sa.K1b = PK + 262144; sa.K2b = PK + 393216; sa.eid = EID; sa.gate = GATE; peer_scores_phase(sa, bid, nblk, lds); }
    GRID_BAR();
    { PeerGArgs ga; ga.X = OUTP; ga.Xo = OUTP; ga.eid = EID; ga.gate = GATE; ga.U = TABU; ga.V = TABV; ga.Us = TABUS; ga.Vs = TABVS; ga.lng = INP(41); ga.lnb = INP(42); ga.xb = ACTA; peer_gather_phase(ga, bid, nblk); }
#undef GRID_BAR
#undef GEMM_PHASE
#undef WSP
#undef INP
#undef OUTP
#undef W0IN
#undef WLR
#undef W0OUT
#undef WQ0
#undef W1IN
#undef W1OUT
#undef WQ1
#undef PK
#undef GATES
#undef CUM
#undef APP
#undef EID
#undef GATE
#undef ACTA
#undef TABU
#undef TABV
#undef TABUS
#undef TABVS
#undef PBUF
#undef MIX
#undef QBUF
#undef LRW
#undef LRA
#undef LRG
}

extern "C" void kernel_launch(void* const* d_in, const int* in_sizes, int n_in, void* d_out, int out_size, void* d_ws, size_t ws_size, hipStream_t stream) {
    static int grid = 0;
    if (grid == 0) {
        if (n_in != 43 || ws_size < WS_END) { fprintf(stderr, "kernel_launch: unexpected n_in %d or ws_size %zu (< %zu); nothing launched\n", n_in, ws_size, (size_t)WS_END); grid = -1; return; }
        int dev = 0, cus = 0;
        if (hipGetDevice(&dev) != hipSuccess || hipDeviceGetAttribute(&cus, hipDeviceAttributeMultiprocessorCount, dev) != hipSuccess) { fprintf(stderr, "kernel_launch: device query failed\n"); grid = -1; return; }
        if (hipFuncSetAttribute((const void*)mega_kernel, hipFuncAttributeMaxDynamicSharedMemorySize, LDS_BYTES) != hipSuccess) { fprintf(stderr, "kernel_launch: hipFuncSetAttribute failed\n"); grid = -1; return; }
        (void)hipGetLastError();
        grid = cus;
    }
    if (grid < 0) return;
    (void)hipMemsetAsync((char*)d_ws + WS_CTL, 0, CTL_ZERO_BYTES, stream);
    MegaArgs a; memset(&a, 0, sizeof(a));
    for (int i = 0; i < 43; ++i) a.in[i] = (const float*)d_in[i];
    a.out = (float*)d_out; a.ws = (unsigned char*)d_ws;
    hipLaunchKernelGGL(mega_kernel, dim3(grid), dim3(NTHR), LDS_BYTES, stream, a);
}
```

```cpp
#include <hip/hip_runtime.h>
#include <cstdio>
#include <cstdint>
#include <cmath>
#include <cstring>
__device__ __forceinline__ int opaque_tid() { int t = (int)threadIdx.x; asm volatile("" : "+v"(t)); return t; }
__device__ __forceinline__ unsigned char* opq_ptr(unsigned char* p) { return p; }
namespace pg8 {
#define PG8_LAS __attribute__((address_space(3)))
typedef unsigned short bf16_t;
typedef short bf16x8 __attribute__((ext_vector_type(8)));
typedef float f32x4 __attribute__((ext_vector_type(4)));
typedef unsigned u32x4 __attribute__((ext_vector_type(4)));
constexpr int BM = 256, BK = 64, HALF = 128, HTB = HALF * BK * 2  , STAGE_BYTES = 8 * HTB, NXCD = 8, WGM = 8;

__host__ __device__ __forceinline__ int lds_byte(int r, int c) { const int st = (r >> 4) * 2 + (c >> 5), rr = r & 15, cc = c & 31, ob = rr * 64 + cc * 2; return st * 1024 + (ob ^ (((ob >> 9) & 1) << 5)); }
__host__ __device__ __forceinline__ void stage_rc(int b, int& R, int& C) { const int st = b / 1024, sb = b % 1024, swz = sb ^ (((sb >> 9) & 1) << 5); R = (st >> 1) * 16 + swz / 64; C = (st & 1) * 32 + (swz % 64) / 2; }
__host__ __device__ __forceinline__ int perm32(int rho) { const int n = rho >> 4, i = rho & 15; return 8 * (i >> 2) + 4 * n + (i & 3); }

struct Unit { int pm, pn; };
struct Gemm { const bf16_t* A; const bf16_t* Bt; int M, N, K; };

struct StaticOrder {
    int nM, nN, nwg, G, c;
    __host__ __device__ void init(int M, int N, int G_, int c_) { nM = M / BM; nN = N / BM; nwg = nM * nN; G = G_; c = c_; }
    __host__ __device__ bool next(int i, Unit& u) const {
        const long L = (long)i * G + c; if (L >= nwg) return false;
        int wgid = (int)L; { const int q = nwg / NXCD, r = nwg % NXCD, xcd = wgid % NXCD, off = wgid / NXCD; wgid = (xcd < r ? xcd * (q + 1) : r * (q + 1) + (xcd - r) * q) + off; }
        const int nig = WGM * nN, gid = wgid / nig, fm = gid * WGM, gsz = (nM - fm) < WGM ? (nM - fm) : WGM;
        u.pm = fm + ((wgid % nig) % gsz); u.pn = (wgid % nig) / gsz; return true;
    }
    __device__ __forceinline__ void a_ready(const Unit&) const {}
    __device__ __forceinline__ void done(const Unit&) const {}
};

__device__ __forceinline__ unsigned cvt_pk_bf16(float lo, float hi) { unsigned r; asm volatile("v_cvt_pk_bf16_f32 %0, %1, %2" : "=v"(r) : "v"(lo), "v"(hi)); return r; }
typedef float f32x2 __attribute__((ext_vector_type(2)));
__device__ __forceinline__ f32x2 gelu_pk(f32x2 v) {
    const f32x2 av = __builtin_elementwise_abs(v), d = av * 0.2316418882f + 1.0f;
    f32x2 t; t.x = __builtin_amdgcn_rcpf(d.x); t.y = __builtin_amdgcn_rcpf(d.y);
    f32x2 q = t * 0.5307027145f + (-0.7265760135f); q = q * t + 0.7107068705f; q = q * t + (-0.142248368f); q = q * t + 0.127414796f; q = q * t;
    const f32x2 s = (v * v) * (-0.72134752044f);
    f32x2 e; e.x = __builtin_amdgcn_exp2f(s.x); e.y = __builtin_amdgcn_exp2f(s.y);
    const f32x2 m = v * (q * e), r = v - m;
    f32x2 o; o.x = v.x < 0.f ? m.x : r.x; o.y = v.y < 0.f ? m.y : r.y; return o;
}

template <int ACT  > struct EpiBf16 {
    static constexpr bool PERM = true, AFTER_DRAIN = false; static_assert(ACT == 0 || ACT == 1, "EpiBf16: ACT is 0 (none) or 1 (gelu_pk)");
    bf16_t* O; int ldc; const float* bias; int split_cols; size_t split_stride; float scale0;
    __device__ __forceinline__ void operator()(const f32x4 (&acc)[2][2][4][2], const Unit& u, int wr, int wc, int fr, int fq) const {
        const int row0 = u.pm * BM + wr * 64 + fr; int colt = u.pn * BM; bf16_t* base = O;
        float sc = 1.f; if (split_cols) { const int t = colt / split_cols; base += (size_t)t * split_stride; colt -= t * split_cols; if (t == 0) sc = scale0; }
        const int col0 = colt + wc * 32 + 8 * fq, bcol0 = u.pn * BM + wc * 32 + 8 * fq;
        f32x4 bv[2][2];
#pragma unroll
        for (int bj = 0; bj < 2; ++bj)
#pragma unroll
            for (int n = 0; n < 2; ++n) bv[bj][n] = bias ? *(const f32x4*)(bias + bcol0 + bj * HALF + 4 * n) : (f32x4){0.f, 0.f, 0.f, 0.f};
#pragma unroll
        for (int ai = 0; ai < 2; ++ai)
#pragma unroll
            for (int m = 0; m < 4; ++m) { bf16_t* rowp = base + (size_t)(row0 + ai * HALF + m * 16) * ldc + col0;
#pragma unroll
                for (int bj = 0; bj < 2; ++bj) { f32x4 v0 = acc[ai][bj][m][0] + bv[bj][0], v1 = acc[ai][bj][m][1] + bv[bj][1];
                    if (ACT == 1) { f32x2 a = gelu_pk((f32x2){v0[0], v0[1]}), b = gelu_pk((f32x2){v0[2], v0[3]}), c = gelu_pk((f32x2){v1[0], v1[1]}), d = gelu_pk((f32x2){v1[2], v1[3]});
                        v0 = (f32x4){a.x, a.y, b.x, b.y}; v1 = (f32x4){c.x, c.y, d.x, d.y}; }
                    v0 = v0 * sc; v1 = v1 * sc; u32x4 w; w.x = cvt_pk_bf16(v0[0], v0[1]); w.y = cvt_pk_bf16(v0[2], v0[3]); w.z = cvt_pk_bf16(v1[0], v1[1]); w.w = cvt_pk_bf16(v1[2], v1[3]);
                    *(u32x4*)(rowp + bj * HALF) = w; } }
    }
};

struct PanelStats {
    unsigned* xbuf;
    unsigned* cnt;
    unsigned* tmo;
    int ntn; float eps;
    unsigned code;
    __device__ __forceinline__ bool run(const f32x4 (&v)[2][2][4][2], const Unit& u, int wr, int wc, int fr, int fq, PG8_LAS unsigned char* lds, int wid, int lane) const {
        typedef float f32x2v __attribute__((ext_vector_type(2)));
        PG8_LAS f32x2v* P = (PG8_LAS f32x2v*)lds;
        PG8_LAS f32x2v* S = (PG8_LAS f32x2v*)(lds + 8192);
        PG8_LAS unsigned* flag = (PG8_LAS unsigned*)(lds + 8192 + 2048);
#pragma unroll
        for (int ai = 0; ai < 2; ++ai)
#pragma unroll
            for (int m = 0; m < 4; ++m) {
                float s = 0.f;
#pragma unroll
                for (int bj = 0; bj < 2; ++bj)
#pragma unroll
                    for (int n = 0; n < 2; ++n) { const f32x4 x = v[ai][bj][m][n]; s += (x[0] + x[1]) + (x[2] + x[3]); }
                s += __shfl_xor(s, 16); s += __shfl_xor(s, 32);
                const float mw = s * (1.0f / 64.0f); float q = 0.f;
#pragma unroll
                for (int bj = 0; bj < 2; ++bj)
#pragma unroll
                    for (int n = 0; n < 2; ++n) { const f32x4 d = v[ai][bj][m][n] - mw; q += (d[0] * d[0] + d[1] * d[1]) + (d[2] * d[2] + d[3] * d[3]); }
                q += __shfl_xor(q, 16); q += __shfl_xor(q, 32);
                if (fq == 0) P[(ai * HALF + wr * 64 + m * 16 + fr) * 4 + wc] = (f32x2v){mw, q};
            }
        asm volatile("s_waitcnt lgkmcnt(0)" ::: "memory"); __builtin_amdgcn_s_barrier(); asm volatile("" ::: "memory");
#if defined(BROKEN_EXCHANGE_NO_WAIT)
#warning BROKEN CONTROL BUILD: the row-statistics exchange does not wait; results are wrong by design
        if (blockIdx.x >= 64) { const long long t0_ = clock64(); while (clock64() - t0_ < 60000) __builtin_amdgcn_s_sleep(8); }
#endif
        const int row = wid * 32 + (lane & 31);
        if (lane < 32) {
            const f32x2v a = P[row * 4 + 0], b = P[row * 4 + 1], c = P[row * 4 + 2], d = P[row * 4 + 3];
            const float mt = (a.x + b.x + c.x + d.x) * 0.25f;
            const float da = a.x - mt, db = b.x - mt, dc = c.x - mt, dd = d.x - mt;
            const float m2 = (a.y + b.y) + (c.y + d.y) + 64.0f * ((da * da + db * db) + (dc * dc + dd * dd));
            unsigned long long* slot = (unsigned long long*)xbuf + ((size_t)(u.pm * BM + row) * 4 + u.pn);
            __hip_atomic_store(slot, ((unsigned long long)__float_as_uint(m2) << 32) | __float_as_uint(mt), __ATOMIC_RELAXED, __HIP_MEMORY_SCOPE_AGENT);
        }
        asm volatile("s_waitcnt vmcnt(0)" ::: "memory");
        if (lane == 0) __hip_atomic_fetch_add(cnt + 64 * u.pm, 1u, __ATOMIC_RELAXED, __HIP_MEMORY_SCOPE_AGENT);
        if (wid == 0) {
            bool dead = false; const unsigned long long t0 = __builtin_amdgcn_s_memrealtime(); const unsigned want = 8u * (unsigned)ntn;
            for (;;) {
#if defined(BROKEN_EXCHANGE_NO_WAIT)
                break;
#endif
                if ((unsigned)__builtin_amdgcn_readfirstlane(__hip_atomic_load(cnt + 64 * u.pm, __ATOMIC_RELAXED, __HIP_MEMORY_SCOPE_AGENT)) >= want) break;
                if (__builtin_amdgcn_s_memrealtime() - t0 > 2000000ull) {
                    if (lane == 0) { unsigned expect = 0u; __hip_atomic_compare_exchange_strong(tmo + 1, &expect, code | (unsigned)(u.pm & 0xff), __ATOMIC_RELAXED, __ATOMIC_RELAXED, __HIP_MEMORY_SCOPE_AGENT);
                                     __hip_atomic_store(tmo, 1u, __ATOMIC_RELAXED, __HIP_MEMORY_SCOPE_AGENT); }
                    dead = true; break; }
                __builtin_amdgcn_s_sleep(2);
            }
            __builtin_amdgcn_fence(__ATOMIC_ACQUIRE, "agent");
            if (lane == 0) flag[0] = dead ? 1u : 0u;
        }
        asm volatile("s_waitcnt vmcnt(0) lgkmcnt(0)" ::: "memory"); __builtin_amdgcn_s_barrier(); asm volatile("" ::: "memory");
        const bool bad = flag[0] != 0u;
        if (lane < 32) {
            const unsigned long long* slot = (const unsigned long long*)xbuf + (size_t)(u.pm * BM + row) * 4; float mt[4], m2[4]; float ms = 0.f;
#pragma unroll
            for (int t = 0; t < 4; ++t) { if (t < ntn) { const unsigned long long w = __hip_atomic_load(slot + t, __ATOMIC_RELAXED, __HIP_MEMORY_SCOPE_AGENT); mt[t] = __uint_as_float((unsigned)w); m2[t] = __uint_as_float((unsigned)(w >> 32)); } else { mt[t] = 0.f; m2[t] = 0.f; } ms += mt[t]; }
            const float mean = ms / (float)ntn; float q = 0.f;
#pragma unroll
            for (int t = 0; t < 4; ++t) if (t < ntn) { const float dm = mt[t] - mean; q += m2[t] + 256.0f * dm * dm; }
            S[row] = (f32x2v){mean, 1.0f / sqrtf(q / (256.0f * (float)ntn) + eps)};
        }
        asm volatile("s_waitcnt lgkmcnt(0)" ::: "memory"); __builtin_amdgcn_s_barrier(); asm volatile("" ::: "memory");
        return bad;
    }
};
struct EpiLnRes {
    static constexpr bool PERM = false, AFTER_DRAIN = true;
    const float* base; float* out; int ldc; const float* bias; PanelStats st; unsigned poison;
    __device__ __forceinline__ void fused(f32x4 (&acc)[2][2][4][2], const Unit& u, int wr, int wc, int fr, int fq, PG8_LAS unsigned char* lds, int wid, int lane) const {
        typedef float f32x2v __attribute__((ext_vector_type(2)));
        const PG8_LAS f32x2v* S = (const PG8_LAS f32x2v*)(lds + 8192);
        const int col0 = u.pn * BM + wc * 32 + 4 * fq;
#pragma unroll
        for (int bj = 0; bj < 2; ++bj)
#pragma unroll
            for (int n = 0; n < 2; ++n) { const f32x4 bv = bias ? *(const f32x4*)(bias + col0 + bj * HALF + n * 16) : (f32x4){0.f, 0.f, 0.f, 0.f};
#pragma unroll
                for (int ai = 0; ai < 2; ++ai)
#pragma unroll
                    for (int m = 0; m < 4; ++m) acc[ai][bj][m][n] += bv; }
        f32x4 pre[4][2][2];
#pragma unroll
        for (int m = 0; m < 4; ++m) { const size_t off = (size_t)(u.pm * BM + wr * 64 + m * 16 + fr) * ldc + col0;
#pragma unroll
            for (int bj = 0; bj < 2; ++bj)
#pragma unroll
                for (int n = 0; n < 2; ++n) pre[m][bj][n] = *(const f32x4*)(base + off + bj * HALF + n * 16); }
        const bool bad = st.run(acc, u, wr, wc, fr, fq, lds, wid, lane) || poison != 0u;
        const float qnan = __builtin_nanf("");
#pragma unroll
        for (int ai = 0; ai < 2; ++ai)
#pragma unroll
            for (int m = 0; m < 4; ++m) { const int r = ai * HALF + wr * 64 + m * 16 + fr; const f32x2v sr = S[r]; const size_t off = (size_t)(u.pm * BM + r) * ldc + col0;
#pragma unroll
                for (int bj = 0; bj < 2; ++bj)
#pragma unroll
                    for (int n = 0; n < 2; ++n) { const f32x4 bs = ai == 0 ? pre[m][bj][n] : *(const f32x4*)(base + off + bj * HALF + n * 16); f32x4 o = bs + (acc[ai][bj][m][n] - sr.x) * sr.y;
                        if (bad) o = (f32x4){qnan, qnan, qnan, qnan}; *(f32x4*)(out + off + bj * HALF + n * 16) = o; }
                if (m & 1) asm volatile("" ::: "memory"); }
    }
};
struct EpiLnResLn {
    static constexpr bool PERM = false, AFTER_DRAIN = true;
    const float* base; float* out; bf16_t* xn; int ldc; const float* bias; PanelStats st1, st2; unsigned poison;
    __device__ __forceinline__ void fused(f32x4 (&acc)[2][2][4][2], const Unit& u, int wr, int wc, int fr, int fq, PG8_LAS unsigned char* lds, int wid, int lane) const {
        typedef float f32x2v __attribute__((ext_vector_type(2))); typedef unsigned u32x2v __attribute__((ext_vector_type(2)));
        const PG8_LAS f32x2v* S = (const PG8_LAS f32x2v*)(lds + 8192);
        const int col0 = u.pn * BM + wc * 32 + 4 * fq;
#pragma unroll
        for (int bj = 0; bj < 2; ++bj)
#pragma unroll
            for (int n = 0; n < 2; ++n) { const f32x4 bv = bias ? *(const f32x4*)(bias + col0 + bj * HALF + n * 16) : (f32x4){0.f, 0.f, 0.f, 0.f};
#pragma unroll
                for (int ai = 0; ai < 2; ++ai)
#pragma unroll
                    for (int m = 0; m < 4; ++m) acc[ai][bj][m][n] += bv; }
        bool bad = st1.run(acc, u, wr, wc, fr, fq, lds, wid, lane) || poison != 0u;
        const float qnan = __builtin_nanf("");
#pragma unroll
        for (int ai = 0; ai < 2; ++ai)
#pragma unroll
            for (int m = 0; m < 4; ++m) { const int r = ai * HALF + wr * 64 + m * 16 + fr; const f32x2v sr = S[r]; const size_t off = (size_t)(u.pm * BM + r) * ldc + col0;
#pragma unroll
                for (int bj = 0; bj < 2; ++bj)
#pragma unroll
                    for (int n = 0; n < 2; ++n) { const f32x4 bs = *(const f32x4*)(base + off + bj * HALF + n * 16); acc[ai][bj][m][n] = bs + (acc[ai][bj][m][n] - sr.x) * sr.y; }
                asm volatile("" : "+v"(acc[ai][0][m][0]), "+v"(acc[ai][0][m][1]), "+v"(acc[ai][1][m][0]), "+v"(acc[ai][1][m][1]));
                if (m & 1) asm volatile("" ::: "memory"); }
        const bool bad1 = bad;
        bad = st2.run(acc, u, wr, wc, fr, fq, lds, wid, lane) || bad;
#pragma unroll
        for (int ai = 0; ai < 2; ++ai)
#pragma unroll
            for (int m = 0; m < 4; ++m) { const int r = ai * HALF + wr * 64 + m * 16 + fr; const f32x2v sr = S[r]; const size_t off = (size_t)(u.pm * BM + r) * ldc + col0;
#pragma unroll
                for (int bj = 0; bj < 2; ++bj)
#pragma unroll
                    for (int n = 0; n < 2; ++n) { const f32x4 x1 = acc[ai][bj][m][n]; *(f32x4*)(out + off + bj * HALF + n * 16) = bad1 ? (f32x4){qnan, qnan, qnan, qnan} : x1;
                        const f32x4 o = (x1 - sr.x) * sr.y; u32x2v w; w.x = cvt_pk_bf16(o[0], o[1]); w.y = cvt_pk_bf16(o[2], o[3]);
                        if (bad) { w.x = 0x7fc07fc0u; w.y = 0x7fc07fc0u; } *(u32x2v*)(xn + off + bj * HALF + n * 16) = w; }
                asm volatile("" ::: "memory"); }
    }
};

template <class Epi, class Sched, bool ALIGN_EPI = false, bool SP2 = false>
__device__ __forceinline__ void gemm_phase(PG8_LAS unsigned char* lds, const Gemm g, const Sched& S, const Epi& E) {
    const int tid = opaque_tid(), wid = __builtin_amdgcn_readfirstlane(tid >> 6), lane = tid & 63, wr = wid >> 2, wc = wid & 3, fr = lane & 15, fq = lane >> 4;
    const int K = g.K, nt = K / BK;
    unsigned voffA[2], voffB[2];
#pragma unroll
    for (int i = 0; i < 2; ++i) { int R, C; stage_rc(tid * 16 + i * 8192, R, C); const int Rb = Epi::PERM ? ((R & ~31) + perm32(R & 31)) : R;
        voffA[i] = (unsigned)(R * K + C) * 2u; voffB[i] = (unsigned)(Rb * K + C) * 2u; }
    const size_t kstep = (size_t)(BK * 2);
    const size_t hstep = (size_t)HALF * K * 2;
    const size_t tstep = 2 * hstep;
    const unsigned ldsw = (unsigned)wid * 1024u;
    const int aoff = lds_byte(wr * 64 + fr, fq * 8), boff = lds_byte(wc * 32 + fr, fq * 8);
#define PG8_SA(b, h) (((b) * 2 + (h)) * HTB)
#define PG8_SB(b, h) ((4 + (b) * 2 + (h)) * HTB)
#define PG8_STAGE(bufoff, gbase, voff) do { _Pragma("unroll") for (int _i = 0; _i < 2; ++_i) \
        __builtin_amdgcn_global_load_lds((const unsigned*)((const char*)(gbase) + (voff)[_i]), (PG8_LAS unsigned*)(lds + (bufoff) + ldsw + _i * 8192), 16, 0, 0); } while (0)
#define PG8_LDA(dst, b, h) do { _Pragma("unroll") for (int m = 0; m < 4; ++m) _Pragma("unroll") for (int k = 0; k < 2; ++k) dst[m][k] = *(const PG8_LAS bf16x8*)(lds + PG8_SA(b, h) + aoff + m * 2048 + k * 1024); } while (0)
#define PG8_LDB(dst, b, h) do { _Pragma("unroll") for (int n = 0; n < 2; ++n) _Pragma("unroll") for (int k = 0; k < 2; ++k) dst[n][k] = *(const PG8_LAS bf16x8*)(lds + PG8_SB(b, h) + boff + n * 2048 + k * 1024); } while (0)
#define PG8_MMA(ai, bj, At, Bt) do { __builtin_amdgcn_s_setprio(1); _Pragma("unroll") for (int m = 0; m < 4; ++m) _Pragma("unroll") for (int n = 0; n < 2; ++n) _Pragma("unroll") for (int k = 0; k < 2; ++k) \
        acc[ai][bj][m][n] = __builtin_amdgcn_mfma_f32_16x16x32_bf16(Bt[n][k], At[m][k], acc[ai][bj][m][n], 0, 0, 0); __builtin_amdgcn_s_setprio(0); } while (0)
#define PG8_WAIT_V(n) asm volatile("s_waitcnt vmcnt(" #n ")" ::: "memory")
#define PG8_WAIT_L(n) asm volatile("s_waitcnt lgkmcnt(" #n ")" ::: "memory")
#define PG8_BAR __builtin_amdgcn_s_barrier()
#define PG8_SCHED __builtin_amdgcn_sched_barrier(0)
    Unit cur, nxt; int ui = 0;
    if (!S.next(0, cur)) return;
    f32x4 acc[2][2][4][2];
#pragma unroll
    for (int a = 0; a < 2; ++a)
#pragma unroll
        for (int b = 0; b < 2; ++b)
#pragma unroll
            for (int m = 0; m < 4; ++m)
#pragma unroll
                for (int n = 0; n < 2; ++n) acc[a][b][m][n] = (f32x4){0.f, 0.f, 0.f, 0.f};
    bf16x8 At[4][2], B0[2][2], B1[2][2];
    const char* cA = (const char*)g.A + (size_t)cur.pm * tstep; const char* cB = (const char*)g.Bt + (size_t)cur.pn * tstep;
    S.a_ready(cur);
    if constexpr (SP2) {
        PG8_STAGE(PG8_SB(0, 0), cB, voffB); PG8_STAGE(PG8_SB(0, 1), cB + hstep, voffB); PG8_STAGE(PG8_SA(0, 0), cA, voffA); PG8_STAGE(PG8_SA(0, 1), cA + hstep, voffA);
        if (wr == 1) PG8_BAR;
        PG8_WAIT_V(2); PG8_BAR;
        PG8_STAGE(PG8_SB(1, 0), cB + kstep, voffB); PG8_STAGE(PG8_SA(1, 0), cA + kstep, voffA); PG8_STAGE(PG8_SB(1, 1), cB + hstep + kstep, voffB);
        PG8_WAIT_V(6); PG8_BAR;
    } else {
        PG8_STAGE(PG8_SB(0, 0), cB, voffB); PG8_STAGE(PG8_SA(0, 0), cA, voffA); PG8_STAGE(PG8_SB(0, 1), cB + hstep, voffB); PG8_STAGE(PG8_SA(0, 1), cA + hstep, voffA);
        if (wr == 1) PG8_BAR;
        PG8_WAIT_V(4); PG8_BAR;
        PG8_STAGE(PG8_SB(1, 0), cB + kstep, voffB); PG8_STAGE(PG8_SA(1, 0), cA + kstep, voffA); PG8_STAGE(PG8_SB(1, 1), cB + hstep + kstep, voffB);
        PG8_WAIT_V(6); PG8_BAR;
    }
    for (;;) {
        const bool has_next = S.next(ui + 1, nxt);
        const char* nA = has_next ? (const char*)g.A + (size_t)nxt.pm * tstep : cA; const char* nB = has_next ? (const char*)g.Bt + (size_t)nxt.pn * tstep : cB;
        for (int t = 0; t < nt; t += 2) {
            const bool last = (t == nt - 2);
            const char* a1 = cA + (size_t)(t + 1) * kstep;
            const char* a2 = last ? nA : cA + (size_t)(t + 2) * kstep; const char* b2 = last ? nB : cB + (size_t)(t + 2) * kstep;
            const char* a3 = a2 + kstep; const char* b3 = b2 + kstep;
            if (last && has_next) S.a_ready(nxt);
            if constexpr (SP2) {
            PG8_LDB(B0, 0, 0); PG8_LDB(B1, 0, 1); PG8_SCHED; PG8_LDA(At, 0, 0); PG8_STAGE(PG8_SA(1, 1), a1 + hstep, voffA);
            PG8_WAIT_V(8); PG8_WAIT_L(0); PG8_BAR; PG8_MMA(0, 0, At, B0); PG8_MMA(0, 1, At, B1); PG8_BAR; PG8_SCHED;
            PG8_LDA(At, 0, 1); PG8_STAGE(PG8_SB(0, 0), b2, voffB); PG8_STAGE(PG8_SB(0, 1), b2 + hstep, voffB); PG8_STAGE(PG8_SA(0, 0), a2, voffA);
            PG8_WAIT_V(8); PG8_WAIT_L(0); PG8_BAR; PG8_MMA(1, 0, At, B0); PG8_MMA(1, 1, At, B1); PG8_BAR; PG8_SCHED;
            PG8_LDB(B0, 1, 0); PG8_LDB(B1, 1, 1); PG8_SCHED; PG8_LDA(At, 1, 0); PG8_STAGE(PG8_SA(0, 1), a2 + hstep, voffA);
            PG8_WAIT_V(8); PG8_WAIT_L(0); PG8_BAR; PG8_MMA(0, 0, At, B0); PG8_MMA(0, 1, At, B1); PG8_BAR; PG8_SCHED;
            PG8_LDA(At, 1, 1); PG8_STAGE(PG8_SB(1, 0), b3, voffB); PG8_STAGE(PG8_SB(1, 1), b3 + hstep, voffB); PG8_STAGE(PG8_SA(1, 0), a3, voffA);
            PG8_WAIT_V(8); PG8_WAIT_L(0); PG8_BAR; PG8_MMA(1, 0, At, B0); PG8_MMA(1, 1, At, B1); PG8_BAR; PG8_SCHED;
            } else {
            PG8_LDB(B0, 0, 0); PG8_SCHED; PG8_LDA(At, 0, 0); PG8_STAGE(PG8_SA(1, 1), a1 + hstep, voffA);
            PG8_WAIT_L(8); PG8_BAR; PG8_WAIT_L(0); PG8_MMA(0, 0, At, B0); PG8_BAR; PG8_SCHED;
            PG8_LDB(B1, 0, 1); PG8_STAGE(PG8_SB(0, 0), b2, voffB);
            PG8_BAR; PG8_WAIT_L(0); PG8_MMA(0, 1, At, B1); PG8_BAR;
            PG8_LDA(At, 0, 1); PG8_STAGE(PG8_SA(0, 0), a2, voffA);
            PG8_BAR; PG8_WAIT_L(0); PG8_MMA(1, 0, At, B0); PG8_BAR; PG8_SCHED;
            PG8_STAGE(PG8_SB(0, 1), b2 + hstep, voffB);
            PG8_WAIT_V(6); PG8_BAR; PG8_MMA(1, 1, At, B1); PG8_BAR;
            PG8_LDB(B0, 1, 0); PG8_SCHED; PG8_LDA(At, 1, 0); PG8_STAGE(PG8_SA(0, 1), a2 + hstep, voffA);
            PG8_WAIT_L(8); PG8_BAR; PG8_WAIT_L(0); PG8_MMA(0, 0, At, B0); PG8_BAR; PG8_SCHED;
            PG8_LDB(B1, 1, 1); PG8_STAGE(PG8_SB(1, 0), b3, voffB);
            PG8_BAR; PG8_WAIT_L(0); PG8_MMA(0, 1, At, B1); PG8_BAR;
            PG8_LDA(At, 1, 1); PG8_STAGE(PG8_SA(1, 0), a3, voffA);
            PG8_BAR; PG8_WAIT_L(0); PG8_MMA(1, 0, At, B0); PG8_BAR; PG8_SCHED;
            PG8_STAGE(PG8_SB(1, 1), b3 + hstep, voffB);
            PG8_WAIT_V(6); PG8_BAR; PG8_MMA(1, 1, At, B1); PG8_BAR;
            }
        }
        if constexpr (ALIGN_EPI) { if (wr == 0) PG8_BAR; }
        if constexpr (!Epi::AFTER_DRAIN) { E(acc, cur, wr, wc, fr, fq); S.done(cur); }
        if (!has_next) break;
#pragma unroll
        for (int a = 0; a < 2; ++a)
#pragma unroll
            for (int b = 0; b < 2; ++b)
#pragma unroll
                for (int m = 0; m < 4; ++m)
#pragma unroll
                    for (int n = 0; n < 2; ++n) acc[a][b][m][n] = (f32x4){0.f, 0.f, 0.f, 0.f};
        cur = nxt; cA = nA; cB = nB; ++ui;
        if constexpr (ALIGN_EPI) { if (wr == 1) PG8_BAR; }
    }
    PG8_WAIT_V(0);
    if constexpr (!ALIGN_EPI) { if (wr == 0) PG8_BAR; }
    PG8_BAR;
    if constexpr (Epi::AFTER_DRAIN) { E.fused(acc, cur, wr, wc, fr, fq, lds, wid, lane); S.done(cur); }
#undef PG8_SA
#undef PG8_SB
#undef PG8_STAGE
#undef PG8_LDA
#undef PG8_LDB
#undef PG8_MMA
#undef PG8_WAIT_V
#undef PG8_WAIT_L
#undef PG8_BAR
#undef PG8_SCHED
}
}
#include <hip/hip_bf16.h>
#include <cmath>
namespace attn_body {
using bf16=__hip_bfloat16;
using bf16x8=__attribute__((ext_vector_type(8)))short;
using s16x4=__attribute__((ext_vector_type(4)))short;
using f32x16=__attribute__((ext_vector_type(16)))float;
using u32x4=__attribute__((ext_vector_type(4)))unsigned;
using f32x4b=__attribute__((ext_vector_type(4)))float;
constexpr int BATCH=8,NHEAD=16,SEQ=2048,D=64,DM=4096,DMO=1024;
constexpr int NW=8,QBLK=32,QB=QBLK*NW,KVBLK=64,NQB=SEQ/QB;
constexpr int ATTN_PITCH=DM, ATTN_UNIT_ROWS=QB;
constexpr int LDS_BIAS_OFF=86016;
__device__ __forceinline__ int crow(int r,int hi){return (r&3)+8*(r>>2)+4*hi;}
#define SBAR() __builtin_amdgcn_sched_barrier(0)
__device__ __forceinline__ void cmask(f32x16&p0,f32x16&p1,int jb,int qrel,int hi){
  const float NEG=-INFINITY; int kb=64*jb+4*hi;
  #pragma unroll
  for(int r=0;r<16;++r){int kv=kb+(r&3)+8*(r>>2); if(kv>qrel)p0[r]=NEG; if(kv+32>qrel)p1[r]=NEG;}
}

constexpr int NSLOT=3, SLOTB=8192;
constexpr int LDS_K=0, LDS_V=NSLOT*SLOTB, LDS_WS=2*NSLOT*SLOTB, LDS_OST=LDS_WS+NW*64*4, LDS_BYTES=LDS_OST+NW*4096;
constexpr float C2=0.125f*1.4426950408889634f;
__device__ __forceinline__ void glds16(const void*gsrc,unsigned lds_dst){unsigned keep;
  asm volatile("s_mov_b32 %0, m0\n\ts_mov_b32 m0, %2\n\ts_nop 0\n\tglobal_load_lds_dwordx4 %1, off\n\ts_mov_b32 m0, %0":"=&s"(keep):"v"(gsrc),"s"(lds_dst):"memory");}
__device__ __forceinline__ float max3f(float a,float b,float c){float r;asm("v_max3_f32 %0, %1, %2, %3":"=v"(r):"v"(a),"v"(b),"v"(c));return r;}
__device__ __forceinline__ float max2f(float a,float b){float r;asm("v_max_f32_e32 %0, %1, %2":"=v"(r):"v"(a),"v"(b));return r;}
__device__ __forceinline__ float fadd_s(float a,float b){float r;asm("v_add_f32_e32 %0, %1, %2":"=v"(r):"v"(a),"v"(b));return r;}
__device__ __forceinline__ float fsub_s(float a,float b){float r;asm("v_sub_f32_e32 %0, %1, %2":"=v"(r):"v"(a),"v"(b));return r;}
typedef float f32x2_t __attribute__((ext_vector_type(2))); typedef __bf16 bf16x2_t __attribute__((ext_vector_type(2)));
__device__ __forceinline__ unsigned cvtpk_s(float lo,float hi){f32x2_t v={lo,hi};bf16x2_t b=__builtin_convertvector(v,bf16x2_t);return __builtin_bit_cast(unsigned,b);}
#define WAIT_BAR(N) asm volatile("s_waitcnt vmcnt(" #N ") lgkmcnt(0)\n\ts_barrier":::"memory")

__device__ __forceinline__ void qkt(f32x16&p0,f32x16&p1,const char*Kslot,const bf16x8*qr,const f32x16&negm,int r32,int hi){
  const char*kb=Kslot+hi*1024+r32*16;
  #pragma unroll
  for(int d0=0;d0<4;++d0){
    const bf16x8 b0=*reinterpret_cast<const bf16x8*>(kb+d0*2048);
    const bf16x8 b1=*reinterpret_cast<const bf16x8*>(kb+d0*2048+512);
    if(d0==0){p0=__builtin_amdgcn_mfma_f32_32x32x16_bf16(b0,qr[0],negm,0,0,0);p1=__builtin_amdgcn_mfma_f32_32x32x16_bf16(b1,qr[0],negm,0,0,0);}
    else{p0=__builtin_amdgcn_mfma_f32_32x32x16_bf16(b0,qr[d0],p0,0,0,0);p1=__builtin_amdgcn_mfma_f32_32x32x16_bf16(b1,qr[d0],p1,0,0,0);}}
}
typedef __attribute__((address_space(3))) const char* lds_cptr;
typedef short v4i16_t __attribute__((ext_vector_type(4)));
__device__ __forceinline__ void kload8(bf16x8*kf,lds_cptr kp){
  kf[0]=*(const __attribute__((address_space(3))) bf16x8*)(kp);      kf[1]=*(const __attribute__((address_space(3))) bf16x8*)(kp+512);
  kf[2]=*(const __attribute__((address_space(3))) bf16x8*)(kp+2048); kf[3]=*(const __attribute__((address_space(3))) bf16x8*)(kp+2560);
  kf[4]=*(const __attribute__((address_space(3))) bf16x8*)(kp+4096); kf[5]=*(const __attribute__((address_space(3))) bf16x8*)(kp+4608);
  kf[6]=*(const __attribute__((address_space(3))) bf16x8*)(kp+6144); kf[7]=*(const __attribute__((address_space(3))) bf16x8*)(kp+6656);
}
__device__ __forceinline__ void kload2(bf16x8*kf,lds_cptr kp,int j){ kf[2*j]=*(const __attribute__((address_space(3))) bf16x8*)(kp+j*2048); kf[2*j+1]=*(const __attribute__((address_space(3))) bf16x8*)(kp+j*2048+512); }
__device__ __forceinline__ s16x4 vtr(lds_cptr p){ return __builtin_bit_cast(s16x4,__builtin_amdgcn_ds_read_tr16_b64_v4i16((__attribute__((address_space(3))) v4i16_t*)p)); }
__device__ __forceinline__ float rowmax(const f32x16&p0,const f32x16&p1){
  float a=max3f(p0[0],p0[1],p1[0]),b=max3f(p0[2],p0[3],p1[1]);a=max3f(a,p1[2],p1[3]);
  #pragma unroll
  for(int r=4;r<16;r+=4){a=max3f(a,p0[r],p0[r+1]);b=max3f(b,p0[r+2],p0[r+3]);a=max3f(a,p1[r],p1[r+1]);b=max3f(b,p1[r+2],p1[r+3]);}
  const float m=max2f(a,b);
  auto rr=__builtin_amdgcn_permlane32_swap(__float_as_uint(m),__float_as_uint(m),false,false);
  return max2f(__uint_as_float(rr[0]),__uint_as_float(rr[1]));
}
__device__ __forceinline__ void pv(f32x16*o,int vb,bf16x8 pa0,bf16x8 pa1,bf16x8 pa2,bf16x8 pa3){
  #pragma unroll
  for(int d0=0;d0<2;++d0){s16x4 lo[4],hi[4];
    #pragma unroll
    for(int ks=0;ks<4;++ks){
      asm volatile("ds_read_b64_tr_b16 %0,%1 offset:%c2":"=&v"(lo[ks]):"v"(vb),"i"(d0*4096+ks*1024):"memory");
      asm volatile("ds_read_b64_tr_b16 %0,%1 offset:%c2":"=&v"(hi[ks]):"v"(vb),"i"(d0*4096+ks*1024+512):"memory");}
    asm volatile("s_waitcnt lgkmcnt(0)":::"memory");SBAR();
    #define PK(k) (bf16x8){lo[k][0],lo[k][1],lo[k][2],lo[k][3],hi[k][0],hi[k][1],hi[k][2],hi[k][3]}
    o[d0]=__builtin_amdgcn_mfma_f32_32x32x16_bf16(pa0,PK(0),o[d0],0,0,0);
    o[d0]=__builtin_amdgcn_mfma_f32_32x32x16_bf16(pa1,PK(1),o[d0],0,0,0);
    o[d0]=__builtin_amdgcn_mfma_f32_32x32x16_bf16(pa2,PK(2),o[d0],0,0,0);
    o[d0]=__builtin_amdgcn_mfma_f32_32x32x16_bf16(pa3,PK(3),o[d0],0,0,0);
    #undef PK
  }
}

#ifndef ATTN_STORE16
#define ATTN_STORE16(p,v) (*(u32x4*)(p)=(v))
#endif
template<int THRL> __device__ __forceinline__ void attn_unit(int b,int h,int qb,const bf16*Q,const bf16*__restrict__ K,const bf16*__restrict__ V,const bf16*__restrict__ OG,const float*__restrict__ CUM,bf16*O,char*shm){
  const int tid=opaque_tid(),lane=tid&63,r32=lane&31,hi=lane>>5; const int wid=__builtin_amdgcn_readfirstlane(tid>>6);
  const long rowbase=(long)b*SEQ; const int q0=qb*QB;
  const bf16*Qw=Q+(rowbase+q0+wid*QBLK)*DM+h*D;
  const bf16*Kh=K+rowbase*DM+h*D,*Vh=V+rowbase*DM+h*D;
  const unsigned lds0=(unsigned)(uintptr_t)shm;
  float*wsf=(float*)(shm+LDS_WS)+wid*64;
  const bf16*ksrc=Kh+(long)lane*DM+wid*8;
  const bf16*vsrc=Vh+(long)(16*(wid&3)+(lane>>2))*DM+(wid>>2)*32+(lane&3)*8;
  const unsigned kdst=lds0+LDS_K+wid*1024, vdst=lds0+LDS_V+wid*1024;
  #define DMA_K(t,slot) glds16(ksrc+(long)(t)*KVBLK*DM,(unsigned)__builtin_amdgcn_readfirstlane(kdst+(slot)))
  #define DMA_V(t,slot) glds16(vsrc+(long)(t)*KVBLK*DM,(unsigned)__builtin_amdgcn_readfirstlane(vdst+(slot)))
  const int vb0=(int)(lds0+LDS_V)+((lane>>4)&1)*32+(lane&3)*8+(4*hi+((lane&15)>>2))*64;
  const char*Kbase=shm+LDS_K; bf16x8 kf[8];
  const lds_cptr shm3=(lds_cptr)shm; const lds_cptr kp0=shm3+LDS_K+hi*1024+r32*16; const lds_cptr vp0=shm3+LDS_V+((lane>>4)&1)*32+(lane&3)*8+(4*hi+((lane&15)>>2))*64;
  const int NT=(q0+QB)/KVBLK;
  { float*bl=(float*)(shm+LDS_BIAS_OFF); const float*cs=CUM+((long)b*NHEAD+h)*SEQ;
    for(int j=tid;j<q0+QB;j+=NW*64)bl[j]=cs[j]*(-1.4426950408889634f);
    asm volatile("s_waitcnt vmcnt(0) lgkmcnt(0)\n\ts_barrier":::"memory"); }
  const lds_cptr bp0=(lds_cptr)shm+LDS_BIAS_OFF+hi*16;
  #define BIAS(P0,P1,t) do{ const lds_cptr bp_=bp0+(t)*256; \
    _Pragma("unroll") for(int g_=0;g_<4;++g_){ const f32x4b b0_=*(const __attribute__((address_space(3))) f32x4b*)(bp_+g_*32); const f32x4b b1_=*(const __attribute__((address_space(3))) f32x4b*)(bp_+128+g_*32); \
      P0[4*g_]+=b0_[0];P0[4*g_+1]+=b0_[1];P0[4*g_+2]+=b0_[2];P0[4*g_+3]+=b0_[3]; P1[4*g_]+=b1_[0];P1[4*g_+1]+=b1_[1];P1[4*g_+2]+=b1_[2];P1[4*g_+3]+=b1_[3]; } }while(0)
  DMA_K(0,0);DMA_V(0,0);DMA_K(1,SLOTB);
  bf16x8 qr[4];
  #pragma unroll
  for(int d0=0;d0<4;++d0)qr[d0]=*reinterpret_cast<const bf16x8*>(&Qw[(long)r32*DM+d0*16+hi*8]);
  float mhat=0.f,l_reg=0.f;f32x16 o[2];o[0]=f32x16{};o[1]=f32x16{};f32x16 negm=f32x16{};asm volatile("":"+v"(negm));
  const int qrel=wid*QBLK+r32;
  #define CMASK(P0,P1,t) do{int jb_=(t)-(NT-4); if(jb_>=0)cmask(P0,P1,jb_,qrel,hi);}while(0)
  bool resc=false;
  #define START(P0,P1) do{ const float rm=rowmax(P0,P1); resc=false; \
    { const float dl=rm; mhat=fadd_s(mhat,dl); \
      _Pragma("unroll") for(int r=0;r<16;++r){P0[r]=fsub_s(P0[r],dl);P1[r]=fsub_s(P1[r],dl);} \
      _Pragma("unroll") for(int r=0;r<16;++r)negm[r]=-mhat; asm volatile("":"+v"(negm)); } \
    _Pragma("unroll") for(int r=0;r<16;++r)P0[r]=__builtin_amdgcn_exp2f(P0[r]); }while(0)
  #define RESC() do{ if(resc){ asm volatile("s_waitcnt lgkmcnt(0)":::"memory"); \
      _Pragma("unroll") for(int d_=0;d_<2;++d_) _Pragma("unroll") for(int r=0;r<16;++r)o[d_][r]*=wsf[crow(r,hi)]; } }while(0)
  f32x16 pA0,pA1,pB0,pB1;
  int sl_prev=0,sl_cur=0,sl_next=SLOTB;
  #define ROT() do{sl_prev=sl_cur;sl_cur=sl_next;sl_next=(sl_next==(NSLOT-1)*SLOTB)?0:sl_next+SLOTB;}while(0)
  DMA_K(2,2*SLOTB);
  WAIT_BAR(3);
  qkt(pA0,pA1,Kbase,qr,negm,r32,hi);asm volatile("s_nop 15\n\ts_nop 7":"+v"(pA0),"+v"(pA1));BIAS(pA0,pA1,0);CMASK(pA0,pA1,0);
  START(pA0,pA1);
  _Pragma("unroll") for(int r=0;r<16;++r)pA1[r]=__builtin_amdgcn_exp2f(pA1[r]);
  WAIT_BAR(0);
  DMA_K(3,0);DMA_V(1,SLOTB);
  ROT();
  kload8(kf,kp0+sl_cur);
  WAIT_BAR(2);
  s16x4 vlo[8],vhi[8]; u32x4 pw0,pw1,pw2,pw3;
  #define PKW(P,B) cvtpk_s(P[B],P[B+1])
  #define PAF(k) __builtin_bit_cast(bf16x8,pw##k)
  #define VFR(i) (bf16x8){vlo[i][0],vlo[i][1],vlo[i][2],vlo[i][3],vhi[i][0],vhi[i][1],vhi[i][2],vhi[i][3]}
  #define PIN(x) asm volatile("":"+v"(x))
  #define MX3(a,b,c) __builtin_fmaxf(__builtin_fmaxf((a),(b)),(c))
  #define GAPA(MF,A0,A1,A2,A3,W0,W1,PW) do{ MF; sacc+=A0; sacc+=A1; sacc+=A2; sacc+=A3; PIN(sacc); W0; W1; PIN(PW); SBAR(); }while(0)
  #define EX(v) __builtin_amdgcn_exp2f(v)
  #define GAPB(MF,X,B) do{ MF; X[B]=EX(X[B]); X[B+1]=EX(X[B+1]); X[B+2]=EX(X[B+2]); X[B+3]=EX(X[B+3]); PIN(X); SBAR(); }while(0)
  #define VRD(i) do{ vlo[i]=vtr(vp_+(((i)>>2)*4096+((i)&3)*1024)); vhi[i]=vtr(vp_+(((i)>>2)*4096+((i)&3)*1024+512)); }while(0)
  #define KRD(G,j) do{ if(G){ kload2(kf,kp0+sl_next,j); SBAR(); } }while(0)
  #define STEP(C0,C1,P0,P1,t,GK,GV,GL) do{ SBAR(); \
    const lds_cptr vp_=vp0+sl_prev; \
    VRD(0); SBAR(); float sacc=(P0[0]+P0[1]); \
    GAPA(C0=__builtin_amdgcn_mfma_f32_32x32x16_bf16(kf[0],qr[0],negm,0,0,0), P0[2],P0[3],P0[4],P0[5],     pw0[0]=PKW(P0,0), pw0[1]=PKW(P0,2), pw0); \
    VRD(4); SBAR(); GAPA(C1=__builtin_amdgcn_mfma_f32_32x32x16_bf16(kf[1],qr[0],negm,0,0,0), P0[6],P0[7],P0[8],P0[9],     pw0[2]=PKW(P0,4), pw0[3]=PKW(P0,6), pw0); \
    VRD(1); SBAR(); GAPA(C0=__builtin_amdgcn_mfma_f32_32x32x16_bf16(kf[2],qr[1],C0,0,0,0),   P0[10],P0[11],P0[12],P0[13], pw1[0]=PKW(P0,8), pw1[1]=PKW(P0,10), pw1); \
    VRD(5); SBAR(); GAPA(C1=__builtin_amdgcn_mfma_f32_32x32x16_bf16(kf[3],qr[1],C1,0,0,0),   P0[14],P0[15],P1[0],P1[1],   pw1[2]=PKW(P0,12),pw1[3]=PKW(P0,14), pw1); \
    VRD(2); SBAR(); GAPA(C0=__builtin_amdgcn_mfma_f32_32x32x16_bf16(kf[4],qr[2],C0,0,0,0),   P1[2],P1[3],P1[4],P1[5],     pw2[0]=PKW(P1,0), pw2[1]=PKW(P1,2), pw2); \
    VRD(6); SBAR(); GAPA(C1=__builtin_amdgcn_mfma_f32_32x32x16_bf16(kf[5],qr[2],C1,0,0,0),   P1[6],P1[7],P1[8],P1[9],     pw2[2]=PKW(P1,4), pw2[3]=PKW(P1,6), pw2); \
    VRD(3); SBAR(); GAPA(C0=__builtin_amdgcn_mfma_f32_32x32x16_bf16(kf[6],qr[3],C0,0,0,0),   P1[10],P1[11],P1[12],P1[13], pw3[0]=PKW(P1,8), pw3[1]=PKW(P1,10), pw3); \
    VRD(7); SBAR(); GAPA(C1=__builtin_amdgcn_mfma_f32_32x32x16_bf16(kf[7],qr[3],C1,0,0,0),   P1[14],P1[15],0.f,0.f,       pw3[2]=PKW(P1,12),pw3[3]=PKW(P1,14), pw3); \
    l_reg+=sacc; \
    if(GK){DMA_K((t)+3,sl_cur);} if(GV){DMA_V((t)+1,sl_next);} \
    BIAS(C0,C1,t); \
    CMASK(C0,C1,t); \
    { float a=MX3(C0[0],C0[1],C1[0]),b=MX3(C0[2],C0[3],C1[1]); a=MX3(a,C1[2],C1[3]); \
      _Pragma("unroll") for(int r=4;r<16;r+=4){a=MX3(a,C0[r],C0[r+1]);b=MX3(b,C0[r+2],C0[r+3]);a=MX3(a,C1[r],C1[r+1]);b=MX3(b,C1[r+2],C1[r+3]);} \
      float rm=__builtin_fmaxf(a,b); { auto rr=__builtin_amdgcn_permlane32_swap(__float_as_uint(rm),__float_as_uint(rm),false,false); rm=__builtin_fmaxf(__uint_as_float(rr[0]),__uint_as_float(rr[1])); } \
      resc=false; \
      if(__builtin_expect(__any(rm>(float)THRL),0)){ const float dl=__builtin_fmaxf(rm,0.f); mhat+=dl; \
        _Pragma("unroll") for(int r=0;r<16;++r){C0[r]-=dl;C1[r]-=dl;} \
        _Pragma("unroll") for(int r=0;r<16;++r)negm[r]=-mhat; asm volatile("":"+v"(negm)); \
        const float f=__builtin_amdgcn_exp2f(-dl); l_reg*=f; if(hi==0)wsf[r32]=f; resc=true; } } \
    SBAR(); \
    GAPB(o[0]=__builtin_amdgcn_mfma_f32_32x32x16_bf16(PAF(0),VFR(0),o[0],0,0,0), C0,0); \
    GAPB(o[1]=__builtin_amdgcn_mfma_f32_32x32x16_bf16(PAF(0),VFR(4),o[1],0,0,0), C0,4); \
    KRD(GL,0); GAPB(o[0]=__builtin_amdgcn_mfma_f32_32x32x16_bf16(PAF(1),VFR(1),o[0],0,0,0), C0,8); \
    KRD(GL,1); GAPB(o[1]=__builtin_amdgcn_mfma_f32_32x32x16_bf16(PAF(1),VFR(5),o[1],0,0,0), C0,12); \
    KRD(GL,2); GAPB(o[0]=__builtin_amdgcn_mfma_f32_32x32x16_bf16(PAF(2),VFR(2),o[0],0,0,0), C1,0); \
    KRD(GL,3); GAPB(o[1]=__builtin_amdgcn_mfma_f32_32x32x16_bf16(PAF(2),VFR(6),o[1],0,0,0), C1,4); \
    GAPB(o[0]=__builtin_amdgcn_mfma_f32_32x32x16_bf16(PAF(3),VFR(3),o[0],0,0,0), C1,8); \
    GAPB(o[1]=__builtin_amdgcn_mfma_f32_32x32x16_bf16(PAF(3),VFR(7),o[1],0,0,0), C1,12); \
    }while(0)
  int t=1;
  #undef CMASK
  #define CMASK(P0,P1,t) do{}while(0)
  for(;t+5<NT;t+=2){
    STEP(pB0,pB1,pA0,pA1,t,true,true,true);     WAIT_BAR(2); RESC(); ROT();
    STEP(pA0,pA1,pB0,pB1,t+1,true,true,true);   WAIT_BAR(2); RESC(); ROT();
  }
  #undef CMASK
  #define CMASK(P0,P1,t) do{int jb_=(t)-(NT-4); if(jb_>=0)cmask(P0,P1,jb_,qrel,hi);}while(0)
  #define ENDW(tt) do{ if((tt)+3<NT){WAIT_BAR(2);} else if((tt)+2<NT){WAIT_BAR(1);} else {WAIT_BAR(0);} }while(0)
  for(;t+1<NT;t+=2){
    STEP(pB0,pB1,pA0,pA1,t,(t+3<NT),(t+1<NT),(t+1<NT));       ENDW(t);   RESC(); ROT();
    STEP(pA0,pA1,pB0,pB1,t+1,(t+4<NT),(t+2<NT),(t+2<NT));     ENDW(t+1); RESC(); ROT();
  }
  STEP(pB0,pB1,pA0,pA1,NT-1,false,false,false); RESC();
  { float sacc=pB0[0]+pB0[1]; _Pragma("unroll") for(int r=2;r<16;++r)sacc+=pB0[r]; _Pragma("unroll") for(int r=0;r<16;++r)sacc+=pB1[r]; l_reg+=sacc;
    pw0=(u32x4){PKW(pB0,0),PKW(pB0,2),PKW(pB0,4),PKW(pB0,6)};pw1=(u32x4){PKW(pB0,8),PKW(pB0,10),PKW(pB0,12),PKW(pB0,14)};pw2=(u32x4){PKW(pB1,0),PKW(pB1,2),PKW(pB1,4),PKW(pB1,6)};pw3=(u32x4){PKW(pB1,8),PKW(pB1,10),PKW(pB1,12),PKW(pB1,14)};
    SBAR(); pv(o,vb0+sl_cur,PAF(0),PAF(1),PAF(2),PAF(3)); }
  #undef PKW
  #undef PAF
  #undef VFR
  #undef PIN
  #undef MX3
  #undef GAPA
  #undef GAPB
  #undef EX
  #undef VRD
  #undef KRD
  #undef STEP
  #undef ENDW
  {auto rr=__builtin_amdgcn_permlane32_swap(__float_as_uint(l_reg),__float_as_uint(l_reg),false,false);l_reg=__uint_as_float(rr[0])+__uint_as_float(rr[1]);}
  if(hi==0)wsf[32+r32]=l_reg;asm volatile("s_waitcnt lgkmcnt(0)":::"memory");
  float rli[16];
  #pragma unroll
  for(int r=0;r<16;++r)rli[r]=__builtin_amdgcn_rcpf(wsf[32+crow(r,hi)]);
  bf16*Ow=O+(rowbase+q0+wid*QBLK)*DMO+h*D; const bf16*Gw=OG+(rowbase+q0+wid*QBLK)*DM+h*D;
  { bf16*stg=(bf16*)(shm+LDS_OST)+wid*2048;
    #pragma unroll
    for(int r=0;r<16;++r){const int orow=crow(r,hi);
      #pragma unroll
      for(int d0=0;d0<2;++d0)stg[orow*64+d0*32+r32]=__float2bfloat16(o[d0][r]*rli[r]);}
    asm volatile("s_waitcnt lgkmcnt(0)":::"memory");
    #pragma unroll
    for(int i=0;i<4;++i){const int row=i*8+(lane>>3),ch=lane&7; u32x4 v=*(const u32x4*)(stg+row*64+ch*8); const u32x4 g=*(const u32x4*)(Gw+(long)row*DM+ch*8);
      #pragma unroll
      for(int e=0;e<4;++e){ const float o0=__uint_as_float(v[e]<<16),o1=__uint_as_float(v[e]&0xffff0000u),g0=__uint_as_float(g[e]<<16),g1=__uint_as_float(g[e]&0xffff0000u);
        v[e]=cvtpk_s(o0*__builtin_amdgcn_rcpf(1.0f+__builtin_amdgcn_exp2f(-1.4426950408889634f*g0)),o1*__builtin_amdgcn_rcpf(1.0f+__builtin_amdgcn_exp2f(-1.4426950408889634f*g1))); }
      ATTN_STORE16(Ow+(long)row*DMO+ch*8,v);} }
  asm volatile("s_waitcnt lgkmcnt(0)\n\ts_barrier":::"memory");
  #undef DMA_K
  #undef DMA_V
  #undef BIAS
  #undef CMASK
  #undef START
  #undef RESC
  #undef ROT
}
constexpr int ATTN_LDS_BYTES=LDS_BYTES;
struct AttnTensors { const bf16* Q; const bf16* K; const bf16* V; const bf16* OG; const float* CUM; bf16* O; };
struct AttnUnit { int bh; int qb; };
struct StaticOrder {
  int vcu, stride;
  __device__ __forceinline__ explicit StaticOrder(int grid,int block):vcu((grid%8==0)?(block%8)*(grid/8)+block/8:block),stride(grid){}
  __device__ __forceinline__ bool next(int i,AttnUnit&u)const{ const int su=vcu+(i>>2)*stride; if(su>=256)return false; const int p=su&1,k=i&3; u.bh=su>>1; u.qb=(k==0)?p:(k==1)?7-p:(k==2)?2+p:5-p; return true; }
  __device__ __forceinline__ void a_ready(const AttnUnit&)const{}
  __device__ __forceinline__ void done(const AttnUnit&)const{}
};
template<class Sched,int THRL=8> __device__ __forceinline__ void attn_phase(char*lds,const AttnTensors&T,const Sched&S){
  AttnUnit u;
  for(int i=0;S.next(i,u);++i){ S.a_ready(u); attn_unit<THRL>(u.bh/NHEAD,u.bh%NHEAD,u.qb,T.Q,T.K,T.V,T.OG,T.CUM,T.O,lds); S.done(u); }
}
#undef SBAR
#undef WAIT_BAR
}
#define GAS __attribute__((address_space(1)))
#define LAS __attribute__((address_space(3)))
typedef GAS unsigned gu32;
typedef GAS unsigned long long gu64;
#define RLX_AGENT __ATOMIC_RELAXED, __HIP_MEMORY_SCOPE_AGENT
#define XB_TMO      128
#define XB_XCNT(j)  (256  + 64 * (j))
#define XB_XSUB(j)  (1280 + 64 * (j))
#define XB_XGEN(j)  (2304 + 64 * (j))
#define XB_TOP      3328
#define XB_TOPGEN   3392
#define XCD_BAR_WORDS 3456
#define XB_SPIN_CAP (1u << 18)

__device__ __forceinline__ unsigned xb_ld(unsigned* p)              { return __hip_atomic_load(p, __ATOMIC_RELAXED, __HIP_MEMORY_SCOPE_AGENT); }
__device__ __forceinline__ unsigned xb_add(unsigned* p, unsigned v) { return __hip_atomic_fetch_add(p, v, __ATOMIC_RELAXED, __HIP_MEMORY_SCOPE_AGENT); }
__device__ __forceinline__ unsigned xb_xcc_id() { return (unsigned)__builtin_amdgcn_s_getreg((3 << 11) | 20) & 0xFu; }
#define XB_SPIN(cond, bar) do { unsigned _sp = 0; while (cond) { __builtin_amdgcn_s_sleep(1); \
    if ((++_sp & 255u) == 0u) { if (xb_ld(&(bar)[XB_TMO])) break; if (_sp > XB_SPIN_CAP) { atomicAdd(&(bar)[XB_TMO], 1u); break; } } } } while (0)

struct XcdBarrier {
    unsigned* bar; unsigned x;
    volatile LAS unsigned* st;
};

__device__ __forceinline__ XcdBarrier xcd_barrier_post(unsigned* bar, volatile LAS unsigned* st) {
    XcdBarrier b; b.bar = bar; b.x = xb_xcc_id(); b.st = st;
    if (threadIdx.x == 0) (void)xb_add(&bar[XB_XCNT(b.x)], 1u);
    return b;
}
__device__ __forceinline__ void xcd_barrier_complete(unsigned* bar, unsigned x, unsigned& nloc, unsigned& nx) {
    const unsigned G = gridDim.x * gridDim.y * gridDim.z;
    unsigned sum, cnt, mine, sp = 0u;
    for (;;) {
        sum = 0u; cnt = 0u; mine = 0u;
#pragma unroll
        for (unsigned j = 0; j < 16; ++j) { const unsigned c = xb_ld(&bar[XB_XCNT(j)]); sum += c; cnt += (c > 0u) ? 1u : 0u; mine = (j == x) ? c : mine; }
        if (sum == G) break;
        __builtin_amdgcn_s_sleep(1);
        if ((++sp & 255u) == 0u) { if (xb_ld(&bar[XB_TMO])) break; if (sp > XB_SPIN_CAP) { atomicAdd(&bar[XB_TMO], 1u); break; } }
    }
    nloc = mine > 0u ? mine : 1u; nx = cnt > 0u ? cnt : 1u;
}

__device__ __forceinline__ void xcd_barrier(const XcdBarrier& b) {
    asm volatile("s_waitcnt vmcnt(0)" ::: "memory");
    __syncthreads();
    if (threadIdx.x == 0) {
        unsigned* bar = b.bar;
        __builtin_amdgcn_s_waitcnt(0);
        unsigned nloc = b.st[0], nx = b.st[1];
        if (nloc == 0u) { xcd_barrier_complete(bar, b.x, nloc, nx); b.st[0] = nloc; b.st[1] = nx; }
        const unsigned old = xb_add(&bar[XB_XSUB(b.x)], 1u);
        const unsigned gen = old / nloc;
        if (old + 1u == (gen + 1u) * nloc) {
            __builtin_amdgcn_fence(__ATOMIC_RELEASE, "agent");
            asm volatile("s_waitcnt vmcnt(0)" ::: "memory");
            const unsigned og = xb_add(&bar[XB_TOP], 1u);
            const unsigned tg = og / nx;
            if (og + 1u == (tg + 1u) * nx) xb_add(&bar[XB_TOPGEN], 1u);
            else XB_SPIN(xb_ld(&bar[XB_TOPGEN]) == tg, bar);
            __builtin_amdgcn_fence(__ATOMIC_ACQUIRE, "agent");
            xb_add(&bar[XB_XGEN(b.x)], 1u);
            asm volatile("s_waitcnt vmcnt(0)" ::: "memory");
        } else {
            XB_SPIN(xb_ld(&bar[XB_XGEN(b.x)]) == gen, bar);
            __builtin_amdgcn_fence(__ATOMIC_ACQUIRE, "agent");
            asm volatile("s_waitcnt vmcnt(0)" ::: "memory");
        }
    }
    __syncthreads();
}

typedef unsigned short bf16_t;
typedef short bf16x8_t __attribute__((ext_vector_type(8)));
typedef float f32x4_t __attribute__((ext_vector_type(4)));
constexpr int T_TOK = 16384, DM = 1024, SEQ = 2048, NBATCH = 8;
constexpr int L0_COLS = 3848, L0_MAIN = 3840, L1_COLS = 4112, L1_MAIN = 4096;
constexpr float DN_ALPHA = 1.4142135623730951f;
constexpr float LN_EPS = 1e-5f;
constexpr int NTHR = 512;

__device__ __forceinline__ unsigned f2bf(float f) { return (unsigned)__builtin_bit_cast(unsigned short, (__bf16)f); }
typedef float pk_f32x2_t __attribute__((ext_vector_type(2))); typedef __bf16 pk_bf16x2_t __attribute__((ext_vector_type(2)));
__device__ __forceinline__ unsigned pk2(float lo, float hi) { const pk_f32x2_t v = {lo, hi}; return __builtin_bit_cast(unsigned, __builtin_convertvector(v, pk_bf16x2_t)); }
__device__ __forceinline__ float bflo(unsigned w) { return __uint_as_float(w << 16); }
__device__ __forceinline__ float bfhi(unsigned w) { return __uint_as_float(w & 0xffff0000u); }
__device__ __forceinline__ float bf2f(bf16_t h) { return __uint_as_float(((unsigned)h) << 16); }
#define LDS_BARRIER() do { asm volatile("s_waitcnt lgkmcnt(0)" ::: "memory"); __builtin_amdgcn_s_barrier(); asm volatile("" ::: "memory"); } while (0)
template <int CTRL, int RM> __device__ __forceinline__ float dpp_f(float x) { return __builtin_bit_cast(float, __builtin_amdgcn_update_dpp(0, __builtin_bit_cast(int, x), CTRL, RM, 0xF, true)); }
__device__ __forceinline__ float red4_sum(float x) { x += dpp_f<0xB1, 0xF>(x); x += dpp_f<0x4E, 0xF>(x); return x; }
__device__ __forceinline__ float red8_sum(float x) { x = red4_sum(x); x += dpp_f<0x141, 0xF>(x); return x; }
__device__ __forceinline__ float red16_sum(float x) { x = red8_sum(x); x += dpp_f<0x140, 0xF>(x); return x; }
__device__ __forceinline__ float wave_sum(float x) { x = red16_sum(x); x += dpp_f<0x142, 0xA>(x); x += dpp_f<0x143, 0xC>(x);
    return __builtin_bit_cast(float, __builtin_amdgcn_readlane(__builtin_bit_cast(int, x), 63)); }
template <int CTRL, int RM> __device__ __forceinline__ float dpp_id(float x, float ident) { return __builtin_bit_cast(float, __builtin_amdgcn_update_dpp(__builtin_bit_cast(int, ident), __builtin_bit_cast(int, x), CTRL, RM, 0xF, false)); }
__device__ __forceinline__ float wave_scan_sum(float x) { x += dpp_id<0x111, 0xF>(x, 0.f); x += dpp_id<0x112, 0xF>(x, 0.f); x += dpp_id<0x114, 0xF>(x, 0.f); x += dpp_id<0x118, 0xF>(x, 0.f);
    x += dpp_id<0x142, 0xA>(x, 0.f); x += dpp_id<0x143, 0xC>(x, 0.f); return x; }
__device__ __forceinline__ float wave_scan_max(float x) { const float ni = -INFINITY; x = fmaxf(x, dpp_id<0x111, 0xF>(x, ni)); x = fmaxf(x, dpp_id<0x112, 0xF>(x, ni)); x = fmaxf(x, dpp_id<0x114, 0xF>(x, ni)); x = fmaxf(x, dpp_id<0x118, 0xF>(x, ni));
    x = fmaxf(x, dpp_id<0x142, 0xA>(x, ni)); x = fmaxf(x, dpp_id<0x143, 0xC>(x, ni)); return x; }
__device__ __forceinline__ float wave_max(float x) { x = fmaxf(x, dpp_f<0xB1, 0xF>(x)); x = fmaxf(x, dpp_f<0x4E, 0xF>(x)); x = fmaxf(x, dpp_f<0x141, 0xF>(x)); x = fmaxf(x, dpp_f<0x140, 0xF>(x));
    x = fmaxf(x, __shfl_xor(x, 16)); x = fmaxf(x, __shfl_xor(x, 32)); return x; }
__device__ __forceinline__ float sigmoid_f(float x) { return 1.0f / (1.0f + __expf(-x)); }
__device__ __forceinline__ float log_sigmoid_f(float x) { return fminf(x, 0.f) - log1pf(__expf(-fabsf(x))); }
__device__ __forceinline__ void unpack8(const uint4 w, float* f) {
    f[0] = bflo(w.x); f[1] = bfhi(w.x); f[2] = bflo(w.y); f[3] = bfhi(w.y); f[4] = bflo(w.z); f[5] = bfhi(w.z); f[6] = bflo(w.w); f[7] = bfhi(w.w);
}
__device__ __forceinline__ void unpack4(const uint2 w, float* f) { f[0] = bflo(w.x); f[1] = bfhi(w.x); f[2] = bflo(w.y); f[3] = bfhi(w.y); }

__device__ __forceinline__ void transpose_cvt_phase(const float* __restrict__ W, int K, int ldw, int c0, int N, bf16_t* __restrict__ WT, int bid, int nblk, float* tile  ) {
    const int nb = N / 64, nunits = (K / 64) * nb;
    for (int u = bid; u < nunits; u += nblk) {
        const int kb = u / nb, nbi = u % nb; const int k0 = kb * 64, n0 = nbi * 64;
        for (int i = opaque_tid(); i < 4096; i += NTHR) { const int kk = i >> 6, nn = i & 63; tile[kk * 65 + nn] = W[(size_t)(k0 + kk) * ldw + c0 + n0 + nn]; }
        __syncthreads();
        for (int i = opaque_tid(); i < 2048; i += NTHR) { const int nn = i >> 5, kp = (i & 31) * 2;
            const unsigned v = pk2(tile[kp * 65 + nn], tile[(kp + 1) * 65 + nn]); *(unsigned*)(WT + (size_t)(n0 + nn) * K + k0 + kp) = v; }
        __syncthreads();
    }
}
__device__ __forceinline__ void cvt_bf16_phase(const float* __restrict__ src, bf16_t* __restrict__ dst, size_t n8, int bid, int nblk) {
    for (size_t i = (size_t)bid * NTHR + opaque_tid(); i < n8; i += (size_t)nblk * NTHR) {
        const float4 a = ((const float4*)src)[2 * i], b = ((const float4*)src)[2 * i + 1];
        uint4 o; o.x = pk2(a.x, a.y); o.y = pk2(a.z, a.w); o.z = pk2(b.x, b.y); o.w = pk2(b.z, b.w); ((uint4*)dst)[i] = o; }
}
__device__ __forceinline__ void build_wlr_phase(const float* __restrict__ w_up, const float* __restrict__ a_up, const float* __restrict__ g_up, bf16_t* __restrict__ WT, int bid, int nblk) {
    for (int i = bid * NTHR + opaque_tid(); i < 1536 * 256; i += nblk * NTHR) { const int n = i >> 8, k = i & 255; float v = 0.f;
        if (n < 512) { if (k < 64) v = w_up[k * 512 + n]; }
        else if (n < 1024) { if (k >= 64 && k < 128) v = a_up[(k - 64) * 512 + (n - 512)]; }
        else { if (k >= 128) v = g_up[(k - 128) * 512 + (n - 1024)]; }
        WT[i] = (bf16_t)f2bf(v); }
}

namespace pg8 {
struct EpiF32 {
    static constexpr bool PERM = false, AFTER_DRAIN = false;
    float* C; long ldc;
    __device__ __forceinline__ void operator()(const f32x4 (&acc)[2][2][4][2], const Unit& u, int wr, int wc, int fr, int fq) const {
        const int row0 = u.pm * BM + wr * 64 + fr, col0 = u.pn * BM + wc * 32 + 4 * fq;
#pragma unroll
        for (int ai = 0; ai < 2; ++ai)
#pragma unroll
            for (int m = 0; m < 4; ++m) { float* rowp = C + (size_t)(row0 + ai * HALF + m * 16) * ldc + col0;
#pragma unroll
                for (int bj = 0; bj < 2; ++bj)
#pragma unroll
                    for (int n = 0; n < 2; ++n) *(f32x4*)(rowp + bj * HALF + n * 16) = acc[ai][bj][m][n]; }
    }
};
struct EpiBf16P {
    static constexpr bool PERM = true, AFTER_DRAIN = false;
    bf16_t* O; long ldc;
    __device__ __forceinline__ void operator()(const f32x4 (&acc)[2][2][4][2], const Unit& u, int wr, int wc, int fr, int fq) const {
        const int row0 = u.pm * BM + wr * 64 + fr; const int col0 = u.pn * BM + wc * 32 + 8 * fq;
#pragma unroll
        for (int ai = 0; ai < 2; ++ai)
#pragma unroll
            for (int m = 0; m < 4; ++m) { bf16_t* rowp = O + (size_t)(row0 + ai * HALF + m * 16) * ldc + col0;
#pragma unroll
                for (int bj = 0; bj < 2; ++bj) { const f32x4 v0 = acc[ai][bj][m][0], v1 = acc[ai][bj][m][1];
                    u32x4 w; w.x = cvt_pk_bf16(v0[0], v0[1]); w.y = cvt_pk_bf16(v0[2], v0[3]); w.z = cvt_pk_bf16(v1[0], v1[1]); w.w = cvt_pk_bf16(v1[2], v1[3]);
                    *(u32x4*)(rowp + bj * HALF) = w; } }
    }
};
struct EpiLowrank {
    static constexpr bool PERM = false, AFTER_DRAIN = false;
    float* lrw; bf16_t* lra; bf16_t* lrg; const float* w0; const float* a0;
    __device__ __forceinline__ void operator()(const f32x4 (&acc)[2][2][4][2], const Unit& u, int wr, int wc, int fr, int fq) const {
        const int row0 = u.pm * BM + wr * 64 + fr; const int sel = u.pn >> 1; const int colb = (u.pn & 1) * BM + wc * 32 + 4 * fq;
#pragma unroll
        for (int ai = 0; ai < 2; ++ai)
#pragma unroll
            for (int m = 0; m < 4; ++m) { const size_t rowoff = (size_t)(row0 + ai * HALF + m * 16) * 512;
#pragma unroll
                for (int bj = 0; bj < 2; ++bj)
#pragma unroll
                    for (int n = 0; n < 2; ++n) { const int c = colb + bj * HALF + n * 16; f32x4 v = acc[ai][bj][m][n];
                        if (sel == 0) { const f32x4 bv = *(const f32x4*)(w0 + c); *(f32x4*)(lrw + rowoff + c) = v + bv; }
                        else if (sel == 1) { const f32x4 bv = *(const f32x4*)(a0 + c); v = v + bv; uint2 o; o.x = pk2(v[0], v[1]); o.y = pk2(v[2], v[3]); *(uint2*)(lra + rowoff + c) = o; }
                        else { uint2 o; o.x = pk2(v[0], v[1]); o.y = pk2(v[2], v[3]); *(uint2*)(lrg + rowoff + c) = o; } } }
    }
};
}

template <int NG>
__device__ __forceinline__ void gates_phase(const float* X, const float* __restrict__ W, int ldw, int c0, float* __restrict__ out, int bid, int nblk, float* wg  ) {
    for (int i = opaque_tid(); i < NG * 1024; i += NTHR) { const int k = i / NG, g = i % NG; wg[g * 1024 + k] = W[(size_t)k * ldw + c0 + g]; }
    __syncthreads();
    const int lane = opaque_tid() & 63, wv = opaque_tid() >> 6;
    for (int t = bid * 8 + wv; t < T_TOK; t += nblk * 8) {
        float x[16];
#pragma unroll
        for (int j = 0; j < 16; ++j) x[j] = X[(size_t)t * 1024 + lane + 64 * j];
#pragma unroll 1
        for (int g = 0; g < NG; ++g) { float p = 0.f;
#pragma unroll
            for (int j = 0; j < 16; ++j) p += x[j] * wg[g * 1024 + lane + 64 * j];
            p = wave_sum(p); if (lane == 0) out[(size_t)t * 16 + g] = p; }
    }
    __syncthreads();
}
__device__ __forceinline__ void rwkv_prep_phase(const bf16_t* __restrict__ P0, const float* __restrict__ mu, bf16_t* __restrict__ App, int bid, int nblk) {
    for (size_t i = (size_t)bid * NTHR + opaque_tid(); i < (size_t)T_TOK * 256; i += (size_t)nblk * NTHR) {
        const int t = (int)(i >> 8), c = (int)(i & 255), col = 1536 + c;
        const float cur = bf2f(P0[(size_t)t * L0_MAIN + col]); const float prev = (t % SEQ) ? bf2f(P0[(size_t)(t - 1) * L0_MAIN + col]) : 0.f;
        float v = cur + (prev - cur) * mu[col];
        if (c < 64) v = tanhf(v); else if (c >= 128) v = sigmoid_f(v);
        App[i] = (bf16_t)f2bf(v); }
}
__device__ __forceinline__ void ln_phase(const float* xin, const float* mix, const float* g, const float* b, float* xout, bf16_t* xb, int bid, int nblk) {
    const int lane = opaque_tid() & 63, wv = opaque_tid() >> 6;
    for (int t = bid * 8 + wv; t < T_TOK; t += nblk * 8) {
        float4 y[4]; float s = 0.f;
#pragma unroll
        for (int j = 0; j < 4; ++j) { const float4 a = *(const float4*)(xin + (size_t)t * 1024 + 4 * lane + 256 * j), m = *(const float4*)(mix + (size_t)t * 1024 + 4 * lane + 256 * j);
            y[j].x = DN_ALPHA * a.x + m.x; y[j].y = DN_ALPHA * a.y + m.y; y[j].z = DN_ALPHA * a.z + m.z; y[j].w = DN_ALPHA * a.w + m.w; s += (y[j].x + y[j].y) + (y[j].z + y[j].w); }
        const float mean = wave_sum(s) * (1.f / 1024.f); float q = 0.f;
#pragma unroll
        for (int j = 0; j < 4; ++j) { y[j].x -= mean; y[j].y -= mean; y[j].z -= mean; y[j].w -= mean; q += (y[j].x * y[j].x + y[j].y * y[j].y) + (y[j].z * y[j].z + y[j].w * y[j].w); }
        const float rstd = rsqrtf(wave_sum(q) * (1.f / 1024.f) + LN_EPS);
#pragma unroll
        for (int j = 0; j < 4; ++j) { const float4 gg = *(const float4*)(g + 4 * lane + 256 * j), bb = *(const float4*)(b + 4 * lane + 256 * j);
            float4 o; o.x = y[j].x * rstd * gg.x + bb.x; o.y = y[j].y * rstd * gg.y + bb.y; o.z = y[j].z * rstd * gg.z + bb.z; o.w = y[j].w * rstd * gg.w + bb.w;
            *(float4*)(xout + (size_t)t * 1024 + 4 * lane + 256 * j) = o; uint2 w; w.x = pk2(o.x, o.y); w.y = pk2(o.z, o.w); *(uint2*)(xb + (size_t)t * 1024 + 4 * lane + 256 * j) = w; }
    }
}
__device__ __forceinline__ void fox_cumsum_phase(const float* __restrict__ gates, const float* __restrict__ f_b, float* __restrict__ cum, int bid, int nblk) {
    const int lane = opaque_tid() & 63, wv = opaque_tid() >> 6;
    for (int bh = bid * 8 + wv; bh < 128; bh += nblk * 8) {
        const int b = bh >> 4, h = bh & 15; const float fb = f_b[h];
        float lf[32]; double run = 0.0;
#pragma unroll
        for (int j = 0; j < 32; ++j) { const int s = lane * 32 + j; lf[j] = log_sigmoid_f(gates[((size_t)b * SEQ + s) * 16 + h] + fb); run += (double)lf[j]; }
        double incl = run;
#pragma unroll
        for (int o = 1; o < 64; o <<= 1) { const double v = __shfl_up(incl, o); if (lane >= o) incl += v; }
        double acc = incl - run;
#pragma unroll
        for (int j = 0; j < 32; ++j) { acc += (double)lf[j]; cum[(size_t)bh * SEQ + lane * 32 + j] = (float)acc; }
    }
}

__device__ __forceinline__ void fox_qknorm_phase(bf16_t* P1, const float* __restrict__ qn_g, const float* __restrict__ kn_g, int bid, int nblk) {
    const int tid = opaque_tid(); const int lane = tid & 63, wv = tid >> 6;
    for (int t = bid * 8 + wv; t < T_TOK; t += nblk * 8) {
#pragma unroll
        for (int which = 0; which < 2; ++which) {
            bf16_t* p = P1 + (size_t)t * L1_MAIN + which * 1024 + lane * 16; const float* g = (which ? kn_g : qn_g) + lane * 16;
            float f[16]; unpack8(*(const uint4*)p, f); unpack8(*(const uint4*)(p + 8), f + 8);
            float ss = 0.f;
#pragma unroll
            for (int j = 0; j < 16; ++j) ss += f[j] * f[j];
            ss = red4_sum(ss);
            const float r = rsqrtf(ss * (1.f / 64.f) + 1e-6f) * (which ? 1.0f : 0.125f * 1.4426950408889634f);
#pragma unroll
            for (int j = 0; j < 16; ++j) f[j] = f[j] * r * g[j];
            uint4 w0, w1; w0.x = pk2(f[0], f[1]); w0.y = pk2(f[2], f[3]); w0.z = pk2(f[4], f[5]); w0.w = pk2(f[6], f[7]); w1.x = pk2(f[8], f[9]); w1.y = pk2(f[10], f[11]); w1.z = pk2(f[12], f[13]); w1.w = pk2(f[14], f[15]);
            *(uint4*)p = w0; *(uint4*)(p + 8) = w1; }
    }
}

__device__ __forceinline__ void mlstm_prepass_phase(bf16_t* P0, const float* __restrict__ conv_w, const float* __restrict__ conv_b, int bid, int nblk) {
    const int tid = opaque_tid(); const int ch = tid & 63, seg = tid >> 6;
    for (int u = bid; u < NBATCH * 16; u += nblk) {
        const int b = u >> 4, c = (u & 15) * 64 + ch;
        const float w0 = conv_w[c], w1 = conv_w[1024 + c], w2 = conv_w[2048 + c], w3 = conv_w[3072 + c], bs = conv_b[c]; const float scl = (c < 512) ? 0.08838834764831845f : 1.0f;
        bf16_t* base = P0 + ((size_t)b * SEQ + seg * 256) * L0_MAIN + 1792 + c;
        float z1 = 0.f, z2 = 0.f, z3 = 0.f;
        if (seg > 0) { z1 = bf2f(base[-(long)L0_MAIN]); z2 = bf2f(base[-2 * (long)L0_MAIN]); z3 = bf2f(base[-3 * (long)L0_MAIN]); }
        __syncthreads();
#pragma unroll 1
        for (int t0 = 0; t0 < 256; t0 += 16) { float zz[16];
#pragma unroll
            for (int i = 0; i < 16; ++i) zz[i] = bf2f(base[(size_t)(t0 + i) * L0_MAIN]);
#pragma unroll
            for (int i = 0; i < 16; ++i) { const float cv = w3 * zz[i] + w2 * z1 + w1 * z2 + w0 * z3 + bs; z3 = z2; z2 = z1; z1 = zz[i]; zz[i] = cv * sigmoid_f(cv) * scl; }
#pragma unroll
            for (int i = 0; i < 16; ++i) base[(size_t)(t0 + i) * L0_MAIN] = (bf16_t)f2bf(zz[i]); }
        __syncthreads();
    }
    for (size_t i = (size_t)bid * NTHR + tid; i < (size_t)T_TOK * 64; i += (size_t)nblk * NTHR) { bf16_t* p = P0 + (i >> 6) * L0_MAIN + 3328 + (i & 63) * 8; float f[8]; unpack8(*(const uint4*)p, f);
        *(uint4*)p = make_uint4(pk2(sigmoid_f(f[0]), sigmoid_f(f[1])), pk2(sigmoid_f(f[2]), sigmoid_f(f[3])), pk2(sigmoid_f(f[4]), sigmoid_f(f[5])), pk2(sigmoid_f(f[6]), sigmoid_f(f[7]))); }
}

struct RwkvArgs { const bf16_t* P0; const float* lrw; const bf16_t* lra; const bf16_t* lrg; const float* mu; const float* k_k; const float* k_a; const float* r_k; const float* ln_g; const float* ln_b; bf16_t* ycat; };
constexpr int RW_CS = 32;
constexpr int RW_LDS_BYTES = 8 * RW_CS * 64 * 4;

#define RW_LOAD_RAW(chunk) do { const int sg_ = (chunk) * RW_CS + ls; const size_t row_ = tok0 + sg_; \
    const bf16_t* pc_ = A.P0 + row_ * L0_MAIN + hc; \
    rc = *(const uint2*)(pc_); kc = *(const uint2*)(pc_ + 512); vc = *(const uint2*)(pc_ + 1024); \
    if (sg_ > 0) { const bf16_t* pp_ = pc_ - L0_MAIN; rp = *(const uint2*)(pp_); kp = *(const uint2*)(pp_ + 512); vp = *(const uint2*)(pp_ + 1024); } \
    else { rp = make_uint2(0u, 0u); kp = rp; vp = rp; } \
    rwl = *(const float4*)(A.lrw + row_ * 512 + hc); ra = *(const uint2*)(A.lra + row_ * 512 + hc); rg = *(const uint2*)(A.lrg + row_ * 512 + hc); } while (0)

__device__ __forceinline__ void rwkv_scan_unit(const RwkvArgs& A, int bh, float* smem) {
    const int tid = opaque_tid(); const int b = bh >> 3, h = bh & 7;
    float* sr = smem; float* sw = sr + 2048; float* sk = sw + 2048; float* skk = sk + 2048; float* snb = skk + 2048; float* sv = snb + 2048; float* sg = sv + 2048; float* sy = sg + 2048;
    const int ls = tid >> 4, lc = (tid & 15) * 4; const int hc = h * 64 + lc;
    float c_mur[4], c_muk[4], c_muv[4], c_kk[4], c_ka[4], c_rk[4], c_lng[4], c_lnb[4];
#pragma unroll
    for (int j = 0; j < 4; ++j) { c_mur[j] = A.mu[hc + j]; c_muk[j] = A.mu[512 + hc + j]; c_muv[j] = A.mu[1024 + hc + j]; c_kk[j] = A.k_k[hc + j]; c_ka[j] = A.k_a[hc + j];
        c_rk[j] = A.r_k[hc + j]; c_lng[j] = A.ln_g[hc + j]; c_lnb[j] = A.ln_b[hc + j]; }
    const int srow = tid >> 3, sq = (tid & 7) * 8;
    float S[8];
#pragma unroll
    for (int j = 0; j < 8; ++j) S[j] = 0.f;
    const size_t tok0 = (size_t)b * SEQ;
    uint2 rc, kc, vc, rp, kp, vp, ra, rg; float4 rwl;
    RW_LOAD_RAW(0);
    for (int chunk = 0; chunk < SEQ / RW_CS; ++chunk) {
        {
            float frc[4], fkc[4], fvc[4], frp[4], fkp[4], fvp[4], fa[4], fg[4];
            unpack4(rc, frc); unpack4(kc, fkc); unpack4(vc, fvc); unpack4(rp, frp); unpack4(kp, fkp); unpack4(vp, fvp); unpack4(ra, fa); unpack4(rg, fg);
            const float zw[4] = {rwl.x, rwl.y, rwl.z, rwl.w};
            float r_l[4], k_l[4], v_l[4], w_[4], a_[4], kkr[4]; float ss = 0.f;
#pragma unroll
            for (int j = 0; j < 4; ++j) {
                r_l[j] = frc[j] + (frp[j] - frc[j]) * c_mur[j]; k_l[j] = fkc[j] + (fkp[j] - fkc[j]) * c_muk[j]; v_l[j] = fvc[j] + (fvp[j] - fvc[j]) * c_muv[j];
                const float sig = sigmoid_f(zw[j]); w_[j] = __expf(-0.6065306597126334f * sig); a_[j] = sigmoid_f(fa[j]);
                kkr[j] = k_l[j] * c_kk[j]; ss += kkr[j] * kkr[j]; }
            ss = red16_sum(ss);
            const float inv = 1.0f / fmaxf(sqrtf(ss), 1e-12f);
            const int o = ls * 64 + lc;
#pragma unroll
            for (int j = 0; j < 4; ++j) { const float kk = kkr[j] * inv;
                sr[o + j] = r_l[j]; sw[o + j] = w_[j]; sk[o + j] = k_l[j] * (1.0f + (a_[j] - 1.0f) * c_ka[j]); skk[o + j] = kk; snb[o + j] = -kk * a_[j]; sv[o + j] = v_l[j]; sg[o + j] = fg[j]; }
        }
        __syncthreads();
        if (chunk + 1 < SEQ / RW_CS) RW_LOAD_RAW(chunk + 1);
        for (int s = 0; s < RW_CS; ++s) {
            const float4 kk0 = *(const float4*)(skk + s * 64 + sq), kk1 = *(const float4*)(skk + s * 64 + sq + 4);
            const float4 w0 = *(const float4*)(sw + s * 64 + sq), w1 = *(const float4*)(sw + s * 64 + sq + 4);
            const float4 nb0 = *(const float4*)(snb + s * 64 + sq), nb1 = *(const float4*)(snb + s * 64 + sq + 4);
            const float4 k0 = *(const float4*)(sk + s * 64 + sq), k1 = *(const float4*)(sk + s * 64 + sq + 4);
            const float4 r0 = *(const float4*)(sr + s * 64 + sq), r1 = *(const float4*)(sr + s * 64 + sq + 4);
            const float vv = sv[s * 64 + srow];
            float sa = (S[0] * kk0.x + S[1] * kk0.y) + (S[2] * kk0.z + S[3] * kk0.w) + (S[4] * kk1.x + S[5] * kk1.y) + (S[6] * kk1.z + S[7] * kk1.w);
            sa = red8_sum(sa);
            S[0] = S[0] * w0.x + sa * nb0.x + vv * k0.x; S[1] = S[1] * w0.y + sa * nb0.y + vv * k0.y; S[2] = S[2] * w0.z + sa * nb0.z + vv * k0.z; S[3] = S[3] * w0.w + sa * nb0.w + vv * k0.w;
            S[4] = S[4] * w1.x + sa * nb1.x + vv * k1.x; S[5] = S[5] * w1.y + sa * nb1.y + vv * k1.y; S[6] = S[6] * w1.z + sa * nb1.z + vv * k1.z; S[7] = S[7] * w1.w + sa * nb1.w + vv * k1.w;
            float y = (S[0] * r0.x + S[1] * r0.y) + (S[2] * r0.z + S[3] * r0.w) + (S[4] * r1.x + S[5] * r1.y) + (S[6] * r1.z + S[7] * r1.w);
            y = red8_sum(y);
            if ((tid & 7) == 0) sy[s * 64 + srow] = y;
        }
        __syncthreads();
        {
            const int o = ls * 64 + lc; float y4[4]; float s1 = 0.f, bp = 0.f;
#pragma unroll
            for (int j = 0; j < 4; ++j) { y4[j] = sy[o + j]; s1 += y4[j]; bp += sr[o + j] * sk[o + j] * c_rk[j]; }
            s1 = red16_sum(s1);
            bp = red16_sum(bp);
            const float mean = s1 * (1.f / 64.f); float q = 0.f;
#pragma unroll
            for (int j = 0; j < 4; ++j) { y4[j] -= mean; q += y4[j] * y4[j]; }
            q = red16_sum(q);
            const float rstd = rsqrtf(q * (1.f / 64.f) + 64.0f * 1e-5f);
            float ov[4];
#pragma unroll
            for (int j = 0; j < 4; ++j) ov[j] = (y4[j] * rstd * c_lng[j] + c_lnb[j] + bp * sv[o + j]) * sg[o + j];
            uint2 w; w.x = pk2(ov[0], ov[1]); w.y = pk2(ov[2], ov[3]);
            *(uint2*)(A.ycat + (tok0 + (size_t)chunk * RW_CS + ls) * 1024 + hc) = w;
        }
        __syncthreads();
    }
}
struct MlstmArgs { const bf16_t* P0; const float* gates; const float* conv_w; const float* conv_b; const float* ig_b; const float* fg_b; const float* hn_g; const float* hn_b; bf16_t* ycat; };
constexpr int ML_QS = 132;
constexpr int ML_LDS_FLOATS = 64 * ML_QS + 64 * 128 + 64 * 64 + 64 * 65 + 64 * ML_QS + 4 * 8 * 128 + 64 * 10 + 512 + 128;
constexpr int ML_LDS_BYTES = ML_LDS_FLOATS * 4;

__device__ __forceinline__ void mlstm_unit(const MlstmArgs& A, int bh, float* smem) {
    float* qs = smem; float* ks = qs + 64 * ML_QS; bf16_t* vsb = (bf16_t*)(ks + 64 * 128); float* sc = ks + 64 * 128 + 64 * 64; float* hs = sc + 64 * 65; float* red = hs + 64 * ML_QS;
    float* sig = red + 4 * 8 * 128; float* slf = sig + 64; float* sb = slf + 64; float* smt = sb + 64; float* scarry = smt + 64; float* sden = scarry + 64; float* sws = sden + 64;
    float* smean = sws + 64; float* srstd = smean + 64; float* spad = srstd + 64; float* sdenp = spad + 64;   float* sn = sdenp + 512;
    const int tid = opaque_tid(); const int v = tid & 127, part = tid >> 7; const int b = bh >> 2, h = bh & 3;
    const size_t tok0 = (size_t)b * SEQ;
    const int cq = h * 128 + v;
    float wq[4], wk[4];
#pragma unroll
    for (int j = 0; j < 4; ++j) { wq[j] = A.conv_w[j * 1024 + cq]; wk[j] = A.conv_w[j * 1024 + 512 + cq]; }
    const float bq = A.conv_b[cq], bk = A.conv_b[512 + cq];
    const float igb = A.ig_b[h], fgb = A.fg_b[h];
    const float hng = A.hn_g[cq], hnb = A.hn_b[cq];
    float zq1 = 0.f, zq2 = 0.f, zq3 = 0.f, zk1 = 0.f, zk2 = 0.f, zk3 = 0.f;
    float C[32];
#pragma unroll
    for (int k = 0; k < 32; ++k) C[k] = 0.f;
    if (tid < 128) sn[tid] = 0.f;
    float m_run = 0.f;
    for (int chunk = 0; chunk < SEQ / 64; ++chunk) {
        const size_t row0 = tok0 + (size_t)chunk * 64;
        if (part == 0) {
            for (int t = 0; t < 64; ++t) { const bf16_t* pr = A.P0 + (row0 + t) * L0_MAIN;
                const float zq = bf2f(pr[1792 + cq]), zk = bf2f(pr[2304 + cq]);
                const float cvq = wq[3] * zq + wq[2] * zq1 + wq[1] * zq2 + wq[0] * zq3 + bq; const float cvk = wk[3] * zk + wk[2] * zk1 + wk[1] * zk2 + wk[0] * zk3 + bk;
                zq3 = zq2; zq2 = zq1; zq1 = zq; zk3 = zk2; zk2 = zk1; zk1 = zk;
                qs[t * ML_QS + v] = cvq * sigmoid_f(cvq) * 0.08838834764831845f; ks[t * 128 + v] = cvk * sigmoid_f(cvk); vsb[t * 128 + v] = pr[2816 + cq]; }
            if (tid < 64) { const float* gr = A.gates + (row0 + tid) * 16; sig[tid] = gr[h] + igb; slf[tid] = log_sigmoid_f(gr[4 + h] + fgb); }
        }
        __syncthreads();
        if (tid < 64) { float bsum = 0.f; for (int s = 0; s <= tid; ++s) bsum += slf[s]; sb[tid] = bsum; }
        __syncthreads();
        const float b_last = sb[63];
        float gmax = -INFINITY; for (int s = 0; s < 64; ++s) gmax = fmaxf(gmax, b_last - sb[s] + sig[s]);
        const float m_new = fmaxf(b_last + m_run, gmax); const float keep = __expf(b_last + m_run - m_new);
        if (tid < 64) { const float bt = sb[tid]; float mx = -INFINITY; for (int s = 0; s <= tid; ++s) mx = fmaxf(mx, bt - sb[s] + sig[s]);
            const float mt = fmaxf(bt + m_run, mx); smt[tid] = mt; scarry[tid] = __expf(bt + m_run - mt); sws[tid] = __expf(b_last - bt + sig[tid] - m_new); }
        __syncthreads();
        { const int t = tid & 63, sh = tid >> 6; const float bt = sb[t], mt = smt[t]; float dsum = 0.f;
            for (int s = sh * 8; s < sh * 8 + 8; ++s) { float val = 0.f;
                if (s <= t) { float dot = 0.f;
#pragma unroll 8
                    for (int k = 0; k < 128; k += 4) { const float4 qa = *(const float4*)(qs + t * ML_QS + k), kb = *(const float4*)(ks + s * 128 + k); dot += (qa.x * kb.x + qa.y * kb.y) + (qa.z * kb.z + qa.w * kb.w); }
                    val = dot * __expf(bt - sb[s] + sig[s] - mt); }
                sc[t * 65 + s] = val; dsum += val; }
            sdenp[sh * 64 + t] = dsum; }
        __syncthreads();
        if (tid < 64) { float qn = 0.f; for (int k = 0; k < 128; ++k) qn += qs[tid * ML_QS + k] * sn[k];
            float den = scarry[tid] * qn;
#pragma unroll
            for (int p = 0; p < 8; ++p) den += sdenp[p * 64 + tid];
            sden[tid] = fmaxf(fabsf(den), __expf(-smt[tid])); }
        __syncthreads();
        for (int batch = 0; batch < 8; ++batch) {
#pragma unroll 2
            for (int tt = 0; tt < 8; ++tt) { const int t = batch * 8 + tt; float qc = 0.f;
#pragma unroll
                for (int k = 0; k < 32; k += 4) { const float4 qa = *(const float4*)(qs + t * ML_QS + part * 32 + k); qc += (qa.x * C[k] + qa.y * C[k + 1]) + (qa.z * C[k + 2] + qa.w * C[k + 3]); }
                red[(part * 8 + tt) * 128 + v] = qc; }
            __syncthreads();
#pragma unroll
            for (int j = 0; j < 2; ++j) { const int tt = part * 2 + j, t = batch * 8 + tt;
                const float qc = (red[(0 * 8 + tt) * 128 + v] + red[(1 * 8 + tt) * 128 + v]) + (red[(2 * 8 + tt) * 128 + v] + red[(3 * 8 + tt) * 128 + v]);
                float acc = 0.f; for (int s = 0; s <= t; ++s) acc += sc[t * 65 + s] * bf2f(vsb[s * 128 + v]);
                hs[t * ML_QS + v] = (acc + scarry[t] * qc) / sden[t]; }
            __syncthreads();
        }
        { const int t = tid >> 3, oc = tid & 7; float s1 = 0.f;
#pragma unroll
            for (int k = 0; k < 16; ++k) s1 += hs[t * ML_QS + oc * 16 + k];
            s1 = red8_sum(s1); const float mean = s1 * (1.f / 128.f); float q = 0.f;
#pragma unroll
            for (int k = 0; k < 16; ++k) { const float d = hs[t * ML_QS + oc * 16 + k] - mean; q += d * d; }
            q = red8_sum(q); if (oc == 0) { smean[t] = mean; srstd[t] = rsqrtf(q * (1.f / 128.f) + LN_EPS); } }
        __syncthreads();
        for (int t = part * 16; t < part * 16 + 16; ++t) { const float hn = (hs[t * ML_QS + v] - smean[t]) * srstd[t] * hng + hnb; const float og = bf2f(A.P0[(row0 + t) * L0_MAIN + 3328 + cq]);
            A.ycat[(row0 + t) * 1024 + 512 + cq] = (bf16_t)f2bf(hn * sigmoid_f(og)); }
#pragma unroll
        for (int k = 0; k < 32; ++k) C[k] *= keep;
        for (int s = 0; s < 64; ++s) { const float wv = sws[s] * bf2f(vsb[s * 128 + v]);
#pragma unroll
            for (int k = 0; k < 32; k += 4) { const float4 kb = *(const float4*)(ks + s * 128 + part * 32 + k); C[k] += kb.x * wv; C[k + 1] += kb.y * wv; C[k + 2] += kb.z * wv; C[k + 3] += kb.w * wv; } }
        if (tid < 128) { float nn = keep * sn[tid]; for (int s = 0; s < 64; ++s) nn += sws[s] * ks[s * 128 + tid]; sn[tid] = nn; }
        m_run = m_new;
        __syncthreads();
    }
}

struct AttnArgs { const bf16_t* P1; const float* cum; const float* qn_g; const float* kn_g; bf16_t* out; };
constexpr int AT_LDS_BYTES = (2 * 32 * 64 + 32) * 4;
__device__ __forceinline__ void attn_unit_valu(const AttnArgs& A, int bh, int qb, float* smem) {
    float* Ks = smem; float* Vs = Ks + 2048; float* cj = Vs + 2048;
    const int tid = opaque_tid(); const int b = bh >> 4, h = bh & 15; const int hf = tid & 1; const int i = qb * 256 + (tid >> 1); const size_t row = (size_t)b * SEQ + i;
    float q[32], o[32];
    { float ss = 0.f;
#pragma unroll
        for (int c = 0; c < 4; ++c) { const uint4 w = *(const uint4*)(A.P1 + row * L1_MAIN + h * 64 + hf * 32 + c * 8); unpack8(w, q + c * 8); }
#pragma unroll
        for (int d = 0; d < 32; ++d) ss += q[d] * q[d];
        ss += __shfl_xor(ss, 1);
        const float r = rsqrtf(ss * (1.f / 64.f) + 1e-6f) * 0.125f;
#pragma unroll
        for (int d = 0; d < 32; ++d) { q[d] = q[d] * r * A.qn_g[h * 64 + hf * 32 + d]; o[d] = 0.f; } }
    const float ci = A.cum[(size_t)bh * SEQ + i];
    float m = -INFINITY, l = 0.f;
    const int ntiles = (qb * 256 + 256) / 32;
    const int lkey = tid >> 4, ld4 = (tid & 15) * 4;
    float kg[4];
#pragma unroll
    for (int j = 0; j < 4; ++j) kg[j] = A.kn_g[h * 64 + ld4 + j];
    for (int kt = 0; kt < ntiles; ++kt) {
        { const size_t krow = (size_t)b * SEQ + kt * 32 + lkey; float fk[4], fv[4];
            unpack4(*(const uint2*)(A.P1 + krow * L1_MAIN + 1024 + h * 64 + ld4), fk); unpack4(*(const uint2*)(A.P1 + krow * L1_MAIN + 2048 + h * 64 + ld4), fv);
            float ss = (fk[0] * fk[0] + fk[1] * fk[1]) + (fk[2] * fk[2] + fk[3] * fk[3]);
            ss = red16_sum(ss);
            const float r = rsqrtf(ss * (1.f / 64.f) + 1e-6f);
#pragma unroll
            for (int j = 0; j < 4; ++j) { Ks[lkey * 64 + ld4 + j] = fk[j] * r * kg[j]; Vs[lkey * 64 + ld4 + j] = fv[j]; }
            if ((tid & 15) == 0) cj[lkey] = A.cum[(size_t)bh * SEQ + kt * 32 + lkey]; }
        __syncthreads();
#pragma unroll 1
        for (int sub = 0; sub < 8; ++sub) {
            float s[4]; float mx = -INFINITY;
#pragma unroll
            for (int jj = 0; jj < 4; ++jj) { const int j = sub * 4 + jj; float dot = 0.f;
#pragma unroll
                for (int d = 0; d < 32; d += 4) { const float4 kv = *(const float4*)(Ks + j * 64 + hf * 32 + d); dot += (q[d] * kv.x + q[d + 1] * kv.y) + (q[d + 2] * kv.z + q[d + 3] * kv.w); }
                dot += __shfl_xor(dot, 1);
                float sv_ = dot + ci - cj[j]; if (kt * 32 + j > i) sv_ = -INFINITY; s[jj] = sv_; mx = fmaxf(mx, sv_); }
            const float mnew = fmaxf(m, mx); const float scl = __expf(m - mnew); float psum = 0.f;
#pragma unroll
            for (int jj = 0; jj < 4; ++jj) { s[jj] = __expf(s[jj] - mnew); psum += s[jj]; }
            l = l * scl + psum; m = mnew;
#pragma unroll
            for (int d = 0; d < 32; ++d) o[d] *= scl;
#pragma unroll
            for (int jj = 0; jj < 4; ++jj) { const int j = sub * 4 + jj; const float p = s[jj];
#pragma unroll
                for (int d = 0; d < 32; d += 4) { const float4 vv = *(const float4*)(Vs + j * 64 + hf * 32 + d); o[d] += p * vv.x; o[d + 1] += p * vv.y; o[d + 2] += p * vv.z; o[d + 3] += p * vv.w; } }
        }
        __syncthreads();
    }
    const float il = 1.0f / l;
#pragma unroll
    for (int c = 0; c < 4; ++c) { float og[8]; unpack8(*(const uint4*)(A.P1 + row * L1_MAIN + 3072 + h * 64 + hf * 32 + c * 8), og);
        uint4 w; w.x = pk2(o[c * 8 + 0] * il * sigmoid_f(og[0]), o[c * 8 + 1] * il * sigmoid_f(og[1])); w.y = pk2(o[c * 8 + 2] * il * sigmoid_f(og[2]), o[c * 8 + 3] * il * sigmoid_f(og[3]));
        w.z = pk2(o[c * 8 + 4] * il * sigmoid_f(og[4]), o[c * 8 + 5] * il * sigmoid_f(og[5])); w.w = pk2(o[c * 8 + 6] * il * sigmoid_f(og[6]), o[c * 8 + 7] * il * sigmoid_f(og[7]));
        *(uint4*)(A.out + row * 1024 + h * 64 + hf * 32 + c * 8) = w; }
}
__device__ __forceinline__ void attn_valu_phase(const AttnArgs& A, int bid, int nblk, float* smem) {
    for (int su = bid; su < 256; su += nblk) { const int bh = su >> 1, pr = su & 1;
#pragma unroll 1
        for (int u = 0; u < 4; ++u) { const int qb = (u == 0) ? pr : (u == 1) ? 7 - pr : (u == 2) ? 2 + pr : 5 - pr; attn_unit_valu(A, bh, qb, smem); } }
}

struct PeerSArgs { const bf16_t* Q; const bf16_t* K1b; const bf16_t* K2b; int* eid; float* gate; };
constexpr int PS_QT = 0, PS_KB = 64 * 528, PS_KB2 = PS_KB + 128 * 272, PS_L1 = PS_KB + 2 * 128 * 272, PS_L2 = PS_L1 + 4096, PS_LDS_BYTES = PS_L2 + 4096;
__device__ __forceinline__ unsigned ord_f(float f) { const unsigned b = __float_as_uint(f); return b ^ ((b >> 31) ? 0xFFFFFFFFu : 0x80000000u); }
__device__ __forceinline__ float unord_f(unsigned u) { const unsigned b = (u & 0x80000000u) ? (u ^ 0x80000000u) : ~u; return __uint_as_float(b); }
#define TOPK_INSERT(L, x) do { unsigned x_ = (x); _Pragma("unroll") for (int q_ = 0; q_ < 16; ++q_) { const unsigned hi_ = max(L[q_], x_); x_ = min(L[q_], x_); L[q_] = hi_; } } while (0)

__device__ __forceinline__ void peer_scores_unit(const PeerSArgs& A, int tile, int h, unsigned char* smem) {
    const int tid = opaque_tid(), lane = tid & 63, wv = tid >> 6;
#pragma unroll
    for (int i = 0; i < 4; ++i) { const int idx = tid + 512 * i; const int row = idx >> 5, c = idx & 31;
        *(uint4*)(smem + PS_QT + row * 528 + c * 16) = *(const uint4*)(A.Q + (size_t)(tile * 64 + row) * 2048 + h * 256 + c * 8); }
#pragma unroll
    for (int i = 0; i < 4; ++i) { const int idx = tid + 512 * i; const int row = idx >> 4, c = idx & 15;
        *(uint4*)(smem + PS_KB + row * 272 + c * 16) = *(const uint4*)(A.K1b + (size_t)(h * 128 + row) * 128 + c * 8);
        *(uint4*)(smem + PS_KB2 + row * 272 + c * 16) = *(const uint4*)(A.K2b + (size_t)(h * 128 + row) * 128 + c * 8); }
    __syncthreads();
    const int half = wv >> 2, mt = wv & 3; const int fr = lane & 15, fq = lane >> 4;
    f32x4_t acc[8];
#pragma unroll
    for (int n = 0; n < 8; ++n) acc[n] = (f32x4_t){0.f, 0.f, 0.f, 0.f};
    { const unsigned char* qbase = smem + PS_QT + (16 * mt + fr) * 528 + (half * 128 + 8 * fq) * 2; const unsigned char* kbase = smem + (half ? PS_KB2 : PS_KB) + fr * 272 + (8 * fq) * 2;
#pragma unroll
        for (int ks = 0; ks < 4; ++ks) { const bf16x8_t qf = *(const bf16x8_t*)(qbase + ks * 64);
#pragma unroll
            for (int n = 0; n < 8; ++n) { const bf16x8_t kf = *(const bf16x8_t*)(kbase + n * 16 * 272 + ks * 64); acc[n] = __builtin_amdgcn_mfma_f32_16x16x32_bf16(kf, qf, acc[n], 0, 0, 0); } } }
    __syncthreads();
    { float* sT = (float*)(smem + PS_KB + half * 128 * 272);
#pragma unroll
        for (int n = 0; n < 8; ++n)
#pragma unroll
            for (int r = 0; r < 4; ++r) sT[(16 * n + 4 * fq + r) * 68 + 16 * mt + fr] = acc[n][r]; }
    __syncthreads();
    unsigned* part = (unsigned*)(smem + PS_QT);
    { const int qt = wv & 3; const float* sT = (const float*)(smem + PS_KB + half * 128 * 272); unsigned L[16];
#pragma unroll
        for (int j = 0; j < 16; ++j) L[j] = 0u;
#pragma unroll 4
        for (int kk = 0; kk < 32; ++kk) { const int key = 32 * qt + kk; const unsigned u = (ord_f(sT[key * 68 + lane]) & ~0x7Fu) | (unsigned)(127 - key); TOPK_INSERT(L, u); }
        unsigned* dst = part + (half * 4 + qt) * 1024;
#pragma unroll
        for (int j = 0; j < 16; ++j) dst[j * 64 + lane] = L[j]; }
    __syncthreads();
#pragma unroll 1
    for (int round = 0; round < 2; ++round) { const int qt = wv & 3; const int step = 1 << round;
        if ((qt & (2 * step - 1)) == 0) { unsigned* pa = part + (half * 4 + qt) * 1024; const unsigned* pb = part + (half * 4 + qt + step) * 1024; unsigned C[16];
#pragma unroll
            for (int j = 0; j < 16; ++j) C[j] = max(pa[j * 64 + lane], pb[(15 - j) * 64 + lane]);
#pragma unroll
            for (int d = 8; d >= 1; d >>= 1)
#pragma unroll
                for (int j = 0; j < 16; ++j) if ((j & d) == 0) { const unsigned hi_ = max(C[j], C[j + d]), lo_ = min(C[j], C[j + d]); C[j] = hi_; C[j + d] = lo_; }
            unsigned* dst = (round == 1) ? (unsigned*)(smem + (half ? PS_L2 : PS_L1)) : pa;
#pragma unroll
            for (int j = 0; j < 16; ++j) dst[j * 64 + lane] = C[j]; }
        __syncthreads(); }
    if (wv == 0) { const unsigned* l1 = (const unsigned*)(smem + PS_L1); const unsigned* l2 = (const unsigned*)(smem + PS_L2);
        float v1[16], v2[16];
#pragma unroll
        for (int j = 0; j < 16; ++j) { v1[j] = unord_f(l1[j * 64 + lane]); v2[j] = unord_f(l2[j * 64 + lane]); }
        unsigned L[16];
#pragma unroll
        for (int j = 0; j < 16; ++j) L[j] = (ord_f(v1[0] + v2[j]) & ~0xFFu) | (unsigned)(255 - j);
#pragma unroll
        for (int i = 1; i < 16; ++i)
#pragma unroll
            for (int j = 0; j < 16; ++j) if ((i + 1) * (j + 1) <= 16) { const unsigned u = (ord_f(v1[i] + v2[j]) & ~0xFFu) | (unsigned)(255 - (i * 16 + j)); TOPK_INSERT(L, u); }
        float e[16]; float sum = 0.f; const float mx = unord_f(L[0]);
#pragma unroll
        for (int k = 0; k < 16; ++k) { e[k] = __expf(unord_f(L[k]) - mx); sum += e[k]; }
        const float inv = 1.0f / sum; const size_t ob = (size_t)(tile * 64 + lane) * 128 + h * 16;
        int eo[16];
#pragma unroll
        for (int k = 0; k < 16; ++k) { const int idx = 255 - (int)(L[k] & 0xFFu); const int i = idx >> 4, j = idx & 15;
            const int e1 = 127 - (int)(l1[i * 64 + lane] & 0x7Fu), e2 = 127 - (int)(l2[j * 64 + lane] & 0x7Fu); eo[k] = e1 * 128 + e2; }
#pragma unroll
        for (int c = 0; c < 4; ++c) { *(int4*)(A.eid + ob + 4 * c) = make_int4(eo[4 * c], eo[4 * c + 1], eo[4 * c + 2], eo[4 * c + 3]);
            *(float4*)(A.gate + ob + 4 * c) = make_float4(e[4 * c] * inv, e[4 * c + 1] * inv, e[4 * c + 2] * inv, e[4 * c + 3] * inv); } }
    __syncthreads();
}
__device__ __forceinline__ void peer_scores_phase(const PeerSArgs& A, int bid, int nblk, unsigned char* smem) {
    for (int u = bid; u < 256 * 8; u += nblk) peer_scores_unit(A, u >> 3, u & 7, smem);
}

typedef float f32x2_t __attribute__((ext_vector_type(2)));
__device__ __forceinline__ void cvt_fp8_rows_phase(const float* __restrict__ src, unsigned char* __restrict__ dst, float* __restrict__ inv_scale, int bid, int nblk) {
    const int tid = opaque_tid(); const int lane = tid & 63, wv = tid >> 6;
    for (int r = bid * 8 + wv; r < 16384; r += nblk * 8) {
        float f[16]; float mx = 0.f;
#pragma unroll
        for (int c = 0; c < 4; ++c) { const float4 v = *(const float4*)(src + (size_t)r * 1024 + 16 * lane + 4 * c); f[4 * c] = v.x; f[4 * c + 1] = v.y; f[4 * c + 2] = v.z; f[4 * c + 3] = v.w;
            mx = fmaxf(fmaxf(mx, fmaxf(fabsf(v.x), fabsf(v.y))), fmaxf(fabsf(v.z), fabsf(v.w))); }
        mx = wave_max(mx);
        const float sc = (mx > 0.f) ? 240.0f / mx : 1.0f;
        unsigned w[4];
#pragma unroll
        for (int c = 0; c < 4; ++c) { int p = 0; p = __builtin_amdgcn_cvt_pk_fp8_f32(f[4 * c] * sc, f[4 * c + 1] * sc, p, false); p = __builtin_amdgcn_cvt_pk_fp8_f32(f[4 * c + 2] * sc, f[4 * c + 3] * sc, p, true); w[c] = (unsigned)p; }
        *(uint4*)(dst + (size_t)r * 1024 + 16 * lane) = make_uint4(w[0], w[1], w[2], w[3]);
        if (lane == 0) inv_scale[r] = (mx > 0.f) ? mx * (1.0f / 240.0f) : 1.0f;
    }
}
__device__ __forceinline__ void cvt_i8_rows_phase(const float* __restrict__ src, unsigned char* __restrict__ dst, float* __restrict__ inv_scale, int bid, int nblk) {
    const int tid = opaque_tid(); const int lane = tid & 63, wv = tid >> 6;
    for (int r = bid * 8 + wv; r < 16384; r += nblk * 8) {
        float f[16]; float mx = 0.f;
#pragma unroll
        for (int c = 0; c < 4; ++c) { const float4 v = *(const float4*)(src + (size_t)r * 1024 + 16 * lane + 4 * c); f[4 * c] = v.x; f[4 * c + 1] = v.y; f[4 * c + 2] = v.z; f[4 * c + 3] = v.w;
            mx = fmaxf(fmaxf(mx, fmaxf(fabsf(v.x), fabsf(v.y))), fmaxf(fabsf(v.z), fabsf(v.w))); }
        mx = wave_max(mx);
        const float sc = (mx > 0.f) ? 127.0f / mx : 1.0f;
        unsigned w[4];
#pragma unroll
        for (int c = 0; c < 4; ++c) { const int q0 = __float2int_rn(f[4 * c] * sc), q1 = __float2int_rn(f[4 * c + 1] * sc), q2 = __float2int_rn(f[4 * c + 2] * sc), q3 = __float2int_rn(f[4 * c + 3] * sc);
            w[c] = (unsigned)(q0 & 0xFF) | ((unsigned)(q1 & 0xFF) << 8) | ((unsigned)(q2 & 0xFF) << 16) | ((unsigned)(q3 & 0xFF) << 24); }
        *(uint4*)(dst + (size_t)r * 1024 + 16 * lane) = make_uint4(w[0], w[1], w[2], w[3]);
        if (lane == 0) inv_scale[r] = (mx > 0.f) ? mx * (1.0f / 127.0f) : 1.0f;
    }
}
__device__ __forceinline__ void unpack_fp8x16(const uint4 w, float* f) {
    const unsigned ww[4] = {w.x, w.y, w.z, w.w};
#pragma unroll
    for (int c = 0; c < 4; ++c) { const f32x2_t lo = __builtin_amdgcn_cvt_pk_f32_fp8((int)ww[c], false), hi = __builtin_amdgcn_cvt_pk_f32_fp8((int)ww[c], true); f[4 * c] = lo[0]; f[4 * c + 1] = lo[1]; f[4 * c + 2] = hi[0]; f[4 * c + 3] = hi[1]; }
}
struct PeerGArgs { const float* X; float* Xo; const int* eid; const float* gate; const unsigned char* U; const unsigned char* V; const float* Us; const float* Vs; const float* lng; const float* lnb; bf16_t* xb; };
__device__ __forceinline__ void peer_gather_token(const PeerGArgs& A, int t, int lane) {
    float x[16];
#pragma unroll
    for (int c = 0; c < 4; ++c) { const float4 v = *(const float4*)(A.X + (size_t)t * 1024 + 16 * lane + 4 * c); x[4 * c] = v.x; x[4 * c + 1] = v.y; x[4 * c + 2] = v.z; x[4 * c + 3] = v.w; }
    const int e_lo = A.eid[(size_t)t * 128 + lane], e_hi = A.eid[(size_t)t * 128 + 64 + lane];
    const float g_lo = A.gate[(size_t)t * 128 + lane], g_hi = A.gate[(size_t)t * 128 + 64 + lane];
    const float us_lo = A.Us[e_lo], us_hi = A.Us[e_hi], vs_lo = A.Vs[e_lo], vs_hi = A.Vs[e_hi];
    float acc[16];
#pragma unroll
    for (int j = 0; j < 16; ++j) acc[j] = 0.f;
    for (int k0 = 0; k0 < 128; k0 += 8) {
        uint4 u[8], v[8]; float g[8], us[8];
#pragma unroll
        for (int i = 0; i < 8; ++i) { const int k = k0 + i; const int e = __shfl(k0 < 64 ? e_lo : e_hi, k & 63); g[i] = __shfl(k0 < 64 ? g_lo : g_hi, k & 63) * __shfl(k0 < 64 ? vs_lo : vs_hi, k & 63); us[i] = __shfl(k0 < 64 ? us_lo : us_hi, k & 63);
            u[i] = *(const uint4*)(A.U + (size_t)e * 1024 + 16 * lane); v[i] = *(const uint4*)(A.V + (size_t)e * 1024 + 16 * lane); }
#pragma unroll
        for (int i = 0; i < 8; ++i) { float f[16]; unpack_fp8x16(u[i], f); float dot = 0.f;
#pragma unroll
            for (int j = 0; j < 16; ++j) dot += x[j] * f[j];
            dot = wave_sum(dot) * us[i];
            const float c = g[i] * 0.5f * dot * (1.0f + erff(dot * 0.7071067811865476f));
            unpack_fp8x16(v[i], f);
#pragma unroll
            for (int j = 0; j < 16; ++j) acc[j] += c * f[j]; }
    }
    float s = 0.f;
#pragma unroll
    for (int j = 0; j < 16; ++j) { acc[j] += DN_ALPHA * x[j]; s += acc[j]; }
    const float mean = wave_sum(s) * (1.f / 1024.f); float q = 0.f;
#pragma unroll
    for (int j = 0; j < 16; ++j) { acc[j] -= mean; q += acc[j] * acc[j]; }
    const float rstd = rsqrtf(wave_sum(q) * (1.f / 1024.f) + LN_EPS);
    float ov[16];
#pragma unroll
    for (int c = 0; c < 4; ++c) { const float4 gg = *(const float4*)(A.lng + 16 * lane + 4 * c), bb = *(const float4*)(A.lnb + 16 * lane + 4 * c);
        ov[4 * c] = acc[4 * c] * rstd * gg.x + bb.x; ov[4 * c + 1] = acc[4 * c + 1] * rstd * gg.y + bb.y; ov[4 * c + 2] = acc[4 * c + 2] * rstd * gg.z + bb.z; ov[4 * c + 3] = acc[4 * c + 3] * rstd * gg.w + bb.w;
        *(float4*)(A.Xo + (size_t)t * 1024 + 16 * lane + 4 * c) = make_float4(ov[4 * c], ov[4 * c + 1], ov[4 * c + 2], ov[4 * c + 3]); }
    *(uint4*)(A.xb + (size_t)t * 1024 + 16 * lane) = make_uint4(pk2(ov[0], ov[1]), pk2(ov[2], ov[3]), pk2(ov[4], ov[5]), pk2(ov[6], ov[7]));
    *(uint4*)(A.xb + (size_t)t * 1024 + 16 * lane + 8) = make_uint4(pk2(ov[8], ov[9]), pk2(ov[10], ov[11]), pk2(ov[12], ov[13]), pk2(ov[14], ov[15]));
}
__device__ __forceinline__ void peer_gather_phase(const PeerGArgs& A, int bid, int nblk) {
    const int tid = opaque_tid(); const int lane = tid & 63, wv = tid >> 6;
    for (int t = bid * 8 + wv; t < T_TOK; t += nblk * 8) peer_gather_token(A, t, lane);
}

namespace mlm {
typedef __attribute__((address_space(3))) unsigned char lds_u8;
typedef short v4i16_t __attribute__((ext_vector_type(4)));
typedef unsigned u32x4_t __attribute__((ext_vector_type(4)));
typedef unsigned u32x2_t __attribute__((ext_vector_type(2)));
#define MLM_LDS(T, off) (*(__attribute__((address_space(3))) T*)(smem + (off)))
constexpr int RS = 136;
constexpr int OFF_QS = 0, OFF_KS = OFF_QS + 64 * RS * 2, OFF_VS = OFF_KS + 64 * RS * 2, OFF_OG = OFF_VS + 64 * RS * 2, OFF_CT = OFF_OG + 64 * RS * 2, OFF_SC = OFF_CT + 128 * RS * 2, OFF_F = OFF_SC + 64 * 72 * 2;
constexpr int F_SIG = 0, F_SLF = 64, F_SU = 128, F_SBM = 192, F_CARRY = 256, F_WS = 320, F_SEN = 384, F_SQN = 448, F_DENP = 512, F_STAT = 640, F_SN = 896, F_SCAL = 1024, F_HNG = 1032, F_HNB = 1160, F_END = 1288;
constexpr int LDS_BYTES = OFF_F + F_END * 4;
__device__ __forceinline__ bf16x8_t tr_frag(const lds_u8* p, int row_stride_bytes) {
    const v4i16_t lo = __builtin_amdgcn_ds_read_tr16_b64_v4i16((__attribute__((address_space(3))) v4i16_t*)p);
    const v4i16_t hi = __builtin_amdgcn_ds_read_tr16_b64_v4i16((__attribute__((address_space(3))) v4i16_t*)(p + 4 * row_stride_bytes));
    return (bf16x8_t){lo[0], lo[1], lo[2], lo[3], hi[0], hi[1], hi[2], hi[3]};
}
#define MLM_LOAD_RAW(chunk) do { const size_t r0_ = tok0 + (size_t)(chunk) * 64 + 2 * tp; const bf16_t* pb_ = A.P0 + r0_ * L0_MAIN + h * 128 + 8 * g; \
    rq[0] = *(const uint4*)(pb_ + 1792); rq[1] = *(const uint4*)(pb_ + L0_MAIN + 1792); rk[0] = *(const uint4*)(pb_ + 2304); rk[1] = *(const uint4*)(pb_ + L0_MAIN + 2304); \
    rv[0] = *(const uint4*)(pb_ + 2816); rv[1] = *(const uint4*)(pb_ + L0_MAIN + 2816); rog[0] = *(const uint4*)(pb_ + 3328); rog[1] = *(const uint4*)(pb_ + L0_MAIN + 3328); \
    if (tid < 64) { const float* gr_ = A.gates + (tok0 + (size_t)(chunk) * 64 + tid) * 16; rgi = gr_[h]; rgf = gr_[4 + h]; } } while (0)

struct MlState { f32x4_t Cacc[8]; float m_old; };
__device__ __forceinline__ void mlstm_unit_mfma(const MlstmArgs& A, int bh, unsigned char* smem_g, int c_begin, int c_end, MlState& st) {
    lds_u8* smem = (lds_u8*)smem_g;
    __attribute__((address_space(3))) float* F = (__attribute__((address_space(3))) float*)(smem + OFF_F);
    const int tid0 = opaque_tid(); const int b = bh >> 2, h = bh & 3;
    const size_t tok0 = (size_t)b * SEQ;
#define MLM_IDX() int tid = tid0; asm volatile("" : "+v"(tid)); const int lane = tid & 63, w = __builtin_amdgcn_readfirstlane(tid >> 6), fr = lane & 15, fq = lane >> 4; \
    const int g = tid & 15, tp = tid >> 4;   const int mt = w & 3, nh = w >> 2;   \
    (void)lane; (void)fr; (void)fq; (void)g; (void)tp; (void)mt; (void)nh
    if (c_begin == 0) {
    MLM_IDX();
    for (int i = tid; i < 128 * RS / 2; i += NTHR) ((__attribute__((address_space(3))) unsigned*)(smem + OFF_CT))[i] = 0u;
    if (tid < 128) F[F_SN + tid] = 0.f;
    if (tid < 128) { F[F_HNG + tid] = A.hn_g[h * 128 + tid]; F[F_HNB + tid] = A.hn_b[h * 128 + tid]; }
#pragma unroll
    for (int n = 0; n < 8; ++n) st.Cacc[n] = (f32x4_t){0.f, 0.f, 0.f, 0.f};
    st.m_old = 0.f;
    }
    const float igb = A.ig_b[h], fgb = A.fg_b[h];
    f32x4_t Cacc[8];
#pragma unroll
    for (int n = 0; n < 8; ++n) Cacc[n] = st.Cacc[n];
    float m_old = st.m_old;
    uint4 rq[2], rk[2], rv[2], rog[2]; float rgi = 0.f, rgf = 0.f;
    { MLM_IDX(); MLM_LOAD_RAW(c_begin); }
    __syncthreads();
    for (int chunk_ = c_begin; chunk_ < c_end; ++chunk_) {
        int chunk = chunk_; asm volatile("" : "+s"(chunk));
        MLM_IDX();
        const size_t row0 = tok0 + (size_t)chunk * 64;
        {
#pragma unroll
            for (int r = 0; r < 2; ++r) { const int off = ((2 * tp + r) * RS + 8 * g) * 2;
                MLM_LDS(u32x4_t, OFF_QS + off) = (u32x4_t){rq[r].x, rq[r].y, rq[r].z, rq[r].w}; MLM_LDS(u32x4_t, OFF_KS + off) = (u32x4_t){rk[r].x, rk[r].y, rk[r].z, rk[r].w};
                MLM_LDS(u32x4_t, OFF_VS + off) = (u32x4_t){rv[r].x, rv[r].y, rv[r].z, rv[r].w}; MLM_LDS(u32x4_t, OFF_OG + off) = (u32x4_t){rog[r].x, rog[r].y, rog[r].z, rog[r].w}; }
            if (tid < 64) { F[F_SIG + tid] = rgi + igb; F[F_SLF + tid] = log_sigmoid_f(rgf + fgb); }
        }
        LDS_BARRIER();
        if (chunk + 1 < c_end) MLM_LOAD_RAW(chunk + 1);
        if (w == 0) {
            const float ig = F[F_SIG + lane], lf = F[F_SLF + lane];
            const float bs = wave_scan_sum(lf);
            const float u = ig - bs; const float pm = wave_scan_max(u);
            const float mtv = bs + fmaxf(m_old, pm);
            const float b_last = __shfl(bs, 63), pm_last = __shfl(pm, 63);
            const float m_new = fmaxf(b_last + m_old, b_last + pm_last);
            F[F_SU + lane] = u; F[F_SBM + lane] = bs - mtv; F[F_CARRY + lane] = __expf(bs + m_old - mtv); F[F_WS + lane] = __expf(b_last + u - m_new); F[F_SEN + lane] = __expf(-mtv);
            if (lane == 0) F[F_SCAL] = __expf(b_last + m_old - m_new);
            m_old = m_new;
        }
        bf16x8_t qf[4];
#pragma unroll
        for (int ks = 0; ks < 4; ++ks) qf[ks] = *(const __attribute__((address_space(3))) bf16x8_t*)(smem + OFF_QS + ((16 * mt + fr) * RS + 32 * ks + 8 * fq) * 2);
        f32x4_t sacc[2];
#pragma unroll
        for (int n2 = 0; n2 < 2; ++n2) { sacc[n2] = (f32x4_t){0.f, 0.f, 0.f, 0.f};
#pragma unroll
            for (int ks = 0; ks < 4; ++ks) { const bf16x8_t kf = *(const __attribute__((address_space(3))) bf16x8_t*)(smem + OFF_KS + ((16 * (2 * nh + n2) + fr) * RS + 32 * ks + 8 * fq) * 2);
                sacc[n2] = __builtin_amdgcn_mfma_f32_16x16x32_bf16(qf[ks], kf, sacc[n2], 0, 0, 0); } }
        { const int t = tid >> 3, p = tid & 7; float f16[16];
            { const u32x4_t a_ = MLM_LDS(u32x4_t, OFF_QS + (t * RS + 16 * p) * 2), b_ = MLM_LDS(u32x4_t, OFF_QS + (t * RS + 16 * p + 8) * 2);
              unpack8(make_uint4(a_[0], a_[1], a_[2], a_[3]), f16); unpack8(make_uint4(b_[0], b_[1], b_[2], b_[3]), f16 + 8); }
            float qn = 0.f;
#pragma unroll
            for (int k = 0; k < 16; ++k) qn += f16[k] * F[F_SN + 16 * p + k];
            qn = red8_sum(qn); if (p == 0) F[F_SQN + t] = qn; }
        LDS_BARRIER();
        {
            const f32x4_t bm = *(const __attribute__((address_space(3))) f32x4_t*)(F + F_SBM + 16 * mt + 4 * fq); float rs[4] = {0.f, 0.f, 0.f, 0.f};
#pragma unroll
            for (int n2 = 0; n2 < 2; ++n2) { const int s = 16 * (2 * nh + n2) + fr; const float us = F[F_SU + s];
#pragma unroll
                for (int r = 0; r < 4; ++r) { const int t = 16 * mt + 4 * fq + r; const float wgt = __expf(bm[r] + us); const float val = (s <= t) ? sacc[n2][r] * wgt : 0.f; rs[r] += val;
                    *(__attribute__((address_space(3))) bf16_t*)(smem + OFF_SC + (t * 72 + s) * 2) = (bf16_t)f2bf(val); } }
#pragma unroll
            for (int r = 0; r < 4; ++r) { float v = rs[r]; v = red16_sum(v); if (fr == 0) F[F_DENP + nh * 64 + 16 * mt + 4 * fq + r] = v; }
        }
        LDS_BARRIER();
        f32x4_t nacc[4], qacc[4];
#pragma unroll
        for (int j = 0; j < 4; ++j) { nacc[j] = (f32x4_t){0.f, 0.f, 0.f, 0.f}; qacc[j] = (f32x4_t){0.f, 0.f, 0.f, 0.f}; }
#pragma unroll
        for (int ks = 0; ks < 2; ++ks) { const bf16x8_t af = *(const __attribute__((address_space(3))) bf16x8_t*)(smem + OFF_SC + ((16 * mt + fr) * 72 + 32 * ks + 8 * fq) * 2);
#pragma unroll
            for (int j = 0; j < 4; ++j) { const bf16x8_t vf = tr_frag(smem + OFF_VS + ((32 * ks + 8 * fq + (fr >> 2)) * RS + 16 * (4 * nh + j) + 4 * (fr & 3)) * 2, RS * 2);
                nacc[j] = __builtin_amdgcn_mfma_f32_16x16x32_bf16(af, vf, nacc[j], 0, 0, 0); }
            __builtin_amdgcn_sched_barrier(0); }
#pragma unroll
        for (int ks = 0; ks < 4; ++ks) { const bf16x8_t qf2 = *(const __attribute__((address_space(3))) bf16x8_t*)(smem + OFF_QS + ((16 * mt + fr) * RS + 32 * ks + 8 * fq) * 2);
#pragma unroll
            for (int j = 0; j < 4; ++j) { const bf16x8_t cf = *(const __attribute__((address_space(3))) bf16x8_t*)(smem + OFF_CT + ((16 * (4 * nh + j) + fr) * RS + 32 * ks + 8 * fq) * 2);
                qacc[j] = __builtin_amdgcn_mfma_f32_16x16x32_bf16(qf2, cf, qacc[j], 0, 0, 0); }
            __builtin_amdgcn_sched_barrier(0); }
        float hv[4][4];
        {
            const f32x4_t cy = *(const __attribute__((address_space(3))) f32x4_t*)(F + F_CARRY + 16 * mt + 4 * fq), d0 = *(const __attribute__((address_space(3))) f32x4_t*)(F + F_DENP + 16 * mt + 4 * fq),
                          d1 = *(const __attribute__((address_space(3))) f32x4_t*)(F + F_DENP + 64 + 16 * mt + 4 * fq), qn = *(const __attribute__((address_space(3))) f32x4_t*)(F + F_SQN + 16 * mt + 4 * fq),
                          en = *(const __attribute__((address_space(3))) f32x4_t*)(F + F_SEN + 16 * mt + 4 * fq);
#pragma unroll
            for (int r = 0; r < 4; ++r) { const float den = d0[r] + d1[r] + cy[r] * qn[r]; const float inv = 1.0f / fmaxf(fabsf(den), en[r]); float s1 = 0.f, s2 = 0.f;
#pragma unroll
                for (int j = 0; j < 4; ++j) { const float hh = (nacc[j][r] + cy[r] * qacc[j][r]) * inv; hv[j][r] = hh; s1 += hh; s2 += hh * hh; }
                s1 = red16_sum(s1);
                s2 = red16_sum(s2);
                if (fr == 0) { F[F_STAT + (nh * 64 + 16 * mt + 4 * fq + r) * 2] = s1; F[F_STAT + (nh * 64 + 16 * mt + 4 * fq + r) * 2 + 1] = s2; } }
        }
        LDS_BARRIER();
        {
#pragma unroll
            for (int r = 0; r < 4; ++r) { const int t = 16 * mt + 4 * fq + r;
                const float s1 = F[F_STAT + t * 2] + F[F_STAT + (64 + t) * 2], s2 = F[F_STAT + t * 2 + 1] + F[F_STAT + (64 + t) * 2 + 1];
                const float mean = s1 * (1.f / 128.f); const float var = fmaxf(s2 * (1.f / 128.f) - mean * mean, 0.f); const float rstd = rsqrtf(var + LN_EPS);
#pragma unroll
                for (int j = 0; j < 4; ++j) { const int v = 16 * (4 * nh + j) + fr; const float og = bf2f(*(const __attribute__((address_space(3))) bf16_t*)(smem + OFF_OG + (t * RS + v) * 2));
                    const float o = ((hv[j][r] - mean) * rstd * F[F_HNG + v] + F[F_HNB + v]) * og;
                    A.ycat[(row0 + t) * 1024 + 512 + h * 128 + v] = (bf16_t)f2bf(o); } }
        }
        {
            const float keep = F[F_SCAL];
#pragma unroll
            for (int n = 0; n < 8; ++n) Cacc[n] = Cacc[n] * keep;
#pragma unroll
            for (int ks = 0; ks < 2; ++ks) {
                const bf16x8_t kraw = tr_frag(smem + OFF_KS + ((32 * ks + 8 * fq + (fr >> 2)) * RS + 16 * w + 4 * (fr & 3)) * 2, RS * 2);
                const f32x4_t w0 = *(const __attribute__((address_space(3))) f32x4_t*)(F + F_WS + 32 * ks + 8 * fq), w1 = *(const __attribute__((address_space(3))) f32x4_t*)(F + F_WS + 32 * ks + 8 * fq + 4);
                float kfv[8];
#pragma unroll
                for (int j = 0; j < 8; ++j) kfv[j] = bf2f((bf16_t)kraw[j]) * (j < 4 ? w0[j] : w1[j - 4]);
                const u32x4_t pk = (u32x4_t){pk2(kfv[0], kfv[1]), pk2(kfv[2], kfv[3]), pk2(kfv[4], kfv[5]), pk2(kfv[6], kfv[7])};
                const bf16x8_t af = __builtin_bit_cast(bf16x8_t, pk);
#pragma unroll
                for (int n = 0; n < 8; ++n) { const bf16x8_t vf = tr_frag(smem + OFF_VS + ((32 * ks + 8 * fq + (fr >> 2)) * RS + 16 * n + 4 * (fr & 3)) * 2, RS * 2);
                    Cacc[n] = __builtin_amdgcn_mfma_f32_16x16x32_bf16(af, vf, Cacc[n], 0, 0, 0); }
                __builtin_amdgcn_sched_barrier(0); }
#pragma unroll
            for (int n = 0; n < 8; ++n) MLM_LDS(u32x2_t, OFF_CT + ((16 * n + fr) * RS + 16 * w + 4 * fq) * 2) = (u32x2_t){pk2(Cacc[n][0], Cacc[n][1]), pk2(Cacc[n][2], Cacc[n][3])};
            if (tid < 128) { float nn = keep * F[F_SN + tid];
#pragma unroll 16
                for (int s = 0; s < 64; ++s) nn += F[F_WS + s] * bf2f(*(const __attribute__((address_space(3))) bf16_t*)(smem + OFF_KS + (s * RS + tid) * 2));
                F[F_SN + tid] = nn; }
        }
        LDS_BARRIER();
    }
#pragma unroll
    for (int n = 0; n < 8; ++n) st.Cacc[n] = Cacc[n];
    st.m_old = m_old;
}
#undef MLM_LOAD_RAW
#undef MLM_IDX
#undef MLM_LDS
}

namespace rwc {
typedef __attribute__((address_space(3))) unsigned char lds_u8;
typedef short v4i16_t __attribute__((ext_vector_type(4)));
typedef unsigned u32x4_t __attribute__((ext_vector_type(4)));
constexpr int MS = 72, SLOT = 64 * MS * 2;
struct Args { const bf16_t* P0; const float* lrw; const bf16_t* lra; const bf16_t* lrg; const float* mu; const float* k_k; const float* k_a; const float* r_k; const float* ln_g; const float* ln_b;
              bf16_t* Gm; bf16_t* P1m; bf16_t* Hm; bf16_t* P2m; float* bonus; bf16_t* ycat; };
#define RWC_LDS(T, off) (*(__attribute__((address_space(3))) T*)(smem + (off)))
__device__ __forceinline__ bf16x8_t ldf(const lds_u8* smem, int slot, int row, int kcol) { return RWC_LDS(bf16x8_t, slot * SLOT + (row * MS + kcol) * 2); }
__device__ __forceinline__ bf16x8_t trf(const lds_u8* smem, int slot, int krow, int col) {
    const lds_u8* p = smem + slot * SLOT + (krow * MS + col) * 2;
    const v4i16_t lo = __builtin_amdgcn_ds_read_tr16_b64_v4i16((__attribute__((address_space(3))) v4i16_t*)p);
    const v4i16_t hi = __builtin_amdgcn_ds_read_tr16_b64_v4i16((__attribute__((address_space(3))) v4i16_t*)(p + 4 * MS * 2));
    return (bf16x8_t){lo[0], lo[1], lo[2], lo[3], hi[0], hi[1], hi[2], hi[3]};
}
__device__ __forceinline__ float ldb(const lds_u8* smem, int slot, int row, int col) { return bf2f(RWC_LDS(bf16_t, slot * SLOT + (row * MS + col) * 2)); }
__device__ __forceinline__ void stb(lds_u8* smem, int slot, int row, int col, float v) { RWC_LDS(bf16_t, slot * SLOT + (row * MS + col) * 2) = (bf16_t)f2bf(v); }
#define RWC_IDX() int tid = tid0; asm volatile("" : "+v"(tid)); const int lane = tid & 63, w = __builtin_amdgcn_readfirstlane(tid >> 6), fr = lane & 15, fq = lane >> 4; \
    const int et = tid >> 3, ec = (tid & 7) * 8; (void)lane; (void)fr; (void)fq; (void)et; (void)ec; (void)w
#define RWC_MFMA(a, b, c) __builtin_amdgcn_mfma_f32_16x16x32_bf16((a), (b), (c), 0, 0, 0)

constexpr int A_FOFF = 14 * SLOT;
constexpr int A_LDS_BYTES = A_FOFF + (8 * 64 + 64) * 4;
__device__ __forceinline__ void prep_unit(const Args& A, int unit, unsigned char* smem_g) {
    lds_u8* smem = (lds_u8*)smem_g;
    __attribute__((address_space(3))) float* Lg = (__attribute__((address_space(3))) float*)(smem + 12 * SLOT);
    __attribute__((address_space(3))) float* FA = (__attribute__((address_space(3))) float*)(smem + A_FOFF);
    const int tid0 = opaque_tid();
    const int bh = unit >> 5, c = unit & 31, b = bh >> 3, h = bh & 7;
    float r_l[8], kp[8], v_l[8], al[8], be[8];
    {
        RWC_IDX(); const int hc = h * 64 + ec; const int sg = c * 64 + et; const size_t row = (size_t)b * SEQ + sg;
        const bf16_t* pc = A.P0 + row * L0_MAIN + hc;
        float frc[8], fkc[8], fvc[8], frp[8], fkp[8], fvp[8], fa[8];
        unpack8(*(const uint4*)pc, frc); unpack8(*(const uint4*)(pc + 512), fkc); unpack8(*(const uint4*)(pc + 1024), fvc);
        if (sg > 0) { unpack8(*(const uint4*)(pc - L0_MAIN), frp); unpack8(*(const uint4*)(pc - L0_MAIN + 512), fkp); unpack8(*(const uint4*)(pc - L0_MAIN + 1024), fvp); }
        else {
#pragma unroll
            for (int j = 0; j < 8; ++j) { frp[j] = 0.f; fkp[j] = 0.f; fvp[j] = 0.f; } }
        const float4 z0 = *(const float4*)(A.lrw + row * 512 + hc), z1 = *(const float4*)(A.lrw + row * 512 + hc + 4); const float zw[8] = {z0.x, z0.y, z0.z, z0.w, z1.x, z1.y, z1.z, z1.w};
        unpack8(*(const uint4*)(A.lra + row * 512 + hc), fa);
        float kkr[8], ss = 0.f, bp = 0.f;
#pragma unroll
        for (int j = 0; j < 8; ++j) { r_l[j] = frc[j] + (frp[j] - frc[j]) * A.mu[hc + j]; const float k_l = fkc[j] + (fkp[j] - fkc[j]) * A.mu[512 + hc + j]; v_l[j] = fvc[j] + (fvp[j] - fvc[j]) * A.mu[1024 + hc + j];
            const float a_ = sigmoid_f(fa[j]); kkr[j] = k_l * A.k_k[hc + j]; ss += kkr[j] * kkr[j]; kp[j] = k_l * (1.0f + (a_ - 1.0f) * A.k_a[hc + j]); be[j] = a_;
            bp += r_l[j] * kp[j] * A.r_k[hc + j];
            Lg[et * 64 + ec + j] = -0.6065306597126334f * sigmoid_f(zw[j]); }
        ss = red8_sum(ss); bp = red8_sum(bp);
        const float inv = 1.0f / fmaxf(sqrtf(ss), 1e-12f);
#pragma unroll
        for (int j = 0; j < 8; ++j) { const float kk = kkr[j] * inv; al[j] = -kk; be[j] = kk * be[j]; }
        if ((tid & 7) == 0) A.bonus[(size_t)unit * 64 + et] = bp;
    }
    __syncthreads();
    {
        RWC_IDX(); const int ch = tid & 63, part = tid >> 6; float x[8]; float run = 0.f;
#pragma unroll
        for (int i = 0; i < 8; ++i) { run += Lg[(8 * part + i) * 64 + ch]; x[i] = run; }
        FA[part * 64 + ch] = run;
        __syncthreads();
        float off = 0.f;
#pragma unroll
        for (int p = 0; p < 7; ++p) off += (p < part) ? FA[p * 64 + ch] : 0.f;
#pragma unroll
        for (int i = 0; i < 8; ++i) Lg[(8 * part + i) * 64 + ch] = x[i] + off;
    }
    __syncthreads();
    {
        RWC_IDX(); float o0[8], o1[8], o2[8], o3[8], o4[8], o5[8];
#pragma unroll
        for (int j = 0; j < 8; ++j) { const float lt = Lg[et * 64 + ec + j], lm = (et > 0) ? Lg[(et - 1) * 64 + ec + j] : 0.f, lL = Lg[63 * 64 + ec + j];
            const float em1 = __expf(lm), en = __expf(-lt), e_t = __expf(lt), eh = __expf(lL - lt);
            o0[j] = al[j] * em1; o1[j] = be[j] * en; o2[j] = kp[j] * en; o3[j] = r_l[j] * e_t; o4[j] = be[j] * eh; o5[j] = kp[j] * eh;
            if (et == 63) FA[512 + ec + j] = __expf(lL); }
        const int off = (et * MS + ec) * 2;
        RWC_LDS(u32x4_t, 0 * SLOT + off) = (u32x4_t){pk2(o0[0], o0[1]), pk2(o0[2], o0[3]), pk2(o0[4], o0[5]), pk2(o0[6], o0[7])};
        RWC_LDS(u32x4_t, 1 * SLOT + off) = (u32x4_t){pk2(o1[0], o1[1]), pk2(o1[2], o1[3]), pk2(o1[4], o1[5]), pk2(o1[6], o1[7])};
        RWC_LDS(u32x4_t, 2 * SLOT + off) = (u32x4_t){pk2(o2[0], o2[1]), pk2(o2[2], o2[3]), pk2(o2[4], o2[5]), pk2(o2[6], o2[7])};
        RWC_LDS(u32x4_t, 3 * SLOT + off) = (u32x4_t){pk2(o3[0], o3[1]), pk2(o3[2], o3[3]), pk2(o3[4], o3[5]), pk2(o3[6], o3[7])};
        RWC_LDS(u32x4_t, 4 * SLOT + off) = (u32x4_t){pk2(o4[0], o4[1]), pk2(o4[2], o4[3]), pk2(o4[4], o4[5]), pk2(o4[6], o4[7])};
        RWC_LDS(u32x4_t, 5 * SLOT + off) = (u32x4_t){pk2(o5[0], o5[1]), pk2(o5[2], o5[3]), pk2(o5[4], o5[5]), pk2(o5[6], o5[7])};
        RWC_LDS(u32x4_t, 6 * SLOT + off) = (u32x4_t){pk2(v_l[0], v_l[1]), pk2(v_l[2], v_l[3]), pk2(v_l[4], v_l[5]), pk2(v_l[6], v_l[7])};
    }
    __syncthreads();
    {
        RWC_IDX(); const int m = w >> 1, mt0 = 2 * (w & 1); const int X = (m < 2) ? 0 : 3, Y = (m & 1) ? 2 : 1;
        f32x4_t acc[2][4];
#pragma unroll
        for (int i = 0; i < 2; ++i)
#pragma unroll
            for (int n = 0; n < 4; ++n) acc[i][n] = (f32x4_t){0.f, 0.f, 0.f, 0.f};
#pragma unroll
        for (int ks = 0; ks < 2; ++ks) { const bf16x8_t a0 = ldf(smem, X, 16 * mt0 + fr, 32 * ks + 8 * fq), a1 = ldf(smem, X, 16 * (mt0 + 1) + fr, 32 * ks + 8 * fq);
#pragma unroll
            for (int n = 0; n < 4; ++n) { const bf16x8_t bb = ldf(smem, Y, 16 * n + fr, 32 * ks + 8 * fq); acc[0][n] = RWC_MFMA(a0, bb, acc[0][n]); acc[1][n] = RWC_MFMA(a1, bb, acc[1][n]); } }
        const bool incl = (m >= 2); const int dst = (m == 0) ? 10 : 6 + m;
#pragma unroll
        for (int i = 0; i < 2; ++i)
#pragma unroll
            for (int n = 0; n < 4; ++n)
#pragma unroll
                for (int r = 0; r < 4; ++r) { const int tt = 16 * (mt0 + i) + 4 * fq + r, s = 16 * n + fr; const float val = (s < tt || (incl && s == tt)) ? acc[i][n][r] : 0.f;
                    stb(smem, dst, tt, s, val); if (m == 0) stb(smem, 12, tt, s, val + ((s == tt) ? 1.0f : 0.f)); }
    }
    __syncthreads();
    int Qc = 10, Qn = 11, Tc = 12, Tn = 13;
#pragma unroll 1
    for (int round = 0; round < 6; ++round) {
        { RWC_IDX(); const int mt = w & 3;
            if (w >= 4) { if (round < 5) { f32x4_t acc[4];
#pragma unroll
                    for (int n = 0; n < 4; ++n) acc[n] = (f32x4_t){0.f, 0.f, 0.f, 0.f};
#pragma unroll
                    for (int ks = 0; ks < 2; ++ks) { const bf16x8_t a = ldf(smem, Qc, 16 * mt + fr, 32 * ks + 8 * fq);
#pragma unroll
                        for (int n = 0; n < 4; ++n) { const bf16x8_t bb = trf(smem, Qc, 32 * ks + 8 * fq + (fr >> 2), 16 * n + 4 * (fr & 3)); acc[n] = RWC_MFMA(a, bb, acc[n]); } }
#pragma unroll
                    for (int n = 0; n < 4; ++n)
#pragma unroll
                        for (int r = 0; r < 4; ++r) stb(smem, Qn, 16 * mt + 4 * fq + r, 16 * n + fr, acc[n][r]); } }
            else { if (round >= 1) { f32x4_t acc[4];
#pragma unroll
                    for (int n = 0; n < 4; ++n)
#pragma unroll
                        for (int r = 0; r < 4; ++r) acc[n][r] = ldb(smem, Tc, 16 * mt + 4 * fq + r, 16 * n + fr);
#pragma unroll
                    for (int ks = 0; ks < 2; ++ks) { const bf16x8_t a = ldf(smem, Tc, 16 * mt + fr, 32 * ks + 8 * fq);
#pragma unroll
                        for (int n = 0; n < 4; ++n) { const bf16x8_t bb = trf(smem, Qc, 32 * ks + 8 * fq + (fr >> 2), 16 * n + 4 * (fr & 3)); acc[n] = RWC_MFMA(a, bb, acc[n]); } }
#pragma unroll
                    for (int n = 0; n < 4; ++n)
#pragma unroll
                        for (int r = 0; r < 4; ++r) stb(smem, Tn, 16 * mt + 4 * fq + r, 16 * n + fr, acc[n][r]); } }
        }
        __syncthreads();
        if (round < 5) { const int t_ = Qc; Qc = Qn; Qn = t_; }
        if (round >= 1) { const int t_ = Tc; Tc = Tn; Tn = t_; }
    }
    {
        RWC_IDX(); const int mt = w & 3; const int X = (w < 4) ? Tc : 7, Y = (w < 4) ? 0 : 6; f32x4_t acc[4];
#pragma unroll
        for (int n = 0; n < 4; ++n) acc[n] = (f32x4_t){0.f, 0.f, 0.f, 0.f};
#pragma unroll
        for (int ks = 0; ks < 2; ++ks) { const bf16x8_t a = ldf(smem, X, 16 * mt + fr, 32 * ks + 8 * fq);
#pragma unroll
            for (int n = 0; n < 4; ++n) { const bf16x8_t bb = trf(smem, Y, 32 * ks + 8 * fq + (fr >> 2), 16 * n + 4 * (fr & 3)); acc[n] = RWC_MFMA(a, bb, acc[n]); } }
#pragma unroll
        for (int n = 0; n < 4; ++n)
#pragma unroll
            for (int r = 0; r < 4; ++r) stb(smem, (w < 4) ? 1 : 2, 16 * mt + 4 * fq + r, 16 * n + fr, acc[n][r]);
    }
    __syncthreads();
    {
        RWC_IDX(); const int mt = w >> 1, n0 = 2 * (w & 1); f32x4_t acc[2];
#pragma unroll
        for (int i = 0; i < 2; ++i) acc[i] = (f32x4_t){0.f, 0.f, 0.f, 0.f};
#pragma unroll
        for (int ks = 0; ks < 2; ++ks) { const bf16x8_t a = ldf(smem, Tc, 16 * mt + fr, 32 * ks + 8 * fq);
#pragma unroll
            for (int i = 0; i < 2; ++i) { const bf16x8_t bb = trf(smem, 2, 32 * ks + 8 * fq + (fr >> 2), 16 * (n0 + i) + 4 * (fr & 3)); acc[i] = RWC_MFMA(a, bb, acc[i]); } }
#pragma unroll
        for (int i = 0; i < 2; ++i)
#pragma unroll
            for (int r = 0; r < 4; ++r) stb(smem, 10, 16 * mt + 4 * fq + r, 16 * (n0 + i) + fr, acc[i][r]);
    }
    __syncthreads();
    {
        RWC_IDX(); const int mt = w & 3; f32x4_t a1[4], a2[4];
        if (w < 4) {
#pragma unroll
            for (int n = 0; n < 4; ++n)
#pragma unroll
                for (int r = 0; r < 4; ++r) { a1[n][r] = ldb(smem, 3, 16 * mt + 4 * fq + r, 16 * n + fr); a2[n][r] = 0.f; }
#pragma unroll
            for (int ks = 0; ks < 2; ++ks) { const bf16x8_t xb = ldf(smem, 8, 16 * mt + fr, 32 * ks + 8 * fq), xk = ldf(smem, 9, 16 * mt + fr, 32 * ks + 8 * fq);
#pragma unroll
                for (int n = 0; n < 4; ++n) { const int kr = 32 * ks + 8 * fq + (fr >> 2), cc = 16 * n + 4 * (fr & 3);
                    a1[n] = RWC_MFMA(xb, trf(smem, 1, kr, cc), a1[n]); a2[n] = RWC_MFMA(xb, trf(smem, 10, kr, cc), a2[n]); a2[n] = RWC_MFMA(xk, trf(smem, 6, kr, cc), a2[n]); } }
        } else {
#pragma unroll
            for (int n = 0; n < 4; ++n)
#pragma unroll
                for (int r = 0; r < 4; ++r) { const int k = 16 * mt + 4 * fq + r; a1[n][r] = (k == 16 * n + fr) ? FA[512 + k] : 0.f; a2[n][r] = 0.f; }
#pragma unroll
            for (int ks = 0; ks < 2; ++ks) { const int kr = 32 * ks + 8 * fq + (fr >> 2); const bf16x8_t xb = trf(smem, 4, kr, 16 * mt + 4 * (fr & 3)), xk = trf(smem, 5, kr, 16 * mt + 4 * (fr & 3));
#pragma unroll
                for (int n = 0; n < 4; ++n) { const int cc = 16 * n + 4 * (fr & 3);
                    a1[n] = RWC_MFMA(xb, trf(smem, 1, kr, cc), a1[n]); a2[n] = RWC_MFMA(xb, trf(smem, 10, kr, cc), a2[n]); a2[n] = RWC_MFMA(xk, trf(smem, 6, kr, cc), a2[n]); } }
        }
        __syncthreads();
#pragma unroll
        for (int n = 0; n < 4; ++n)
#pragma unroll
            for (int r = 0; r < 4; ++r) { stb(smem, (w < 4) ? 3 : 7, 16 * mt + 4 * fq + r, 16 * n + fr, a1[n][r]); stb(smem, (w < 4) ? 0 : 11, 16 * mt + 4 * fq + r, 16 * n + fr, a2[n][r]); }
    }
    __syncthreads();
    {
        RWC_IDX(); const size_t go = ((size_t)unit * 64 + et) * 64 + ec; const int off = (et * MS + ec) * 2;
        { const u32x4_t v = RWC_LDS(u32x4_t, 3 * SLOT + off); *(uint4*)(A.P1m + go) = make_uint4(v[0], v[1], v[2], v[3]); }
        { const u32x4_t v = RWC_LDS(u32x4_t, 0 * SLOT + off); *(uint4*)(A.P2m + go) = make_uint4(v[0], v[1], v[2], v[3]); }
        { const u32x4_t v = RWC_LDS(u32x4_t, 7 * SLOT + off); *(uint4*)(A.Gm + go) = make_uint4(v[0], v[1], v[2], v[3]); }
        { const u32x4_t v = RWC_LDS(u32x4_t, 11 * SLOT + off); *(uint4*)(A.Hm + go) = make_uint4(v[0], v[1], v[2], v[3]); }
    }
    __syncthreads();
}

constexpr int B_FOFF = 8 * SLOT;
constexpr int B_LDS_BYTES = B_FOFF + (256 + 64) * 4;
#define RWC_PREFETCH(cc) do { const size_t go_ = ((size_t)(bh * 32 + (cc)) * 64 + et) * 64 + ec; pg = *(const uint4*)(A.Gm + go_); p1 = *(const uint4*)(A.P1m + go_); ph = *(const uint4*)(A.Hm + go_); p2 = *(const uint4*)(A.P2m + go_); \
        const int sg_ = (cc) * 64 + et; const size_t row_ = (size_t)b * SEQ + sg_; pgg = *(const uint4*)(A.lrg + row_ * 512 + h * 64 + ec); \
        const bf16_t* pv_ = A.P0 + row_ * L0_MAIN + 1024 + h * 64 + ec; pvc = *(const uint4*)pv_; if (sg_ > 0) pvp = *(const uint4*)(pv_ - L0_MAIN); else pvp = make_uint4(0u, 0u, 0u, 0u); \
        if (tid < 64) pbn = A.bonus[(size_t)(bh * 32 + (cc)) * 64 + tid]; } while (0)
__device__ __forceinline__ void scan_unit(const Args& A, int bh, unsigned char* smem_g) {
    lds_u8* smem = (lds_u8*)smem_g;
    __attribute__((address_space(3))) float* FB = (__attribute__((address_space(3))) float*)(smem + B_FOFF);
    const int tid0 = opaque_tid(); const int b = bh >> 3, h = bh & 7;
    f32x4_t Z[2]; Z[0] = (f32x4_t){0.f, 0.f, 0.f, 0.f}; Z[1] = Z[0];
    uint4 pg, p1, ph, p2, pgg, pvc, pvp; float pbn = 0.f;
    { RWC_IDX(); RWC_PREFETCH(0); }
#pragma unroll 1
    for (int c_ = 0; c_ < SEQ / 64; ++c_) {
        int c = c_; asm volatile("" : "+s"(c));
        RWC_IDX(); const int mt = w >> 1, n0 = 2 * (w & 1);
        {
            const int off = (et * MS + ec) * 2;
            RWC_LDS(u32x4_t, 2 * SLOT + off) = (u32x4_t){pg.x, pg.y, pg.z, pg.w}; RWC_LDS(u32x4_t, 3 * SLOT + off) = (u32x4_t){p1.x, p1.y, p1.z, p1.w};
            RWC_LDS(u32x4_t, 4 * SLOT + off) = (u32x4_t){ph.x, ph.y, ph.z, ph.w}; RWC_LDS(u32x4_t, 5 * SLOT + off) = (u32x4_t){p2.x, p2.y, p2.z, p2.w};
            RWC_LDS(u32x4_t, 6 * SLOT + off) = (u32x4_t){pgg.x, pgg.y, pgg.z, pgg.w};
            float fc[8], fp[8], vl[8]; unpack8(pvc, fc); unpack8(pvp, fp);
#pragma unroll
            for (int j = 0; j < 8; ++j) vl[j] = fc[j] + (fp[j] - fc[j]) * A.mu[1024 + h * 64 + ec + j];
            RWC_LDS(u32x4_t, 7 * SLOT + off) = (u32x4_t){pk2(vl[0], vl[1]), pk2(vl[2], vl[3]), pk2(vl[4], vl[5]), pk2(vl[6], vl[7])};
            if (tid < 64) FB[256 + tid] = pbn;
#pragma unroll
            for (int i = 0; i < 2; ++i)
#pragma unroll
                for (int r = 0; r < 4; ++r) stb(smem, 0, 16 * mt + 4 * fq + r, 16 * (n0 + i) + fr, Z[i][r]);
        }
        LDS_BARRIER();
        if (c + 1 < SEQ / 64) RWC_PREFETCH(c + 1);
        f32x4_t ya[2], zn[2];
#pragma unroll
        for (int i = 0; i < 2; ++i)
#pragma unroll
            for (int r = 0; r < 4; ++r) { ya[i][r] = ldb(smem, 5, 16 * mt + 4 * fq + r, 16 * (n0 + i) + fr); zn[i][r] = ldb(smem, 4, 16 * mt + 4 * fq + r, 16 * (n0 + i) + fr); }
#pragma unroll
        for (int ks = 0; ks < 2; ++ks) { const bf16x8_t ap = ldf(smem, 3, 16 * mt + fr, 32 * ks + 8 * fq), ag = ldf(smem, 2, 16 * mt + fr, 32 * ks + 8 * fq);
#pragma unroll
            for (int i = 0; i < 2; ++i) { const bf16x8_t bz = trf(smem, 0, 32 * ks + 8 * fq + (fr >> 2), 16 * (n0 + i) + 4 * (fr & 3)); ya[i] = RWC_MFMA(ap, bz, ya[i]); zn[i] = RWC_MFMA(ag, bz, zn[i]); } }
        Z[0] = zn[0]; Z[1] = zn[1];
#pragma unroll
        for (int r = 0; r < 4; ++r) { float s1 = ya[0][r] + ya[1][r], s2 = ya[0][r] * ya[0][r] + ya[1][r] * ya[1][r]; s1 = red16_sum(s1); s2 = red16_sum(s2);
            if (fr == 0) { FB[((w & 1) * 64 + 16 * mt + 4 * fq + r) * 2] = s1; FB[((w & 1) * 64 + 16 * mt + 4 * fq + r) * 2 + 1] = s2; } }
        LDS_BARRIER();
#pragma unroll
        for (int r = 0; r < 4; ++r) { const int t = 16 * mt + 4 * fq + r; const float s1 = FB[t * 2] + FB[(64 + t) * 2], s2 = FB[t * 2 + 1] + FB[(64 + t) * 2 + 1];
            const float mean = s1 * (1.f / 64.f); const float rstd = rsqrtf(fmaxf(s2 * (1.f / 64.f) - mean * mean, 0.f) + 64.0f * 1e-5f); const float bn = FB[256 + t];
#pragma unroll
            for (int i = 0; i < 2; ++i) { const int v = 16 * (n0 + i) + fr; const float o = ((ya[i][r] - mean) * rstd * A.ln_g[h * 64 + v] + A.ln_b[h * 64 + v] + bn * ldb(smem, 7, t, v)) * ldb(smem, 6, t, v);
                stb(smem, 1, t, v, o); } }
        LDS_BARRIER();
        { const u32x4_t v = RWC_LDS(u32x4_t, 1 * SLOT + (et * MS + ec) * 2); *(uint4*)(A.ycat + ((size_t)b * SEQ + c * 64 + et) * 1024 + h * 64 + ec) = make_uint4(v[0], v[1], v[2], v[3]); }
    }
}
#undef RWC_PREFETCH
#undef RWC_IDX
#undef RWC_MFMA
#undef RWC_LDS
}

namespace pg2 {
typedef __attribute__((address_space(3))) unsigned char lds_u8;
constexpr int NT = 4, NE = NT * 128;
constexpr int WAVE_LDS = NE * 4 * 3 + 64 * 4 + 64 * 4 + NT * 1024 + 64;
constexpr int LDS_BYTES = 8 * WAVE_LDS;
__device__ __forceinline__ float gelu_erf(float v) {
    const float av = fabsf(v), t = __builtin_amdgcn_rcpf(av * 0.2316418882f + 1.0f);
    float q = t * 0.5307027145f + (-0.7265760135f); q = q * t + 0.7107068705f; q = q * t + (-0.142248368f); q = q * t + 0.127414796f; q = q * t;
    const float e = __builtin_amdgcn_exp2f((v * v) * (-0.72134752044f)); const float m = v * (q * e); return v < 0.f ? m : v - m;
}

template <int EMASK, int SKIP> __device__ __forceinline__ void gather_tile(const PeerGArgs& A, int tile, int lane, lds_u8* wl) {
    __attribute__((address_space(3))) unsigned* keys = (__attribute__((address_space(3))) unsigned*)wl;
    __attribute__((address_space(3))) float* vals = (__attribute__((address_space(3))) float*)(wl + NE * 4);
    __attribute__((address_space(3))) float* uscp; __attribute__((address_space(3))) unsigned* usc_dummy_ = (__attribute__((address_space(3))) unsigned*)(wl + NE * 8);
    __attribute__((address_space(3))) unsigned* cnt = (__attribute__((address_space(3))) unsigned*)(wl + NE * 12);
    __attribute__((address_space(3))) unsigned* base = (__attribute__((address_space(3))) unsigned*)(wl + NE * 12 + 256);
    uscp = (__attribute__((address_space(3))) float*)(wl + NE * 8); (void)usc_dummy_;
    const int t0 = tile * NT;
    {
        cnt[lane] = 0u;
        asm volatile("s_waitcnt lgkmcnt(0)" ::: "memory"); __builtin_amdgcn_wave_barrier();
        int e[2 * NT]; float g[2 * NT]; unsigned slot[2 * NT];
#pragma unroll
        for (int j = 0; j < 2 * NT; ++j) { e[j] = A.eid[(size_t)(t0 + (j >> 1)) * 128 + (j & 1) * 64 + lane] & EMASK; g[j] = A.gate[(size_t)(t0 + (j >> 1)) * 128 + (j & 1) * 64 + lane]; }
#pragma unroll
        for (int j = 0; j < 2 * NT; ++j) slot[j] = __hip_atomic_fetch_add((__attribute__((address_space(3))) unsigned*)&cnt[e[j] >> 8], 1u, __ATOMIC_RELAXED, __HIP_MEMORY_SCOPE_WAVEFRONT);
        asm volatile("s_waitcnt lgkmcnt(0)" ::: "memory"); __builtin_amdgcn_wave_barrier();
        const unsigned c = cnt[lane]; const unsigned incl = (unsigned)__float2int_rn(wave_scan_sum((float)c));
        base[lane] = incl - c;
        asm volatile("s_waitcnt lgkmcnt(0)" ::: "memory"); __builtin_amdgcn_wave_barrier();
#pragma unroll
        for (int j = 0; j < 2 * NT; ++j) { const unsigned pos = base[e[j] >> 8] + slot[j]; keys[pos] = (unsigned)e[j] | ((unsigned)(j >> 1) << 14); vals[pos] = g[j] * A.Vs[e[j]]; uscp[pos] = A.Us[e[j]]; }
        asm volatile("s_waitcnt lgkmcnt(0)" ::: "memory"); __builtin_amdgcn_wave_barrier();
    }
    if (!(SKIP & 1)) {
        typedef unsigned u32x4_t __attribute__((ext_vector_type(4)));
        lds_u8* xl = wl + NE * 12 + 512;
        __attribute__((address_space(3))) float* xsl = (__attribute__((address_space(3))) float*)(xl + NT * 1024);
#pragma unroll
        for (int s = 0; s < NT; ++s) { int lane_x = lane; asm volatile("" : "+v"(lane_x)); const float* xr = A.X + (size_t)(t0 + s) * 1024 + 16 * lane_x; float xv[16]; float mx = 0.f;
#pragma unroll
            for (int c4 = 0; c4 < 4; ++c4) { const float4 v = *(const float4*)(xr + 4 * c4); xv[4 * c4] = v.x; xv[4 * c4 + 1] = v.y; xv[4 * c4 + 2] = v.z; xv[4 * c4 + 3] = v.w; mx = fmaxf(fmaxf(mx, fmaxf(fabsf(v.x), fabsf(v.y))), fmaxf(fabsf(v.z), fabsf(v.w))); }
            mx = wave_max(mx); const float sc = (mx > 0.f) ? 127.0f / mx : 1.0f; unsigned w4[4];
#pragma unroll
            for (int c4 = 0; c4 < 4; ++c4) { const int q0 = __float2int_rn(xv[4 * c4] * sc), q1 = __float2int_rn(xv[4 * c4 + 1] * sc), q2 = __float2int_rn(xv[4 * c4 + 2] * sc), q3 = __float2int_rn(xv[4 * c4 + 3] * sc);
                w4[c4] = (unsigned)(q0 & 0xFF) | ((unsigned)(q1 & 0xFF) << 8) | ((unsigned)(q2 & 0xFF) << 16) | ((unsigned)(q3 & 0xFF) << 24); }
            *(__attribute__((address_space(3))) u32x4_t*)(xl + s * 1024 + lane_x * 16) = (u32x4_t){w4[0], w4[1], w4[2], w4[3]};
            if (lane_x == 0) xsl[s] = (mx > 0.f) ? mx * (1.0f / 127.0f) : 1.0f; }
        asm volatile("s_waitcnt lgkmcnt(0)" ::: "memory"); __builtin_amdgcn_wave_barrier();
#define PG2_LOADU(buf, i0_) do { _Pragma("unroll") for (int i = 0; i < 8; ++i) { ek##buf[i] = __builtin_amdgcn_readfirstlane((int)keys[(i0_) + i]); u##buf[i] = *(const uint4*)(A.U + (size_t)(ek##buf[i] & 0x3FFF) * 1024 + 16 * lane); } } while (0)
#define PG2_PROCU(buf, i0_) do { float dv = 0.f; \
            _Pragma("unroll") for (int i = 0; i < 8; ++i) { const int ts = ek##buf[i] >> 14; \
                const u32x4_t xa = *(const __attribute__((address_space(3))) u32x4_t*)(xl + ts * 1024 + lane * 16); \
                int d = __builtin_amdgcn_sdot4((int)xa[0], (int)u##buf[i].x, 0, false); d = __builtin_amdgcn_sdot4((int)xa[1], (int)u##buf[i].y, d, false); d = __builtin_amdgcn_sdot4((int)xa[2], (int)u##buf[i].z, d, false); d = __builtin_amdgcn_sdot4((int)xa[3], (int)u##buf[i].w, d, false); \
                const float tot = wave_sum((float)d); dv = (lane == i) ? tot : dv; __builtin_amdgcn_sched_barrier(0); } \
            if (lane < 8) { const float act = dv * uscp[(i0_) + lane] * xsl[keys[(i0_) + lane] >> 14]; vals[(i0_) + lane] = vals[(i0_) + lane] * gelu_erf(act); } } while (0)
        uint4 u0[8], u1[8]; int ek0[8], ek1[8];
        PG2_LOADU(0, 0);
#pragma unroll 1
        for (int i0 = 0; i0 < NE; i0 += 16) {
            PG2_LOADU(1, i0 + 8);
            PG2_PROCU(0, i0);
            if (i0 + 16 < NE) PG2_LOADU(0, i0 + 16);
            PG2_PROCU(1, i0 + 8);
        }
#undef PG2_LOADU
#undef PG2_PROCU
        asm volatile("s_waitcnt lgkmcnt(0)" ::: "memory"); __builtin_amdgcn_wave_barrier();
    }
    float acc[NT][16];
#pragma unroll
    for (int s = 0; s < NT; ++s)
#pragma unroll
        for (int j = 0; j < 16; ++j) acc[s][j] = 0.f;
#define PG2_LOADV(buf, i0_) do { _Pragma("unroll") for (int i = 0; i < 8; ++i) { ek##buf[i] = __builtin_amdgcn_readfirstlane((int)keys[(i0_) + i]); cv##buf[i] = vals[(i0_) + i]; v##buf[i] = *(const uint4*)(A.V + (size_t)(ek##buf[i] & 0x3FFF) * 1024 + 16 * lane); } } while (0)
#define PG2_PROCV(buf) do { if (SKIP & 2) break; _Pragma("unroll") for (int i = 0; i < 8; ++i) { float f[16]; unpack_fp8x16(v##buf[i], f); const int ts = ek##buf[i] >> 14; const float c = __builtin_bit_cast(float, __builtin_amdgcn_readfirstlane(__builtin_bit_cast(int, cv##buf[i]))); \
        _Pragma("unroll") for (int S = 0; S < NT; ++S) { if (ts == S) { _Pragma("unroll") for (int j = 0; j < 16; ++j) acc[S][j] += c * f[j]; } } __builtin_amdgcn_sched_barrier(0); } } while (0)
    if (!(SKIP & 2)) {
        uint4 v0[8], v1[8]; int ek0[8], ek1[8]; float cv0[8], cv1[8];
        PG2_LOADV(0, 0);
#pragma unroll 1
        for (int i0 = 0; i0 < NE; i0 += 16) {
            PG2_LOADV(1, i0 + 8);
            PG2_PROCV(0);
            if (i0 + 16 < NE) PG2_LOADV(0, i0 + 16);
            PG2_PROCV(1);
        }
    }
#undef PG2_LOADV
#undef PG2_PROCV
#pragma unroll
    for (int s = 0; s < NT; ++s) { int lane_e = lane; asm volatile("" : "+v"(lane_e)); const size_t ro = (size_t)(t0 + s) * 1024 + 16 * lane_e; float y[16]; float sm = 0.f;
#pragma unroll
        for (int c4 = 0; c4 < 4; ++c4) { const float4 v = *(const float4*)(A.X + ro + 4 * c4); y[4 * c4] = acc[s][4 * c4] + DN_ALPHA * v.x; y[4 * c4 + 1] = acc[s][4 * c4 + 1] + DN_ALPHA * v.y; y[4 * c4 + 2] = acc[s][4 * c4 + 2] + DN_ALPHA * v.z; y[4 * c4 + 3] = acc[s][4 * c4 + 3] + DN_ALPHA * v.w; }
#pragma unroll
        for (int j = 0; j < 16; ++j) sm += y[j];
        const float mean = wave_sum(sm) * (1.f / 1024.f); float q = 0.f;
#pragma unroll
        for (int j = 0; j < 16; ++j) { y[j] -= mean; q += y[j] * y[j]; }
        const float rstd = rsqrtf(wave_sum(q) * (1.f / 1024.f) + LN_EPS);
#pragma unroll
        for (int c4 = 0; c4 < 4; ++c4) { const float4 gg = *(const float4*)(A.lng + 16 * lane_e + 4 * c4), bb = *(const float4*)(A.lnb + 16 * lane_e + 4 * c4);
            y[4 * c4] = y[4 * c4] * rstd * gg.x + bb.x; y[4 * c4 + 1] = y[4 * c4 + 1] * rstd * gg.y + bb.y; y[4 * c4 + 2] = y[4 * c4 + 2] * rstd * gg.z + bb.z; y[4 * c4 + 3] = y[4 * c4 + 3] * rstd * gg.w + bb.w;
            *(float4*)(A.Xo + ro + 4 * c4) = make_float4(y[4 * c4], y[4 * c4 + 1], y[4 * c4 + 2], y[4 * c4 + 3]); }
        *(uint4*)(A.xb + ro) = make_uint4(pk2(y[0], y[1]), pk2(y[2], y[3]), pk2(y[4], y[5]), pk2(y[6], y[7]));
        *(uint4*)(A.xb + ro + 8) = make_uint4(pk2(y[8], y[9]), pk2(y[10], y[11]), pk2(y[12], y[13]), pk2(y[14], y[15])); }
}
template <int EMASK = 0x3FFF, int SKIP = 0> __device__ __forceinline__ void gather_phase(const PeerGArgs& A, int bid, int nblk, unsigned char* smem_g) {
    const int tid = opaque_tid(); const int lane = tid & 63, wv = __builtin_amdgcn_readfirstlane(tid >> 6);
    lds_u8* wl = (lds_u8*)smem_g + wv * WAVE_LDS;
    for (int tile = bid * 8 + wv; tile < T_TOK / NT; tile += nblk * 8) gather_tile<EMASK, SKIP>(A, tile, lane, wl);
}
}

constexpr size_t MiB = 1u << 20;
constexpr size_t WS_CTL = 0, CTL_ZERO_BYTES = 64 * 1024, WS_W0IN = 1 * MiB, WS_WLR = 9 * MiB, WS_W0OUT = 10 * MiB, WS_WQ0 = 12 * MiB, WS_W1IN = 16 * MiB, WS_W1OUT = 24 * MiB, WS_WQ1 = 26 * MiB;
constexpr size_t WS_PK = 30 * MiB;
constexpr size_t WS_GATES = 31 * MiB, WS_CUM = 32 * MiB, WS_APP = 33 * MiB, WS_EID = 41 * MiB, WS_GATE = 49 * MiB, WS_ACTA = 57 * MiB;
constexpr size_t WS_TABU = 89 * MiB, WS_TABV = 121 * MiB, WS_P = 153 * MiB, WS_LRW = 281 * MiB, WS_LRA = 313 * MiB, WS_LRG = 329 * MiB, WS_END = 345 * MiB;
constexpr size_t WS_MIX = WS_P, WS_Q = WS_P + 64 * MiB;
constexpr int CW_BAR = 1024;
static_assert((CW_BAR + XCD_BAR_WORDS) * 4 <= (int)CTL_ZERO_BYTES, "barrier words inside the memset region");
constexpr int LDS_BYTES = 160 * 1024, LDS_MISC_OFF = LDS_BYTES - 256;
static_assert(pg2::LDS_BYTES <= LDS_MISC_OFF && mlm::LDS_BYTES <= LDS_MISC_OFF && rwc::A_LDS_BYTES <= LDS_MISC_OFF && rwc::B_LDS_BYTES <= LDS_MISC_OFF, "mlstm / rwkv LDS");
static_assert(attn_body::LDS_BIAS_OFF + 8192 <= LDS_MISC_OFF && ML_LDS_BYTES <= LDS_MISC_OFF && PS_LDS_BYTES <= LDS_MISC_OFF && pg8::STAGE_BYTES <= LDS_MISC_OFF, "phase scratch below the LDS control words");

#if defined(MLSTM_VALU)
#define MLSTM_UNIT(ma, u, c0, c1, st) mlstm_unit(ma, u, (float*)lds)
#else
#define MLSTM_UNIT(ma, u, c0, c1, st) mlm::mlstm_unit_mfma(ma, u, lds, c0, c1, st)
#endif
#if defined(GATHER_V1)
#define PEER_GATHER(ga) peer_gather_phase(ga, bid, nblk)
#else
#define PEER_GATHER(ga) pg2::gather_phase(ga, bid, nblk, lds)
#endif
#ifndef PROBE_SKIP
#define PROBE_SKIP 0
#endif
#ifndef PROBE_DUP
#define PROBE_DUP 0
#endif
struct MegaArgs { const float* in[43]; float* out; unsigned char* ws; };

__global__ void __launch_bounds__(NTHR, 2) mega_kernel(MegaArgs a) {
    extern __shared__ __attribute__((aligned(16))) unsigned char lds[];
    const int tid = opaque_tid(); const int bid = (int)blockIdx.x, nblk = (int)gridDim.x;
#define WSP(T, off) ((T*)(opq_ptr(a.ws) + (off)))
#define INP(i) ((const float*)opq_ptr((unsigned char*)a.in[i]))
#define OUTP ((float*)opq_ptr((unsigned char*)a.out))
#define W0IN WSP(bf16_t, WS_W0IN)
#define WLR WSP(bf16_t, WS_WLR)
#define W0OUT WSP(bf16_t, WS_W0OUT)
#define WQ0 WSP(bf16_t, WS_WQ0)
#define W1IN WSP(bf16_t, WS_W1IN)
#define W1OUT WSP(bf16_t, WS_W1OUT)
#define WQ1 WSP(bf16_t, WS_WQ1)
#define PK WSP(bf16_t, WS_PK)
#define GATES WSP(float, WS_GATES)
#define CUM WSP(float, WS_CUM)
#define APP WSP(bf16_t, WS_APP)
#define EID WSP(int, WS_EID)
#define GATE WSP(float, WS_GATE)
#define ACTA WSP(bf16_t, WS_ACTA)
#define TABU WSP(unsigned char, WS_TABU)
#define TABV WSP(unsigned char, WS_TABV)
#define TABUS WSP(float, WS_TABU + 16 * MiB)
#define TABVS WSP(float, WS_TABV + 16 * MiB)
#define PBUF WSP(bf16_t, WS_P)
#define MIX WSP(float, WS_MIX)
#define QBUF WSP(bf16_t, WS_Q)
#define LRW WSP(float, WS_LRW)
#define LRA WSP(bf16_t, WS_LRA)
#define LRG WSP(bf16_t, WS_LRG)
    if (tid < 64) ((LAS unsigned*)((LAS unsigned char*)lds + LDS_MISC_OFF))[tid] = 0u;
    __syncthreads();
    XcdBarrier bar = xcd_barrier_post(WSP(unsigned, WS_CTL) + CW_BAR, (volatile LAS unsigned*)((LAS unsigned char*)lds + LDS_MISC_OFF + 32));
#define GRID_BAR() xcd_barrier(bar)
#define GEMM_PHASE(EpiT, Aop, Bop, Mv, Nv, Kv, Eobj) do { pg8::Gemm g_; g_.A = (Aop); g_.Bt = (Bop); g_.M = (Mv); g_.N = (Nv); g_.K = (Kv); pg8::StaticOrder S_; S_.init((Mv), (Nv), nblk, bid); \
        pg8::gemm_phase<EpiT, pg8::StaticOrder, true, true>((PG8_LAS unsigned char*)lds, g_, S_, (Eobj)); } while (0)

#if PROBE_DUP == 9
    for (int rep_ = 0; rep_ < 2; ++rep_)
#endif
    {
        float* tile = (float*)lds;
        transpose_cvt_phase(INP(1), 1024, L0_COLS, 0, L0_MAIN, W0IN, bid, nblk, tile);
        transpose_cvt_phase(INP(19), 1024, 1024, 0, 1024, W0OUT, bid, nblk, tile);
        transpose_cvt_phase(INP(22), 1024, 2048, 0, 2048, WQ0, bid, nblk, tile);
        transpose_cvt_phase(INP(29), 1024, L1_COLS, 0, L1_MAIN, W1IN, bid, nblk, tile);
        transpose_cvt_phase(INP(33), 1024, 1024, 0, 1024, W1OUT, bid, nblk, tile);
        transpose_cvt_phase(INP(36), 1024, 2048, 0, 2048, WQ1, bid, nblk, tile);
        build_wlr_phase(INP(4), INP(6), INP(7), WLR, bid, nblk);
        cvt_bf16_phase(INP(23), PK, 131072 / 8, bid, nblk); cvt_bf16_phase(INP(24), PK + 131072, 131072 / 8, bid, nblk);
        cvt_bf16_phase(INP(37), PK + 262144, 131072 / 8, bid, nblk); cvt_bf16_phase(INP(38), PK + 393216, 131072 / 8, bid, nblk);
        cvt_bf16_phase(INP(0), ACTA, (size_t)T_TOK * 1024 / 8, bid, nblk);
    }
    GRID_BAR();
#if PROBE_DUP == 4
    for (int rep_ = 0; rep_ < 8; ++rep_) { GRID_BAR(); }
#endif
    { pg8::EpiBf16P E; E.O = PBUF; E.ldc = L0_MAIN; GEMM_PHASE(pg8::EpiBf16P, ACTA, W0IN, T_TOK, L0_MAIN, 1024, E); }
    gates_phase<8>(INP(0), INP(1), L0_COLS, L0_MAIN, GATES, bid, nblk, (float*)lds);
    GRID_BAR();
    rwkv_prep_phase(PBUF, INP(2), APP, bid, nblk);
    mlstm_prepass_phase(PBUF, INP(13), INP(14), bid, nblk);
    GRID_BAR();
    { pg8::EpiLowrank E; E.lrw = LRW; E.lra = LRA; E.lrg = LRG; E.w0 = INP(3); E.a0 = INP(5); GEMM_PHASE(pg8::EpiLowrank, APP, WLR, T_TOK, 1536, 256, E); }
    GRID_BAR();
    {
        MlstmArgs ma; ma.P0 = PBUF; ma.gates = GATES; ma.conv_w = INP(13); ma.conv_b = INP(14); ma.ig_b = INP(15); ma.fg_b = INP(16); ma.hn_g = INP(17); ma.hn_b = INP(18); ma.ycat = ACTA;
#if defined(RWKV_SEQ)
        RwkvArgs ra; ra.P0 = PBUF; ra.lrw = LRW; ra.lra = LRA; ra.lrg = LRG; ra.mu = INP(2); ra.k_k = INP(8); ra.k_a = INP(9); ra.r_k = INP(10); ra.ln_g = INP(11); ra.ln_b = INP(12); ra.ycat = ACTA;
        { mlm::MlState mst; for (int u = bid; u < 96; u += nblk) { if (u < 64) rwkv_scan_unit(ra, u, (float*)lds); else MLSTM_UNIT(ma, u - 64, 0, SEQ / 64, mst); } }
#else
        rwc::Args ra; ra.P0 = PBUF; ra.lrw = LRW; ra.lra = LRA; ra.lrg = LRG; ra.mu = INP(2); ra.k_k = INP(8); ra.k_a = INP(9); ra.r_k = INP(10); ra.ln_g = INP(11); ra.ln_b = INP(12);
        ra.Gm = WSP(bf16_t, WS_TABU); ra.P1m = WSP(bf16_t, WS_TABU + 16 * MiB); ra.Hm = WSP(bf16_t, WS_TABV); ra.P2m = WSP(bf16_t, WS_TABV + 16 * MiB); ra.bonus = CUM; ra.ycat = ACTA;
        constexpr int ML_SPLIT = 20;
        mlm::MlState mst;
        if (bid < 32) MLSTM_UNIT(ma, bid, 0, ML_SPLIT, mst);
        else { for (int u = bid - 32; u < 64 * 32; u += nblk - 32) rwc::prep_unit(ra, u, lds); }
        GRID_BAR();
        if (bid < 32) MLSTM_UNIT(ma, bid, ML_SPLIT, SEQ / 64, mst);
        else { for (int u = bid - 32; u < 64; u += nblk - 32) rwc::scan_unit(ra, u, lds); }
#endif
    }
    GRID_BAR();
    cvt_i8_rows_phase(INP(25), TABU, TABUS, bid, nblk); cvt_fp8_rows_phase(INP(26), TABV, TABVS, bid, nblk);
    { pg8::EpiF32 E; E.C = MIX; E.ldc = 1024; GEMM_PHASE(pg8::EpiF32, ACTA, W0OUT, T_TOK, 1024, 1024, E); }
    GRID_BAR();
    ln_phase(INP(0), MIX, INP(20), INP(21), OUTP, ACTA, bid, nblk);
    GRID_BAR();
    { pg8::EpiBf16P E; E.O = QBUF; E.ldc = 2048; GEMM_PHASE(pg8::EpiBf16P, ACTA, WQ0, T_TOK, 2048, 1024, E);
#if PROBE_DUP == 5
      GRID_BAR(); GEMM_PHASE(pg8::EpiBf16P, ACTA, WQ0, T_TOK, 2048, 1024, E); GRID_BAR(); GEMM_PHASE(pg8::EpiBf16P, ACTA, WQ0, T_TOK, 2048, 1024, E);
#endif
    }
    GRID_BAR();
    { PeerSArgs sa; sa.Q = QBUF; sa.K1b = PK; sa.K2b = PK + 131072; sa.eid = EID; sa.gate = GATE; peer_scores_phase(sa, bid, nblk, lds);
#if PROBE_DUP == 3
      GRID_BAR(); peer_scores_phase(sa, bid, nblk, lds);
#endif
    }
    GRID_BAR();
#if PROBE_DUP == 11
    { PeerGArgs ga; ga.X = OUTP; ga.Xo = MIX; ga.eid = EID; ga.gate = GATE; ga.U = TABU; ga.V = TABV; ga.Us = TABUS; ga.Vs = TABVS; ga.lng = INP(27); ga.lnb = INP(28); ga.xb = QBUF; pg2::gather_phase<0x3FF, PROBE_SKIP>(ga, bid, nblk, lds); }
    GRID_BAR();
#endif
#if PROBE_DUP == 2
    { PeerGArgs ga; ga.X = OUTP; ga.Xo = MIX; ga.eid = EID; ga.gate = GATE; ga.U = TABU; ga.V = TABV; ga.Us = TABUS; ga.Vs = TABVS; ga.lng = INP(27); ga.lnb = INP(28); ga.xb = QBUF; PEER_GATHER(ga); }
    GRID_BAR();
#endif
    { PeerGArgs ga; ga.X = OUTP; ga.Xo = OUTP; ga.eid = EID; ga.gate = GATE; ga.U = TABU; ga.V = TABV; ga.Us = TABUS; ga.Vs = TABVS; ga.lng = INP(27); ga.lnb = INP(28); ga.xb = ACTA; PEER_GATHER(ga); }
    GRID_BAR();
    cvt_i8_rows_phase(INP(39), TABU, TABUS, bid, nblk); cvt_fp8_rows_phase(INP(40), TABV, TABVS, bid, nblk);
    { pg8::EpiBf16P E; E.O = PBUF; E.ldc = L1_MAIN; GEMM_PHASE(pg8::EpiBf16P, ACTA, W1IN, T_TOK, L1_MAIN, 1024, E); }
    gates_phase<16>(OUTP, INP(29), L1_COLS, L1_MAIN, GATES, bid, nblk, (float*)lds);
    GRID_BAR();
    fox_cumsum_phase(GATES, INP(32), CUM, bid, nblk);
#if defined(ATTN_VALU)
    GRID_BAR();
    { AttnArgs aa; aa.P1 = PBUF; aa.cum = CUM; aa.qn_g = INP(30); aa.kn_g = INP(31); aa.out = ACTA; attn_valu_phase(aa, bid, nblk, (float*)lds); }
#else
    fox_qknorm_phase(PBUF, INP(30), INP(31), bid, nblk);
    GRID_BAR();
    { const attn_body::AttnTensors AT{(const attn_body::bf16*)PBUF, (const attn_body::bf16*)(PBUF + 1024), (const attn_body::bf16*)(PBUF + 2048), (const attn_body::bf16*)(PBUF + 3072), CUM, (attn_body::bf16*)ACTA};
      const attn_body::StaticOrder S_(nblk, bid); attn_body::attn_phase<attn_body::StaticOrder>((char*)lds, AT, S_);
#if PROBE_DUP == 6
      GRID_BAR(); attn_body::attn_phase<attn_body::StaticOrder>((char*)lds, AT, S_);
#endif
    }
#endif
    GRID_BAR();
    { pg8::EpiF32 E; E.C = MIX; E.ldc = 1024; GEMM_PHASE(pg8::EpiF32, ACTA, W1OUT, T_TOK, 1024, 1024, E); }
    GRID_BAR();
    ln_phase(OUTP, MIX, INP(34), INP(35), OUTP, ACTA, bid, nblk);
    GRID_BAR();
    { pg8::EpiBf16P E; E.O = QBUF; E.ldc = 2048; GEMM_PHASE(pg8::EpiBf16P, ACTA, WQ1, T_TOK, 2048, 1024, E); }
    GRID_BAR();
    { PeerSArgs sa; sa.Q = QBUF; sa.K1b = PK + 262144; sa.K2b = PK + 393216; sa.eid = EID; sa.gate = GATE; peer_scores_phase(sa, bid, nblk, lds); }
    GRID_BAR();
    { PeerGArgs ga; ga.X = OUTP; ga.Xo = OUTP; ga.eid = EID; ga.gate = GATE; ga.U = TABU; ga.V = TABV; ga.Us = TABUS; ga.Vs = TABVS; ga.lng = INP(41); ga.lnb = INP(42); ga.xb = ACTA; PEER_GATHER(ga); }
#undef GRID_BAR
#undef GEMM_PHASE
#undef WSP
#undef INP
#undef OUTP
#undef W0IN
#undef WLR
#undef W0OUT
#undef WQ0
#undef W1IN
#undef W1OUT
#undef WQ1
#undef PK
#undef GATES
#undef CUM
#undef APP
#undef EID
#undef GATE
#undef ACTA
#undef TABU
#undef TABV
#undef TABUS
#undef TABVS
#undef PBUF
#undef MIX
#undef QBUF
#undef LRW
#undef LRA
#undef LRG
}

extern "C" void kernel_launch(void* const* d_in, const int* in_sizes, int n_in, void* d_out, int out_size, void* d_ws, size_t ws_size, hipStream_t stream) {
    static int grid = 0;
    if (grid == 0) {
        if (n_in != 43 || ws_size < WS_END) { fprintf(stderr, "kernel_launch: unexpected n_in %d or ws_size %zu (< %zu); nothing launched\n", n_in, ws_size, (size_t)WS_END); grid = -1; return; }
        int dev = 0, cus = 0;
        if (hipGetDevice(&dev) != hipSuccess || hipDeviceGetAttribute(&cus, hipDeviceAttributeMultiprocessorCount, dev) != hipSuccess) { fprintf(stderr, "kernel_launch: device query failed\n"); grid = -1; return; }
        if (hipFuncSetAttribute((const void*)mega_kernel, hipFuncAttributeMaxDynamicSharedMemorySize, LDS_BYTES) != hipSuccess) { fprintf(stderr, "kernel_launch: hipFuncSetAttribute failed\n"); grid = -1; return; }
        (void)hipGetLastError();
        grid = cus;
    }
    if (grid < 0) return;
    (void)hipMemsetAsync((char*)d_ws + WS_CTL, 0, CTL_ZERO_BYTES, stream);
    MegaArgs a; memset(&a, 0, sizeof(a));
    for (int i = 0; i < 43; ++i) a.in[i] = (const float*)d_in[i];
    a.out = (float*)d_out; a.ws = (unsigned char*)d_ws;
    hipLaunchKernelGGL(mega_kernel, dim3(grid), dim3(NTHR), LDS_BYTES, stream, a);
}
```
